# Optimizing an MI355X kernel written in HIP

```python
import jax
import jax.numpy as jnp
from jax import lax
import numpy as np

D_MODEL = 1024
BATCH = 8
SEQ = 4096
DEPTH = 4

CTX_LEN = 256
GRID_W = 64
EPS = 1e-6
MIX_W = D_MODEL // 2
N_BRANCH = 3
CHUNK = 64

A_HEADS = 4
A_DV = MIX_W // A_HEADS
A_DQK = A_DV // 2
A_CONV = 3

B_DH = 64
B_HEADS = MIX_W // B_DH
B_KV = 2
B_GROUP = B_HEADS // B_KV
Q_BLOCK = 128
ROPE_THETA = 10000.0

C_HEADS = 4
C_DV = MIX_W // C_HEADS
C_DK = C_DV // 2
C_RANK = 16
C_TAU = 16.0

N_EXPERTS = 32
TOP_K = 4
D_FF = D_MODEL
SWIGLU_LIMIT = 7.0
SWIGLU_ALPHA = 1.702

_SPLITS = (
    ("a_qk", 2 * A_HEADS * A_DQK), ("a_v", MIX_W), ("a_i", 2 * A_HEADS), ("a_f", 2 * A_HEADS), ("a_o", MIX_W),
    ("b_q", B_HEADS * B_DH), ("b_k", B_KV * B_DH), ("b_v", B_KV * B_DH),
    ("c_q", C_HEADS * C_DK), ("c_k", C_HEADS * C_DK), ("c_v", MIX_W), ("c_a", 2 * C_RANK), ("c_r", MIX_W),
    ("gate", N_BRANCH * D_MODEL),
)
IN_W = sum(n for _, n in _SPLITS)

kernel_name = "hybrid_flow_mlstm_gqa_gla_moe_trunk"


def split_cols(y):
    offs = np.cumsum([n for _, n in _SPLITS])[:-1]
    return dict(zip([k for k, _ in _SPLITS], jnp.split(y, offs, axis=-1)))


def rms_norm(x, g):
    xf = x.astype(jnp.float32)
    y = xf * lax.rsqrt(jnp.mean(xf * xf, axis=-1, keepdims=True) + EPS)
    return (y * g.astype(jnp.float32)).astype(x.dtype)


def modulate(h, shift, scale):
    return h * (1 + scale) + shift


def heads(y, n):
    return y.reshape(*y.shape[:-1], n, -1).swapaxes(1, 2)


def merge_heads(h):
    h = h.swapaxes(1, 2)
    return h.reshape(*h.shape[:2], -1)


def head_rms(y, g, n):
    shp = y.shape
    return rms_norm(y.reshape(*shp[:-1], n, -1), g.reshape(n, -1)).reshape(shp)


def dir_heads(y, n):
    return y.reshape(*y.shape[:-1], 2, n).transpose(2, 0, 3, 1)


def centred_dwconv(x, w, b):
    y = lax.conv_general_dilated(x, w[:, None, :].astype(x.dtype), window_strides=(1,), padding="SAME",
                                 dimension_numbers=("NWC", "WIO", "NWC"), feature_group_count=x.shape[-1])
    return y + b


def rope_axis(x, cos, sin):
    x1, x2 = jnp.split(x, 2, axis=-1)
    return jnp.concatenate([x1 * cos - x2 * sin, x2 * cos + x1 * sin], axis=-1)


def rope_2d(x, cos, sin):
    n = cos.shape[-1] // 2
    cos, sin = cos.astype(x.dtype), sin.astype(x.dtype)
    xr, xc = jnp.split(x, 2, axis=-1)
    return jnp.concatenate([rope_axis(xr, cos[:, :n], sin[:, :n]), rope_axis(xc, cos[:, n:], sin[:, n:])], axis=-1)


def to_chunks(t):
    b, h, L = t.shape[:3]
    return jnp.moveaxis(t.reshape(b, h, L // CHUNK, CHUNK, *t.shape[3:]), 2, 0)


def from_chunks(t):
    n, b, h, c = t.shape[:4]
    return jnp.moveaxis(t, 0, 2).reshape(b, h, n * c, *t.shape[4:])


def mlstm_scan(q, k, v, ig, lf, state):
    mask = jnp.tril(jnp.ones((CHUNK, CHUNK), bool))

    def step(carry, inp):
        C, n, m = carry
        qc, kc, vc, ic, fc = inp
        b = jnp.cumsum(fc, axis=-1)
        log_d = jnp.where(mask, b[..., :, None] - b[..., None, :] + ic[..., None, :], -jnp.inf)
        log_inter = b + m[..., None]
        m_j = jnp.maximum(log_inter, jnp.max(log_d, axis=-1))
        s = jnp.einsum("bhjd,bhsd->bhjs", qc, kc) * jnp.exp(log_d - m_j[..., None])
        w_inter = jnp.exp(log_inter - m_j)
        num = jnp.einsum("bhjs,bhsv->bhjv", s, vc) + w_inter[..., None] * jnp.einsum("bhjd,bhdv->bhjv", qc, C)
        den = jnp.sum(s, axis=-1) + w_inter * jnp.einsum("bhjd,bhd->bhj", qc, n)
        h = num / jnp.maximum(jnp.abs(den), jnp.exp(-m_j))[..., None]
        m_new = m_j[..., -1]
        w_s = jnp.exp(b[..., -1:] - b + ic - m_new[..., None])
        decay = jnp.exp(b[..., -1] + m - m_new)
        C = decay[..., None, None] * C + jnp.einsum("bhs,bhsd,bhsv->bhdv", w_s, kc, vc)
        n = decay[..., None] * n + jnp.einsum("bhs,bhsd->bhd", w_s, kc)
        return (C, n, m_new), h

    state, h = lax.scan(step, state, tuple(to_chunks(t) for t in (q, k, v, ig, lf)))
    return from_chunks(h), state


def gla_scan(q, k, v, la, S):
    mask = jnp.tril(jnp.ones((CHUNK, CHUNK), bool))[..., None]

    def step(S, inp):
        qc, kc, vc, lc = inp
        b = jnp.cumsum(lc, axis=2)
        rel = jnp.where(mask, b[:, :, :, None, :] - b[:, :, None, :, :], -jnp.inf)
        a = jnp.einsum("bhjd,bhsd,bhjsd->bhjs", qc, kc, jnp.exp(rel))
        o = jnp.einsum("bhjs,bhsv->bhjv", a, vc) + jnp.einsum("bhjd,bhdv->bhjv", qc * jnp.exp(b), S)
        k_dec = kc * jnp.exp(b[:, :, -1:, :] - b)
        S = jnp.exp(b[:, :, -1, :])[..., None] * S + jnp.einsum("bhsd,bhsv->bhdv", k_dec, vc)
        return S, o

    S, o = lax.scan(step, S, tuple(to_chunks(t) for t in (q, k, v, la)))
    return from_chunks(o), S


def bidir_scan(scan_fn, ctx_in, lat_in, state0):
    out_c, out_l = 0, 0
    for d, rev in enumerate((False, True)):
        flip = (lambda t: jnp.flip(t, axis=2)) if rev else (lambda t: t)
        h_c, st = scan_fn(*[flip(t) for t in ctx_in[d]], state0)
        h_l, _ = scan_fn(*[flip(t) for t in lat_in[d]], st)
        out_c = out_c + flip(h_c)
        out_l = out_l + flip(h_l)
    return out_c, out_l


def mlstm_prep(p, conv_w, conv_b, gate_b):
    qk = jax.nn.silu(centred_dwconv(p["a_qk"], conv_w, conv_b))
    q, k = jnp.split(qk, 2, axis=-1)
    q = heads(q, A_HEADS).astype(jnp.float32)
    k = heads(k, A_HEADS).astype(jnp.float32) * (A_DQK ** -0.5)
    v = heads(p["a_v"], A_HEADS).astype(jnp.float32)
    i_pre = dir_heads(p["a_i"].astype(jnp.float32) + gate_b[0], A_HEADS)
    f_log = dir_heads(jax.nn.log_sigmoid(p["a_f"].astype(jnp.float32) + gate_b[1]), A_HEADS)
    return tuple((q, k, v, i_pre[d], f_log[d]) for d in range(2))


def gla_prep(p, w_up, b_up):
    q = heads(p["c_q"], C_HEADS).astype(jnp.float32) * (C_DK ** -0.5)
    k = heads(p["c_k"], C_HEADS).astype(jnp.float32)
    v = heads(p["c_v"], C_HEADS).astype(jnp.float32)
    low = jnp.split(p["c_a"], 2, axis=-1)
    out = []
    for d in range(2):
        la = jax.nn.log_sigmoid((low[d] @ w_up[d] + b_up[d]).astype(jnp.float32)) / C_TAU
        out.append((q, k, v, heads(la, C_HEADS)))
    return tuple(out)


def gqa_prep(p, q_g, k_g):
    q = rms_norm(heads(p["b_q"], B_HEADS), q_g)
    k = rms_norm(heads(p["b_k"], B_KV), k_g)
    v = heads(p["b_v"], B_KV)
    return q, k, v


def block_attend(q, k, v):
    b, h, lq, dh = q.shape
    nb = lq // Q_BLOCK
    qb = jnp.moveaxis(q.reshape(b, B_KV, B_GROUP, nb, Q_BLOCK, dh), 3, 0)

    def one(qi):
        s = jnp.einsum("bkgqd,bkld->bkgql", qi, k).astype(jnp.float32) * (dh ** -0.5)
        pr = jax.nn.softmax(s, axis=-1).astype(v.dtype)
        return jnp.einsum("bkgql,bkld->bkgqd", pr, v)

    o = lax.map(one, qb)
    return merge_heads(jnp.moveaxis(o, 0, 3).reshape(b, h, lq, dh))


def mlstm_out(h, p, g):
    y = merge_heads(h).astype(p["a_o"].dtype)
    return head_rms(y, g, A_HEADS) * jax.nn.sigmoid(p["a_o"])


def gla_out(h, p, g):
    y = merge_heads(h).astype(p["c_r"].dtype)
    return head_rms(y, g, C_HEADS) * jax.nn.silu(p["c_r"])


def merge_branches(ys, gate, w_branch, w_out):
    g = jax.nn.sigmoid(gate.astype(jnp.float32)).astype(gate.dtype)
    g = g.reshape(*gate.shape[:-1], N_BRANCH, D_MODEL)
    merged = sum(g[..., n, :] * (y @ w_branch[n]) for n, y in enumerate(ys))
    return merged @ w_out


def mixer_sublayer(hl, hc, w_in, a_conv_w, a_conv_b, a_gate_b, a_norm_g, b_q_norm_g, b_k_norm_g,
                   c_w_up, c_b_up, c_norm_g, w_branch, w_out, cos, sin, with_ctx):
    pl = split_cols(hl @ w_in)
    pc = split_cols(hc @ w_in)
    bsz = hl.shape[0]
    zeros = lambda *s: jnp.zeros((bsz,) + s, jnp.float32)

    ha_c, ha_l = bidir_scan(mlstm_scan, mlstm_prep(pc, a_conv_w, a_conv_b, a_gate_b),
                            mlstm_prep(pl, a_conv_w, a_conv_b, a_gate_b),
                            (zeros(A_HEADS, A_DQK, A_DV), zeros(A_HEADS, A_DQK), zeros(A_HEADS)))
    q_l, k_l, v_l = gqa_prep(pl, b_q_norm_g, b_k_norm_g)
    q_l, k_l = rope_2d(q_l, cos, sin), rope_2d(k_l, cos, sin)
    q_c, k_c, v_c = gqa_prep(pc, b_q_norm_g, b_k_norm_g)
    att_l = block_attend(q_l, jnp.concatenate([k_c, k_l], axis=2), jnp.concatenate([v_c, v_l], axis=2))
    hg_c, hg_l = bidir_scan(gla_scan, gla_prep(pc, c_w_up, c_b_up), gla_prep(pl, c_w_up, c_b_up),
                            zeros(C_HEADS, C_DK, C_DV))

    yl = merge_branches((mlstm_out(ha_l, pl, a_norm_g), att_l, gla_out(hg_l, pl, c_norm_g)),
                        pl["gate"], w_branch, w_out)
    if not with_ctx:
        return yl, None
    att_c = block_attend(q_c, k_c, v_c)
    yc = merge_branches((mlstm_out(ha_c, pc, a_norm_g), att_c, gla_out(hg_c, pc, c_norm_g)),
                        pc["gate"], w_branch, w_out)
    return yl, yc


def moe(t, w_router, b_router, w1, b1, w2, b2):
    logits = (t @ w_router + b_router).astype(jnp.float32)
    top_v, top_i = lax.top_k(logits, TOP_K)
    w = jax.nn.softmax(top_v, axis=-1)
    dense_w = jnp.sum(jax.nn.one_hot(top_i, N_EXPERTS, dtype=jnp.float32) * w[..., None], axis=1).astype(t.dtype)
    out = jnp.zeros_like(t)
    for e in range(N_EXPERTS):
        gu = t @ w1[e] + b1[e]
        gate = jnp.minimum(gu[:, 0::2], SWIGLU_LIMIT)
        up = jnp.clip(gu[:, 1::2], -SWIGLU_LIMIT, SWIGLU_LIMIT)
        a = (up + 1) * gate * jax.nn.sigmoid(SWIGLU_ALPHA * gate)
        out = out + dense_w[:, e:e + 1] * (a @ w2[e] + b2[e])
    return out


def setup_inputs(seed: int = 0) -> dict:
    key = jax.random.key(seed)
    ks = iter(jax.random.split(key, 32))
    nrm = lambda shape, scale: jax.random.normal(next(ks), shape, jnp.float32) * scale
    near_one = lambda shape: 1.0 + nrm(shape, 0.02)
    gate_base = jnp.array([0.0, 3.0], jnp.float32)[None, :, None]
    return {
        "x": nrm((BATCH, SEQ, D_MODEL), 1.0),
        "c": nrm((BATCH, D_MODEL), 1.0),
        "ctx": nrm((BATCH, CTX_LEN, D_MODEL), 1.0),
        "c_ctx": nrm((D_MODEL,), 1.0),
        "w_ada": nrm((DEPTH, D_MODEL, 6 * D_MODEL), 0.5 * D_MODEL ** -0.5),
        "b_ada": nrm((DEPTH, 6 * D_MODEL), 0.01),
        "g_norm1": near_one((DEPTH, D_MODEL)),
        "w_in": nrm((DEPTH, D_MODEL, IN_W), D_MODEL ** -0.5),
        "a_conv_w": nrm((DEPTH, A_CONV, 2 * A_HEADS * A_DQK), A_CONV ** -0.5),
        "a_conv_b": nrm((DEPTH, 2 * A_HEADS * A_DQK), 0.01),
        "a_gate_b": gate_base + nrm((DEPTH, 2, 2 * A_HEADS), 0.1),
        "a_norm_g": near_one((DEPTH, MIX_W)),
        "b_q_norm_g": near_one((DEPTH, B_DH)),
        "b_k_norm_g": near_one((DEPTH, B_DH)),
        "c_w_up": nrm((DEPTH, 2, C_RANK, C_HEADS * C_DK), C_RANK ** -0.5),
        "c_b_up": nrm((DEPTH, 2, C_HEADS * C_DK), 0.1),
        "c_norm_g": near_one((DEPTH, MIX_W)),
        "w_branch": nrm((DEPTH, N_BRANCH, MIX_W, D_MODEL), MIX_W ** -0.5),
        "w_out": nrm((DEPTH, D_MODEL, D_MODEL), D_MODEL ** -0.5),
        "g_norm2": near_one((DEPTH, D_MODEL)),
        "w_router": nrm((DEPTH, D_MODEL, N_EXPERTS), D_MODEL ** -0.5),
        "b_router": nrm((DEPTH, N_EXPERTS), 0.01),
        "w_e1": nrm((DEPTH, N_EXPERTS, D_MODEL, 2 * D_FF), D_MODEL ** -0.5),
        "b_e1": nrm((DEPTH, N_EXPERTS, 2 * D_FF), 0.01),
        "w_e2": nrm((DEPTH, N_EXPERTS, D_FF, D_MODEL), D_FF ** -0.5),
        "b_e2": nrm((DEPTH, N_EXPERTS, D_MODEL), 0.01),
        "g_final": near_one((D_MODEL,)),
    }


def reference(x, c, ctx, c_ctx, w_ada, b_ada, g_norm1, w_in, a_conv_w, a_conv_b, a_gate_b, a_norm_g,
              b_q_norm_g, b_k_norm_g, c_w_up, c_b_up, c_norm_g, w_branch, w_out, g_norm2,
              w_router, b_router, w_e1, b_e1, w_e2, b_e2, g_final):
    seq = x.shape[1]
    rows = seq // GRID_W
    row = jnp.repeat(jnp.arange(rows), GRID_W)
    col = jnp.tile(jnp.arange(GRID_W), rows)
    n_f = B_DH // 4
    freqs = ROPE_THETA ** (-jnp.arange(n_f, dtype=jnp.float32) / n_f)
    ang = jnp.concatenate([row[:, None] * freqs, col[:, None] * freqs], axis=-1)
    cos, sin = jnp.cos(ang), jnp.sin(ang)
    s_lat = jax.nn.silu(c)
    s_ctx = jax.nn.silu(c_ctx)
    for l in range(DEPTH):
        last = l == DEPTH - 1
        sh1, sc1, g1, sh2, sc2, g2 = [m[:, None, :] for m in jnp.split(s_lat @ w_ada[l] + b_ada[l], 6, axis=-1)]
        csh1, csc1, cg1, csh2, csc2, cg2 = jnp.split(s_ctx @ w_ada[l] + b_ada[l], 6, axis=-1)
        hl = modulate(rms_norm(x, g_norm1[l]), sh1, sc1)
        hc = modulate(rms_norm(ctx, g_norm1[l]), csh1, csc1)
        yl, yc = mixer_sublayer(hl, hc, w_in[l], a_conv_w[l], a_conv_b[l], a_gate_b[l], a_norm_g[l],
                                b_q_norm_g[l], b_k_norm_g[l], c_w_up[l], c_b_up[l], c_norm_g[l],
                                w_branch[l], w_out[l], cos, sin, not last)
        x = x + g1 * yl
        hl = modulate(rms_norm(x, g_norm2[l]), sh2, sc2)
        n_lat = hl.shape[0] * hl.shape[1]
        if last:
            f = moe(hl.reshape(-1, D_MODEL), w_router[l], b_router[l], w_e1[l], b_e1[l], w_e2[l], b_e2[l])
            x = x + g2 * f.reshape(hl.shape)
        else:
            ctx = ctx + cg1 * yc
            hc = modulate(rms_norm(ctx, g_norm2[l]), csh2, csc2)
            tok = jnp.concatenate([hl.reshape(-1, D_MODEL), hc.reshape(-1, D_MODEL)], axis=0)
            f = moe(tok, w_router[l], b_router[l], w_e1[l], b_e1[l], w_e2[l], b_e2[l])
            x = x + g2 * f[:n_lat].reshape(hl.shape)
            ctx = ctx + cg2 * f[n_lat:].reshape(hc.shape)
    return rms_norm(x, g_final)
```

```cpp
#include <hip/hip_runtime.h>
#include <hip/hip_bf16.h>
#include <cstdio>
#include <cstdint>

#ifndef MK_ONE_LAUNCH
#define MK_ONE_LAUNCH 0
#endif

#define DI __device__ __forceinline__
#define GAS __attribute__((address_space(1)))
#define LAS __attribute__((address_space(3)))

constexpr int DM = 1024, NBATCH = 8, SEQ = 4096, DEPTH = 4, CTXL = 256;
constexpr int M_LAT = NBATCH * SEQ, M_CTX = NBATCH * CTXL, MROWS = M_LAT + M_CTX;
constexpr int IN_W = 6960, PW = 7168;
constexpr int NCHUNK = MROWS / 64;
constexpr int KVLEN = CTXL + SEQ;
constexpr int NEXP = 32, TOPK = 4, DFF = 1024;
constexpr int MOE_ROWS_MAX = MROWS * TOPK + NEXP * 256;
constexpr float EPS = 1e-6f;
constexpr int C_AQK = 0, C_AV = 512, C_AI = 1024, C_AF = 1032, C_AO = 1040, C_BQ = 1552, C_BK = 2064, C_BV = 2192, C_CQ = 2320, C_CK = 2576, C_CV = 2832, C_CA = 3344, C_CR = 3376, C_GATE = 3888;
static_assert(C_GATE + 3 * DM == IN_W, "split");
enum { I_X = 0, I_C, I_CTX, I_CCTX, I_WADA, I_BADA, I_GN1, I_WIN, I_ACW, I_ACB, I_AGB, I_ANG, I_BQG, I_BKG, I_CWUP, I_CBUP, I_CNG, I_WBR, I_WOUT, I_GN2, I_WR, I_BR, I_WE1, I_BE1, I_WE2, I_BE2, I_GF, N_IN };

constexpr size_t al256(size_t x) { return (x + 255) & ~(size_t)255; }
constexpr size_t WS_CTL = 0, CTL_ZERO_BYTES = 1u << 20;
constexpr size_t WS_MOD = WS_CTL + CTL_ZERO_BYTES;
constexpr size_t WS_BLKCNT = WS_MOD + al256((size_t)DEPTH * 9 * 6 * DM * 4);
constexpr size_t WS_MOEMETA = WS_BLKCNT + al256(1024 * 32 * 4);
constexpr size_t WS_TOKE = WS_MOEMETA + 4096;
constexpr size_t WS_TOKP = WS_TOKE + (size_t)MROWS * 16;
constexpr size_t WS_TOKW = WS_TOKP + (size_t)MROWS * 16;
constexpr size_t WS_SLOTW = WS_TOKW + (size_t)MROWS * 16;
constexpr size_t WS_WTIN = WS_SLOTW + al256((size_t)MOE_ROWS_MAX * 4);
constexpr size_t WS_WTBR = WS_WTIN + (size_t)DEPTH * PW * DM * 2;
constexpr size_t WS_WTOUT = WS_WTBR + (size_t)DEPTH * 3 * DM * 512 * 2;
constexpr size_t WS_WTE1 = WS_WTOUT + (size_t)DEPTH * DM * DM * 2;
constexpr size_t WS_WTE2 = WS_WTE1 + (size_t)DEPTH * NEXP * 2 * DFF * DM * 2;
constexpr size_t WS_X = WS_WTE2 + (size_t)DEPTH * NEXP * DM * DFF * 2;
constexpr size_t WS_H = WS_X + (size_t)MROWS * DM * 4;
constexpr size_t WS_P = WS_H + (size_t)MROWS * DM * 2;
constexpr size_t WS_QR = WS_P + (size_t)MROWS * PW * 2;
constexpr size_t WS_KR = WS_QR + (size_t)MROWS * 512 * 2;
constexpr size_t WS_VR = WS_KR + (size_t)NBATCH * KVLEN * 128 * 2;
constexpr size_t WS_YA = WS_VR + (size_t)NBATCH * KVLEN * 128 * 2;
constexpr size_t WS_YB = WS_YA + (size_t)MROWS * 512 * 2;
constexpr size_t WS_YC = WS_YB + (size_t)MROWS * 512 * 2;
constexpr size_t WS_MRG = WS_YC + (size_t)MROWS * 512 * 2;
constexpr int REC = 8320;
constexpr size_t WS_STA = WS_MRG + (size_t)MROWS * DM * 2;
constexpr size_t WS_STC = WS_STA + (size_t)NCHUNK * 8 * REC * 4;
constexpr size_t WS_XG = WS_STC + (size_t)NCHUNK * 8 * REC * 4;
constexpr size_t WS_A2 = WS_XG + (size_t)MOE_ROWS_MAX * DM * 2;
constexpr size_t WS_YS = WS_A2 + (size_t)MOE_ROWS_MAX * DFF * 2;
constexpr size_t WS_END = WS_YS + (size_t)MOE_ROWS_MAX * DM * 2;
constexpr int CW_BAR = 4096;

constexpr int RING_OFF = 0, RING_BYTES = 139264;
constexpr int LDSCTL_OFF = RING_BYTES, MISC_OFF = LDSCTL_OFF + 320;
constexpr int LDS_BYTES = 147456;

typedef unsigned short bf16_t;
typedef unsigned v4u __attribute__((ext_vector_type(4)));
typedef unsigned v2u __attribute__((ext_vector_type(2)));
typedef float f32x4 __attribute__((ext_vector_type(4)));
typedef short bf16x8 __attribute__((ext_vector_type(8)));

DI float bf2f(unsigned h) { return __uint_as_float(h << 16); }
DI unsigned f2bf(float f) { unsigned u = __float_as_uint(f); return (u + 0x7fffu + ((u >> 16) & 1u)) >> 16; }
DI unsigned pk2(float lo, float hi) { return f2bf(lo) | (f2bf(hi) << 16); }
DI void unpack8(const v4u v, float (&o)[8]) { o[0] = bf2f(v.x & 0xffffu); o[1] = bf2f(v.x >> 16); o[2] = bf2f(v.y & 0xffffu); o[3] = bf2f(v.y >> 16); o[4] = bf2f(v.z & 0xffffu); o[5] = bf2f(v.z >> 16); o[6] = bf2f(v.w & 0xffffu); o[7] = bf2f(v.w >> 16); }
DI float sigmoid_f(float x) { return 1.f / (1.f + __expf(-x)); }
DI float silu_f(float x) { return x * sigmoid_f(x); }
DI float logsigmoid_f(float x) { return fminf(x, 0.f) - __logf(1.f + __expf(-fabsf(x))); }
namespace pg8 {
#define PG8_LAS __attribute__((address_space(3)))
typedef unsigned short bf16_t;
typedef short bf16x8 __attribute__((ext_vector_type(8)));
typedef float f32x4 __attribute__((ext_vector_type(4)));
typedef unsigned u32x4 __attribute__((ext_vector_type(4)));
constexpr int BM = 256, BK = 64, HALF = 128, HTB = HALF * BK * 2  , STAGE_BYTES = 8 * HTB, NXCD = 8, WGM = 8;

__host__ __device__ __forceinline__ int lds_byte(int r, int c) { const int st = (r >> 4) * 2 + (c >> 5), rr = r & 15, cc = c & 31, ob = rr * 64 + cc * 2; return st * 1024 + (ob ^ (((ob >> 9) & 1) << 5)); }
__host__ __device__ __forceinline__ void stage_rc(int b, int& R, int& C) { const int st = b / 1024, sb = b % 1024, swz = sb ^ (((sb >> 9) & 1) << 5); R = (st >> 1) * 16 + swz / 64; C = (st & 1) * 32 + (swz % 64) / 2; }
__host__ __device__ __forceinline__ int perm32(int rho) { const int n = rho >> 4, i = rho & 15; return 8 * (i >> 2) + 4 * n + (i & 3); }

struct Unit { int pm, pn, e; };
struct Gemm { const bf16_t* A; const bf16_t* Bt; int M, N, K; size_t bstride; };

struct StaticOrder {
    int nM, nN, nwg, G, c; const int* tile_e;
    __host__ __device__ void init(int M, int N, int G_, int c_, const int* te = nullptr) { nM = M / BM; nN = N / BM; nwg = nM * nN; G = G_; c = c_; tile_e = te; }
    __host__ __device__ bool next(int i, Unit& u) const {
        const long L = (long)i * G + c; if (L >= nwg) return false;
        int wgid = (int)L; { const int q = nwg / NXCD, r = nwg % NXCD, xcd = wgid % NXCD, off = wgid / NXCD; wgid = (xcd < r ? xcd * (q + 1) : r * (q + 1) + (xcd - r) * q) + off; }
        const int nig = WGM * nN, gid = wgid / nig, fm = gid * WGM, gsz = (nM - fm) < WGM ? (nM - fm) : WGM;
        u.pm = fm + ((wgid % nig) % gsz); u.pn = (wgid % nig) / gsz; u.e = tile_e ? tile_e[u.pm] : 0; return true;
    }
    __device__ __forceinline__ void a_ready(const Unit&) const {}
    __device__ __forceinline__ void done(const Unit&) const {}
};

__device__ __forceinline__ unsigned cvt_pk_bf16(float lo, float hi) { unsigned r; asm volatile("v_cvt_pk_bf16_f32 %0, %1, %2" : "=v"(r) : "v"(lo), "v"(hi)); return r; }
__device__ __forceinline__ u32x4 pack8(const f32x4 a, const f32x4 b) { u32x4 w; w.x = cvt_pk_bf16(a[0], a[1]); w.y = cvt_pk_bf16(a[2], a[3]); w.z = cvt_pk_bf16(b[0], b[1]); w.w = cvt_pk_bf16(b[2], b[3]); return w; }
__device__ __forceinline__ float bfl(unsigned v) { return __uint_as_float(v << 16); }
__device__ __forceinline__ float bfh(unsigned v) { return __uint_as_float(v & 0xffff0000u); }
__device__ __forceinline__ float sigm(float x) { return 1.f / (1.f + __expf(-x)); }

struct EpiStoreBf16 {
    static constexpr bool PERM = true, AFTER_DRAIN = false;
    bf16_t* O; int ldc;
    __device__ __forceinline__ void operator()(const f32x4 (&acc)[2][2][4][2], const Unit& u, int wr, int wc, int fr, int fq) const {
        const int row0 = u.pm * BM + wr * 64 + fr, col0 = u.pn * BM + wc * 32 + 8 * fq;
#pragma unroll
        for (int ai = 0; ai < 2; ++ai)
#pragma unroll
            for (int m = 0; m < 4; ++m) { bf16_t* rowp = O + (size_t)(row0 + ai * HALF + m * 16) * ldc + col0;
#pragma unroll
                for (int bj = 0; bj < 2; ++bj) *(u32x4*)(rowp + bj * HALF) = pack8(acc[ai][bj][m][0], acc[ai][bj][m][1]); }
    }
};
struct EpiBranch {
    static constexpr bool PERM = true, AFTER_DRAIN = false;
    bf16_t* MRG; const bf16_t* P; int ldp, gate_col, first;
    __device__ __forceinline__ void operator()(const f32x4 (&acc)[2][2][4][2], const Unit& u, int wr, int wc, int fr, int fq) const {
        const int row0 = u.pm * BM + wr * 64 + fr, col0 = u.pn * BM + wc * 32 + 8 * fq;
#pragma unroll
        for (int ai = 0; ai < 2; ++ai)
#pragma unroll
            for (int m = 0; m < 4; ++m) { const size_t row = (size_t)(row0 + ai * HALF + m * 16);
#pragma unroll
                for (int bj = 0; bj < 2; ++bj) {
                    const int col = col0 + bj * HALF;
                    const u32x4 gv = *(const u32x4*)(P + row * ldp + gate_col + col);
                    u32x4 pv = (u32x4){0u, 0u, 0u, 0u}; if (!first) pv = *(const u32x4*)(MRG + row * 1024 + col);
                    f32x4 a = acc[ai][bj][m][0], b = acc[ai][bj][m][1];
                    a[0] = bfl(pv.x) + sigm(bfl(gv.x)) * a[0]; a[1] = bfh(pv.x) + sigm(bfh(gv.x)) * a[1]; a[2] = bfl(pv.y) + sigm(bfl(gv.y)) * a[2]; a[3] = bfh(pv.y) + sigm(bfh(gv.y)) * a[3];
                    b[0] = bfl(pv.z) + sigm(bfl(gv.z)) * b[0]; b[1] = bfh(pv.z) + sigm(bfh(gv.z)) * b[1]; b[2] = bfl(pv.w) + sigm(bfl(gv.w)) * b[2]; b[3] = bfh(pv.w) + sigm(bfh(gv.w)) * b[3];
                    *(u32x4*)(MRG + row * 1024 + col) = pack8(a, b); } }
    }
};
struct EpiResid {
    static constexpr bool PERM = false, AFTER_DRAIN = false;
    float* X; const float* gmod;
    __device__ __forceinline__ void operator()(const f32x4 (&acc)[2][2][4][2], const Unit& u, int wr, int wc, int fr, int fq) const {
        const int row0 = u.pm * BM + wr * 64 + fr, col0 = u.pn * BM + wc * 32 + 4 * fq;
        const int mi = u.pm < 128 ? (u.pm >> 4) : 8;
        const float* gv = gmod + (size_t)mi * 6144;
#pragma unroll
        for (int bj = 0; bj < 2; ++bj)
#pragma unroll
            for (int n = 0; n < 2; ++n) { const int col = col0 + bj * HALF + n * 16; const f32x4 g = *(const f32x4*)(gv + col);
#pragma unroll
                for (int ai = 0; ai < 2; ++ai)
#pragma unroll
                    for (int m = 0; m < 4; ++m) { float* p = X + (size_t)(row0 + ai * HALF + m * 16) * 1024 + col; const f32x4 x = *(const f32x4*)p; *(f32x4*)p = x + g * acc[ai][bj][m][n]; } }
    }
};
struct EpiSwiglu {
    static constexpr bool PERM = true, AFTER_DRAIN = false;
    bf16_t* A2; const float* b1;
    __device__ __forceinline__ void operator()(const f32x4 (&acc)[2][2][4][2], const Unit& u, int wr, int wc, int fr, int fq) const {
        const int row0 = u.pm * BM + wr * 64 + fr, j0 = u.pn * HALF + wc * 32 + 8 * fq;
        const float* bp = b1 + (size_t)u.e * 2048 + 2 * j0;
        float bg[8], bu[8];
#pragma unroll
        for (int q = 0; q < 4; ++q) { const f32x4 t = *(const f32x4*)(bp + 4 * q); bg[2 * q] = t[0]; bu[2 * q] = t[1]; bg[2 * q + 1] = t[2]; bu[2 * q + 1] = t[3]; }
#pragma unroll
        for (int ai = 0; ai < 2; ++ai)
#pragma unroll
            for (int m = 0; m < 4; ++m) {
                float o[8];
#pragma unroll
                for (int e = 0; e < 8; ++e) {
                    float g = acc[ai][0][m][e >> 2][e & 3] + bg[e], up = acc[ai][1][m][e >> 2][e & 3] + bu[e];
                    g = fminf(g, 7.0f); up = fminf(fmaxf(up, -7.0f), 7.0f);
                    o[e] = (up + 1.0f) * g * sigm(1.702f * g); }
                u32x4 w; w.x = cvt_pk_bf16(o[0], o[1]); w.y = cvt_pk_bf16(o[2], o[3]); w.z = cvt_pk_bf16(o[4], o[5]); w.w = cvt_pk_bf16(o[6], o[7]);
                *(u32x4*)(A2 + (size_t)(row0 + ai * HALF + m * 16) * 1024 + j0) = w; }
    }
};
struct EpiMoeOut {
    static constexpr bool PERM = true, AFTER_DRAIN = false;
    bf16_t* YS; const float* b2; const float* slotw;
    __device__ __forceinline__ void operator()(const f32x4 (&acc)[2][2][4][2], const Unit& u, int wr, int wc, int fr, int fq) const {
        const int row0 = u.pm * BM + wr * 64 + fr, col0 = u.pn * BM + wc * 32 + 8 * fq;
        const float* bp = b2 + (size_t)u.e * 1024 + col0;
        f32x4 bv[2][2];
#pragma unroll
        for (int bj = 0; bj < 2; ++bj)
#pragma unroll
            for (int n = 0; n < 2; ++n) bv[bj][n] = *(const f32x4*)(bp + bj * HALF + 4 * n);
#pragma unroll
        for (int ai = 0; ai < 2; ++ai)
#pragma unroll
            for (int m = 0; m < 4; ++m) { const size_t row = (size_t)(row0 + ai * HALF + m * 16); const float w = slotw[row];
#pragma unroll
                for (int bj = 0; bj < 2; ++bj) *(u32x4*)(YS + row * 1024 + col0 + bj * HALF) = pack8((acc[ai][bj][m][0] + bv[bj][0]) * w, (acc[ai][bj][m][1] + bv[bj][1]) * w); }
    }
};

template <class Epi, class Sched, bool ALIGN_EPI = false, bool SP2 = false>
__device__ __forceinline__ void gemm_phase(PG8_LAS unsigned char* lds, const Gemm g, const Sched& S, const Epi& E) {
    int tid_ = threadIdx.x; asm volatile("" : "+v"(tid_));
    const int tid = tid_, wid = __builtin_amdgcn_readfirstlane(tid >> 6), lane = tid & 63, wr = wid >> 2, wc = wid & 3, fr = lane & 15, fq = lane >> 4;
    const int K = g.K, nt = K / BK;
    unsigned voffA[2], voffB[2];
#pragma unroll
    for (int i = 0; i < 2; ++i) { int R, C; stage_rc(tid * 16 + i * 8192, R, C); const int Rb = Epi::PERM ? ((R & ~31) + perm32(R & 31)) : R;
        voffA[i] = (unsigned)(R * K + C) * 2u; voffB[i] = (unsigned)(Rb * K + C) * 2u; }
    const size_t kstep = (size_t)(BK * 2);
    const size_t hstep = (size_t)HALF * K * 2;
    const size_t tstep = 2 * hstep;
    const unsigned ldsw = (unsigned)wid * 1024u;
    const int aoff = lds_byte(wr * 64 + fr, fq * 8), boff = lds_byte(wc * 32 + fr, fq * 8);
#define PG8_SA(b, h) (((b) * 2 + (h)) * HTB)
#define PG8_SB(b, h) ((4 + (b) * 2 + (h)) * HTB)
#define PG8_STAGE(bufoff, gbase, voff) do { _Pragma("unroll") for (int _i = 0; _i < 2; ++_i) \
        __builtin_amdgcn_global_load_lds((const unsigned*)((const char*)(gbase) + (voff)[_i]), (PG8_LAS unsigned*)(lds + (bufoff) + ldsw + _i * 8192), 16, 0, 0); } while (0)
#define PG8_LDA(dst, b, h) do { _Pragma("unroll") for (int m = 0; m < 4; ++m) _Pragma("unroll") for (int k = 0; k < 2; ++k) dst[m][k] = *(const PG8_LAS bf16x8*)(lds + PG8_SA(b, h) + aoff + m * 2048 + k * 1024); } while (0)
#define PG8_LDB(dst, b, h) do { _Pragma("unroll") for (int n = 0; n < 2; ++n) _Pragma("unroll") for (int k = 0; k < 2; ++k) dst[n][k] = *(const PG8_LAS bf16x8*)(lds + PG8_SB(b, h) + boff + n * 2048 + k * 1024); } while (0)
#define PG8_MMA(ai, bj, At, Bt) do { __builtin_amdgcn_s_setprio(1); _Pragma("unroll") for (int m = 0; m < 4; ++m) _Pragma("unroll") for (int n = 0; n < 2; ++n) _Pragma("unroll") for (int k = 0; k < 2; ++k) \
        acc[ai][bj][m][n] = __builtin_amdgcn_mfma_f32_16x16x32_bf16(Bt[n][k], At[m][k], acc[ai][bj][m][n], 0, 0, 0); __builtin_amdgcn_s_setprio(0); } while (0)
#define PG8_WAIT_V(n) asm volatile("s_waitcnt vmcnt(" #n ")" ::: "memory")
#define PG8_WAIT_L(n) asm volatile("s_waitcnt lgkmcnt(" #n ")" ::: "memory")
#define PG8_BAR __builtin_amdgcn_s_barrier()
#define PG8_SCHED __builtin_amdgcn_sched_barrier(0)
    Unit cur, nxt; int ui = 0;
    if (!S.next(0, cur)) return;
    f32x4 acc[2][2][4][2];
#pragma unroll
    for (int a = 0; a < 2; ++a)
#pragma unroll
        for (int b = 0; b < 2; ++b)
#pragma unroll
            for (int m = 0; m < 4; ++m)
#pragma unroll
                for (int n = 0; n < 2; ++n) acc[a][b][m][n] = (f32x4){0.f, 0.f, 0.f, 0.f};
    bf16x8 At[4][2], B0[2][2], B1[2][2];
    const char* cA = (const char*)g.A + (size_t)cur.pm * tstep; const char* cB = (const char*)g.Bt + (size_t)cur.e * g.bstride + (size_t)cur.pn * tstep;
    S.a_ready(cur);
    if constexpr (SP2) {
        PG8_STAGE(PG8_SB(0, 0), cB, voffB); PG8_STAGE(PG8_SB(0, 1), cB + hstep, voffB); PG8_STAGE(PG8_SA(0, 0), cA, voffA); PG8_STAGE(PG8_SA(0, 1), cA + hstep, voffA);
        if (wr == 1) PG8_BAR;
        PG8_WAIT_V(2); PG8_BAR;
        PG8_STAGE(PG8_SB(1, 0), cB + kstep, voffB); PG8_STAGE(PG8_SA(1, 0), cA + kstep, voffA); PG8_STAGE(PG8_SB(1, 1), cB + hstep + kstep, voffB);
        PG8_WAIT_V(6); PG8_BAR;
    } else {
        PG8_STAGE(PG8_SB(0, 0), cB, voffB); PG8_STAGE(PG8_SA(0, 0), cA, voffA); PG8_STAGE(PG8_SB(0, 1), cB + hstep, voffB); PG8_STAGE(PG8_SA(0, 1), cA + hstep, voffA);
        if (wr == 1) PG8_BAR;
        PG8_WAIT_V(4); PG8_BAR;
        PG8_STAGE(PG8_SB(1, 0), cB + kstep, voffB); PG8_STAGE(PG8_SA(1, 0), cA + kstep, voffA); PG8_STAGE(PG8_SB(1, 1), cB + hstep + kstep, voffB);
        PG8_WAIT_V(6); PG8_BAR;
    }
    for (;;) {
        const bool has_next = S.next(ui + 1, nxt);
        const char* nA = has_next ? (const char*)g.A + (size_t)nxt.pm * tstep : cA; const char* nB = has_next ? (const char*)g.Bt + (size_t)nxt.e * g.bstride + (size_t)nxt.pn * tstep : cB;
        for (int t = 0; t < nt; t += 2) {
            const bool last = (t == nt - 2);
            const char* a1 = cA + (size_t)(t + 1) * kstep;
            const char* a2 = last ? nA : cA + (size_t)(t + 2) * kstep; const char* b2 = last ? nB : cB + (size_t)(t + 2) * kstep;
            const char* a3 = a2 + kstep; const char* b3 = b2 + kstep;
            if (last && has_next) S.a_ready(nxt);
            if constexpr (SP2) {
            PG8_LDB(B0, 0, 0); PG8_LDB(B1, 0, 1); PG8_SCHED; PG8_LDA(At, 0, 0); PG8_STAGE(PG8_SA(1, 1), a1 + hstep, voffA);
            PG8_WAIT_V(8); PG8_WAIT_L(0); PG8_BAR; PG8_MMA(0, 0, At, B0); PG8_MMA(0, 1, At, B1); PG8_BAR; PG8_SCHED;
            PG8_LDA(At, 0, 1); PG8_STAGE(PG8_SB(0, 0), b2, voffB); PG8_STAGE(PG8_SB(0, 1), b2 + hstep, voffB); PG8_STAGE(PG8_SA(0, 0), a2, voffA);
            PG8_WAIT_V(8); PG8_WAIT_L(0); PG8_BAR; PG8_MMA(1, 0, At, B0); PG8_MMA(1, 1, At, B1); PG8_BAR; PG8_SCHED;
            PG8_LDB(B0, 1, 0); PG8_LDB(B1, 1, 1); PG8_SCHED; PG8_LDA(At, 1, 0); PG8_STAGE(PG8_SA(0, 1), a2 + hstep, voffA);
            PG8_WAIT_V(8); PG8_WAIT_L(0); PG8_BAR; PG8_MMA(0, 0, At, B0); PG8_MMA(0, 1, At, B1); PG8_BAR; PG8_SCHED;
            PG8_LDA(At, 1, 1); PG8_STAGE(PG8_SB(1, 0), b3, voffB); PG8_STAGE(PG8_SB(1, 1), b3 + hstep, voffB); PG8_STAGE(PG8_SA(1, 0), a3, voffA);
            PG8_WAIT_V(8); PG8_WAIT_L(0); PG8_BAR; PG8_MMA(1, 0, At, B0); PG8_MMA(1, 1, At, B1); PG8_BAR; PG8_SCHED;
            } else {
            PG8_LDB(B0, 0, 0); PG8_SCHED; PG8_LDA(At, 0, 0); PG8_STAGE(PG8_SA(1, 1), a1 + hstep, voffA);
            PG8_WAIT_L(8); PG8_BAR; PG8_WAIT_L(0); PG8_MMA(0, 0, At, B0); PG8_BAR; PG8_SCHED;
            PG8_LDB(B1, 0, 1); PG8_STAGE(PG8_SB(0, 0), b2, voffB);
            PG8_BAR; PG8_WAIT_L(0); PG8_MMA(0, 1, At, B1); PG8_BAR;
            PG8_LDA(At, 0, 1); PG8_STAGE(PG8_SA(0, 0), a2, voffA);
            PG8_BAR; PG8_WAIT_L(0); PG8_MMA(1, 0, At, B0); PG8_BAR; PG8_SCHED;
            PG8_STAGE(PG8_SB(0, 1), b2 + hstep, voffB);
            PG8_WAIT_V(6); PG8_BAR; PG8_MMA(1, 1, At, B1); PG8_BAR;
            PG8_LDB(B0, 1, 0); PG8_SCHED; PG8_LDA(At, 1, 0); PG8_STAGE(PG8_SA(0, 1), a2 + hstep, voffA);
            PG8_WAIT_L(8); PG8_BAR; PG8_WAIT_L(0); PG8_MMA(0, 0, At, B0); PG8_BAR; PG8_SCHED;
            PG8_LDB(B1, 1, 1); PG8_STAGE(PG8_SB(1, 0), b3, voffB);
            PG8_BAR; PG8_WAIT_L(0); PG8_MMA(0, 1, At, B1); PG8_BAR;
            PG8_LDA(At, 1, 1); PG8_STAGE(PG8_SA(1, 0), a3, voffA);
            PG8_BAR; PG8_WAIT_L(0); PG8_MMA(1, 0, At, B0); PG8_BAR; PG8_SCHED;
            PG8_STAGE(PG8_SB(1, 1), b3 + hstep, voffB);
            PG8_WAIT_V(6); PG8_BAR; PG8_MMA(1, 1, At, B1); PG8_BAR;
            }
        }
        if constexpr (ALIGN_EPI) { if (wr == 0) PG8_BAR; }
        if constexpr (!Epi::AFTER_DRAIN) { E(acc, cur, wr, wc, fr, fq); S.done(cur); }
        if (!has_next) break;
#pragma unroll
        for (int a = 0; a < 2; ++a)
#pragma unroll
            for (int b = 0; b < 2; ++b)
#pragma unroll
                for (int m = 0; m < 4; ++m)
#pragma unroll
                    for (int n = 0; n < 2; ++n) acc[a][b][m][n] = (f32x4){0.f, 0.f, 0.f, 0.f};
        cur = nxt; cA = nA; cB = nB; ++ui;
        if constexpr (ALIGN_EPI) { if (wr == 1) PG8_BAR; }
    }
    PG8_WAIT_V(0);
    if constexpr (!ALIGN_EPI) { if (wr == 0) PG8_BAR; }
    PG8_BAR;
    if constexpr (Epi::AFTER_DRAIN) { E.fused(acc, cur, wr, wc, fr, fq, lds, wid, lane); S.done(cur); }
#undef PG8_SA
#undef PG8_SB
#undef PG8_STAGE
#undef PG8_LDA
#undef PG8_LDB
#undef PG8_MMA
#undef PG8_WAIT_V
#undef PG8_WAIT_L
#undef PG8_BAR
#undef PG8_SCHED
}
}
namespace attn_body {
using bf16=__hip_bfloat16;
using bf16x8=__attribute__((ext_vector_type(8)))short;
using s16x4=__attribute__((ext_vector_type(4)))short;
using f32x16=__attribute__((ext_vector_type(16)))float;
using u32x4=__attribute__((ext_vector_type(4)))unsigned;
constexpr int D=64,QP=512,KP=128;
constexpr int NW=8,QBLK=32,QB=QBLK*NW,KVBLK=64;
constexpr int ATTN_UNIT_ROWS=QB;
__device__ __forceinline__ int crow(int r,int hi){return (r&3)+8*(r>>2)+4*hi;}
#define SBAR() __builtin_amdgcn_sched_barrier(0)
__device__ __forceinline__ void cmask(f32x16&p0,f32x16&p1,int jb,int qrel,int hi){
  const float NEG=-INFINITY; int kb=64*jb+4*hi;
  #pragma unroll
  for(int r=0;r<16;++r){int kv=kb+(r&3)+8*(r>>2); if(kv>qrel)p0[r]=NEG; if(kv+32>qrel)p1[r]=NEG;}
}

constexpr int NSLOT=3, SLOTB=8192;
constexpr int LDS_K=0, LDS_V=NSLOT*SLOTB, LDS_WS=2*NSLOT*SLOTB, LDS_OST=LDS_WS+NW*64*4, LDS_BYTES=LDS_OST+NW*4096;
constexpr float C2=0.125f*1.4426950408889634f;
__device__ __forceinline__ void glds16(const void*gsrc,unsigned lds_dst){unsigned keep;
  asm volatile("s_mov_b32 %0, m0\n\ts_mov_b32 m0, %2\n\ts_nop 0\n\tglobal_load_lds_dwordx4 %1, off\n\ts_mov_b32 m0, %0":"=&s"(keep):"v"(gsrc),"s"(lds_dst):"memory");}
__device__ __forceinline__ float max3f(float a,float b,float c){float r;asm("v_max3_f32 %0, %1, %2, %3":"=v"(r):"v"(a),"v"(b),"v"(c));return r;}
__device__ __forceinline__ float max2f(float a,float b){float r;asm("v_max_f32_e32 %0, %1, %2":"=v"(r):"v"(a),"v"(b));return r;}
__device__ __forceinline__ float fadd_s(float a,float b){float r;asm("v_add_f32_e32 %0, %1, %2":"=v"(r):"v"(a),"v"(b));return r;}
__device__ __forceinline__ float fsub_s(float a,float b){float r;asm("v_sub_f32_e32 %0, %1, %2":"=v"(r):"v"(a),"v"(b));return r;}
typedef float f32x2_t __attribute__((ext_vector_type(2))); typedef __bf16 bf16x2_t __attribute__((ext_vector_type(2)));
__device__ __forceinline__ unsigned cvtpk_s(float lo,float hi){f32x2_t v={lo,hi};bf16x2_t b=__builtin_convertvector(v,bf16x2_t);return __builtin_bit_cast(unsigned,b);}
#define WAIT_BAR(N) asm volatile("s_waitcnt vmcnt(" #N ") lgkmcnt(0)\n\ts_barrier":::"memory")

__device__ __forceinline__ void qkt(f32x16&p0,f32x16&p1,const char*Kslot,const bf16x8*qr,const f32x16&negm,int r32,int hi){
  const char*kb=Kslot+hi*1024+r32*16;
  #pragma unroll
  for(int d0=0;d0<4;++d0){
    const bf16x8 b0=*reinterpret_cast<const bf16x8*>(kb+d0*2048);
    const bf16x8 b1=*reinterpret_cast<const bf16x8*>(kb+d0*2048+512);
    if(d0==0){p0=__builtin_amdgcn_mfma_f32_32x32x16_bf16(b0,qr[0],negm,0,0,0);p1=__builtin_amdgcn_mfma_f32_32x32x16_bf16(b1,qr[0],negm,0,0,0);}
    else{p0=__builtin_amdgcn_mfma_f32_32x32x16_bf16(b0,qr[d0],p0,0,0,0);p1=__builtin_amdgcn_mfma_f32_32x32x16_bf16(b1,qr[d0],p1,0,0,0);}}
}
typedef __attribute__((address_space(3))) const char* lds_cptr;
typedef short v4i16_t __attribute__((ext_vector_type(4)));
__device__ __forceinline__ void kload8(bf16x8*kf,lds_cptr kp){
  kf[0]=*(const __attribute__((address_space(3))) bf16x8*)(kp);      kf[1]=*(const __attribute__((address_space(3))) bf16x8*)(kp+512);
  kf[2]=*(const __attribute__((address_space(3))) bf16x8*)(kp+2048); kf[3]=*(const __attribute__((address_space(3))) bf16x8*)(kp+2560);
  kf[4]=*(const __attribute__((address_space(3))) bf16x8*)(kp+4096); kf[5]=*(const __attribute__((address_space(3))) bf16x8*)(kp+4608);
  kf[6]=*(const __attribute__((address_space(3))) bf16x8*)(kp+6144); kf[7]=*(const __attribute__((address_space(3))) bf16x8*)(kp+6656);
}
__device__ __forceinline__ void kload2(bf16x8*kf,lds_cptr kp,int j){ kf[2*j]=*(const __attribute__((address_space(3))) bf16x8*)(kp+j*2048); kf[2*j+1]=*(const __attribute__((address_space(3))) bf16x8*)(kp+j*2048+512); }
__device__ __forceinline__ s16x4 vtr(lds_cptr p){ return __builtin_bit_cast(s16x4,__builtin_amdgcn_ds_read_tr16_b64_v4i16((__attribute__((address_space(3))) v4i16_t*)p)); }
__device__ __forceinline__ float rowmax(const f32x16&p0,const f32x16&p1){
  float a=max3f(p0[0],p0[1],p1[0]),b=max3f(p0[2],p0[3],p1[1]);a=max3f(a,p1[2],p1[3]);
  #pragma unroll
  for(int r=4;r<16;r+=4){a=max3f(a,p0[r],p0[r+1]);b=max3f(b,p0[r+2],p0[r+3]);a=max3f(a,p1[r],p1[r+1]);b=max3f(b,p1[r+2],p1[r+3]);}
  const float m=max2f(a,b);
  auto rr=__builtin_amdgcn_permlane32_swap(__float_as_uint(m),__float_as_uint(m),false,false);
  return max2f(__uint_as_float(rr[0]),__uint_as_float(rr[1]));
}
__device__ __forceinline__ void pv(f32x16*o,int vb,bf16x8 pa0,bf16x8 pa1,bf16x8 pa2,bf16x8 pa3){
  #pragma unroll
  for(int d0=0;d0<2;++d0){s16x4 lo[4],hi[4];
    #pragma unroll
    for(int ks=0;ks<4;++ks){
      asm volatile("ds_read_b64_tr_b16 %0,%1 offset:%c2":"=&v"(lo[ks]):"v"(vb),"i"(d0*4096+ks*1024):"memory");
      asm volatile("ds_read_b64_tr_b16 %0,%1 offset:%c2":"=&v"(hi[ks]):"v"(vb),"i"(d0*4096+ks*1024+512):"memory");}
    asm volatile("s_waitcnt lgkmcnt(0)":::"memory");SBAR();
    #define PK(k) (bf16x8){lo[k][0],lo[k][1],lo[k][2],lo[k][3],hi[k][0],hi[k][1],hi[k][2],hi[k][3]}
    o[d0]=__builtin_amdgcn_mfma_f32_32x32x16_bf16(pa0,PK(0),o[d0],0,0,0);
    o[d0]=__builtin_amdgcn_mfma_f32_32x32x16_bf16(pa1,PK(1),o[d0],0,0,0);
    o[d0]=__builtin_amdgcn_mfma_f32_32x32x16_bf16(pa2,PK(2),o[d0],0,0,0);
    o[d0]=__builtin_amdgcn_mfma_f32_32x32x16_bf16(pa3,PK(3),o[d0],0,0,0);
    #undef PK
  }
}

#ifndef ATTN_STORE16
#define ATTN_STORE16(p,v) (*(u32x4*)(p)=(v))
#endif
template<int THRL> __device__ __forceinline__ void attn_unit(long qrow0,int h,int NT,const bf16*Q,const bf16*__restrict__ Kh,const bf16*__restrict__ Vh,bf16*O,char*shm){
  int tid_=threadIdx.x; asm volatile("":"+v"(tid_)); const int tid=tid_,lane=tid&63,r32=lane&31,hi=lane>>5; const int wid=__builtin_amdgcn_readfirstlane(tid>>6);
  const bf16*Qw=Q+(qrow0+wid*QBLK)*QP+h*D;
  const unsigned lds0=(unsigned)(uintptr_t)shm;
  float*wsf=(float*)(shm+LDS_WS)+wid*64;
  const bf16*ksrc=Kh+(long)lane*KP+wid*8;
  const bf16*vsrc=Vh+(long)(16*(wid&3)+(lane>>2))*KP+(wid>>2)*32+(lane&3)*8;
  const unsigned kdst=lds0+LDS_K+wid*1024, vdst=lds0+LDS_V+wid*1024;
  #define DMA_K(t,slot) glds16(ksrc+(long)(t)*KVBLK*KP,(unsigned)__builtin_amdgcn_readfirstlane(kdst+(slot)))
  #define DMA_V(t,slot) glds16(vsrc+(long)(t)*KVBLK*KP,(unsigned)__builtin_amdgcn_readfirstlane(vdst+(slot)))
  const int vb0=(int)(lds0+LDS_V)+((lane>>4)&1)*32+(lane&3)*8+(4*hi+((lane&15)>>2))*64;
  const char*Kbase=shm+LDS_K; bf16x8 kf[8];
  const lds_cptr shm3=(lds_cptr)shm; const lds_cptr kp0=shm3+LDS_K+hi*1024+r32*16; const lds_cptr vp0=shm3+LDS_V+((lane>>4)&1)*32+(lane&3)*8+(4*hi+((lane&15)>>2))*64;
  DMA_K(0,0);DMA_V(0,0);DMA_K(1,SLOTB);
  bf16x8 qr[4];
  #pragma unroll
  for(int d0=0;d0<4;++d0)qr[d0]=*reinterpret_cast<const bf16x8*>(&Qw[(long)r32*QP+d0*16+hi*8]);
  float mhat=0.f,l_reg=0.f;f32x16 o[2];o[0]=f32x16{};o[1]=f32x16{};f32x16 negm=f32x16{};asm volatile("":"+v"(negm));
  #define CMASK(P0,P1,t) do{}while(0)
  bool resc=false;
  #define START(P0,P1) do{ const float rm=rowmax(P0,P1); resc=false; \
    { const float dl=rm; mhat=fadd_s(mhat,dl); \
      _Pragma("unroll") for(int r=0;r<16;++r){P0[r]=fsub_s(P0[r],dl);P1[r]=fsub_s(P1[r],dl);} \
      _Pragma("unroll") for(int r=0;r<16;++r)negm[r]=-mhat; asm volatile("":"+v"(negm)); } \
    _Pragma("unroll") for(int r=0;r<16;++r)P0[r]=__builtin_amdgcn_exp2f(P0[r]); }while(0)
  #define RESC() do{ if(resc){ asm volatile("s_waitcnt lgkmcnt(0)":::"memory"); \
      _Pragma("unroll") for(int d_=0;d_<2;++d_) _Pragma("unroll") for(int r=0;r<16;++r)o[d_][r]*=wsf[crow(r,hi)]; } }while(0)
  f32x16 pA0,pA1,pB0,pB1;
  int sl_prev=0,sl_cur=0,sl_next=SLOTB;
  #define ROT() do{sl_prev=sl_cur;sl_cur=sl_next;sl_next=(sl_next==(NSLOT-1)*SLOTB)?0:sl_next+SLOTB;}while(0)
  DMA_K(2,2*SLOTB);
  WAIT_BAR(3);
  qkt(pA0,pA1,Kbase,qr,negm,r32,hi);asm volatile("s_nop 15\n\ts_nop 7":"+v"(pA0),"+v"(pA1));CMASK(pA0,pA1,0);
  START(pA0,pA1);
  _Pragma("unroll") for(int r=0;r<16;++r)pA1[r]=__builtin_amdgcn_exp2f(pA1[r]);
  WAIT_BAR(0);
  DMA_K(3,0);DMA_V(1,SLOTB);
  ROT();
  kload8(kf,kp0+sl_cur);
  WAIT_BAR(2);
  s16x4 vlo[8],vhi[8]; u32x4 pw0,pw1,pw2,pw3;
  #define PKW(P,B) cvtpk_s(P[B],P[B+1])
  #define PAF(k) __builtin_bit_cast(bf16x8,pw##k)
  #define VFR(i) (bf16x8){vlo[i][0],vlo[i][1],vlo[i][2],vlo[i][3],vhi[i][0],vhi[i][1],vhi[i][2],vhi[i][3]}
  #define PIN(x) asm volatile("":"+v"(x))
  #define MX3(a,b,c) __builtin_fmaxf(__builtin_fmaxf((a),(b)),(c))
  #define GAPA(MF,A0,A1,A2,A3,W0,W1,PW) do{ MF; sacc+=A0; sacc+=A1; sacc+=A2; sacc+=A3; PIN(sacc); W0; W1; PIN(PW); SBAR(); }while(0)
  #define EX(v) __builtin_amdgcn_exp2f(v)
  #define GAPB(MF,X,B) do{ MF; X[B]=EX(X[B]); X[B+1]=EX(X[B+1]); X[B+2]=EX(X[B+2]); X[B+3]=EX(X[B+3]); PIN(X); SBAR(); }while(0)
  #define VRD(i) do{ vlo[i]=vtr(vp_+(((i)>>2)*4096+((i)&3)*1024)); vhi[i]=vtr(vp_+(((i)>>2)*4096+((i)&3)*1024+512)); }while(0)
  #define KRD(G,j) do{ if(G){ kload2(kf,kp0+sl_next,j); SBAR(); } }while(0)
  #define STEP(C0,C1,P0,P1,t,GK,GV,GL) do{ SBAR(); \
    const lds_cptr vp_=vp0+sl_prev; \
    VRD(0); SBAR(); float sacc=(P0[0]+P0[1]); \
    GAPA(C0=__builtin_amdgcn_mfma_f32_32x32x16_bf16(kf[0],qr[0],negm,0,0,0), P0[2],P0[3],P0[4],P0[5],     pw0[0]=PKW(P0,0), pw0[1]=PKW(P0,2), pw0); \
    VRD(4); SBAR(); GAPA(C1=__builtin_amdgcn_mfma_f32_32x32x16_bf16(kf[1],qr[0],negm,0,0,0), P0[6],P0[7],P0[8],P0[9],     pw0[2]=PKW(P0,4), pw0[3]=PKW(P0,6), pw0); \
    VRD(1); SBAR(); GAPA(C0=__builtin_amdgcn_mfma_f32_32x32x16_bf16(kf[2],qr[1],C0,0,0,0),   P0[10],P0[11],P0[12],P0[13], pw1[0]=PKW(P0,8), pw1[1]=PKW(P0,10), pw1); \
    VRD(5); SBAR(); GAPA(C1=__builtin_amdgcn_mfma_f32_32x32x16_bf16(kf[3],qr[1],C1,0,0,0),   P0[14],P0[15],P1[0],P1[1],   pw1[2]=PKW(P0,12),pw1[3]=PKW(P0,14), pw1); \
    VRD(2); SBAR(); GAPA(C0=__builtin_amdgcn_mfma_f32_32x32x16_bf16(kf[4],qr[2],C0,0,0,0),   P1[2],P1[3],P1[4],P1[5],     pw2[0]=PKW(P1,0), pw2[1]=PKW(P1,2), pw2); \
    VRD(6); SBAR(); GAPA(C1=__builtin_amdgcn_mfma_f32_32x32x16_bf16(kf[5],qr[2],C1,0,0,0),   P1[6],P1[7],P1[8],P1[9],     pw2[2]=PKW(P1,4), pw2[3]=PKW(P1,6), pw2); \
    VRD(3); SBAR(); GAPA(C0=__builtin_amdgcn_mfma_f32_32x32x16_bf16(kf[6],qr[3],C0,0,0,0),   P1[10],P1[11],P1[12],P1[13], pw3[0]=PKW(P1,8), pw3[1]=PKW(P1,10), pw3); \
    VRD(7); SBAR(); GAPA(C1=__builtin_amdgcn_mfma_f32_32x32x16_bf16(kf[7],qr[3],C1,0,0,0),   P1[14],P1[15],0.f,0.f,       pw3[2]=PKW(P1,12),pw3[3]=PKW(P1,14), pw3); \
    l_reg+=sacc; \
    if(GK){DMA_K((t)+3,sl_cur);} if(GV){DMA_V((t)+1,sl_next);} \
    CMASK(C0,C1,t); \
    { float a=MX3(C0[0],C0[1],C1[0]),b=MX3(C0[2],C0[3],C1[1]); a=MX3(a,C1[2],C1[3]); \
      _Pragma("unroll") for(int r=4;r<16;r+=4){a=MX3(a,C0[r],C0[r+1]);b=MX3(b,C0[r+2],C0[r+3]);a=MX3(a,C1[r],C1[r+1]);b=MX3(b,C1[r+2],C1[r+3]);} \
      float rm=__builtin_fmaxf(a,b); { auto rr=__builtin_amdgcn_permlane32_swap(__float_as_uint(rm),__float_as_uint(rm),false,false); rm=__builtin_fmaxf(__uint_as_float(rr[0]),__uint_as_float(rr[1])); } \
      resc=false; \
      if(__builtin_expect(__any(rm>(float)THRL),0)){ const float dl=__builtin_fmaxf(rm,0.f); mhat+=dl; \
        _Pragma("unroll") for(int r=0;r<16;++r){C0[r]-=dl;C1[r]-=dl;} \
        _Pragma("unroll") for(int r=0;r<16;++r)negm[r]=-mhat; asm volatile("":"+v"(negm)); \
        const float f=__builtin_amdgcn_exp2f(-dl); l_reg*=f; if(hi==0)wsf[r32]=f; resc=true; } } \
    SBAR(); \
    GAPB(o[0]=__builtin_amdgcn_mfma_f32_32x32x16_bf16(PAF(0),VFR(0),o[0],0,0,0), C0,0); \
    GAPB(o[1]=__builtin_amdgcn_mfma_f32_32x32x16_bf16(PAF(0),VFR(4),o[1],0,0,0), C0,4); \
    KRD(GL,0); GAPB(o[0]=__builtin_amdgcn_mfma_f32_32x32x16_bf16(PAF(1),VFR(1),o[0],0,0,0), C0,8); \
    KRD(GL,1); GAPB(o[1]=__builtin_amdgcn_mfma_f32_32x32x16_bf16(PAF(1),VFR(5),o[1],0,0,0), C0,12); \
    KRD(GL,2); GAPB(o[0]=__builtin_amdgcn_mfma_f32_32x32x16_bf16(PAF(2),VFR(2),o[0],0,0,0), C1,0); \
    KRD(GL,3); GAPB(o[1]=__builtin_amdgcn_mfma_f32_32x32x16_bf16(PAF(2),VFR(6),o[1],0,0,0), C1,4); \
    GAPB(o[0]=__builtin_amdgcn_mfma_f32_32x32x16_bf16(PAF(3),VFR(3),o[0],0,0,0), C1,8); \
    GAPB(o[1]=__builtin_amdgcn_mfma_f32_32x32x16_bf16(PAF(3),VFR(7),o[1],0,0,0), C1,12); \
    }while(0)
  int t=1;
  #undef CMASK
  #define CMASK(P0,P1,t) do{}while(0)
  for(;t+5<NT;t+=2){
    STEP(pB0,pB1,pA0,pA1,t,true,true,true);     WAIT_BAR(2); RESC(); ROT();
    STEP(pA0,pA1,pB0,pB1,t+1,true,true,true);   WAIT_BAR(2); RESC(); ROT();
  }
  #undef CMASK
  #define CMASK(P0,P1,t) do{}while(0)
  #define ENDW(tt) do{ if((tt)+3<NT){WAIT_BAR(2);} else if((tt)+2<NT){WAIT_BAR(1);} else {WAIT_BAR(0);} }while(0)
  for(;t+1<NT;t+=2){
    STEP(pB0,pB1,pA0,pA1,t,(t+3<NT),(t+1<NT),(t+1<NT));       ENDW(t);   RESC(); ROT();
    STEP(pA0,pA1,pB0,pB1,t+1,(t+4<NT),(t+2<NT),(t+2<NT));     ENDW(t+1); RESC(); ROT();
  }
  STEP(pB0,pB1,pA0,pA1,NT-1,false,false,false); RESC();
  { float sacc=pB0[0]+pB0[1]; _Pragma("unroll") for(int r=2;r<16;++r)sacc+=pB0[r]; _Pragma("unroll") for(int r=0;r<16;++r)sacc+=pB1[r]; l_reg+=sacc;
    pw0=(u32x4){PKW(pB0,0),PKW(pB0,2),PKW(pB0,4),PKW(pB0,6)};pw1=(u32x4){PKW(pB0,8),PKW(pB0,10),PKW(pB0,12),PKW(pB0,14)};pw2=(u32x4){PKW(pB1,0),PKW(pB1,2),PKW(pB1,4),PKW(pB1,6)};pw3=(u32x4){PKW(pB1,8),PKW(pB1,10),PKW(pB1,12),PKW(pB1,14)};
    SBAR(); pv(o,vb0+sl_cur,PAF(0),PAF(1),PAF(2),PAF(3)); }
  #undef PKW
  #undef PAF
  #undef VFR
  #undef PIN
  #undef MX3
  #undef GAPA
  #undef GAPB
  #undef EX
  #undef VRD
  #undef KRD
  #undef STEP
  #undef ENDW
  {auto rr=__builtin_amdgcn_permlane32_swap(__float_as_uint(l_reg),__float_as_uint(l_reg),false,false);l_reg=__uint_as_float(rr[0])+__uint_as_float(rr[1]);}
  if(hi==0)wsf[32+r32]=l_reg;asm volatile("s_waitcnt lgkmcnt(0)":::"memory");
  float rli[16];
  #pragma unroll
  for(int r=0;r<16;++r)rli[r]=__builtin_amdgcn_rcpf(wsf[32+crow(r,hi)]);
  bf16*Ow=O+(qrow0+wid*QBLK)*QP+h*D;
  { bf16*stg=(bf16*)(shm+LDS_OST)+wid*2048;
    #pragma unroll
    for(int r=0;r<16;++r){const int orow=crow(r,hi);
      #pragma unroll
      for(int d0=0;d0<2;++d0)stg[orow*64+d0*32+r32]=__float2bfloat16(o[d0][r]*rli[r]);}
    asm volatile("s_waitcnt lgkmcnt(0)":::"memory");
    #pragma unroll
    for(int i=0;i<4;++i){const int row=i*8+(lane>>3),ch=lane&7; const u32x4 v=*(const u32x4*)(stg+row*64+ch*8); ATTN_STORE16(Ow+(long)row*QP+ch*8,v);} }
  asm volatile("s_waitcnt lgkmcnt(0)\n\ts_barrier":::"memory");
  #undef DMA_K
  #undef DMA_V
  #undef CMASK
  #undef START
  #undef RESC
  #undef ROT
}
constexpr int ATTN_LDS_BYTES=LDS_BYTES;
#undef SBAR
#undef WAIT_BAR
}
typedef GAS unsigned gu32;
typedef GAS unsigned long long gu64;
#define RLX_AGENT __ATOMIC_RELAXED, __HIP_MEMORY_SCOPE_AGENT
#define LDS_WAIT() asm volatile("s_waitcnt lgkmcnt(0)" ::: "memory")
#define VM_WAIT() asm volatile("s_waitcnt vmcnt(0)" ::: "memory")
__device__ __forceinline__ unsigned long long rt() { return __builtin_amdgcn_s_memrealtime(); }

#define XB_TMO      128
#define XB_XCNT(j)  (256  + 64 * (j))
#define XB_XSUB(j)  (1280 + 64 * (j))
#define XB_XGEN(j)  (2304 + 64 * (j))
#define XB_TOP      3328
#define XB_TOPGEN   3392
#define XCD_BAR_WORDS 3456
#define XB_SPIN_CAP (1u << 18)

__device__ __forceinline__ unsigned xb_ld(unsigned* p)              { return __hip_atomic_load(p, __ATOMIC_RELAXED, __HIP_MEMORY_SCOPE_AGENT); }
__device__ __forceinline__ unsigned xb_add(unsigned* p, unsigned v) { return __hip_atomic_fetch_add(p, v, __ATOMIC_RELAXED, __HIP_MEMORY_SCOPE_AGENT); }
__device__ __forceinline__ unsigned xb_xcc_id() { return (unsigned)__builtin_amdgcn_s_getreg((3 << 11) | 20) & 0xFu; }
#define XB_SPIN(cond, bar) do { unsigned _sp = 0; while (cond) { __builtin_amdgcn_s_sleep(1); \
    if ((++_sp & 255u) == 0u) { if (xb_ld(&(bar)[XB_TMO])) break; if (_sp > XB_SPIN_CAP) { atomicAdd(&(bar)[XB_TMO], 1u); break; } } } } while (0)

struct XcdBarrier {
    unsigned* bar; unsigned x;
    volatile LAS unsigned* st;
};

__device__ __forceinline__ XcdBarrier xcd_barrier_post(unsigned* bar, volatile LAS unsigned* st) {
    XcdBarrier b; b.bar = bar; b.x = xb_xcc_id(); b.st = st;
    if (threadIdx.x == 0) (void)xb_add(&bar[XB_XCNT(b.x)], 1u);
    return b;
}
__device__ __forceinline__ void xcd_barrier_complete(unsigned* bar, unsigned x, unsigned& nloc, unsigned& nx) {
    const unsigned G = gridDim.x * gridDim.y * gridDim.z;
    unsigned sum, cnt, mine, sp = 0u;
    for (;;) {
        sum = 0u; cnt = 0u; mine = 0u;
#pragma unroll
        for (unsigned j = 0; j < 16; ++j) { const unsigned c = xb_ld(&bar[XB_XCNT(j)]); sum += c; cnt += (c > 0u) ? 1u : 0u; mine = (j == x) ? c : mine; }
        if (sum == G) break;
        __builtin_amdgcn_s_sleep(1);
        if ((++sp & 255u) == 0u) { if (xb_ld(&bar[XB_TMO])) break; if (sp > XB_SPIN_CAP) { atomicAdd(&bar[XB_TMO], 1u); break; } }
    }
    nloc = mine > 0u ? mine : 1u; nx = cnt > 0u ? cnt : 1u;
}

__device__ __forceinline__ void xcd_barrier(const XcdBarrier& b) {
    asm volatile("s_waitcnt vmcnt(0)" ::: "memory");
    __syncthreads();
    if (threadIdx.x == 0) {
        unsigned* bar = b.bar;
        __builtin_amdgcn_s_waitcnt(0);
        unsigned nloc = b.st[0], nx = b.st[1];
        if (nloc == 0u) { xcd_barrier_complete(bar, b.x, nloc, nx); b.st[0] = nloc; b.st[1] = nx; }
        const unsigned old = xb_add(&bar[XB_XSUB(b.x)], 1u);
        const unsigned gen = old / nloc;
        if (old + 1u == (gen + 1u) * nloc) {
            __builtin_amdgcn_fence(__ATOMIC_RELEASE, "agent");
            asm volatile("s_waitcnt vmcnt(0)" ::: "memory");
            const unsigned og = xb_add(&bar[XB_TOP], 1u);
            const unsigned tg = og / nx;
            if (og + 1u == (tg + 1u) * nx) xb_add(&bar[XB_TOPGEN], 1u);
            else XB_SPIN(xb_ld(&bar[XB_TOPGEN]) == tg, bar);
            __builtin_amdgcn_fence(__ATOMIC_ACQUIRE, "agent");
            xb_add(&bar[XB_XGEN(b.x)], 1u);
            asm volatile("s_waitcnt vmcnt(0)" ::: "memory");
        } else {
            XB_SPIN(xb_ld(&bar[XB_XGEN(b.x)]) == gen, bar);
            __builtin_amdgcn_fence(__ATOMIC_ACQUIRE, "agent");
            asm volatile("s_waitcnt vmcnt(0)" ::: "memory");
        }
    }
    __syncthreads();
}

DI float wave_sum(float v) {
#pragma unroll
    for (int o = 1; o < 64; o <<= 1) v += __shfl_xor(v, o);
    return v;
}
DI float wave_max(float v) {
#pragma unroll
    for (int o = 1; o < 64; o <<= 1) v = fmaxf(v, __shfl_xor(v, o));
    return v;
}
DI float wave_incl_sum(float v, int lane) {
#pragma unroll
    for (int o = 1; o < 64; o <<= 1) { const float t = __shfl_up(v, o); if (lane >= o) v += t; }
    return v;
}
DI float wave_incl_max(float v, int lane) {
#pragma unroll
    for (int o = 1; o < 64; o <<= 1) { const float t = __shfl_up(v, o); if (lane >= o) v = fmaxf(v, t); }
    return v;
}
template <int NT, int KS> DI void mma_tile(f32x4 (&acc)[NT], const LAS bf16_t* A, int lda, const LAS bf16_t* Bt, int ldb, int lane) {
    const int fr = lane & 15, fq = lane >> 4;
#pragma unroll
    for (int ks = 0; ks < KS; ++ks) {
        const bf16x8 a = *(const LAS bf16x8*)(A + fr * lda + ks * 32 + fq * 8);
#pragma unroll
        for (int nt = 0; nt < NT; ++nt) {
            const bf16x8 b = *(const LAS bf16x8*)(Bt + (nt * 16 + fr) * ldb + ks * 32 + fq * 8);
            acc[nt] = __builtin_amdgcn_mfma_f32_16x16x32_bf16(a, b, acc[nt], 0, 0, 0);
        }
    }
}

struct Ctx {
    LAS unsigned char* lds;
    unsigned char* ws;
    const float* const* in;
    float* out;
    int tid, lane, wave, G, bx;
};
#define INP(k) (C.in[k])
DI Ctx launder(const Ctx& C0) { Ctx C = C0; int t = C0.tid; asm volatile("" : "+v"(t)); C.tid = t; C.lane = t & 63; C.wave = __builtin_amdgcn_readfirstlane(t >> 6); return C; }

struct MapId { DI int operator()(int c) const { return c; } };
struct MapE1 { DI int operator()(int c) const { const int j = c >> 1; return (j >> 7) * 256 + (c & 1) * 128 + (j & 127); } };
template <class Map> DI void tr_item(const float* W, int K, int N, bf16_t* WT, LAS float* scr, int kb, int nb, int lane, Map map) {
    const int k0 = 64 * kb, n0 = 64 * nb;
    const bool nv = (n0 + lane) < N;
    const float* src = W + (size_t)k0 * N + n0 + lane;
#pragma unroll 8
    for (int i = 0; i < 64; ++i) scr[i * 65 + lane] = nv ? src[(size_t)i * N] : 0.f;
    LDS_WAIT(); asm volatile("" ::: "memory");
    const int c = lane & 7;
#pragma unroll
    for (int j = 0; j < 8; ++j) {
        const int n = (lane >> 3) + 8 * j;
        if (n0 + n < N) {
            const LAS float* s = scr + (8 * c) * 65 + n;
            v4u o; o.x = pk2(s[0], s[65]); o.y = pk2(s[130], s[195]); o.z = pk2(s[260], s[325]); o.w = pk2(s[390], s[455]);
            *(v4u*)(WT + (size_t)map(n0 + n) * K + k0 + 8 * c) = o;
        }
    }
    LDS_WAIT(); asm volatile("" ::: "memory");
}
DI void p0_prologue(const Ctx& C) {
    {
        LAS float* sc = (LAS float*)(C.lds + RING_OFF);
        LAS float* red = (LAS float*)(C.lds + RING_OFF + 9 * 1024 * 4);
        for (int i = C.tid; i < 9 * 1024; i += 512) { const float v = (i < 8192) ? INP(I_C)[i] : INP(I_CCTX)[i - 8192]; sc[i] = silu_f(v); }
        __syncthreads();
        float* MOD = (float*)(C.ws + WS_MOD);
        for (int u = C.bx; u < DEPTH * 96; u += C.G) {
            const int l = u / 96, cg = u % 96, ci = C.tid & 63, kg = C.tid >> 6;
            const float* w = INP(I_WADA) + ((size_t)l * 1024 + kg * 128) * 6144 + cg * 64 + ci;
            float s[9];
#pragma unroll
            for (int b = 0; b < 9; ++b) s[b] = 0.f;
#pragma unroll 4
            for (int k = 0; k < 128; ++k) { const float wv = w[(size_t)k * 6144];
#pragma unroll
                for (int b = 0; b < 9; ++b) s[b] += sc[b * 1024 + kg * 128 + k] * wv; }
#pragma unroll
            for (int b = 0; b < 9; ++b) red[(kg * 9 + b) * 64 + ci] = s[b];
            __syncthreads();
            for (int o = C.tid; o < 9 * 64; o += 512) { const int b = o >> 6, c2 = o & 63; float t = 0.f;
#pragma unroll
                for (int g = 0; g < 8; ++g) t += red[(g * 9 + b) * 64 + c2];
                MOD[((size_t)l * 9 + b) * 6144 + cg * 64 + c2] = t + INP(I_BADA)[l * 6144 + cg * 64 + c2]; }
            __syncthreads();
        }
    }
    {
        LAS float* scr = (LAS float*)(C.lds + RING_OFF + C.wave * 16640);
        const int gw = C.bx * 8 + C.wave, NGW = C.G * 8;
        constexpr int IT_IN = 16 * 109, IT_BR = 8 * 16, IT_OUT = 16 * 16, IT_E1 = 16 * 32, IT_E2 = 16 * 16;
        constexpr int N0 = DEPTH * IT_IN, N1 = N0 + DEPTH * 3 * IT_BR, N2 = N1 + DEPTH * IT_OUT, N3 = N2 + DEPTH * NEXP * IT_E1, N4 = N3 + DEPTH * NEXP * IT_E2;
        for (int it = gw; it < N4; it += NGW) {
            if (it < N0) { const int m = it / IT_IN, r = it % IT_IN; tr_item(INP(I_WIN) + (size_t)m * DM * IN_W, DM, IN_W, (bf16_t*)(C.ws + WS_WTIN) + (size_t)m * PW * DM, scr, r / 109, r % 109, C.lane, MapId()); }
            else if (it < N1) { const int q = it - N0, m = q / IT_BR, r = q % IT_BR; tr_item(INP(I_WBR) + (size_t)m * 512 * DM, 512, DM, (bf16_t*)(C.ws + WS_WTBR) + (size_t)m * DM * 512, scr, r / 16, r % 16, C.lane, MapId()); }
            else if (it < N2) { const int q = it - N1, m = q / IT_OUT, r = q % IT_OUT; tr_item(INP(I_WOUT) + (size_t)m * DM * DM, DM, DM, (bf16_t*)(C.ws + WS_WTOUT) + (size_t)m * DM * DM, scr, r / 16, r % 16, C.lane, MapId()); }
            else if (it < N3) { const int q = it - N2, m = q / IT_E1, r = q % IT_E1; tr_item(INP(I_WE1) + (size_t)m * DM * 2048, DM, 2048, (bf16_t*)(C.ws + WS_WTE1) + (size_t)m * 2048 * DM, scr, r / 32, r % 32, C.lane, MapE1()); }
            else { const int q = it - N3, m = q / IT_E2, r = q % IT_E2; tr_item(INP(I_WE2) + (size_t)m * DFF * DM, DFF, DM, (bf16_t*)(C.ws + WS_WTE2) + (size_t)m * DM * DFF, scr, r / 16, r % 16, C.lane, MapId()); }
        }
    }
}

DI void phase_norm1(const Ctx& C, int l) {
    const int gw = C.bx * 8 + C.wave, NGW = C.G * 8, lane = C.lane;
    float* X = (float*)(C.ws + WS_X); bf16_t* H = (bf16_t*)(C.ws + WS_H);
    const float* MOD = (const float*)(C.ws + WS_MOD);
    const int* TOKP = (const int*)(C.ws + WS_TOKP); const bf16_t* YS = (const bf16_t*)(C.ws + WS_YS);
    const bool fin = (l == DEPTH);
    const int nrows = fin ? M_LAT : MROWS;
    f32x4 gn[4];
#pragma unroll
    for (int j = 0; j < 4; ++j) gn[j] = *(const f32x4*)((fin ? INP(I_GF) : INP(I_GN1) + (size_t)l * DM) + (lane + 64 * j) * 4);
    for (int r = gw; r < nrows; r += NGW) {
        const int mi = r < M_LAT ? (r >> 12) : 8;
        f32x4 v[4];
        if (l == 0) {
            const float* src = r < M_LAT ? INP(I_X) + (size_t)r * DM : INP(I_CTX) + (size_t)(r - M_LAT) * DM;
#pragma unroll
            for (int j = 0; j < 4; ++j) v[j] = *(const f32x4*)(src + (lane + 64 * j) * 4);
        } else {
            const float* g2 = MOD + ((size_t)(l - 1) * 9 + mi) * 6144 + 5 * DM;
            const int4 sl = *(const int4*)(TOKP + (size_t)r * 4);
            const bf16_t* y0 = YS + (size_t)sl.x * DM; const bf16_t* y1 = YS + (size_t)sl.y * DM; const bf16_t* y2 = YS + (size_t)sl.z * DM; const bf16_t* y3 = YS + (size_t)sl.w * DM;
#pragma unroll
            for (int j = 0; j < 4; ++j) {
                const int c = (lane + 64 * j) * 4;
                v[j] = *(const f32x4*)(X + (size_t)r * DM + c);
                const f32x4 g = *(const f32x4*)(g2 + c);
                const v2u a = *(const v2u*)(y0 + c), b = *(const v2u*)(y1 + c), cc = *(const v2u*)(y2 + c), d = *(const v2u*)(y3 + c);
                f32x4 f;
                f[0] = ((bf2f(a.x & 0xffffu) + bf2f(b.x & 0xffffu)) + bf2f(cc.x & 0xffffu)) + bf2f(d.x & 0xffffu);
                f[1] = ((bf2f(a.x >> 16) + bf2f(b.x >> 16)) + bf2f(cc.x >> 16)) + bf2f(d.x >> 16);
                f[2] = ((bf2f(a.y & 0xffffu) + bf2f(b.y & 0xffffu)) + bf2f(cc.y & 0xffffu)) + bf2f(d.y & 0xffffu);
                f[3] = ((bf2f(a.y >> 16) + bf2f(b.y >> 16)) + bf2f(cc.y >> 16)) + bf2f(d.y >> 16);
                v[j] = v[j] + g * f;
            }
        }
        if (!fin) {
#pragma unroll
            for (int j = 0; j < 4; ++j) *(f32x4*)(X + (size_t)r * DM + (lane + 64 * j) * 4) = v[j];
        }
        float ss = 0.f;
#pragma unroll
        for (int j = 0; j < 4; ++j) ss += (v[j][0] * v[j][0] + v[j][1] * v[j][1]) + (v[j][2] * v[j][2] + v[j][3] * v[j][3]);
        const float rstd = 1.0f / sqrtf(wave_sum(ss) * (1.0f / DM) + EPS);
        if (fin) {
#pragma unroll
            for (int j = 0; j < 4; ++j) *(f32x4*)(C.out + (size_t)r * DM + (lane + 64 * j) * 4) = v[j] * rstd * gn[j];
        } else {
            const float* sh = MOD + ((size_t)l * 9 + mi) * 6144; const float* sc = sh + DM;
#pragma unroll
            for (int j = 0; j < 4; ++j) {
                const int c = (lane + 64 * j) * 4;
                const f32x4 s1 = *(const f32x4*)(sc + c), s0 = *(const f32x4*)(sh + c);
                const f32x4 h = v[j] * rstd * gn[j] * (s1 + 1.0f) + s0;
                v2u o; o.x = pk2(h[0], h[1]); o.y = pk2(h[2], h[3]);
                *(v2u*)(H + (size_t)r * DM + c) = o;
            }
        }
    }
}

DI void rope8(float (&x)[8], int lane, int t) {
    const int sub = lane & 7; const bool second = (sub & 2) != 0;
    const float pos = (sub >= 4) ? (float)(t & 63) : (float)(t >> 6);
#pragma unroll
    for (int e = 0; e < 8; ++e) {
        const int i = (sub & 1) * 8 + e;
        const float freq = exp2f(-(float)i * 0.83048202372184058696f);
        float rev = pos * freq * 0.15915494309189533577f; rev -= floorf(rev);
        const float c = __builtin_amdgcn_cosf(rev), s = __builtin_amdgcn_sinf(rev);
        const float other = __shfl_xor(x[e], 2);
        x[e] = second ? (x[e] * c + other * s) : (x[e] * c - other * s);
    }
}
DI void phase_attn_prep(const Ctx& C, int l) {
    const int gw = C.bx * 8 + C.wave, NGW = C.G * 8, lane = C.lane;
    const bf16_t* P = (const bf16_t*)(C.ws + WS_P);
    bf16_t* QR = (bf16_t*)(C.ws + WS_QR); bf16_t* KR = (bf16_t*)(C.ws + WS_KR); bf16_t* VR = (bf16_t*)(C.ws + WS_VR);
    float gq[8], gk[8];
#pragma unroll
    for (int e = 0; e < 8; ++e) { gq[e] = INP(I_BQG)[l * 64 + (lane & 7) * 8 + e]; gk[e] = INP(I_BKG)[l * 64 + (lane & 7) * 8 + e]; }
    constexpr float C2 = 0.125f * 1.4426950408889634f;
    for (int r = gw; r < MROWS; r += NGW) {
        const bool lat = r < M_LAT;
        const int b = lat ? (r >> 12) : ((r - M_LAT) >> 8), t = lat ? (r & 4095) : ((r - M_LAT) & 255), kvpos = lat ? (CTXL + t) : t;
        const bf16_t* prow = P + (size_t)r * PW;
        float x[8];
        unpack8(*(const v4u*)(prow + C_BQ + lane * 8), x);
        float ss = 0.f;
#pragma unroll
        for (int e = 0; e < 8; ++e) ss += x[e] * x[e];
        ss += __shfl_xor(ss, 1); ss += __shfl_xor(ss, 2); ss += __shfl_xor(ss, 4);
        float rstd = 1.0f / sqrtf(ss * (1.0f / 64.0f) + EPS);
#pragma unroll
        for (int e = 0; e < 8; ++e) x[e] = x[e] * rstd * gq[e];
        if (lat) rope8(x, lane, t);
        { v4u o; o.x = pk2(x[0] * C2, x[1] * C2); o.y = pk2(x[2] * C2, x[3] * C2); o.z = pk2(x[4] * C2, x[5] * C2); o.w = pk2(x[6] * C2, x[7] * C2);
          *(v4u*)(QR + (size_t)r * 512 + lane * 8) = o; }
        const int kl = lane & 15;
        unpack8(*(const v4u*)(prow + C_BK + kl * 8), x);
        ss = 0.f;
#pragma unroll
        for (int e = 0; e < 8; ++e) ss += x[e] * x[e];
        ss += __shfl_xor(ss, 1); ss += __shfl_xor(ss, 2); ss += __shfl_xor(ss, 4);
        rstd = 1.0f / sqrtf(ss * (1.0f / 64.0f) + EPS);
#pragma unroll
        for (int e = 0; e < 8; ++e) x[e] = x[e] * rstd * gk[e];
        if (lat) rope8(x, lane, t);
        const size_t kvrow = ((size_t)b * KVLEN + kvpos) * 128;
        if (lane < 16) { v4u o; o.x = pk2(x[0], x[1]); o.y = pk2(x[2], x[3]); o.z = pk2(x[4], x[5]); o.w = pk2(x[6], x[7]); *(v4u*)(KR + kvrow + kl * 8) = o; }
        else if (lane < 32) { *(v4u*)(VR + kvrow + kl * 8) = *(const v4u*)(prow + C_BV + kl * 8); }
    }
}

constexpr int SL_QS = 0, SL_KS = 9216, SL_KT = 18432, SL_VT = 27648, SL_CT = 46080, SL_SB = 64512, SL_HS = 73728, SL_LA = 107520, SL_VEC = 124160;
static_assert(SL_VEC + 16 * 64 * 4 <= RING_BYTES, "scan LDS map");
constexpr int LDT = 72;

DI void conv8(const bf16_t* P, int row0, int t, int pos0, int seqlen, int col, const float* cw, const float* cb, float (&y)[8]) {
    const bf16_t* p = P + (size_t)(row0 + t) * PW + col;
    float xm[8], x0[8], xp[8];
    unpack8(*(const v4u*)p, x0);
    if (pos0 + t - 1 >= 0) unpack8(*(const v4u*)(p - PW), xm); else {
#pragma unroll
        for (int e = 0; e < 8; ++e) xm[e] = 0.f; }
    if (pos0 + t + 1 < seqlen) unpack8(*(const v4u*)(p + PW), xp); else {
#pragma unroll
        for (int e = 0; e < 8; ++e) xp[e] = 0.f; }
#pragma unroll
    for (int e = 0; e < 8; ++e) { const float v = xm[e] * cw[col + e] + x0[e] * cw[512 + col + e] + xp[e] * cw[1024 + col + e] + cb[col + e]; y[e] = silu_f(v); }
}
DI void load_vt(const Ctx& C, const bf16_t* P, int row0, int vcol, int dir, const LAS float* wv) {
    LAS bf16_t* VT = (LAS bf16_t*)(C.lds + RING_OFF + SL_VT);
    const int t = C.tid >> 3, c8 = (C.tid & 7) * 8, j = dir ? 63 - t : t;
    const float w = wv ? wv[j] : 1.0f;
#pragma unroll
    for (int g = 0; g < 2; ++g) {
        float x[8]; unpack8(*(const v4u*)(P + (size_t)(row0 + t) * PW + vcol + g * 64 + c8), x);
#pragma unroll
        for (int e = 0; e < 8; ++e) VT[(g * 64 + c8 + e) * LDT + j] = (bf16_t)f2bf(x[e] * w);
    }
}
DI void load_ct(const Ctx& C, const float* rec) {
    LAS bf16_t* CT = (LAS bf16_t*)(C.lds + RING_OFF + SL_CT);
#pragma unroll
    for (int q = 0; q < 4; ++q) {
        const int idx = C.tid * 4 + q * 2048, v = idx >> 6, d = idx & 63;
        const f32x4 s = *(const f32x4*)(rec + idx);
        v2u o; o.x = pk2(s[0], s[1]); o.y = pk2(s[2], s[3]);
        *(LAS v2u*)(CT + v * LDT + d) = o;
    }
}
DI void delta_state(const Ctx& C, float* rec) {
    const LAS bf16_t* VT = (const LAS bf16_t*)(C.lds + RING_OFF + SL_VT); const LAS bf16_t* KT = (const LAS bf16_t*)(C.lds + RING_OFF + SL_KT);
    f32x4 acc[4];
#pragma unroll
    for (int nt = 0; nt < 4; ++nt) acc[nt] = (f32x4){0.f, 0.f, 0.f, 0.f};
    mma_tile<4, 2>(acc, VT + 16 * C.wave * LDT, LDT, KT, LDT, C.lane);
    const int fr = C.lane & 15, fq = C.lane >> 4;
#pragma unroll
    for (int nt = 0; nt < 4; ++nt)
#pragma unroll
        for (int i = 0; i < 4; ++i) rec[(16 * C.wave + fq * 4 + i) * 64 + nt * 16 + fr] = acc[nt][i];
}
template <bool DEC> DI void scores(const Ctx& C) {
    const LAS bf16_t* QS = (const LAS bf16_t*)(C.lds + RING_OFF + SL_QS); const LAS bf16_t* KS = (const LAS bf16_t*)(C.lds + RING_OFF + SL_KS);
    LAS bf16_t* SB = (LAS bf16_t*)(C.lds + RING_OFF + SL_SB); const LAS float* VEC = (const LAS float*)(C.lds + RING_OFF + SL_VEC);
    const int mt = C.wave & 3, nh = C.wave >> 2, fr = C.lane & 15, fq = C.lane >> 4;
    f32x4 acc[2]; acc[0] = (f32x4){0.f, 0.f, 0.f, 0.f}; acc[1] = acc[0];
    mma_tile<2, 2>(acc, QS + 16 * mt * LDT, LDT, KS + 32 * nh * LDT, LDT, C.lane);
#pragma unroll
    for (int nt = 0; nt < 2; ++nt)
#pragma unroll
        for (int i = 0; i < 4; ++i) {
            const int j = 16 * mt + fq * 4 + i, s = 32 * nh + nt * 16 + fr;
            float v = acc[nt][i];
            if (DEC) v *= __expf(VEC[0 * 64 + s] - VEC[1 * 64 + j]);
            SB[j * LDT + s] = (bf16_t)f2bf(s <= j ? v : 0.f);
        }
}
template <bool SCALE> DI void out_tile(const Ctx& C, f32x4 (&acc)[4]) {
    const LAS bf16_t* QS = (const LAS bf16_t*)(C.lds + RING_OFF + SL_QS); const LAS bf16_t* CT = (const LAS bf16_t*)(C.lds + RING_OFF + SL_CT);
    const LAS bf16_t* SB = (const LAS bf16_t*)(C.lds + RING_OFF + SL_SB); const LAS bf16_t* VT = (const LAS bf16_t*)(C.lds + RING_OFF + SL_VT);
    const LAS float* VEC = (const LAS float*)(C.lds + RING_OFF + SL_VEC);
    const int mt = C.wave & 3, vh = C.wave >> 2, fq = C.lane >> 4;
#pragma unroll
    for (int nt = 0; nt < 4; ++nt) acc[nt] = (f32x4){0.f, 0.f, 0.f, 0.f};
    mma_tile<4, 2>(acc, QS + 16 * mt * LDT, LDT, CT + 64 * vh * LDT, LDT, C.lane);
    if (SCALE) {
#pragma unroll
        for (int i = 0; i < 4; ++i) { const float w = VEC[2 * 64 + 16 * mt + fq * 4 + i];
#pragma unroll
            for (int nt = 0; nt < 4; ++nt) acc[nt][i] *= w; }
    }
    mma_tile<4, 2>(acc, SB + 16 * mt * LDT, LDT, VT + 64 * vh * LDT, LDT, C.lane);
}
template <bool SCALE> DI void accum_hs(const Ctx& C, const f32x4 (&acc)[4], int dir) {
    LAS float* HS = (LAS float*)(C.lds + RING_OFF + SL_HS); const LAS float* VEC = (const LAS float*)(C.lds + RING_OFF + SL_VEC);
    const int mt = C.wave & 3, vh = C.wave >> 2, fr = C.lane & 15, fq = C.lane >> 4;
#pragma unroll
    for (int i = 0; i < 4; ++i) {
        const int j = 16 * mt + fq * 4 + i, t = dir ? 63 - j : j;
        const float w = SCALE ? VEC[3 * 64 + j] : 1.0f;
#pragma unroll
        for (int nt = 0; nt < 4; ++nt) { const int v = 64 * vh + nt * 16 + fr; const float val = acc[nt][i] * w; if (dir == 0) HS[t * 132 + v] = val; else HS[t * 132 + v] += val; }
    }
}
template <int ACT> DI void head_out(const Ctx& C, const bf16_t* P, int row0, int gcol, const float* gain, bf16_t* Y, int h) {
    const LAS float* HS = (const LAS float*)(C.lds + RING_OFF + SL_HS);
    const int t = C.tid >> 3, sub = C.tid & 7;
    float x[16]; float ss = 0.f;
#pragma unroll
    for (int q = 0; q < 4; ++q) { const f32x4 v = *(const LAS f32x4*)(HS + t * 132 + sub * 16 + q * 4); x[4 * q] = v[0]; x[4 * q + 1] = v[1]; x[4 * q + 2] = v[2]; x[4 * q + 3] = v[3]; }
#pragma unroll
    for (int e = 0; e < 16; ++e) ss += x[e] * x[e];
    ss += __shfl_xor(ss, 1); ss += __shfl_xor(ss, 2); ss += __shfl_xor(ss, 4);
    const float rstd = 1.0f / sqrtf(ss * (1.0f / 128.0f) + EPS);
    const bf16_t* gp = P + (size_t)(row0 + t) * PW + gcol + h * 128 + sub * 16;
    float ga[8], gb[8]; unpack8(*(const v4u*)gp, ga); unpack8(*(const v4u*)(gp + 8), gb);
    float o[16];
#pragma unroll
    for (int e = 0; e < 16; ++e) { const float gv = e < 8 ? ga[e] : gb[e - 8]; const float a = ACT == 0 ? sigmoid_f(gv) : silu_f(gv); o[e] = x[e] * rstd * gain[h * 128 + sub * 16 + e] * a; }
    v4u w0, w1; w0.x = pk2(o[0], o[1]); w0.y = pk2(o[2], o[3]); w0.z = pk2(o[4], o[5]); w0.w = pk2(o[6], o[7]); w1.x = pk2(o[8], o[9]); w1.y = pk2(o[10], o[11]); w1.z = pk2(o[12], o[13]); w1.w = pk2(o[14], o[15]);
    bf16_t* yp = Y + (size_t)(row0 + t) * 512 + h * 128 + sub * 16;
    *(v4u*)yp = w0; *(v4u*)(yp + 8) = w1;
}

DI void mlstm_gates(const Ctx& C, const bf16_t* P, int row0, int l, int h, int dir, float& iv, float& fv) {
    const int t = dir ? 63 - C.lane : C.lane;
    const bf16_t* prow = P + (size_t)(row0 + t) * PW;
    const float* gb = INP(I_AGB) + l * 16;
    iv = bf2f(prow[C_AI + dir * 4 + h]) + gb[dir * 4 + h];
    fv = logsigmoid_f(bf2f(prow[C_AF + dir * 4 + h]) + gb[8 + dir * 4 + h]);
}
DI void mlstm_a_unit(const Ctx& C, int l, int c, int h) {
    const bf16_t* P = (const bf16_t*)(C.ws + WS_P);
    const int row0 = c * 64, pos0 = (c < 512 ? (c & 63) : ((c - 512) & 3)) * 64, seqlen = c < 512 ? SEQ : CTXL;
    const float* cw = INP(I_ACW) + (size_t)l * 3 * 512; const float* cb = INP(I_ACB) + (size_t)l * 512;
    LAS float* VEC = (LAS float*)(C.lds + RING_OFF + SL_VEC); LAS bf16_t* KT = (LAS bf16_t*)(C.lds + RING_OFF + SL_KT);
    for (int dir = 0; dir < 2; ++dir) {
        float* rec = (float*)(C.ws + WS_STA) + ((size_t)(c * 4 + h) * 2 + dir) * REC;
        __syncthreads();
        if (C.wave == 0) {
            float iv, fv; mlstm_gates(C, P, row0, l, h, dir, iv, fv);
            const float b = wave_incl_sum(fv, C.lane);
            const float B = __shfl(b, 63);
            const float a = B - b + iv;
            const float Ml = wave_max(a);
            VEC[4 * 64 + C.lane] = __expf(a - Ml);
            if (C.lane == 0) { rec[8256] = B; rec[8257] = Ml; }
        }
        __syncthreads();
        {
            const int t = C.tid >> 3, c8 = (C.tid & 7) * 8, j = dir ? 63 - t : t;
            float y[8]; conv8(P, row0, t, pos0, seqlen, C_AQK + 256 + h * 64 + c8, cw, cb, y);
#pragma unroll
            for (int e = 0; e < 8; ++e) KT[(c8 + e) * LDT + j] = (bf16_t)f2bf(y[e] * 0.125f);
        }
        load_vt(C, P, row0, C_AV + h * 128, dir, VEC + 4 * 64);
        __syncthreads();
        delta_state(C, rec);
        if (C.wave == 1) { float s = 0.f;
#pragma unroll 8
            for (int q = 0; q < 64; ++q) s += bf2f(KT[C.lane * LDT + q]) * VEC[4 * 64 + q];
            rec[8192 + C.lane] = s; }
    }
}
DI void mlstm_c_unit(const Ctx& C, int l, int c, int h) {
    const bf16_t* P = (const bf16_t*)(C.ws + WS_P);
    const int row0 = c * 64, pos0 = (c < 512 ? (c & 63) : ((c - 512) & 3)) * 64, seqlen = c < 512 ? SEQ : CTXL;
    const float* cw = INP(I_ACW) + (size_t)l * 3 * 512; const float* cb = INP(I_ACB) + (size_t)l * 512;
    LAS float* VEC = (LAS float*)(C.lds + RING_OFF + SL_VEC);
    LAS bf16_t* QS = (LAS bf16_t*)(C.lds + RING_OFF + SL_QS); LAS bf16_t* KS = (LAS bf16_t*)(C.lds + RING_OFF + SL_KS); const LAS bf16_t* SB = (const LAS bf16_t*)(C.lds + RING_OFF + SL_SB);
    for (int dir = 0; dir < 2; ++dir) {
        const float* rec = (const float*)(C.ws + WS_STA) + ((size_t)(c * 4 + h) * 2 + dir) * REC;
        __syncthreads();
        if (C.wave == 0) {
            float iv, fv; mlstm_gates(C, P, row0, l, h, dir, iv, fv);
            const float b = wave_incl_sum(fv, C.lane);
            const float g = iv - b;
            const float cm = wave_incl_max(g, C.lane);
            const float m0 = rec[8258];
            const float mm = fmaxf(m0, cm);
            VEC[0 * 64 + C.lane] = g; VEC[1 * 64 + C.lane] = mm; VEC[2 * 64 + C.lane] = __expf(m0 - mm); VEC[5 * 64 + C.lane] = __expf(-(b + mm));
        } else if (C.wave == 1) VEC[6 * 64 + C.lane] = rec[8192 + C.lane];
        {
            const int t = C.tid >> 3, c8 = (C.tid & 7) * 8, j = dir ? 63 - t : t;
            float y[8];
            conv8(P, row0, t, pos0, seqlen, C_AQK + h * 64 + c8, cw, cb, y);
            { v4u o; o.x = pk2(y[0], y[1]); o.y = pk2(y[2], y[3]); o.z = pk2(y[4], y[5]); o.w = pk2(y[6], y[7]); *(LAS v4u*)(QS + j * LDT + c8) = o; }
            conv8(P, row0, t, pos0, seqlen, C_AQK + 256 + h * 64 + c8, cw, cb, y);
            { v4u o; o.x = pk2(y[0] * 0.125f, y[1] * 0.125f); o.y = pk2(y[2] * 0.125f, y[3] * 0.125f); o.z = pk2(y[4] * 0.125f, y[5] * 0.125f); o.w = pk2(y[6] * 0.125f, y[7] * 0.125f); *(LAS v4u*)(KS + j * LDT + c8) = o; }
        }
        load_vt(C, P, row0, C_AV + h * 128, dir, nullptr);
        load_ct(C, rec);
        __syncthreads();
        scores<true>(C);
        __syncthreads();
        if (C.wave == 0) {
            const int j = C.lane; float rs = 0.f, qn = 0.f;
#pragma unroll 8
            for (int s = 0; s < 64; ++s) { rs += bf2f(SB[j * LDT + s]); qn += bf2f(QS[j * LDT + s]) * VEC[6 * 64 + s]; }
            const float den = rs + VEC[2 * 64 + j] * qn;
            VEC[3 * 64 + j] = 1.0f / fmaxf(fabsf(den), VEC[5 * 64 + j]);
        }
        f32x4 acc[4];
        out_tile<true>(C, acc);
        __syncthreads();
        accum_hs<true>(C, acc, dir);
    }
    __syncthreads();
    head_out<0>(C, P, row0, C_AO, INP(I_ANG) + (size_t)l * 512, (bf16_t*)(C.ws + WS_YA), h);
}

DI void gla_logdecay(const Ctx& C, const bf16_t* P, int row0, int l, int h, int dir) {
    LAS float* LA = (LAS float*)(C.lds + RING_OFF + SL_LA);
    {
        const int t = C.tid >> 3, c8 = (C.tid & 7) * 8, j = dir ? 63 - t : t;
        const bf16_t* lp = P + (size_t)(row0 + t) * PW + C_CA + dir * 16;
        float lo[16]; { float a[8], b[8]; unpack8(*(const v4u*)lp, a); unpack8(*(const v4u*)(lp + 8), b);
#pragma unroll
            for (int e = 0; e < 8; ++e) { lo[e] = a[e]; lo[8 + e] = b[e]; } }
        const float* wu = INP(I_CWUP) + ((size_t)(l * 2 + dir) * 16) * 256 + h * 64 + c8;
        const float* bu = INP(I_CBUP) + (size_t)(l * 2 + dir) * 256 + h * 64 + c8;
        float x[8];
#pragma unroll
        for (int e = 0; e < 8; ++e) x[e] = bu[e];
#pragma unroll
        for (int i = 0; i < 16; ++i)
#pragma unroll
            for (int e = 0; e < 8; ++e) x[e] += lo[i] * wu[i * 256 + e];
#pragma unroll
        for (int e = 0; e < 8; ++e) LA[j * 65 + c8 + e] = logsigmoid_f(x[e]) * (1.0f / 16.0f);
    }
    __syncthreads();
    if (C.wave == 0) { float a = 0.f;
#pragma unroll 8
        for (int s = 0; s < 64; ++s) { a += LA[s * 65 + C.lane]; LA[s * 65 + C.lane] = a; } }
    __syncthreads();
}
DI void gla_a_unit(const Ctx& C, int l, int c, int h) {
    const bf16_t* P = (const bf16_t*)(C.ws + WS_P);
    const int row0 = c * 64;
    const LAS float* LA = (const LAS float*)(C.lds + RING_OFF + SL_LA); LAS bf16_t* KT = (LAS bf16_t*)(C.lds + RING_OFF + SL_KT);
    for (int dir = 0; dir < 2; ++dir) {
        float* rec = (float*)(C.ws + WS_STC) + ((size_t)(c * 4 + h) * 2 + dir) * REC;
        __syncthreads();
        gla_logdecay(C, P, row0, l, h, dir);
        {
            const int t = C.tid >> 3, c8 = (C.tid & 7) * 8, j = dir ? 63 - t : t;
            float k[8]; unpack8(*(const v4u*)(P + (size_t)(row0 + t) * PW + C_CK + h * 64 + c8), k);
#pragma unroll
            for (int e = 0; e < 8; ++e) KT[(c8 + e) * LDT + j] = (bf16_t)f2bf(k[e] * __expf(LA[63 * 65 + c8 + e] - LA[j * 65 + c8 + e]));
        }
        if (C.tid < 64) rec[8192 + C.tid] = __expf(LA[63 * 65 + C.tid]);
        load_vt(C, P, row0, C_CV + h * 128, dir, nullptr);
        __syncthreads();
        delta_state(C, rec);
    }
}
DI void gla_c_unit(const Ctx& C, int l, int c, int h) {
    const bf16_t* P = (const bf16_t*)(C.ws + WS_P);
    const int row0 = c * 64;
    const LAS float* LA = (const LAS float*)(C.lds + RING_OFF + SL_LA);
    LAS bf16_t* QS = (LAS bf16_t*)(C.lds + RING_OFF + SL_QS); LAS bf16_t* KS = (LAS bf16_t*)(C.lds + RING_OFF + SL_KS);
    for (int dir = 0; dir < 2; ++dir) {
        const float* rec = (const float*)(C.ws + WS_STC) + ((size_t)(c * 4 + h) * 2 + dir) * REC;
        __syncthreads();
        gla_logdecay(C, P, row0, l, h, dir);
        {
            const int t = C.tid >> 3, c8 = (C.tid & 7) * 8, j = dir ? 63 - t : t;
            float q[8], k[8]; unpack8(*(const v4u*)(P + (size_t)(row0 + t) * PW + C_CQ + h * 64 + c8), q); unpack8(*(const v4u*)(P + (size_t)(row0 + t) * PW + C_CK + h * 64 + c8), k);
            float eb[8];
#pragma unroll
            for (int e = 0; e < 8; ++e) { const float bb = LA[j * 65 + c8 + e]; eb[e] = __expf(bb); q[e] = q[e] * 0.125f * eb[e]; k[e] = k[e] * __expf(-bb); }
            { v4u o; o.x = pk2(q[0], q[1]); o.y = pk2(q[2], q[3]); o.z = pk2(q[4], q[5]); o.w = pk2(q[6], q[7]); *(LAS v4u*)(QS + j * LDT + c8) = o; }
            { v4u o; o.x = pk2(k[0], k[1]); o.y = pk2(k[2], k[3]); o.z = pk2(k[4], k[5]); o.w = pk2(k[6], k[7]); *(LAS v4u*)(KS + j * LDT + c8) = o; }
        }
        load_vt(C, P, row0, C_CV + h * 128, dir, nullptr);
        load_ct(C, rec);
        __syncthreads();
        scores<false>(C);
        __syncthreads();
        f32x4 acc[4];
        out_tile<false>(C, acc);
        accum_hs<false>(C, acc, dir);
    }
    __syncthreads();
    head_out<1>(C, P, row0, C_CR, INP(I_CNG) + (size_t)l * 512, (bf16_t*)(C.ws + WS_YC), h);
}

DI int chain_chunk(int b, int dir, int n) { return n < 4 ? 512 + 4 * b + (dir ? 3 - n : n) : 64 * b + (dir ? 67 - n : n - 4); }
DI void scan_b_units(const Ctx& C) {
    for (int u = C.bx; u < 512; u += C.G) {
        const int mixer = u >> 8, item = (u & 255) * 2 + (C.tid >> 8), chain = item >> 3, slab = item & 7;
        const int b = chain >> 3, h = (chain >> 1) & 3, dir = chain & 1, tl = C.tid & 255, elem = slab * 1024 + tl * 4;
        float* base = (float*)(C.ws + (mixer ? WS_STC : WS_STA));
        f32x4 st = (f32x4){0.f, 0.f, 0.f, 0.f};
        if (mixer == 0) {
            const bool nthr = (slab == 0 && tl < 64), mthr = (slab == 0 && tl == 0);
            float m = 0.f, nst = 0.f;
            f32x4 d[4]; float sB[4], sM[4], dn[4];
#pragma unroll
            for (int q = 0; q < 4; ++q) { float* rec = base + ((size_t)(chain_chunk(b, dir, q) * 4 + h) * 2 + dir) * REC; d[q] = *(const f32x4*)(rec + elem); sB[q] = rec[8256]; sM[q] = rec[8257]; dn[q] = nthr ? rec[8192 + tl] : 0.f; }
            for (int n0 = 0; n0 < 68; n0 += 4) {
#pragma unroll
                for (int q = 0; q < 4; ++q) {
                    const int n = n0 + q;
                    float* rec = base + ((size_t)(chain_chunk(b, dir, n) * 4 + h) * 2 + dir) * REC;
                    const f32x4 dd = d[q]; const float B = sB[q], Ml = sM[q], dnn = dn[q];
                    *(f32x4*)(rec + elem) = st;
                    if (nthr) rec[8192 + tl] = nst;
                    if (mthr) rec[8258] = m;
                    if (n + 4 < 68) { float* r2 = base + ((size_t)(chain_chunk(b, dir, n + 4) * 4 + h) * 2 + dir) * REC; d[q] = *(const f32x4*)(r2 + elem); sB[q] = r2[8256]; sM[q] = r2[8257]; dn[q] = nthr ? r2[8192 + tl] : 0.f; }
                    const float mn = fmaxf(B + m, Ml), dec = __expf(B + m - mn), sc = __expf(Ml - mn);
                    st = st * dec + dd * sc; nst = nst * dec + dnn * sc; m = mn;
                }
            }
        } else {
            f32x4 d[4], dc[4];
#pragma unroll
            for (int q = 0; q < 4; ++q) { const float* rec = base + ((size_t)(chain_chunk(b, dir, q) * 4 + h) * 2 + dir) * REC; d[q] = *(const f32x4*)(rec + elem); dc[q] = *(const f32x4*)(rec + 8192 + (elem & 63)); }
            for (int n0 = 0; n0 < 68; n0 += 4) {
#pragma unroll
                for (int q = 0; q < 4; ++q) {
                    const int n = n0 + q;
                    float* rec = base + ((size_t)(chain_chunk(b, dir, n) * 4 + h) * 2 + dir) * REC;
                    const f32x4 dd = d[q], de = dc[q];
                    *(f32x4*)(rec + elem) = st;
                    if (n + 4 < 68) { const float* r2 = base + ((size_t)(chain_chunk(b, dir, n + 4) * 4 + h) * 2 + dir) * REC; d[q] = *(const f32x4*)(r2 + elem); dc[q] = *(const f32x4*)(r2 + 8192 + (elem & 63)); }
                    st = st * de + dd;
                }
            }
        }
    }
}

constexpr int WRT_LD = 1028;
constexpr int RL_CNT = 32 * WRT_LD * 4;
static_assert(RL_CNT + 3 * 32 * 4 <= RING_BYTES, "router LDS map");
DI void phase_norm2_router(const Ctx& C, int l) {
    const int gw = C.bx * 8 + C.wave, NGW = C.G * 8, lane = C.lane;
    float* X = (float*)(C.ws + WS_X); bf16_t* H = (bf16_t*)(C.ws + WS_H);
    const float* MOD = (const float*)(C.ws + WS_MOD);
    int* TOKE = (int*)(C.ws + WS_TOKE); int* TOKP = (int*)(C.ws + WS_TOKP); float* TOKW = (float*)(C.ws + WS_TOKW);
    LAS float* WrT = (LAS float*)(C.lds + RING_OFF); LAS int* cnt = (LAS int*)(C.lds + RING_OFF + RL_CNT);
    {
        const float* Wr = INP(I_WR) + (size_t)l * DM * NEXP;
        for (int idx = C.tid; idx < DM * NEXP; idx += 512) WrT[(idx & 31) * WRT_LD + (idx >> 5)] = Wr[idx];
        if (C.tid < 32) cnt[C.tid] = 0;
    }
    __syncthreads();
    f32x4 gn[4];
#pragma unroll
    for (int j = 0; j < 4; ++j) gn[j] = *(const f32x4*)(INP(I_GN2) + (size_t)l * DM + (lane + 64 * j) * 4);
    const float brl = lane < 32 ? INP(I_BR)[l * NEXP + lane] : 0.f;
    const int npairs = (l == DEPTH - 1 ? M_LAT : MROWS) / 2;
    for (int p = gw; p < npairs; p += NGW) {
        const int r0 = 2 * p, mi = r0 < M_LAT ? (r0 >> 12) : 8;
        const float* sh = MOD + ((size_t)l * 9 + mi) * 6144 + 3 * DM; const float* sc = sh + DM;
        f32x4 h[2][4];
#pragma unroll
        for (int q = 0; q < 2; ++q) {
            float ss = 0.f;
#pragma unroll
            for (int j = 0; j < 4; ++j) { h[q][j] = *(const f32x4*)(X + (size_t)(r0 + q) * DM + (lane + 64 * j) * 4); ss += (h[q][j][0] * h[q][j][0] + h[q][j][1] * h[q][j][1]) + (h[q][j][2] * h[q][j][2] + h[q][j][3] * h[q][j][3]); }
            const float rstd = 1.0f / sqrtf(wave_sum(ss) * (1.0f / DM) + EPS);
#pragma unroll
            for (int j = 0; j < 4; ++j) {
                const int c = (lane + 64 * j) * 4;
                const f32x4 s1 = *(const f32x4*)(sc + c), s0 = *(const f32x4*)(sh + c);
                h[q][j] = h[q][j] * rstd * gn[j] * (s1 + 1.0f) + s0;
                v2u o; o.x = pk2(h[q][j][0], h[q][j][1]); o.y = pk2(h[q][j][2], h[q][j][3]);
                *(v2u*)(H + (size_t)(r0 + q) * DM + c) = o;
            }
        }
        float my0 = -INFINITY, my1 = -INFINITY;
#pragma unroll 1
        for (int e = 0; e < NEXP; ++e) {
            float a0 = 0.f, a1 = 0.f;
#pragma unroll
            for (int j = 0; j < 4; ++j) { const f32x4 w = *(const LAS f32x4*)(WrT + e * WRT_LD + (lane + 64 * j) * 4);
                a0 += (h[0][j][0] * w[0] + h[0][j][1] * w[1]) + (h[0][j][2] * w[2] + h[0][j][3] * w[3]);
                a1 += (h[1][j][0] * w[0] + h[1][j][1] * w[1]) + (h[1][j][2] * w[2] + h[1][j][3] * w[3]); }
            a0 = wave_sum(a0); a1 = wave_sum(a1);
            if (lane == e) { my0 = a0 + brl; my1 = a1 + brl; }
        }
#pragma unroll
        for (int q = 0; q < 2; ++q) {
            float my = q ? my1 : my0;
            float tv[4]; int ti[4];
#pragma unroll
            for (int k = 0; k < 4; ++k) {
                float v = my; int i = lane;
#pragma unroll
                for (int o = 1; o < 64; o <<= 1) { const float ov = __shfl_xor(v, o); const int oi = __shfl_xor(i, o); if (ov > v || (ov == v && oi < i)) { v = ov; i = oi; } }
                tv[k] = v; ti[k] = i; if (lane == i) my = -INFINITY;
            }
            const float e1 = __expf(tv[1] - tv[0]), e2 = __expf(tv[2] - tv[0]), e3 = __expf(tv[3] - tv[0]);
            const float inv = 1.0f / (((1.0f + e1) + e2) + e3);
            if (lane < 4) {
                const int ek = lane == 0 ? ti[0] : lane == 1 ? ti[1] : lane == 2 ? ti[2] : ti[3];
                const float wk = (lane == 0 ? 1.0f : lane == 1 ? e1 : lane == 2 ? e2 : e3) * inv;
                const int pos = atomicAdd((int*)(cnt + ek), 1);
                const size_t o = (size_t)(r0 + q) * 4 + lane;
                TOKE[o] = ek; TOKP[o] = pos; TOKW[o] = wk;
            }
        }
    }
    __syncthreads();
    if (C.tid < 32) ((int*)(C.ws + WS_BLKCNT))[C.bx * 32 + C.tid] = cnt[C.tid];
}

DI void phase_gather(const Ctx& C, int l) {
    const int gw = C.bx * 8 + C.wave, NGW = C.G * 8, lane = C.lane;
    const bf16_t* H = (const bf16_t*)(C.ws + WS_H); bf16_t* XG = (bf16_t*)(C.ws + WS_XG);
    const int* TOKE = (const int*)(C.ws + WS_TOKE); int* TOKP = (int*)(C.ws + WS_TOKP); const float* TOKW = (const float*)(C.ws + WS_TOKW);
    float* SLOTW = (float*)(C.ws + WS_SLOTW); int* META = (int*)(C.ws + WS_MOEMETA);
    const int* BLKCNT = (const int*)(C.ws + WS_BLKCNT);
    LAS int* base = (LAS int*)(C.lds + RING_OFF + RL_CNT + 128); LAS int* tot = (LAS int*)(C.lds + RING_OFF + RL_CNT + 256);
    __syncthreads();
    if (C.tid < 32) {
        int t = 0, pre = 0;
        for (int b = 0; b < C.G; ++b) { const int c = BLKCNT[b * 32 + C.tid]; pre += (b < C.bx) ? c : 0; t += c; }
        tot[C.tid] = t; base[C.tid] = pre;
    }
    __syncthreads();
    if (C.tid == 0) {
        int off = 0;
#pragma unroll 1
        for (int e = 0; e < NEXP; ++e) {
            const int padded = (tot[e] + 255) & ~255;
            base[e] += off;
            if (C.bx == 0) {
#pragma unroll 1
                for (int t = off >> 8; t < ((off + padded) >> 8); ++t) META[16 + t] = e; }
            off += padded;
        }
        if (C.bx == 0) META[0] = off >> 8;
    }
    __syncthreads();
    const int npairs = (l == DEPTH - 1 ? M_LAT : MROWS) / 2;
    for (int p = gw; p < npairs; p += NGW) {
#pragma unroll
        for (int q = 0; q < 2; ++q) {
            const int r = 2 * p + q;
            const int4 e4 = *(const int4*)(TOKE + (size_t)r * 4); const int4 p4 = *(const int4*)(TOKP + (size_t)r * 4); const f32x4 w4 = *(const f32x4*)(TOKW + (size_t)r * 4);
            const int s0 = base[e4.x] + p4.x, s1 = base[e4.y] + p4.y, s2 = base[e4.z] + p4.z, s3 = base[e4.w] + p4.w;
            const v4u a = *(const v4u*)(H + (size_t)r * DM + lane * 8), b = *(const v4u*)(H + (size_t)r * DM + 512 + lane * 8);
            *(v4u*)(XG + (size_t)s0 * DM + lane * 8) = a; *(v4u*)(XG + (size_t)s0 * DM + 512 + lane * 8) = b;
            *(v4u*)(XG + (size_t)s1 * DM + lane * 8) = a; *(v4u*)(XG + (size_t)s1 * DM + 512 + lane * 8) = b;
            *(v4u*)(XG + (size_t)s2 * DM + lane * 8) = a; *(v4u*)(XG + (size_t)s2 * DM + 512 + lane * 8) = b;
            *(v4u*)(XG + (size_t)s3 * DM + lane * 8) = a; *(v4u*)(XG + (size_t)s3 * DM + 512 + lane * 8) = b;
            if (lane == 0) { *(int4*)(TOKP + (size_t)r * 4) = make_int4(s0, s1, s2, s3); SLOTW[s0] = w4[0]; SLOTW[s1] = w4[1]; SLOTW[s2] = w4[2]; SLOTW[s3] = w4[3]; }
        }
    }
}

DI void phase_attention(const Ctx& C, char* lds_generic) {
    typedef attn_body::bf16 abf;
    const abf* QR = (const abf*)(C.ws + WS_QR); const abf* KR = (const abf*)(C.ws + WS_KR); const abf* VR = (const abf*)(C.ws + WS_VR); abf* YB = (abf*)(C.ws + WS_YB);
    const int vcu = (C.G % 8 == 0) ? (C.bx % 8) * (C.G / 8) + C.bx / 8 : C.bx;
    const int per = (1024 + C.G - 1) / C.G;
    for (int i = 0; i < per; ++i) {
        const int idx = vcu * per + i; if (idx >= 1024) break;
        const int grp = idx >> 6, b = grp >> 1, kvh = grp & 1, hq = kvh * 4 + ((idx >> 4) & 3), qb = idx & 15;
        attn_body::attn_unit<8>((long)b * SEQ + qb * 256, hq, KVLEN / 64, QR, KR + (size_t)b * KVLEN * 128 + kvh * 64, VR + (size_t)b * KVLEN * 128 + kvh * 64, YB, lds_generic);
    }
    for (int idx = C.bx; idx < 64; idx += C.G) {
        const int b = idx >> 3, hq = idx & 7;
        attn_body::attn_unit<8>((long)M_LAT + b * CTXL, hq, CTXL / 64, QR, KR + (size_t)b * KVLEN * 128 + (hq >> 2) * 64, VR + (size_t)b * KVLEN * 128 + (hq >> 2) * 64, YB, lds_generic);
    }
}

constexpr int NPH = 11;
constexpr int N_PHASES = 1 + DEPTH * NPH + 1;
struct KArgs { const float* in[N_IN]; float* out; unsigned char* ws; int ph_lo, ph_hi; };
static_assert(sizeof(KArgs) == N_IN * 8 + 8 + 8 + 8, "no padding bytes in the argument struct");

__global__ void __launch_bounds__(512, 2) mk_fwd(KArgs args) {
    extern __shared__ __attribute__((aligned(16))) unsigned char lds[];
    Ctx C;
    C.lds = (LAS unsigned char*)lds; C.ws = args.ws; C.in = args.in; C.out = args.out;
    C.tid = threadIdx.x; C.lane = C.tid & 63; C.wave = __builtin_amdgcn_readfirstlane(C.tid >> 6); C.G = gridDim.x; C.bx = blockIdx.x;
    for (int u = C.tid; u < (LDS_BYTES - LDSCTL_OFF) / 4; u += 512) ((LAS unsigned*)(C.lds + LDSCTL_OFF))[u] = 0u;
    __syncthreads();
    const int lo = args.ph_lo, hi = args.ph_hi;
    gu32* ctl = (gu32*)(C.ws + WS_CTL);
    XcdBarrier bar; bar.bar = (unsigned*)ctl + CW_BAR; bar.x = 0; bar.st = (volatile LAS unsigned*)(C.lds + MISC_OFF) + 8;
    if (hi - lo > 1) bar = xcd_barrier_post((unsigned*)ctl + CW_BAR, (volatile LAS unsigned*)(C.lds + MISC_OFF) + 8);
#define IN(k) (lo <= (k) && (k) < hi)
#ifndef PH_MASK
#define PH_MASK 0x1fff
#endif
#define ENAB(k) (((PH_MASK) >> (k)) & 1)
#define SEAM(k) do { if (IN(k) && IN((k) + 1)) xcd_barrier(bar); } while (0)
    PG8_LAS unsigned char* glds = (PG8_LAS unsigned char*)(C.lds + RING_OFF);
    bf16_t* const Hb = (bf16_t*)(C.ws + WS_H); bf16_t* const Pb = (bf16_t*)(C.ws + WS_P); bf16_t* const MRG = (bf16_t*)(C.ws + WS_MRG);
    float* const X = (float*)(C.ws + WS_X); const float* const MOD = (const float*)(C.ws + WS_MOD);
    const int* const META = (const int*)(C.ws + WS_MOEMETA);

    if (ENAB(0) && IN(0)) p0_prologue(launder(C));
    SEAM(0);
    for (int l = 0; l < DEPTH; ++l) {
        const int p = 1 + l * NPH;
        if (ENAB(1) && IN(p + 0)) phase_norm1(launder(C), l);
        SEAM(p + 0);
        if (ENAB(2) && IN(p + 1)) {
            pg8::Gemm g{Hb, (const bf16_t*)(C.ws + WS_WTIN) + (size_t)l * PW * DM, MROWS, PW, DM, 0};
            pg8::StaticOrder S; S.init(MROWS, PW, C.G, C.bx);
            pg8::EpiStoreBf16 E{Pb, PW};
            pg8::gemm_phase<pg8::EpiStoreBf16, pg8::StaticOrder, true, true>(glds, g, S, E);
        }
        SEAM(p + 1);
        if (ENAB(3) && IN(p + 2)) {
            phase_attn_prep(launder(C), l);
            { const Ctx Cp = launder(C); for (int u = C.bx; u < NCHUNK * 4; u += C.G) mlstm_a_unit(Cp, l, u >> 2, u & 3); }
            { const Ctx Cp = launder(C); for (int u = C.bx; u < NCHUNK * 4; u += C.G) gla_a_unit(Cp, l, u >> 2, u & 3); }
        }
        SEAM(p + 2);
        if (ENAB(4) && IN(p + 3)) {
            scan_b_units(launder(C));
            __syncthreads();
            phase_attention(launder(C), (char*)lds + RING_OFF);
        }
        SEAM(p + 3);
        if (ENAB(5) && IN(p + 4)) {
            { const Ctx Cp = launder(C); for (int u = C.bx; u < NCHUNK * 4; u += C.G) mlstm_c_unit(Cp, l, u >> 2, u & 3); }
            { const Ctx Cp = launder(C); for (int u = C.bx; u < NCHUNK * 4; u += C.G) gla_c_unit(Cp, l, u >> 2, u & 3); }
        }
        SEAM(p + 4);
        if (ENAB(6) && IN(p + 5)) {
            for (int n = 0; n < 3; ++n) {
                pg8::Gemm g{(const bf16_t*)(C.ws + (n == 0 ? WS_YA : n == 1 ? WS_YB : WS_YC)), (const bf16_t*)(C.ws + WS_WTBR) + ((size_t)l * 3 + n) * DM * 512, MROWS, DM, 512, 0};
                pg8::StaticOrder S; S.init(MROWS, DM, C.G, C.bx);
                pg8::EpiBranch E{MRG, Pb, PW, C_GATE + n * DM, n == 0 ? 1 : 0};
                pg8::gemm_phase<pg8::EpiBranch, pg8::StaticOrder, true, true>(glds, g, S, E);
            }
        }
        SEAM(p + 5);
        if (ENAB(7) && IN(p + 6)) {
            pg8::Gemm g{MRG, (const bf16_t*)(C.ws + WS_WTOUT) + (size_t)l * DM * DM, MROWS, DM, DM, 0};
            pg8::StaticOrder S; S.init(MROWS, DM, C.G, C.bx);
            pg8::EpiResid E{X, MOD + (size_t)l * 9 * 6144 + 2 * DM};
            pg8::gemm_phase<pg8::EpiResid, pg8::StaticOrder, true, true>(glds, g, S, E);
        }
        SEAM(p + 6);
        if (ENAB(8) && IN(p + 7)) phase_norm2_router(launder(C), l);
        SEAM(p + 7);
        if (ENAB(9) && IN(p + 8)) phase_gather(launder(C), l);
        SEAM(p + 8);
        if (ENAB(10) && IN(p + 9)) {
            const int nM = META[0];
            pg8::Gemm g{(const bf16_t*)(C.ws + WS_XG), (const bf16_t*)(C.ws + WS_WTE1) + (size_t)l * NEXP * 2048 * DM, nM * 256, 2048, DM, (size_t)2048 * DM * 2};
            pg8::StaticOrder S; S.init(nM * 256, 2048, C.G, C.bx, META + 16);
            pg8::EpiSwiglu E{(bf16_t*)(C.ws + WS_A2), INP(I_BE1) + (size_t)l * NEXP * 2048};
            pg8::gemm_phase<pg8::EpiSwiglu, pg8::StaticOrder, true, true>(glds, g, S, E);
        }
        SEAM(p + 9);
        if (ENAB(11) && IN(p + 10)) {
            const int nM = META[0];
            pg8::Gemm g{(const bf16_t*)(C.ws + WS_A2), (const bf16_t*)(C.ws + WS_WTE2) + (size_t)l * NEXP * DM * DFF, nM * 256, DM, DFF, (size_t)DM * DFF * 2};
            pg8::StaticOrder S; S.init(nM * 256, DM, C.G, C.bx, META + 16);
            pg8::EpiMoeOut E{(bf16_t*)(C.ws + WS_YS), INP(I_BE2) + (size_t)l * NEXP * DM, (const float*)(C.ws + WS_SLOTW)};
            pg8::gemm_phase<pg8::EpiMoeOut, pg8::StaticOrder, true, true>(glds, g, S, E);
        }
        SEAM(p + 10);
    }
    if (ENAB(12) && IN(1 + DEPTH * NPH)) phase_norm1(launder(C), DEPTH);
#undef IN
#undef SEAM
}

extern "C" void kernel_launch(void* const* d_in, const int* in_sizes, int n_in, void* d_out, int out_size, void* d_ws, size_t ws_size, hipStream_t stream) {
    static int grid = 0;
    if (grid == 0) {
        if (n_in != N_IN || out_size != M_LAT * DM || ws_size < WS_END) { fprintf(stderr, "kernel_launch: unexpected shapes: n_in %d out %d ws %zu (need %zu); nothing launched\n", n_in, out_size, ws_size, (size_t)WS_END); grid = -1; return; }
        int dev = 0, cus = 0, per_cu = 0;
        if (hipGetDevice(&dev) != hipSuccess || hipDeviceGetAttribute(&cus, hipDeviceAttributeMultiprocessorCount, dev) != hipSuccess) { grid = -1; return; }
        if (hipFuncSetAttribute((const void*)mk_fwd, hipFuncAttributeMaxDynamicSharedMemorySize, LDS_BYTES) != hipSuccess) { fprintf(stderr, "kernel_launch: hipFuncSetAttribute failed\n"); grid = -1; return; }
        if (hipOccupancyMaxActiveBlocksPerMultiprocessor(&per_cu, (const void*)mk_fwd, 512, LDS_BYTES) != hipSuccess || per_cu < 1) fprintf(stderr, "kernel_launch: note: occupancy query reports %d\n", per_cu);
        (void)hipGetLastError();
        grid = cus;
    }
    if (grid < 0) return;
    (void)in_sizes;
    if (hipMemsetAsync((char*)d_ws + WS_CTL, 0, CTL_ZERO_BYTES, stream) != hipSuccess) return;
    KArgs a{};
    for (int i = 0; i < N_IN; ++i) a.in[i] = (const float*)d_in[i];
    a.out = (float*)d_out; a.ws = (unsigned char*)d_ws;
#if MK_ONE_LAUNCH
    a.ph_lo = 0; a.ph_hi = N_PHASES;
    hipLaunchKernelGGL(mk_fwd, dim3(grid), dim3(512), LDS_BYTES, stream, a);
#else
    for (int p = 0; p < N_PHASES; ++p) { a.ph_lo = p; a.ph_hi = p + 1; hipLaunchKernelGGL(mk_fwd, dim3(grid), dim3(512), LDS_BYTES, stream, a); }
#endif
}
```

```cpp
#include <hip/hip_runtime.h>
#include <hip/hip_bf16.h>
#include <cstdio>
#include <cstdint>

#ifndef MK_ONE_LAUNCH
#define MK_ONE_LAUNCH 1
#endif

#define DI __device__ __forceinline__
#define GAS __attribute__((address_space(1)))
#define LAS __attribute__((address_space(3)))

constexpr int DM = 1024, NBATCH = 8, SEQ = 4096, DEPTH = 4, CTXL = 256;
constexpr int M_LAT = NBATCH * SEQ, M_CTX = NBATCH * CTXL, MROWS = M_LAT + M_CTX;
constexpr int IN_W = 6960, PW = 7168;
constexpr int NCHUNK = MROWS / 64;
constexpr int KVLEN = CTXL + SEQ;
constexpr int NEXP = 32, TOPK = 4, DFF = 1024;
constexpr int MOE_ROWS_MAX = MROWS * TOPK + NEXP * 256;
constexpr float EPS = 1e-6f;
constexpr int C_AQK = 0, C_AV = 512, C_AI = 1024, C_AF = 1032, C_AO = 1040, C_BQ = 1552, C_BK = 2064, C_BV = 2192, C_CQ = 2320, C_CK = 2576, C_CV = 2832, C_CA = 3344, C_CR = 3376, C_GATE = 3888;
static_assert(C_GATE + 3 * DM == IN_W, "split");
enum { I_X = 0, I_C, I_CTX, I_CCTX, I_WADA, I_BADA, I_GN1, I_WIN, I_ACW, I_ACB, I_AGB, I_ANG, I_BQG, I_BKG, I_CWUP, I_CBUP, I_CNG, I_WBR, I_WOUT, I_GN2, I_WR, I_BR, I_WE1, I_BE1, I_WE2, I_BE2, I_GF, N_IN };

constexpr size_t al256(size_t x) { return (x + 255) & ~(size_t)255; }
constexpr size_t WS_CTL = 0, CTL_ZERO_BYTES = 1u << 20;
constexpr size_t WS_MOD = WS_CTL + CTL_ZERO_BYTES;
constexpr size_t WS_BLKCNT = WS_MOD + al256((size_t)DEPTH * 9 * 6 * DM * 4);
constexpr size_t WS_MOEMETA = WS_BLKCNT + al256(1024 * 32 * 4);
constexpr size_t WS_TOKE = WS_MOEMETA + 4096;
constexpr size_t WS_TOKP = WS_TOKE + (size_t)MROWS * 16;
constexpr size_t WS_TOKW = WS_TOKP + (size_t)MROWS * 16;
constexpr size_t WS_SLOTW = WS_TOKW + (size_t)MROWS * 16;
constexpr size_t WS_WTIN = WS_SLOTW + al256((size_t)MOE_ROWS_MAX * 4);
constexpr size_t WS_WTBR = WS_WTIN + (size_t)DEPTH * PW * DM * 2;
constexpr size_t WS_WTOUT = WS_WTBR + (size_t)DEPTH * 3 * DM * 512 * 2;
constexpr size_t WS_WTE1 = WS_WTOUT + (size_t)DEPTH * DM * DM * 2;
constexpr size_t WS_WTE2 = WS_WTE1 + (size_t)DEPTH * NEXP * 2 * DFF * DM * 2;
constexpr size_t WS_X = WS_WTE2 + (size_t)DEPTH * NEXP * DM * DFF * 2;
constexpr size_t WS_H = WS_X + (size_t)MROWS * DM * 4;
constexpr size_t WS_P = WS_H + (size_t)MROWS * DM * 2;
constexpr size_t WS_QR = WS_P + (size_t)MROWS * PW * 2;
constexpr size_t WS_KR = WS_QR + (size_t)MROWS * 512 * 2;
constexpr size_t WS_VR = WS_KR + (size_t)NBATCH * KVLEN * 128 * 2;
constexpr size_t WS_YA = WS_VR + (size_t)NBATCH * KVLEN * 128 * 2;
constexpr size_t WS_YB = WS_YA + (size_t)MROWS * 512 * 2;
constexpr size_t WS_YC = WS_YB + (size_t)MROWS * 512 * 2;
constexpr size_t WS_MRG = WS_YC + (size_t)MROWS * 512 * 2;
constexpr int RECB = 16896, REC_VEC = 16384;
constexpr size_t WS_STA = WS_MRG + (size_t)MROWS * DM * 2;
constexpr size_t WS_STC = WS_STA + (size_t)NCHUNK * 8 * RECB;
constexpr size_t WS_XG = WS_STC + (size_t)NCHUNK * 8 * RECB;
constexpr size_t WS_A2 = WS_XG + (size_t)MOE_ROWS_MAX * DM * 2;
constexpr size_t WS_YS = WS_A2 + (size_t)MOE_ROWS_MAX * DFF * 2;
constexpr size_t WS_U = WS_YS + (size_t)MOE_ROWS_MAX * DM * 2;
constexpr size_t WS_END = WS_U + (size_t)MROWS * DM * 2;
constexpr int CW_BAR = 4096;

constexpr int RING_OFF = 0, RING_BYTES = 155648;
constexpr int LDSCTL_OFF = RING_BYTES, MISC_OFF = LDSCTL_OFF + 320;
constexpr int LDS_BYTES = 156672;

typedef unsigned short bf16_t;
typedef unsigned v4u __attribute__((ext_vector_type(4)));
typedef unsigned v2u __attribute__((ext_vector_type(2)));
typedef float f32x4 __attribute__((ext_vector_type(4)));
typedef short bf16x8 __attribute__((ext_vector_type(8)));

DI float bf2f(unsigned h) { return __uint_as_float(h << 16); }
typedef float f32x2_h __attribute__((ext_vector_type(2))); typedef __bf16 bf16x2_h __attribute__((ext_vector_type(2)));
DI unsigned pk2(float lo, float hi) { const f32x2_h v = {lo, hi}; return __builtin_bit_cast(unsigned, __builtin_convertvector(v, bf16x2_h)); }
DI unsigned f2bf(float f) { return pk2(f, f) & 0xffffu; }
DI void unpack8(const v4u v, float (&o)[8]) { o[0] = bf2f(v.x & 0xffffu); o[1] = bf2f(v.x >> 16); o[2] = bf2f(v.y & 0xffffu); o[3] = bf2f(v.y >> 16); o[4] = bf2f(v.z & 0xffffu); o[5] = bf2f(v.z >> 16); o[6] = bf2f(v.w & 0xffffu); o[7] = bf2f(v.w >> 16); }
constexpr float FP8_SH = 8.0f, FP8_SW = 512.0f, FP8_SA = 4.0f;
DI float clamp448(float x) { return fminf(fmaxf(x, -448.0f), 448.0f); }
DI unsigned pk4_fp8(float a, float b, float c, float d) { unsigned w = __float_as_uint(a);   w = __builtin_amdgcn_cvt_pk_fp8_f32(clamp448(a), clamp448(b), w, false); w = __builtin_amdgcn_cvt_pk_fp8_f32(clamp448(c), clamp448(d), w, true); return w; }
DI float sigmoid_f(float x) { return __builtin_amdgcn_rcpf(1.f + __expf(-x)); }
DI float silu_f(float x) { return x * sigmoid_f(x); }
DI float logsigmoid_f(float x) { return fminf(x, 0.f) - __logf(1.f + __expf(-fabsf(x))); }
namespace pg8 {
#define PG8_LAS __attribute__((address_space(3)))
typedef unsigned short bf16_t;
typedef short bf16x8 __attribute__((ext_vector_type(8)));
typedef float f32x4 __attribute__((ext_vector_type(4)));
typedef unsigned u32x4 __attribute__((ext_vector_type(4)));
typedef int v4i_t __attribute__((ext_vector_type(4)));
typedef unsigned u32x2 __attribute__((ext_vector_type(2)));
constexpr int BM = 256, BK = 64, HALF = 128, HTB = HALF * BK * 2  , STAGE_BYTES = 8 * HTB, NXCD = 8, WGM = 8;

__host__ __device__ __forceinline__ int lds_byte(int r, int c) { const int st = (r >> 4) * 2 + (c >> 5), rr = r & 15, cc = c & 31, ob = rr * 64 + cc * 2; return st * 1024 + (ob ^ (((ob >> 9) & 1) << 5)); }
__host__ __device__ __forceinline__ void stage_rc(int b, int& R, int& C) { const int st = b / 1024, sb = b % 1024, swz = sb ^ (((sb >> 9) & 1) << 5); R = (st >> 1) * 16 + swz / 64; C = (st & 1) * 32 + (swz % 64) / 2; }
__host__ __device__ __forceinline__ int perm32(int rho) { const int n = rho >> 4, i = rho & 15; return 8 * (i >> 2) + 4 * n + (i & 3); }

struct Unit { int pm, pn, e; };
struct Gemm { const bf16_t* A; const bf16_t* Bt; int M, N, K; size_t bstride; };

struct StaticOrder {
    int nM, nN, nwg, G, c; const int* tile_e;
    __host__ __device__ void init(int M, int N, int G_, int c_, const int* te = nullptr) { nM = M / BM; nN = N / BM; nwg = nM * nN; G = G_; c = c_; tile_e = te; }
    __device__ __forceinline__ bool next(int i, Unit& u) const {
        const long L = (long)i * G + c; if (L >= nwg) return false;
        int wgid = (int)L; { const int q = nwg / NXCD, r = nwg % NXCD, xcd = wgid % NXCD, off = wgid / NXCD; wgid = (xcd < r ? xcd * (q + 1) : r * (q + 1) + (xcd - r) * q) + off; }
        const int nig = WGM * nN, gid = wgid / nig, fm = gid * WGM, gsz = (nM - fm) < WGM ? (nM - fm) : WGM;
        u.pm = fm + ((wgid % nig) % gsz); u.pn = (wgid % nig) / gsz; u.e = tile_e ? __builtin_amdgcn_readfirstlane(tile_e[u.pm]) : 0; return true;
    }
    __device__ __forceinline__ void a_ready(const Unit&) const {}
    __device__ __forceinline__ void done(const Unit&) const {}
};

__device__ __forceinline__ unsigned cvt_pk_bf16(float lo, float hi) { unsigned r; asm volatile("v_cvt_pk_bf16_f32 %0, %1, %2" : "=v"(r) : "v"(lo), "v"(hi)); return r; }
__device__ __forceinline__ u32x4 pack8(const f32x4 a, const f32x4 b) { u32x4 w; w.x = cvt_pk_bf16(a[0], a[1]); w.y = cvt_pk_bf16(a[2], a[3]); w.z = cvt_pk_bf16(b[0], b[1]); w.w = cvt_pk_bf16(b[2], b[3]); return w; }
__device__ __forceinline__ float bfl(unsigned v) { return __uint_as_float(v << 16); }
__device__ __forceinline__ float bfh(unsigned v) { return __uint_as_float(v & 0xffff0000u); }
__device__ __forceinline__ float sigm(float x) { return __builtin_amdgcn_rcpf(1.f + __expf(-x)); }

#ifndef AUX_B
#define AUX_B 0
#endif
#ifndef AUX_F
#define AUX_F 0
#endif
#ifndef AUX_G
#define AUX_G 0
#endif
#ifndef AUX_J
#define AUX_J 0
#endif
#ifndef AUX_K
#define AUX_K 0
#endif
__device__ __forceinline__ __amdgpu_buffer_rsrc_t mk_rs(const void* p) {
    unsigned lo = (unsigned)__builtin_amdgcn_readfirstlane((int)(unsigned)(uintptr_t)p), hi = (unsigned)__builtin_amdgcn_readfirstlane((int)(unsigned)((uintptr_t)p >> 32)); asm volatile("" : "+s"(lo), "+s"(hi));
    return __builtin_amdgcn_make_buffer_rsrc((void*)(((uintptr_t)hi << 32) | (uintptr_t)lo), 0, -1, 0x00020000); }
template <int AUX> __device__ __forceinline__ void st16(__amdgpu_buffer_rsrc_t rs, unsigned off, u32x4 v) { __builtin_amdgcn_raw_buffer_store_b128(v, rs, off, 0, AUX); }
template <int AUX> __device__ __forceinline__ void st8(__amdgpu_buffer_rsrc_t rs, unsigned off, u32x2 v) { __builtin_amdgcn_raw_buffer_store_b64(v, rs, off, 0, AUX); }
__device__ __forceinline__ void st16p(void* p, u32x4 v) { if (AUX_B == 16) asm volatile("global_store_dwordx4 %0, %1, off sc1\n\ts_nop 1" :: "v"(p), "v"(v) : "memory"); else *(u32x4*)p = v; }
__device__ __forceinline__ void st8p(void* p, u32x2 v) { if (AUX_B == 16) asm volatile("global_store_dwordx2 %0, %1, off sc1\n\ts_nop 1" :: "v"(p), "v"(v) : "memory"); else *(u32x2*)p = v; }
struct NoState {};
struct EpiStoreBf16 {
    static constexpr bool PERM = true, AFTER_DRAIN = false, HOOK = false; static constexpr int NST = 16; typedef NoState State;
    bf16_t* O; int ldc, sig_from; float inv; int probe_skip;
    __device__ __forceinline__ unsigned q8(float raw, float c2) const { const float e = __builtin_amdgcn_exp2f(raw * c2); return (unsigned)fmaxf(__builtin_rintf(__builtin_amdgcn_rcpf(__builtin_fmaf(e, 1.0f / 255.0f, 1.0f / 255.0f))), 1.0f); }
    __device__ __forceinline__ void operator()(const f32x4 (&acc)[2][2][4][2], const Unit& u, int wr, int wc, int fr, int fq, NoState&) const {
        const int row0 = u.pm * BM + wr * 64 + fr, col0 = u.pn * BM + wc * 32 + 8 * fq;
        if (probe_skip == 2) return;
#pragma unroll
        for (int bj = 0; bj < 2; ++bj) {
            const int col = col0 + bj * HALF; const bool sg = col >= sig_from;
#pragma unroll
            for (int ai = 0; ai < 2; ++ai)
#pragma unroll
                for (int m = 0; m < 4; ++m) {
                    const f32x4 a = acc[ai][bj][m][0] * inv, b = acc[ai][bj][m][1] * inv;
                    bf16_t* rowp = O + (size_t)(row0 + ai * HALF + m * 16) * ldc;
                    if (probe_skip == 1 && (a[0] + b[3]) != 12345.678f) continue;
                    if (probe_skip == 4 && (ai + m + bj) != 0 && (a[0] + b[3]) != 12345.678f) continue;
                    if (probe_skip == 3) { *(u32x4*)((unsigned char*)O + ((size_t)1 << 31) + (size_t)(u.pm * 28 + u.pn) * 131072 + (size_t)((((ai * 4 + m) * 2 + bj) * 8 + (wr * 4 + wc)) * 1024 + (fr + 16 * fq) * 16)) = pack8(a, b); continue; }
                    if (sg) { const f32x4 ra = acc[ai][bj][m][0], rb = acc[ai][bj][m][1]; const float c2 = inv * -1.4426950408889634f;
                        u32x2 w; w.x = q8(ra[0], c2) | (q8(ra[1], c2) << 8) | (q8(ra[2], c2) << 16) | (q8(ra[3], c2) << 24); w.y = q8(rb[0], c2) | (q8(rb[1], c2) << 8) | (q8(rb[2], c2) << 16) | (q8(rb[3], c2) << 24);
                        st8p((unsigned char*)(rowp + sig_from) + (col - sig_from), w); }
                    else st16p(rowp + col, pack8(a, b)); }
        }
    }
};
struct EpiBranch {
    static constexpr bool PERM = true, AFTER_DRAIN = false, HOOK = true; static constexpr int NST = 16; typedef NoState State;
    bf16_t* MRG; const unsigned char* gates; int ldg;
    static __device__ __forceinline__ float ub(unsigned v, int k) { return (float)((v >> (8 * k)) & 0xffu); }
    __device__ __forceinline__ void hook(f32x4 (&acc)[2][2][4][2], const Unit& u, int seg, int wr, int wc, int lane, NoState&) const {
        const int fr = lane & 15, fq = lane >> 4;
        const int row0 = u.pm * BM + wr * 64 + fr, col0 = u.pn * BM + wc * 32 + 8 * fq;
        const unsigned char* gp = gates + seg * 1024 + col0;
        u32x2 gb[2][4][2], ga[2][4][2];
#pragma unroll
        for (int ai = 0; ai < 2; ++ai)
#pragma unroll
            for (int m = 0; m < 4; ++m) { const size_t ro = (size_t)(row0 + ai * HALF + m * 16) * ldg;
#pragma unroll
                for (int bj = 0; bj < 2; ++bj) { gb[ai][m][bj] = *(const u32x2*)(gp + ro + bj * HALF); ga[ai][m][bj] = *(const u32x2*)(gp + ro - 1024 + bj * HALF); } }
        __builtin_amdgcn_sched_barrier(0);
#pragma unroll
        for (int ai = 0; ai < 2; ++ai)
#pragma unroll
            for (int m = 0; m < 4; ++m)
#pragma unroll
                for (int bj = 0; bj < 2; ++bj) {
                    const u32x2 b_ = gb[ai][m][bj], a_ = ga[ai][m][bj];
                    f32x4& a = acc[ai][bj][m][0]; f32x4& b = acc[ai][bj][m][1];
#pragma unroll
                    for (int k = 0; k < 4; ++k) { a[k] *= ub(a_.x, k) * __builtin_amdgcn_rcpf(ub(b_.x, k)); b[k] *= ub(a_.y, k) * __builtin_amdgcn_rcpf(ub(b_.y, k)); }
                }
    }
    __device__ __forceinline__ void operator()(const f32x4 (&acc)[2][2][4][2], const Unit& u, int wr, int wc, int fr, int fq, NoState&) const {
        const int row0 = u.pm * BM + wr * 64 + fr, col0 = u.pn * BM + wc * 32 + 8 * fq;
        u32x2 gv[2][4][2];
#pragma unroll
        for (int ai = 0; ai < 2; ++ai)
#pragma unroll
            for (int m = 0; m < 4; ++m)
#pragma unroll
                for (int bj = 0; bj < 2; ++bj) gv[ai][m][bj] = *(const u32x2*)(gates + (size_t)(row0 + ai * HALF + m * 16) * ldg + 2048 + col0 + bj * HALF);
        __builtin_amdgcn_sched_barrier(0);
        const __amdgpu_buffer_rsrc_t rsM = mk_rs(MRG);
#pragma unroll
        for (int ai = 0; ai < 2; ++ai)
#pragma unroll
            for (int m = 0; m < 4; ++m) { const size_t row = (size_t)(row0 + ai * HALF + m * 16);
#pragma unroll
                for (int bj = 0; bj < 2; ++bj) {
                    const u32x2 g_ = gv[ai][m][bj];
                    f32x4 a = acc[ai][bj][m][0], b = acc[ai][bj][m][1];
#pragma unroll
                    for (int k = 0; k < 4; ++k) { a[k] *= ub(g_.x, k) * (1.0f / 255.0f); b[k] *= ub(g_.y, k) * (1.0f / 255.0f); }
                    st16<AUX_F>(rsM, (unsigned)row * 2048u + (unsigned)(col0 + bj * HALF) * 2u, pack8(a, b)); } }
    }
};
struct EpiResid {
    static constexpr bool PERM = true, AFTER_DRAIN = false, HOOK = false; static constexpr int NST = 16; typedef NoState State;
    bf16_t* U; int probe_skip;
    __device__ __forceinline__ void operator()(const f32x4 (&acc)[2][2][4][2], const Unit& u, int wr, int wc, int fr, int fq, NoState&) const {
        const int row0 = u.pm * BM + wr * 64 + fr, col0 = u.pn * BM + wc * 32 + 8 * fq;
        if (probe_skip == 2) return;
        const __amdgpu_buffer_rsrc_t rsU = mk_rs(U);
#pragma unroll
        for (int ai = 0; ai < 2; ++ai)
#pragma unroll
            for (int m = 0; m < 4; ++m) { const unsigned rowb = (unsigned)(row0 + ai * HALF + m * 16) * 2048u + (unsigned)col0 * 2u;
#pragma unroll
                for (int bj = 0; bj < 2; ++bj) st16<AUX_G>(rsU, rowb + bj * HALF * 2, pack8(acc[ai][bj][m][0], acc[ai][bj][m][1])); }
    }
};
__device__ __forceinline__ float clamp448(float x) { return fminf(fmaxf(x, -448.0f), 448.0f); }
__device__ __forceinline__ unsigned pk4_fp8(float a, float b, float c, float d) { unsigned w = __float_as_uint(a);   w = __builtin_amdgcn_cvt_pk_fp8_f32(clamp448(a), clamp448(b), w, false); w = __builtin_amdgcn_cvt_pk_fp8_f32(clamp448(c), clamp448(d), w, true); return w; }
__device__ __forceinline__ unsigned pk4_fp8_nc(float a, float b, float c, float d) { unsigned w = __float_as_uint(a); w = __builtin_amdgcn_cvt_pk_fp8_f32(a, b, w, false); w = __builtin_amdgcn_cvt_pk_fp8_f32(c, d, w, true); return w; }
struct EpiSwiglu {
    static constexpr bool PERM = true, AFTER_DRAIN = false, HOOK = false; static constexpr int NST = 8; typedef NoState State;
    unsigned char* A2; const float* b1; float inv, oscale; int probe_skip;
    __device__ __forceinline__ void operator()(const f32x4 (&acc)[2][2][4][2], const Unit& u, int wr, int wc, int fr, int fq, NoState&) const {
        asm volatile("" ::: "memory");
        if (probe_skip == 2) return;
        const int row0 = u.pm * BM + wr * 64 + fr, j0 = u.pn * HALF + wc * 32 + 8 * fq;
        const float* bp = b1 + (size_t)u.e * 2048 + 2 * j0;
        const __amdgpu_buffer_rsrc_t rsA2 = mk_rs(A2);
        float bg[8], bu[8];
#pragma unroll
        for (int q = 0; q < 4; ++q) { const f32x4 t = *(const f32x4*)(bp + 4 * q); bg[2 * q] = t[0]; bu[2 * q] = t[1]; bg[2 * q + 1] = t[2]; bu[2 * q + 1] = t[3]; }
#pragma unroll
        for (int ai = 0; ai < 2; ++ai)
#pragma unroll
            for (int m = 0; m < 4; ++m) {
                float o[8];
#pragma unroll
                for (int e = 0; e < 8; ++e) {
                    float g = acc[ai][0][m][e >> 2][e & 3] * inv + bg[e], up = acc[ai][1][m][e >> 2][e & 3] * inv + bu[e];
                    g = fminf(g, 7.0f); up = fminf(fmaxf(up, -7.0f), 7.0f);
                    o[e] = __builtin_fmaf(up, oscale, oscale) * (g * __builtin_amdgcn_rcpf(1.0f + __builtin_amdgcn_exp2f(g * (-1.702f * 1.4426950408889634f)))); }
                u32x2 w; w.x = pk4_fp8_nc(o[0], o[1], o[2], o[3]); w.y = pk4_fp8_nc(o[4], o[5], o[6], o[7]);
                st8<AUX_J>(rsA2, (unsigned)(row0 + ai * HALF + m * 16) * 1024u + (unsigned)j0, w); }
    }
};
struct EpiMoeOut {
    static constexpr bool PERM = true, AFTER_DRAIN = false, HOOK = false; static constexpr int NST = 16; typedef NoState State;
    bf16_t* YS; const float* b2; const float* slotw; float inv; int probe_skip;
    __device__ __forceinline__ void operator()(const f32x4 (&acc)[2][2][4][2], const Unit& u, int wr, int wc, int fr, int fq, NoState&) const {
        const int row0 = u.pm * BM + wr * 64 + fr, col0 = u.pn * BM + wc * 32 + 8 * fq;
        if (probe_skip == 2) return;
        if (probe_skip == 5) { const __amdgpu_buffer_rsrc_t rsZ = mk_rs((const unsigned char*)YS - WS_YS + WS_MRG);
#pragma unroll
            for (int ai = 0; ai < 2; ++ai)
#pragma unroll
                for (int m = 0; m < 4; ++m) { const unsigned row = (unsigned)(row0 + ai * HALF + m * 16) % 34816u;
#pragma unroll
                    for (int bj = 0; bj < 2; ++bj) st16<0>(rsZ, row * 2048u + (unsigned)(col0 + bj * HALF) * 2u, pack8(acc[ai][bj][m][0] * inv, acc[ai][bj][m][1] * inv)); }
            return; }
        const float* bp = b2 + (size_t)u.e * 1024 + col0;
        const __amdgpu_buffer_rsrc_t rsY = mk_rs(YS);
        f32x4 bv[2][2];
#pragma unroll
        for (int bj = 0; bj < 2; ++bj)
#pragma unroll
            for (int n = 0; n < 2; ++n) bv[bj][n] = *(const f32x4*)(bp + bj * HALF + 4 * n);
#pragma unroll
        for (int ai = 0; ai < 2; ++ai)
#pragma unroll
            for (int m = 0; m < 4; ++m) { const size_t row = (size_t)(row0 + ai * HALF + m * 16); const float w = slotw[row];
#pragma unroll
                for (int bj = 0; bj < 2; ++bj) st16<AUX_K>(rsY, (unsigned)row * 2048u + (unsigned)(col0 + bj * HALF) * 2u, pack8((acc[ai][bj][m][0] * inv + bv[bj][0]) * w, (acc[ai][bj][m][1] * inv + bv[bj][1]) * w)); }
    }
};

template <class Epi, class Sched, bool ALIGN_EPI = false, bool SP2 = false, bool F8 = false>
__device__ __forceinline__ void gemm_phase(PG8_LAS unsigned char* lds, const Gemm g, const Sched& S, const Epi& E, int wave_index) {
    unsigned msk_ = ~0u; asm volatile("" : "+s"(msk_)); const int tid_ = (wave_index << 6) | (int)__builtin_amdgcn_mbcnt_hi(msk_, __builtin_amdgcn_mbcnt_lo(msk_, 0u));
    const int tid = tid_, wid = __builtin_amdgcn_readfirstlane(tid >> 6), lane = tid & 63, wr = wid >> 2, wc = wid & 3, fr = lane & 15, fq = lane >> 4;
    const int K = g.K, nt = K / BK;
    unsigned voffA[2], voffB[2];
#pragma unroll
    for (int i = 0; i < 2; ++i) { int R, C; stage_rc(tid * 16 + i * 8192, R, C); const int Rb = Epi::PERM ? ((R & ~31) + perm32(R & 31)) : R;
        voffA[i] = (unsigned)(R * K + C) * 2u; voffB[i] = (unsigned)(Rb * K + C) * 2u; }
    const unsigned kstep = (unsigned)(BK * 2);
    const unsigned hstep = (unsigned)HALF * (unsigned)K * 2u;
    const unsigned tstep = 2u * hstep;
    const unsigned ldsw = (unsigned)wid * 1024u;
    const int aoff = lds_byte(wr * 64 + fr, fq * 8), boff = lds_byte(wc * 32 + fr, fq * 8);
#define PG8_SA(b, h) (((b) * 2 + (h)) * HTB)
#define PG8_SB(b, h) ((4 + (b) * 2 + (h)) * HTB)
#define PG8_RS_voffA rsA
#define PG8_RS_voffB rsB
#define PG8_STAGE(bufoff, gbase, voff) do { _Pragma("unroll") for (int _i = 0; _i < 2; ++_i) \
        __builtin_amdgcn_raw_ptr_buffer_load_lds(PG8_RS_##voff, (PG8_LAS void*)(lds + (bufoff) + ldsw + _i * 8192), 16, (voff)[_i], (gbase), 0, 0); } while (0)
#define PG8_LDA(dst, b, h) do { _Pragma("unroll") for (int m = 0; m < 4; ++m) _Pragma("unroll") for (int k = 0; k < 2; ++k) dst[m][k] = *(const PG8_LAS bf16x8*)(lds + PG8_SA(b, h) + aoff + m * 2048 + k * 1024); } while (0)
#define PG8_LDB(dst, b, h) do { _Pragma("unroll") for (int n = 0; n < 2; ++n) _Pragma("unroll") for (int k = 0; k < 2; ++k) dst[n][k] = *(const PG8_LAS bf16x8*)(lds + PG8_SB(b, h) + boff + n * 2048 + k * 1024); } while (0)
#define PG8_CAT(x) __builtin_shufflevector(__builtin_bit_cast(v4i_t, (x)[0]), __builtin_bit_cast(v4i_t, (x)[1]), 0, 1, 2, 3, 4, 5, 6, 7)
#define PG8_MMA(ai, bj, At, Bt) do { __builtin_amdgcn_s_setprio(1); _Pragma("unroll") for (int m = 0; m < 4; ++m) _Pragma("unroll") for (int n = 0; n < 2; ++n) { \
        if constexpr (F8) acc[ai][bj][m][n] = __builtin_amdgcn_mfma_scale_f32_16x16x128_f8f6f4(PG8_CAT(Bt[n]), PG8_CAT(At[m]), acc[ai][bj][m][n], 0, 0, 0, 0x7f7f7f7f, 0, 0x7f7f7f7f); \
        else { _Pragma("unroll") for (int k = 0; k < 2; ++k) acc[ai][bj][m][n] = __builtin_amdgcn_mfma_f32_16x16x32_bf16(Bt[n][k], At[m][k], acc[ai][bj][m][n], 0, 0, 0); } } __builtin_amdgcn_s_setprio(0); } while (0)
#define PG8_WAIT_V(n) asm volatile("s_waitcnt vmcnt(" #n ")" ::: "memory")
#define PG8_WAIT_L(n) asm volatile("s_waitcnt lgkmcnt(" #n ")" ::: "memory")
#define PG8_BAR __builtin_amdgcn_s_barrier()
#define PG8_SCHED __builtin_amdgcn_sched_barrier(0)
    Unit cur, nxt; int ui = 0;
    typename Epi::State est;
    if (!S.next(0, cur)) return;
    f32x4 acc[2][2][4][2];
#pragma unroll
    for (int a = 0; a < 2; ++a)
#pragma unroll
        for (int b = 0; b < 2; ++b)
#pragma unroll
            for (int m = 0; m < 4; ++m)
#pragma unroll
                for (int n = 0; n < 2; ++n) { f32x4 z_; asm volatile("v_mov_b32 %0, 0\n\tv_mov_b32 %1, 0\n\tv_mov_b32 %2, 0\n\tv_mov_b32 %3, 0" : "=v"(z_[0]), "=v"(z_[1]), "=v"(z_[2]), "=v"(z_[3])); acc[a][b][m][n] = z_; }
    bf16x8 At[4][2], B0[2][2], B1[2][2];
    const __amdgpu_buffer_rsrc_t rsA = __builtin_amdgcn_make_buffer_rsrc((void*)g.A, 0, -1, 0x00020000), rsB = __builtin_amdgcn_make_buffer_rsrc((void*)g.Bt, 0, -1, 0x00020000);
    unsigned cA = (unsigned)cur.pm * tstep, cB = (unsigned)cur.e * (unsigned)g.bstride + (unsigned)cur.pn * tstep;
    S.a_ready(cur);
    if constexpr (SP2) {
        PG8_STAGE(PG8_SB(0, 0), cB, voffB); PG8_STAGE(PG8_SB(0, 1), cB + hstep, voffB); PG8_STAGE(PG8_SA(0, 0), cA, voffA); PG8_STAGE(PG8_SA(0, 1), cA + hstep, voffA);
        if (wr == 1) PG8_BAR;
        PG8_WAIT_V(2); PG8_BAR;
        PG8_STAGE(PG8_SB(1, 0), cB + kstep, voffB); PG8_STAGE(PG8_SA(1, 0), cA + kstep, voffA); PG8_STAGE(PG8_SB(1, 1), cB + hstep + kstep, voffB);
        PG8_WAIT_V(6); PG8_BAR;
    } else {
        PG8_STAGE(PG8_SB(0, 0), cB, voffB); PG8_STAGE(PG8_SA(0, 0), cA, voffA); PG8_STAGE(PG8_SB(0, 1), cB + hstep, voffB); PG8_STAGE(PG8_SA(0, 1), cA + hstep, voffA);
        if (wr == 1) PG8_BAR;
        PG8_WAIT_V(4); PG8_BAR;
        PG8_STAGE(PG8_SB(1, 0), cB + kstep, voffB); PG8_STAGE(PG8_SA(1, 0), cA + kstep, voffA); PG8_STAGE(PG8_SB(1, 1), cB + hstep + kstep, voffB);
        PG8_WAIT_V(6); PG8_BAR;
    }
    for (;;) {
        const bool has_next = S.next(ui + 1, nxt);
        const unsigned nA = has_next ? (unsigned)nxt.pm * tstep : cA, nB = has_next ? (unsigned)nxt.e * (unsigned)g.bstride + (unsigned)nxt.pn * tstep : cB;
#pragma clang loop unroll(disable)
        for (int t = 0; t < nt; t += 2) {
            if constexpr (Epi::HOOK) { if (t > 0 && (t & 7) == 0) { if (wr == 0) PG8_BAR; E.hook(acc, cur, t >> 3, wr, wc, lane, est); if (wr == 1) PG8_BAR; } }
            const bool last = (t == nt - 2);
            const unsigned a1 = cA + (unsigned)(t + 1) * kstep;
            const unsigned a2 = last ? nA : cA + (unsigned)(t + 2) * kstep, b2 = last ? nB : cB + (unsigned)(t + 2) * kstep;
            const unsigned a3 = a2 + kstep, b3 = b2 + kstep;
            if (last && has_next) S.a_ready(nxt);
            if constexpr (SP2) {
            PG8_LDB(B0, 0, 0); PG8_LDB(B1, 0, 1); PG8_SCHED; PG8_LDA(At, 0, 0); PG8_STAGE(PG8_SA(1, 1), a1 + hstep, voffA);
            PG8_WAIT_V(8); PG8_WAIT_L(0); PG8_BAR; PG8_MMA(0, 0, At, B0); PG8_MMA(0, 1, At, B1); PG8_BAR; PG8_SCHED;
            PG8_LDA(At, 0, 1); PG8_STAGE(PG8_SB(0, 0), b2, voffB); PG8_STAGE(PG8_SB(0, 1), b2 + hstep, voffB); PG8_STAGE(PG8_SA(0, 0), a2, voffA);
            PG8_WAIT_V(8); PG8_WAIT_L(0); PG8_BAR; PG8_MMA(1, 0, At, B0); PG8_MMA(1, 1, At, B1); PG8_BAR; PG8_SCHED;
            PG8_LDB(B0, 1, 0); PG8_LDB(B1, 1, 1); PG8_SCHED; PG8_LDA(At, 1, 0); PG8_STAGE(PG8_SA(0, 1), a2 + hstep, voffA);
            PG8_WAIT_V(8); PG8_WAIT_L(0); PG8_BAR; PG8_MMA(0, 0, At, B0); PG8_MMA(0, 1, At, B1); PG8_BAR; PG8_SCHED;
            PG8_LDA(At, 1, 1); PG8_STAGE(PG8_SB(1, 0), b3, voffB); PG8_STAGE(PG8_SB(1, 1), b3 + hstep, voffB); PG8_STAGE(PG8_SA(1, 0), a3, voffA);
            PG8_WAIT_V(8); PG8_WAIT_L(0); PG8_BAR; PG8_MMA(1, 0, At, B0); PG8_MMA(1, 1, At, B1); PG8_BAR; PG8_SCHED;
            } else {
            PG8_LDB(B0, 0, 0); PG8_SCHED; PG8_LDA(At, 0, 0); PG8_STAGE(PG8_SA(1, 1), a1 + hstep, voffA);
            PG8_WAIT_L(8); PG8_BAR; PG8_WAIT_L(0); PG8_MMA(0, 0, At, B0); PG8_BAR; PG8_SCHED;
            PG8_LDB(B1, 0, 1); PG8_STAGE(PG8_SB(0, 0), b2, voffB);
            PG8_BAR; PG8_WAIT_L(0); PG8_MMA(0, 1, At, B1); PG8_BAR;
            PG8_LDA(At, 0, 1); PG8_STAGE(PG8_SA(0, 0), a2, voffA);
            PG8_BAR; PG8_WAIT_L(0); PG8_MMA(1, 0, At, B0); PG8_BAR; PG8_SCHED;
            PG8_STAGE(PG8_SB(0, 1), b2 + hstep, voffB);
            PG8_WAIT_V(6); PG8_BAR; PG8_MMA(1, 1, At, B1); PG8_BAR;
            PG8_LDB(B0, 1, 0); PG8_SCHED; PG8_LDA(At, 1, 0); PG8_STAGE(PG8_SA(0, 1), a2 + hstep, voffA);
            PG8_WAIT_L(8); PG8_BAR; PG8_WAIT_L(0); PG8_MMA(0, 0, At, B0); PG8_BAR; PG8_SCHED;
            PG8_LDB(B1, 1, 1); PG8_STAGE(PG8_SB(1, 0), b3, voffB);
            PG8_BAR; PG8_WAIT_L(0); PG8_MMA(0, 1, At, B1); PG8_BAR;
            PG8_LDA(At, 1, 1); PG8_STAGE(PG8_SA(1, 0), a3, voffA);
            PG8_BAR; PG8_WAIT_L(0); PG8_MMA(1, 0, At, B0); PG8_BAR; PG8_SCHED;
            PG8_STAGE(PG8_SB(1, 1), b3 + hstep, voffB);
            PG8_WAIT_V(6); PG8_BAR; PG8_MMA(1, 1, At, B1); PG8_BAR;
            }
        }
        if constexpr (ALIGN_EPI) { if (wr == 0) PG8_BAR; }
        if constexpr (!Epi::AFTER_DRAIN) { unsigned m2_ = ~0u; asm volatile("" : "+s"(m2_)); const int le_ = (int)__builtin_amdgcn_mbcnt_hi(m2_, __builtin_amdgcn_mbcnt_lo(m2_, 0u));
            E(acc, cur, wr, wc, le_ & 15, le_ >> 4, est); S.done(cur); }
        if (!has_next) break;
#pragma unroll
        for (int a = 0; a < 2; ++a)
#pragma unroll
            for (int b = 0; b < 2; ++b)
#pragma unroll
                for (int m = 0; m < 4; ++m)
#pragma unroll
                    for (int n = 0; n < 2; ++n) { f32x4 z_; asm volatile("v_mov_b32 %0, 0\n\tv_mov_b32 %1, 0\n\tv_mov_b32 %2, 0\n\tv_mov_b32 %3, 0" : "=v"(z_[0]), "=v"(z_[1]), "=v"(z_[2]), "=v"(z_[3])); acc[a][b][m][n] = z_; }
        cur = nxt; cA = nA; cB = nB; ++ui;
        if constexpr (ALIGN_EPI) { if (wr == 1) PG8_BAR; }
    }
    PG8_WAIT_V(0);
    if constexpr (!ALIGN_EPI) { if (wr == 0) PG8_BAR; }
    PG8_BAR;
    if constexpr (Epi::AFTER_DRAIN) { E.fused(acc, cur, wr, wc, fr, fq, lds, wid, lane); S.done(cur); }
#undef PG8_SA
#undef PG8_SB
#undef PG8_STAGE
#undef PG8_RS_voffA
#undef PG8_RS_voffB
#undef PG8_LDA
#undef PG8_LDB
#undef PG8_MMA
#undef PG8_CAT
#undef PG8_WAIT_V
#undef PG8_WAIT_L
#undef PG8_BAR
#undef PG8_SCHED
}
}
namespace attn_body {
using bf16=__hip_bfloat16;
using bf16x8=__attribute__((ext_vector_type(8)))short;
using s16x4=__attribute__((ext_vector_type(4)))short;
using f32x16=__attribute__((ext_vector_type(16)))float;
using u32x4=__attribute__((ext_vector_type(4)))unsigned;
constexpr int D=64,QP=512,KP=128,OP=1536;
constexpr int NW=8,QBLK=32,QB=QBLK*NW,KVBLK=64;
constexpr int ATTN_UNIT_ROWS=QB;
__device__ __forceinline__ int crow(int r,int hi){return (r&3)+8*(r>>2)+4*hi;}
#define SBAR() __builtin_amdgcn_sched_barrier(0)
__device__ __forceinline__ void cmask(f32x16&p0,f32x16&p1,int jb,int qrel,int hi){
  const float NEG=-INFINITY; int kb=64*jb+4*hi;
  #pragma unroll
  for(int r=0;r<16;++r){int kv=kb+(r&3)+8*(r>>2); if(kv>qrel)p0[r]=NEG; if(kv+32>qrel)p1[r]=NEG;}
}

constexpr int NSLOT=3, SLOTB=8192;
constexpr int LDS_K=0, LDS_V=NSLOT*SLOTB, LDS_WS=2*NSLOT*SLOTB, LDS_OST=LDS_WS+NW*64*4, LDS_BYTES=LDS_OST+NW*4096;
constexpr float C2=0.125f*1.4426950408889634f;
__device__ __forceinline__ void glds16(const void*gsrc,unsigned lds_dst){unsigned keep;
  asm volatile("s_mov_b32 %0, m0\n\ts_mov_b32 m0, %2\n\ts_nop 0\n\tglobal_load_lds_dwordx4 %1, off\n\ts_mov_b32 m0, %0":"=&s"(keep):"v"(gsrc),"s"(lds_dst):"memory");}
__device__ __forceinline__ float max3f(float a,float b,float c){float r;asm("v_max3_f32 %0, %1, %2, %3":"=v"(r):"v"(a),"v"(b),"v"(c));return r;}
__device__ __forceinline__ float max2f(float a,float b){float r;asm("v_max_f32_e32 %0, %1, %2":"=v"(r):"v"(a),"v"(b));return r;}
__device__ __forceinline__ float fadd_s(float a,float b){float r;asm("v_add_f32_e32 %0, %1, %2":"=v"(r):"v"(a),"v"(b));return r;}
__device__ __forceinline__ float fsub_s(float a,float b){float r;asm("v_sub_f32_e32 %0, %1, %2":"=v"(r):"v"(a),"v"(b));return r;}
typedef float f32x2_t __attribute__((ext_vector_type(2))); typedef __bf16 bf16x2_t __attribute__((ext_vector_type(2)));
__device__ __forceinline__ unsigned cvtpk_s(float lo,float hi){f32x2_t v={lo,hi};bf16x2_t b=__builtin_convertvector(v,bf16x2_t);return __builtin_bit_cast(unsigned,b);}
#define WAIT_BAR(N) asm volatile("s_waitcnt vmcnt(" #N ") lgkmcnt(0)\n\ts_barrier":::"memory")

__device__ __forceinline__ void qkt(f32x16&p0,f32x16&p1,const char*Kslot,const bf16x8*qr,const f32x16&negm,int r32,int hi){
  const char*kb=Kslot+hi*1024+r32*16;
  #pragma unroll
  for(int d0=0;d0<4;++d0){
    const bf16x8 b0=*reinterpret_cast<const bf16x8*>(kb+d0*2048);
    const bf16x8 b1=*reinterpret_cast<const bf16x8*>(kb+d0*2048+512);
    if(d0==0){p0=__builtin_amdgcn_mfma_f32_32x32x16_bf16(b0,qr[0],negm,0,0,0);p1=__builtin_amdgcn_mfma_f32_32x32x16_bf16(b1,qr[0],negm,0,0,0);}
    else{p0=__builtin_amdgcn_mfma_f32_32x32x16_bf16(b0,qr[d0],p0,0,0,0);p1=__builtin_amdgcn_mfma_f32_32x32x16_bf16(b1,qr[d0],p1,0,0,0);}}
}
typedef __attribute__((address_space(3))) const char* lds_cptr;
typedef short v4i16_t __attribute__((ext_vector_type(4)));
__device__ __forceinline__ void kload8(bf16x8*kf,lds_cptr kp){
  kf[0]=*(const __attribute__((address_space(3))) bf16x8*)(kp);      kf[1]=*(const __attribute__((address_space(3))) bf16x8*)(kp+512);
  kf[2]=*(const __attribute__((address_space(3))) bf16x8*)(kp+2048); kf[3]=*(const __attribute__((address_space(3))) bf16x8*)(kp+2560);
  kf[4]=*(const __attribute__((address_space(3))) bf16x8*)(kp+4096); kf[5]=*(const __attribute__((address_space(3))) bf16x8*)(kp+4608);
  kf[6]=*(const __attribute__((address_space(3))) bf16x8*)(kp+6144); kf[7]=*(const __attribute__((address_space(3))) bf16x8*)(kp+6656);
}
__device__ __forceinline__ void kload2(bf16x8*kf,lds_cptr kp,int j){ kf[2*j]=*(const __attribute__((address_space(3))) bf16x8*)(kp+j*2048); kf[2*j+1]=*(const __attribute__((address_space(3))) bf16x8*)(kp+j*2048+512); }
__device__ __forceinline__ s16x4 vtr(lds_cptr p){ return __builtin_bit_cast(s16x4,__builtin_amdgcn_ds_read_tr16_b64_v4i16((__attribute__((address_space(3))) v4i16_t*)p)); }
__device__ __forceinline__ float rowmax(const f32x16&p0,const f32x16&p1){
  float a=max3f(p0[0],p0[1],p1[0]),b=max3f(p0[2],p0[3],p1[1]);a=max3f(a,p1[2],p1[3]);
  #pragma unroll
  for(int r=4;r<16;r+=4){a=max3f(a,p0[r],p0[r+1]);b=max3f(b,p0[r+2],p0[r+3]);a=max3f(a,p1[r],p1[r+1]);b=max3f(b,p1[r+2],p1[r+3]);}
  const float m=max2f(a,b);
  auto rr=__builtin_amdgcn_permlane32_swap(__float_as_uint(m),__float_as_uint(m),false,false);
  return max2f(__uint_as_float(rr[0]),__uint_as_float(rr[1]));
}
__device__ __forceinline__ void pv(f32x16*o,int vb,bf16x8 pa0,bf16x8 pa1,bf16x8 pa2,bf16x8 pa3){
  #pragma unroll
  for(int d0=0;d0<2;++d0){s16x4 lo[4],hi[4];
    #pragma unroll
    for(int ks=0;ks<4;++ks){
      asm volatile("ds_read_b64_tr_b16 %0,%1 offset:%c2":"=&v"(lo[ks]):"v"(vb),"i"(d0*4096+ks*1024):"memory");
      asm volatile("ds_read_b64_tr_b16 %0,%1 offset:%c2":"=&v"(hi[ks]):"v"(vb),"i"(d0*4096+ks*1024+512):"memory");}
    asm volatile("s_waitcnt lgkmcnt(0)":::"memory");SBAR();
    #define PK(k) (bf16x8){lo[k][0],lo[k][1],lo[k][2],lo[k][3],hi[k][0],hi[k][1],hi[k][2],hi[k][3]}
    o[d0]=__builtin_amdgcn_mfma_f32_32x32x16_bf16(pa0,PK(0),o[d0],0,0,0);
    o[d0]=__builtin_amdgcn_mfma_f32_32x32x16_bf16(pa1,PK(1),o[d0],0,0,0);
    o[d0]=__builtin_amdgcn_mfma_f32_32x32x16_bf16(pa2,PK(2),o[d0],0,0,0);
    o[d0]=__builtin_amdgcn_mfma_f32_32x32x16_bf16(pa3,PK(3),o[d0],0,0,0);
    #undef PK
  }
}

#ifndef ATTN_STORE16
#define ATTN_STORE16(p,v) (*(u32x4*)(p)=(v))
#endif
template<int THRL> __device__ __forceinline__ void attn_unit(long qrow0,int h,int NT,const bf16*Q,const bf16*__restrict__ Kh,const bf16*__restrict__ Vh,bf16*O,char*shm,int wave_index){
  unsigned msk_=~0u; asm volatile("":"+s"(msk_)); const int tid=(wave_index<<6)|(int)__builtin_amdgcn_mbcnt_hi(msk_,__builtin_amdgcn_mbcnt_lo(msk_,0u)),lane=tid&63,r32=lane&31,hi=lane>>5; const int wid=__builtin_amdgcn_readfirstlane(tid>>6);
  const bf16*Qw=Q+(qrow0+wid*QBLK)*QP+h*D;
  const unsigned lds0=(unsigned)(uintptr_t)shm;
  float*wsf=(float*)(shm+LDS_WS)+wid*64;
  const bf16*ksrc=Kh+(long)lane*KP+wid*8;
  const bf16*vsrc=Vh+(long)(16*(wid&3)+(lane>>2))*KP+(wid>>2)*32+(lane&3)*8;
  const unsigned kdst=lds0+LDS_K+wid*1024, vdst=lds0+LDS_V+wid*1024;
  #define DMA_K(t,slot) glds16(ksrc+(long)(t)*KVBLK*KP,(unsigned)__builtin_amdgcn_readfirstlane(kdst+(slot)))
  #define DMA_V(t,slot) glds16(vsrc+(long)(t)*KVBLK*KP,(unsigned)__builtin_amdgcn_readfirstlane(vdst+(slot)))
  const int vb0=(int)(lds0+LDS_V)+((lane>>4)&1)*32+(lane&3)*8+(4*hi+((lane&15)>>2))*64;
  const char*Kbase=shm+LDS_K; bf16x8 kf[8];
  const lds_cptr shm3=(lds_cptr)shm; const lds_cptr kp0=shm3+LDS_K+hi*1024+r32*16; const lds_cptr vp0=shm3+LDS_V+((lane>>4)&1)*32+(lane&3)*8+(4*hi+((lane&15)>>2))*64;
  DMA_K(0,0);DMA_V(0,0);DMA_K(1,SLOTB);
  bf16x8 qr[4];
  #pragma unroll
  for(int d0=0;d0<4;++d0)qr[d0]=*reinterpret_cast<const bf16x8*>(&Qw[(long)r32*QP+d0*16+hi*8]);
  float mhat=0.f,l_reg=0.f;f32x16 o[2],negm; { float zz=0.f; asm volatile("":"+v"(zz));
    _Pragma("unroll") for(int r=0;r<16;++r){o[0][r]=zz;o[1][r]=zz;negm[r]=zz;} } asm volatile("":"+v"(negm));
  #define CMASK(P0,P1,t) do{}while(0)
  bool resc=false;
  #define START(P0,P1) do{ const float rm=rowmax(P0,P1); resc=false; \
    { const float dl=rm; mhat=fadd_s(mhat,dl); \
      _Pragma("unroll") for(int r=0;r<16;++r){P0[r]=fsub_s(P0[r],dl);P1[r]=fsub_s(P1[r],dl);} \
      _Pragma("unroll") for(int r=0;r<16;++r)negm[r]=-mhat; asm volatile("":"+v"(negm)); } \
    _Pragma("unroll") for(int r=0;r<16;++r)P0[r]=__builtin_amdgcn_exp2f(P0[r]); }while(0)
  #define RESC() do{ if(resc){ asm volatile("s_waitcnt lgkmcnt(0)":::"memory"); \
      _Pragma("unroll") for(int d_=0;d_<2;++d_) _Pragma("unroll") for(int r=0;r<16;++r)o[d_][r]*=wsf[crow(r,hi)]; } }while(0)
  f32x16 pA0,pA1,pB0,pB1;
  int sl_prev=0,sl_cur=0,sl_next=SLOTB;
  #define ROT() do{sl_prev=sl_cur;sl_cur=sl_next;sl_next=(sl_next==(NSLOT-1)*SLOTB)?0:sl_next+SLOTB;}while(0)
  DMA_K(2,2*SLOTB);
  WAIT_BAR(3);
  qkt(pA0,pA1,Kbase,qr,negm,r32,hi);asm volatile("s_nop 15\n\ts_nop 7":"+v"(pA0),"+v"(pA1));CMASK(pA0,pA1,0);
  START(pA0,pA1);
  _Pragma("unroll") for(int r=0;r<16;++r)pA1[r]=__builtin_amdgcn_exp2f(pA1[r]);
  WAIT_BAR(0);
  DMA_K(3,0);DMA_V(1,SLOTB);
  ROT();
  kload8(kf,kp0+sl_cur);
  WAIT_BAR(2);
  s16x4 vlo[8],vhi[8]; u32x4 pw0,pw1,pw2,pw3;
  #define PKW(P,B) cvtpk_s(P[B],P[B+1])
  #define PAF(k) __builtin_bit_cast(bf16x8,pw##k)
  #define VFR(i) (bf16x8){vlo[i][0],vlo[i][1],vlo[i][2],vlo[i][3],vhi[i][0],vhi[i][1],vhi[i][2],vhi[i][3]}
  #define PIN(x) asm volatile("":"+v"(x))
  #define MX3(a,b,c) __builtin_fmaxf(__builtin_fmaxf((a),(b)),(c))
  #define GAPA(MF,A0,A1,A2,A3,W0,W1,PW) do{ MF; sacc+=A0; sacc+=A1; sacc+=A2; sacc+=A3; PIN(sacc); W0; W1; PIN(PW); SBAR(); }while(0)
  #define EX(v) __builtin_amdgcn_exp2f(v)
  #define GAPB(MF,X,B) do{ MF; X[B]=EX(X[B]); X[B+1]=EX(X[B+1]); X[B+2]=EX(X[B+2]); X[B+3]=EX(X[B+3]); PIN(X); SBAR(); }while(0)
  #define VRD(i) do{ vlo[i]=vtr(vp_+(((i)>>2)*4096+((i)&3)*1024)); vhi[i]=vtr(vp_+(((i)>>2)*4096+((i)&3)*1024+512)); }while(0)
  #define KRD(G,j) do{ if(G){ kload2(kf,kp0+sl_next,j); SBAR(); } }while(0)
  #define STEP(C0,C1,P0,P1,t,GK,GV,GL) do{ SBAR(); \
    const lds_cptr vp_=vp0+sl_prev; \
    VRD(0); SBAR(); float sacc=(P0[0]+P0[1]); \
    GAPA(C0=__builtin_amdgcn_mfma_f32_32x32x16_bf16(kf[0],qr[0],negm,0,0,0), P0[2],P0[3],P0[4],P0[5],     pw0[0]=PKW(P0,0), pw0[1]=PKW(P0,2), pw0); \
    VRD(4); SBAR(); GAPA(C1=__builtin_amdgcn_mfma_f32_32x32x16_bf16(kf[1],qr[0],negm,0,0,0), P0[6],P0[7],P0[8],P0[9],     pw0[2]=PKW(P0,4), pw0[3]=PKW(P0,6), pw0); \
    VRD(1); SBAR(); GAPA(C0=__builtin_amdgcn_mfma_f32_32x32x16_bf16(kf[2],qr[1],C0,0,0,0),   P0[10],P0[11],P0[12],P0[13], pw1[0]=PKW(P0,8), pw1[1]=PKW(P0,10), pw1); \
    VRD(5); SBAR(); GAPA(C1=__builtin_amdgcn_mfma_f32_32x32x16_bf16(kf[3],qr[1],C1,0,0,0),   P0[14],P0[15],P1[0],P1[1],   pw1[2]=PKW(P0,12),pw1[3]=PKW(P0,14), pw1); \
    VRD(2); SBAR(); GAPA(C0=__builtin_amdgcn_mfma_f32_32x32x16_bf16(kf[4],qr[2],C0,0,0,0),   P1[2],P1[3],P1[4],P1[5],     pw2[0]=PKW(P1,0), pw2[1]=PKW(P1,2), pw2); \
    VRD(6); SBAR(); GAPA(C1=__builtin_amdgcn_mfma_f32_32x32x16_bf16(kf[5],qr[2],C1,0,0,0),   P1[6],P1[7],P1[8],P1[9],     pw2[2]=PKW(P1,4), pw2[3]=PKW(P1,6), pw2); \
    VRD(3); SBAR(); GAPA(C0=__builtin_amdgcn_mfma_f32_32x32x16_bf16(kf[6],qr[3],C0,0,0,0),   P1[10],P1[11],P1[12],P1[13], pw3[0]=PKW(P1,8), pw3[1]=PKW(P1,10), pw3); \
    VRD(7); SBAR(); GAPA(C1=__builtin_amdgcn_mfma_f32_32x32x16_bf16(kf[7],qr[3],C1,0,0,0),   P1[14],P1[15],0.f,0.f,       pw3[2]=PKW(P1,12),pw3[3]=PKW(P1,14), pw3); \
    l_reg+=sacc; \
    if(GK){DMA_K((t)+3,sl_cur);} if(GV){DMA_V((t)+1,sl_next);} \
    CMASK(C0,C1,t); \
    { float a=MX3(C0[0],C0[1],C1[0]),b=MX3(C0[2],C0[3],C1[1]); a=MX3(a,C1[2],C1[3]); \
      _Pragma("unroll") for(int r=4;r<16;r+=4){a=MX3(a,C0[r],C0[r+1]);b=MX3(b,C0[r+2],C0[r+3]);a=MX3(a,C1[r],C1[r+1]);b=MX3(b,C1[r+2],C1[r+3]);} \
      float rm=__builtin_fmaxf(a,b); { auto rr=__builtin_amdgcn_permlane32_swap(__float_as_uint(rm),__float_as_uint(rm),false,false); rm=__builtin_fmaxf(__uint_as_float(rr[0]),__uint_as_float(rr[1])); } \
      resc=false; \
      if(__builtin_expect(__any(rm>(float)THRL),0)){ const float dl=__builtin_fmaxf(rm,0.f); mhat+=dl; \
        _Pragma("unroll") for(int r=0;r<16;++r){C0[r]-=dl;C1[r]-=dl;} \
        _Pragma("unroll") for(int r=0;r<16;++r)negm[r]=-mhat; asm volatile("":"+v"(negm)); \
        const float f=__builtin_amdgcn_exp2f(-dl); l_reg*=f; if(hi==0)wsf[r32]=f; resc=true; } } \
    SBAR(); \
    GAPB(o[0]=__builtin_amdgcn_mfma_f32_32x32x16_bf16(PAF(0),VFR(0),o[0],0,0,0), C0,0); \
    GAPB(o[1]=__builtin_amdgcn_mfma_f32_32x32x16_bf16(PAF(0),VFR(4),o[1],0,0,0), C0,4); \
    KRD(GL,0); GAPB(o[0]=__builtin_amdgcn_mfma_f32_32x32x16_bf16(PAF(1),VFR(1),o[0],0,0,0), C0,8); \
    KRD(GL,1); GAPB(o[1]=__builtin_amdgcn_mfma_f32_32x32x16_bf16(PAF(1),VFR(5),o[1],0,0,0), C0,12); \
    KRD(GL,2); GAPB(o[0]=__builtin_amdgcn_mfma_f32_32x32x16_bf16(PAF(2),VFR(2),o[0],0,0,0), C1,0); \
    KRD(GL,3); GAPB(o[1]=__builtin_amdgcn_mfma_f32_32x32x16_bf16(PAF(2),VFR(6),o[1],0,0,0), C1,4); \
    GAPB(o[0]=__builtin_amdgcn_mfma_f32_32x32x16_bf16(PAF(3),VFR(3),o[0],0,0,0), C1,8); \
    GAPB(o[1]=__builtin_amdgcn_mfma_f32_32x32x16_bf16(PAF(3),VFR(7),o[1],0,0,0), C1,12); \
    }while(0)
  int t=1;
  #undef CMASK
  #define CMASK(P0,P1,t) do{}while(0)
  for(;t+5<NT;t+=2){
    STEP(pB0,pB1,pA0,pA1,t,true,true,true);     WAIT_BAR(2); RESC(); ROT();
    STEP(pA0,pA1,pB0,pB1,t+1,true,true,true);   WAIT_BAR(2); RESC(); ROT();
  }
  #undef CMASK
  #define CMASK(P0,P1,t) do{}while(0)
  #define ENDW(tt) do{ if((tt)+3<NT){WAIT_BAR(2);} else if((tt)+2<NT){WAIT_BAR(1);} else {WAIT_BAR(0);} }while(0)
  for(;t+1<NT;t+=2){
    STEP(pB0,pB1,pA0,pA1,t,(t+3<NT),(t+1<NT),(t+1<NT));       ENDW(t);   RESC(); ROT();
    STEP(pA0,pA1,pB0,pB1,t+1,(t+4<NT),(t+2<NT),(t+2<NT));     ENDW(t+1); RESC(); ROT();
  }
  STEP(pB0,pB1,pA0,pA1,NT-1,false,false,false); RESC();
  { float sacc=pB0[0]+pB0[1]; _Pragma("unroll") for(int r=2;r<16;++r)sacc+=pB0[r]; _Pragma("unroll") for(int r=0;r<16;++r)sacc+=pB1[r]; l_reg+=sacc;
    pw0=(u32x4){PKW(pB0,0),PKW(pB0,2),PKW(pB0,4),PKW(pB0,6)};pw1=(u32x4){PKW(pB0,8),PKW(pB0,10),PKW(pB0,12),PKW(pB0,14)};pw2=(u32x4){PKW(pB1,0),PKW(pB1,2),PKW(pB1,4),PKW(pB1,6)};pw3=(u32x4){PKW(pB1,8),PKW(pB1,10),PKW(pB1,12),PKW(pB1,14)};
    SBAR(); pv(o,vb0+sl_cur,PAF(0),PAF(1),PAF(2),PAF(3)); }
  #undef PKW
  #undef PAF
  #undef VFR
  #undef PIN
  #undef MX3
  #undef GAPA
  #undef GAPB
  #undef EX
  #undef VRD
  #undef KRD
  #undef STEP
  #undef ENDW
  {auto rr=__builtin_amdgcn_permlane32_swap(__float_as_uint(l_reg),__float_as_uint(l_reg),false,false);l_reg=__uint_as_float(rr[0])+__uint_as_float(rr[1]);}
  if(hi==0)wsf[32+r32]=l_reg;asm volatile("s_waitcnt lgkmcnt(0)":::"memory");
  float rli[16];
  #pragma unroll
  for(int r=0;r<16;++r)rli[r]=__builtin_amdgcn_rcpf(wsf[32+crow(r,hi)]);
  bf16*Ow=O+(qrow0+wid*QBLK)*OP+h*D;
  { bf16*stg=(bf16*)(shm+LDS_OST)+wid*2048;
    #pragma unroll
    for(int r=0;r<16;++r){const int orow=crow(r,hi);
      #pragma unroll
      for(int d0=0;d0<2;++d0)stg[orow*64+d0*32+r32]=__float2bfloat16(o[d0][r]*rli[r]);}
    asm volatile("s_waitcnt lgkmcnt(0)":::"memory");
    #pragma unroll
    for(int i=0;i<4;++i){const int row=i*8+(lane>>3),ch=lane&7; const u32x4 v=*(const u32x4*)(stg+row*64+ch*8); ATTN_STORE16(Ow+(long)row*OP+ch*8,v);} }
  asm volatile("s_waitcnt lgkmcnt(0)\n\ts_barrier":::"memory");
  #undef DMA_K
  #undef DMA_V
  #undef CMASK
  #undef START
  #undef RESC
  #undef ROT
}
constexpr int ATTN_LDS_BYTES=LDS_BYTES;
#undef SBAR
#undef WAIT_BAR
}
typedef GAS unsigned gu32;
typedef GAS unsigned long long gu64;
#define RLX_AGENT __ATOMIC_RELAXED, __HIP_MEMORY_SCOPE_AGENT
#define LDS_WAIT() asm volatile("s_waitcnt lgkmcnt(0)" ::: "memory")
#define VM_WAIT() asm volatile("s_waitcnt vmcnt(0)" ::: "memory")
__device__ __forceinline__ unsigned long long rt() { return __builtin_amdgcn_s_memrealtime(); }

#define XB_TMO      128
#define XB_XCNT(j)  (256  + 64 * (j))
#define XB_XSUB(j)  (1280 + 64 * (j))
#define XB_XGEN(j)  (2304 + 64 * (j))
#define XB_TOP      3328
#define XB_TOPGEN   3392
#define XCD_BAR_WORDS 3456
#define XB_SPIN_CAP (1u << 18)

__device__ __forceinline__ unsigned xb_ld(unsigned* p)              { return __hip_atomic_load(p, __ATOMIC_RELAXED, __HIP_MEMORY_SCOPE_AGENT); }
__device__ __forceinline__ unsigned xb_add(unsigned* p, unsigned v) { return __hip_atomic_fetch_add(p, v, __ATOMIC_RELAXED, __HIP_MEMORY_SCOPE_AGENT); }
__device__ __forceinline__ unsigned xb_xcc_id() { return (unsigned)__builtin_amdgcn_s_getreg((3 << 11) | 20) & 0xFu; }
#define XB_SPIN(cond, bar) do { unsigned _sp = 0; while (cond) { __builtin_amdgcn_s_sleep(1); \
    if ((++_sp & 255u) == 0u) { if (xb_ld(&(bar)[XB_TMO])) break; if (_sp > XB_SPIN_CAP) { atomicAdd(&(bar)[XB_TMO], 1u); break; } } } } while (0)

struct XcdBarrier {
    unsigned* bar; unsigned x;
    volatile LAS unsigned* st;
};

__device__ __forceinline__ XcdBarrier xcd_barrier_post(unsigned* bar, volatile LAS unsigned* st) {
    XcdBarrier b; b.bar = bar; b.x = xb_xcc_id(); b.st = st;
    if (threadIdx.x == 0) (void)xb_add(&bar[XB_XCNT(b.x)], 1u);
    return b;
}
__device__ __forceinline__ void xcd_barrier_complete(unsigned* bar, unsigned x, unsigned& nloc, unsigned& nx) {
    const unsigned G = gridDim.x * gridDim.y * gridDim.z;
    unsigned sum, cnt, mine, sp = 0u;
    for (;;) {
        sum = 0u; cnt = 0u; mine = 0u;
#pragma unroll
        for (unsigned j = 0; j < 16; ++j) { const unsigned c = xb_ld(&bar[XB_XCNT(j)]); sum += c; cnt += (c > 0u) ? 1u : 0u; mine = (j == x) ? c : mine; }
        if (sum == G) break;
        __builtin_amdgcn_s_sleep(1);
        if ((++sp & 255u) == 0u) { if (xb_ld(&bar[XB_TMO])) break; if (sp > XB_SPIN_CAP) { atomicAdd(&bar[XB_TMO], 1u); break; } }
    }
    nloc = mine > 0u ? mine : 1u; nx = cnt > 0u ? cnt : 1u;
}

__device__ __forceinline__ void xcd_barrier(const XcdBarrier& b) {
    asm volatile("s_waitcnt vmcnt(0)" ::: "memory");
    __syncthreads();
    if (threadIdx.x == 0) {
        unsigned zb_; asm volatile("v_mov_b32 %0, 0" : "=v"(zb_));
        unsigned* bar = (unsigned*)((unsigned char*)b.bar + zb_);
        __builtin_amdgcn_s_waitcnt(0);
        unsigned nloc = b.st[0], nx = b.st[1];
        if (nloc == 0u) { xcd_barrier_complete(bar, b.x, nloc, nx); b.st[0] = nloc; b.st[1] = nx; }
        const unsigned old = xb_add(&bar[XB_XSUB(b.x)], 1u);
        const unsigned gen = old / nloc;
        if (old + 1u == (gen + 1u) * nloc) {
            __builtin_amdgcn_fence(__ATOMIC_RELEASE, "agent");
            asm volatile("s_waitcnt vmcnt(0)" ::: "memory");
            const unsigned og = xb_add(&bar[XB_TOP], 1u);
            const unsigned tg = og / nx;
            if (og + 1u == (tg + 1u) * nx) xb_add(&bar[XB_TOPGEN], 1u);
            else XB_SPIN(xb_ld(&bar[XB_TOPGEN]) == tg, bar);
            __builtin_amdgcn_fence(__ATOMIC_ACQUIRE, "agent");
            xb_add(&bar[XB_XGEN(b.x)], 1u);
            asm volatile("s_waitcnt vmcnt(0)" ::: "memory");
        } else {
            XB_SPIN(xb_ld(&bar[XB_XGEN(b.x)]) == gen, bar);
            __builtin_amdgcn_fence(__ATOMIC_ACQUIRE, "agent");
            asm volatile("s_waitcnt vmcnt(0)" ::: "memory");
        }
    }
    __syncthreads();
}

DI float lx_f(float v, int src) { return __builtin_bit_cast(float, __builtin_amdgcn_ds_bpermute(src << 2, __builtin_bit_cast(int, v))); }
DI int lx_i(int v, int src) { return __builtin_amdgcn_ds_bpermute(src << 2, v); }
template <int CTRL> DI float dppf(float v) { return __builtin_bit_cast(float, __builtin_amdgcn_update_dpp(0, __builtin_bit_cast(int, v), CTRL, 0xf, 0xf, false)); }
DI float dx1(float v) { return dppf<0xB1>(v); }
DI float dx2(float v) { return dppf<0x4E>(v); }
DI float sum8(float v) { v += dx1(v); v += dx2(v); v += dppf<0x141>(v); return v; }
DI float wave_sum(float v, int lane) {
    (void)lane; v = sum8(v); v += dppf<0x140>(v);
    const float a = __builtin_bit_cast(float, __builtin_amdgcn_readlane(__builtin_bit_cast(int, v), 0)), b = __builtin_bit_cast(float, __builtin_amdgcn_readlane(__builtin_bit_cast(int, v), 16));
    const float c = __builtin_bit_cast(float, __builtin_amdgcn_readlane(__builtin_bit_cast(int, v), 32)), d = __builtin_bit_cast(float, __builtin_amdgcn_readlane(__builtin_bit_cast(int, v), 48));
    return (a + b) + (c + d);
}
template <int CTRL, int ROWMASK> DI float dppf_old(float old, float v) { return __builtin_bit_cast(float, __builtin_amdgcn_update_dpp(__builtin_bit_cast(int, old), __builtin_bit_cast(int, v), CTRL, ROWMASK, 0xf, false)); }
DI float rl_f(float v, int l) { return __builtin_bit_cast(float, __builtin_amdgcn_readlane(__builtin_bit_cast(int, v), l)); }
DI float wave_max(float v, int lane) {
    (void)lane; v = fmaxf(v, dx1(v)); v = fmaxf(v, dx2(v)); v = fmaxf(v, dppf<0x141>(v)); v = fmaxf(v, dppf<0x140>(v));
    return fmaxf(fmaxf(rl_f(v, 0), rl_f(v, 16)), fmaxf(rl_f(v, 32), rl_f(v, 48)));
}
DI float wave_incl_sum(float v, int lane) {
    (void)lane;
    v += dppf_old<0x111, 0xf>(0.f, v); v += dppf_old<0x112, 0xf>(0.f, v); v += dppf_old<0x114, 0xf>(0.f, v); v += dppf_old<0x118, 0xf>(0.f, v);
    v += dppf_old<0x142, 0xa>(0.f, v); v += dppf_old<0x143, 0xc>(0.f, v);
    return v;
}
DI float wave_incl_max(float v, int lane) {
    (void)lane; const float ninf = -INFINITY;
    v = fmaxf(v, dppf_old<0x111, 0xf>(ninf, v)); v = fmaxf(v, dppf_old<0x112, 0xf>(ninf, v)); v = fmaxf(v, dppf_old<0x114, 0xf>(ninf, v)); v = fmaxf(v, dppf_old<0x118, 0xf>(ninf, v));
    v = fmaxf(v, dppf_old<0x142, 0xa>(ninf, v)); v = fmaxf(v, dppf_old<0x143, 0xc>(ninf, v));
    return v;
}
template <int NT, int KS> DI void mma_tile(f32x4 (&acc)[NT], const LAS bf16_t* A, int lda, const LAS bf16_t* Bt, int ldb, int lane) {
    const int fr = lane & 15, fq = lane >> 4;
#pragma unroll
    for (int ks = 0; ks < KS; ++ks) {
        const bf16x8 a = *(const LAS bf16x8*)(A + fr * lda + ks * 32 + fq * 8);
#pragma unroll
        for (int nt = 0; nt < NT; ++nt) {
            const bf16x8 b = *(const LAS bf16x8*)(Bt + (nt * 16 + fr) * ldb + ks * 32 + fq * 8);
            acc[nt] = __builtin_amdgcn_mfma_f32_16x16x32_bf16(a, b, acc[nt], 0, 0, 0);
        }
    }
}

struct Ctx {
    LAS unsigned char* lds;
    unsigned char* ws;
    const float* const* in;
    float* out;
    int tid, lane, wave, G, bx;
};
#define INP(k) ((const float*)(const GAS float*)C.in[k])
DI unsigned char* opaque_ptr(unsigned char* q) { unsigned lo = (unsigned)(uintptr_t)q, hi = (unsigned)((uintptr_t)q >> 32); lo = (unsigned)__builtin_amdgcn_readfirstlane((int)lo); hi = (unsigned)__builtin_amdgcn_readfirstlane((int)hi);
    asm volatile("" : "+s"(lo), "+s"(hi)); return (unsigned char*)(GAS unsigned char*)(((uintptr_t)hi << 32) | (uintptr_t)lo); }
DI Ctx launder(const Ctx& C0) { Ctx C = C0; unsigned m = ~0u; asm volatile("" : "+s"(m));
    { const LAS unsigned* pw = (const LAS unsigned*)(unsigned)(MISC_OFF + 64);
      unsigned w0 = pw[0], w1 = pw[1], o0 = pw[2], o1 = pw[3]; asm volatile("" : "+v"(w0), "+v"(w1), "+v"(o0), "+v"(o1));
      w0 = (unsigned)__builtin_amdgcn_readfirstlane((int)w0); w1 = (unsigned)__builtin_amdgcn_readfirstlane((int)w1); o0 = (unsigned)__builtin_amdgcn_readfirstlane((int)o0); o1 = (unsigned)__builtin_amdgcn_readfirstlane((int)o1);
      C.ws = (unsigned char*)(GAS unsigned char*)(((uintptr_t)w1 << 32) | (uintptr_t)w0); C.out = (float*)(GAS float*)(((uintptr_t)o1 << 32) | (uintptr_t)o0); }
    C.lane = (int)__builtin_amdgcn_mbcnt_hi(m, __builtin_amdgcn_mbcnt_lo(m, 0u)); C.tid = (C0.wave << 6) | C.lane; return C; }

struct MapId { DI int operator()(int c) const { return c; } };
struct MapTile { DI int operator()(int c) const { const int t = c & 255; return (c & ~255) + 128 * ((t >> 5) & 1) + 32 * (t >> 6) + (t & 31); } };
struct MapE1 { DI int operator()(int c) const { const int j = c >> 1; return (j >> 7) * 256 + (c & 1) * 128 + (j & 127); } };
template <class Map> DI void tr_item(const float* W, int K, int N, bf16_t* WT, LAS float* scr, int kb, int nb, int lane, Map map, int ldw) {
    const int k0 = 64 * kb, n0 = 64 * nb;
    const bool nv = (n0 + lane) < N;
    const float* src = W + (size_t)k0 * N + n0 + lane;
#pragma unroll 8
    for (int i = 0; i < 64; ++i) scr[i * 65 + lane] = nv ? src[(size_t)i * N] : 0.f;
    LDS_WAIT(); asm volatile("" ::: "memory");
    const int c = lane & 7;
#pragma unroll
    for (int j = 0; j < 8; ++j) {
        const int n = (lane >> 3) + 8 * j;
        if (n0 + n < N) {
            const LAS float* s = scr + (8 * c) * 65 + n;
            v4u o; o.x = pk2(s[0], s[65]); o.y = pk2(s[130], s[195]); o.z = pk2(s[260], s[325]); o.w = pk2(s[390], s[455]);
            *(v4u*)(WT + (size_t)map(n0 + n) * ldw + k0 + 8 * c) = o;
        }
    }
    LDS_WAIT(); asm volatile("" ::: "memory");
}
template <bool EDGE, class Map> DI void tr_item8_(const float* W, int K, int N, unsigned char* WT, LAS float* scr, int k0, int n0, int lane, Map map, float scale) {
    const bool nv = !EDGE || (n0 + lane) < N;
    const float* src = W + (size_t)k0 * N + n0 + (nv ? lane : 0);
    { float t[64];
#pragma unroll
        for (int i = 0; i < 64; ++i) t[i] = src[(size_t)i * N];
        __builtin_amdgcn_sched_barrier(0);
#pragma unroll
        for (int i = 0; i < 64; ++i) scr[i * 65 + lane] = t[i]; }
    LDS_WAIT(); asm volatile("" ::: "memory");
    const int c = lane & 3;
#pragma unroll
    for (int j = 0; j < 4; ++j) {
        const int n = (lane >> 2) + 16 * j;
        const LAS float* s = scr + (16 * c) * 65 + n;
        v4u o;
        o.x = pk4_fp8(s[0] * scale, s[65] * scale, s[130] * scale, s[195] * scale); o.y = pk4_fp8(s[260] * scale, s[325] * scale, s[390] * scale, s[455] * scale);
        o.z = pk4_fp8(s[520] * scale, s[585] * scale, s[650] * scale, s[715] * scale); o.w = pk4_fp8(s[780] * scale, s[845] * scale, s[910] * scale, s[975] * scale);
        if (!EDGE || n0 + n < N) *(v4u*)(WT + (size_t)map(n0 + n) * K + k0 + 16 * c) = o;
    }
    LDS_WAIT(); asm volatile("" ::: "memory");
}
template <class Map> DI void tr_item8(const float* W, int K, int N, unsigned char* WT, LAS float* scr, int kb, int nb, int lane, Map map, float scale) {
    if (64 * nb + 64 <= N) tr_item8_<false>(W, K, N, WT, scr, 64 * kb, 64 * nb, lane, map, scale); else tr_item8_<true>(W, K, N, WT, scr, 64 * kb, 64 * nb, lane, map, scale);
}
struct It8 { const float* src; unsigned char* dst; int N, K, k0, n0; bool e1, edge; };
DI void ld8(const It8& d, float (&t)[64], int lane) {
    const bool nv = !d.edge || (d.n0 + lane) < d.N;
    const float* s = d.src + (size_t)d.k0 * d.N + d.n0 + (nv ? lane : 0);
#pragma unroll
    for (int i = 0; i < 64; ++i) t[i] = s[(size_t)i * d.N];
}
DI void st8i(const It8& d, const float (&t)[64], LAS float* scr, int lane, float scale) {
#pragma unroll
    for (int i = 0; i < 64; ++i) scr[i * 65 + lane] = t[i];
    LDS_WAIT(); asm volatile("" ::: "memory");
    const int c = lane & 3;
#pragma unroll
    for (int j = 0; j < 4; ++j) {
        const int n = (lane >> 2) + 16 * j;
        const LAS float* s = scr + (16 * c) * 65 + n;
        v4u o;
        o.x = pk4_fp8(s[0] * scale, s[65] * scale, s[130] * scale, s[195] * scale); o.y = pk4_fp8(s[260] * scale, s[325] * scale, s[390] * scale, s[455] * scale);
        o.z = pk4_fp8(s[520] * scale, s[585] * scale, s[650] * scale, s[715] * scale); o.w = pk4_fp8(s[780] * scale, s[845] * scale, s[910] * scale, s[975] * scale);
        const int col = d.n0 + n, row = d.e1 ? MapE1()(col) : col;
        if (!d.edge || col < d.N) *(v4u*)(d.dst + (size_t)row * d.K + d.k0 + 16 * c) = o;
    }
    LDS_WAIT(); asm volatile("" ::: "memory");
}
DI void p0_prologue(const Ctx& C) {
    __syncthreads();
    {
        LAS float* sc = (LAS float*)(C.lds + RING_OFF);
        LAS float* red = (LAS float*)(C.lds + RING_OFF + 9 * 1024 * 4);
        for (int i = C.tid; i < 9 * 1024; i += 512) { const float v = (i < 8192) ? INP(I_C)[i] : INP(I_CCTX)[i - 8192]; sc[i] = silu_f(v); }
        __syncthreads();
        float* MOD = (float*)(C.ws + WS_MOD);
        for (int u = C.bx; u < DEPTH * 96; u += C.G) {
            const int l = u / 96, cg = u % 96, ci = C.tid & 63, kg = C.tid >> 6;
            const float* w = INP(I_WADA) + ((size_t)l * 1024 + kg * 128) * 6144 + cg * 64 + ci;
            float s[9];
#pragma unroll
            for (int b = 0; b < 9; ++b) s[b] = 0.f;
#pragma unroll 16
            for (int k = 0; k < 128; ++k) { const float wv = w[(size_t)k * 6144];
#pragma unroll
                for (int b = 0; b < 9; ++b) s[b] += sc[b * 1024 + kg * 128 + k] * wv; }
#pragma unroll
            for (int b = 0; b < 9; ++b) red[(kg * 9 + b) * 64 + ci] = s[b];
            __syncthreads();
            for (int o = C.tid; o < 9 * 64; o += 512) { const int b = o >> 6, c2 = o & 63; float t = 0.f;
#pragma unroll
                for (int g = 0; g < 8; ++g) t += red[(g * 9 + b) * 64 + c2];
                MOD[((size_t)l * 9 + b) * 6144 + cg * 64 + c2] = t + INP(I_BADA)[l * 6144 + cg * 64 + c2]; }
            __syncthreads();
        }
    }
    {
        LAS float* scr = (LAS float*)(C.lds + RING_OFF + C.wave * 16640);
        const int gw = C.bx * 8 + C.wave, NGW = C.G * 8;
        constexpr int IT_IN = 16 * 109, IT_BR = 8 * 16, IT_OUT = 16 * 16, IT_E1 = 16 * 32, IT_E2 = 16 * 16;
        constexpr int N0 = DEPTH * IT_IN, N1 = N0 + DEPTH * 3 * IT_BR, N2 = N1 + DEPTH * IT_OUT, N3 = N2 + DEPTH * NEXP * IT_E1, N4 = N3 + DEPTH * NEXP * IT_E2;
        for (int it = N0 + gw; it < N2; it += NGW) {
            if (it < N1) { const int q = it - N0, m = q / IT_BR, r = q % IT_BR; tr_item(INP(I_WBR) + (size_t)m * 512 * DM, 512, DM, (bf16_t*)(C.ws + WS_WTBR) + (size_t)(m / 3) * DM * 1536 + (m % 3) * 512, scr, r / 16, r % 16, C.lane, MapId(), 1536); }
            else { const int q = it - N1, m = q / IT_OUT, r = q % IT_OUT; tr_item(INP(I_WOUT) + (size_t)m * DM * DM, DM, DM, (bf16_t*)(C.ws + WS_WTOUT) + (size_t)m * DM * DM, scr, r / 16, r % 16, C.lane, MapId(), DM); }
        }
        constexpr int NJ = N0 + (N4 - N2);
        auto dec8 = [&](int j) -> It8 { It8 d;
            if (j < N0) { const int m = j / IT_IN, r = j % IT_IN; d.src = INP(I_WIN) + (size_t)m * DM * IN_W; d.dst = (unsigned char*)(C.ws + WS_WTIN) + (size_t)m * PW * DM; d.N = IN_W; d.K = DM; d.k0 = 64 * (r / 109); d.n0 = 64 * (r % 109); d.e1 = false; d.edge = (d.n0 + 64 > IN_W); }
            else { const int it = j - N0 + N2;
                if (it < N3) { const int q = it - N2, m = q / IT_E1, r = q % IT_E1; d.src = INP(I_WE1) + (size_t)m * DM * 2048; d.dst = (unsigned char*)(C.ws + WS_WTE1) + (size_t)m * 2048 * DM; d.N = 2048; d.K = DM; d.k0 = 64 * (r / 32); d.n0 = 64 * (r % 32); d.e1 = true; d.edge = false; }
                else { const int q = it - N3, m = q / IT_E2, r = q % IT_E2; d.src = INP(I_WE2) + (size_t)m * DFF * DM; d.dst = (unsigned char*)(C.ws + WS_WTE2) + (size_t)m * DM * DFF; d.N = DM; d.K = DFF; d.k0 = 64 * (r / 16); d.n0 = 64 * (r % 16); d.e1 = false; d.edge = false; } }
            return d; };
        It8 d0, d1; float t0[64], t1[64];
        int j = gw;
        if (j < NJ) { d0 = dec8(j); ld8(d0, t0, C.lane); }
        for (; j < NJ; j += 2 * NGW) {
            const int j1 = j + NGW, j2 = j1 + NGW;
            if (j1 < NJ) { d1 = dec8(j1); ld8(d1, t1, C.lane); }
            st8i(d0, t0, scr, C.lane, FP8_SW);
            if (j2 < NJ) { d0 = dec8(j2); ld8(d0, t0, C.lane); }
            if (j1 < NJ) st8i(d1, t1, scr, C.lane, FP8_SW);
        }
    }
}

DI void phase_norm1(const Ctx& C, int l, float pscale) {
    const int gw = C.bx * 8 + C.wave, NGW = C.G * 8, lane = C.lane;
    bf16_t* X = (bf16_t*)(C.ws + WS_X); unsigned char* H8 = (unsigned char*)(C.ws + WS_H);
    const float* MOD = (const float*)(C.ws + WS_MOD);
    const int* TOKP = (const int*)(C.ws + WS_TOKP); const bf16_t* YS = (const bf16_t*)(C.ws + WS_YS); const bf16_t* U = (const bf16_t*)(C.ws + WS_U);
    const bool fin = (l == DEPTH);
    const int nrows = fin ? M_LAT : MROWS;
    const int rpw = (nrows + NGW - 1) / NGW, rbeg = gw * rpw, rend = (rbeg + rpw < nrows) ? rbeg + rpw : nrows;
    f32x4 gn[4];
#pragma unroll
    for (int j = 0; j < 4; ++j) gn[j] = *(const f32x4*)((fin ? INP(I_GF) : INP(I_GN1) + (size_t)l * DM) + (lane + 64 * j) * 4);
    int mi_cur = -1; f32x4 g2v[4], g1v[4], s1v[4], s0v[4];
    int4 sl = make_int4(0, 0, 0, 0); v2u xr[4];
    if (rbeg < rend) {
        if (l > 0) { sl = *(const int4*)(TOKP + (size_t)rbeg * 4);
#pragma unroll
            for (int j = 0; j < 4; ++j) xr[j] = *(const v2u*)(X + (size_t)rbeg * DM + (lane + 64 * j) * 4); }
    }
    for (int r = rbeg; r < rend; ++r) {
        const int mi = r < M_LAT ? (r >> 12) : 8;
        if (mi != mi_cur) {
            mi_cur = mi;
#pragma unroll
            for (int j = 0; j < 4; ++j) { const int c = (lane + 64 * j) * 4;
                g2v[j] = (l > 0) ? *(const f32x4*)(MOD + ((size_t)(l - 1) * 9 + mi) * 6144 + 5 * DM + c) * pscale : (f32x4){0.f, 0.f, 0.f, 0.f};
                g1v[j] = (l > 0) ? *(const f32x4*)(MOD + ((size_t)(l - 1) * 9 + mi) * 6144 + 2 * DM + c) * pscale : (f32x4){0.f, 0.f, 0.f, 0.f};
                if (!fin) { s0v[j] = *(const f32x4*)(MOD + ((size_t)l * 9 + mi) * 6144 + c); s1v[j] = *(const f32x4*)(MOD + ((size_t)l * 9 + mi) * 6144 + DM + c) + 1.0f; } }
        }
        f32x4 v[4];
        if (l == 0) {
            const float* src = r < M_LAT ? INP(I_X) + (size_t)r * DM : INP(I_CTX) + (size_t)(r - M_LAT) * DM;
#pragma unroll
            for (int j = 0; j < 4; ++j) v[j] = *(const f32x4*)(src + (lane + 64 * j) * 4);
        } else {
            const bf16_t* y0 = YS + (size_t)sl.x * DM; const bf16_t* y1 = YS + (size_t)sl.y * DM; const bf16_t* y2 = YS + (size_t)sl.z * DM; const bf16_t* y3 = YS + (size_t)sl.w * DM;
            v2u ya[4], yb[4], yc[4], yd[4];
#pragma unroll
            for (int j = 0; j < 4; ++j) { const int c = (lane + 64 * j) * 4; ya[j] = *(const v2u*)(y0 + c); yb[j] = *(const v2u*)(y1 + c); yc[j] = *(const v2u*)(y2 + c); yd[j] = *(const v2u*)(y3 + c); }
#pragma unroll
            for (int j = 0; j < 4; ++j) { const v2u uu = *(const v2u*)(U + (size_t)r * DM + (lane + 64 * j) * 4); const v2u xx = xr[j]; v[j] = (f32x4){bf2f(xx.x & 0xffffu), bf2f(xx.x >> 16), bf2f(xx.y & 0xffffu), bf2f(xx.y >> 16)} + g1v[j] * (f32x4){bf2f(uu.x & 0xffffu), bf2f(uu.x >> 16), bf2f(uu.y & 0xffffu), bf2f(uu.y >> 16)}; }
            if (r + 1 < rend) { sl = *(const int4*)(TOKP + (size_t)(r + 1) * 4);
#pragma unroll
                for (int j = 0; j < 4; ++j) xr[j] = *(const v2u*)(X + (size_t)(r + 1) * DM + (lane + 64 * j) * 4); }
#pragma unroll
            for (int j = 0; j < 4; ++j) {
                const v2u a = ya[j], b = yb[j], cc = yc[j], d = yd[j];
                f32x4 f;
                f[0] = ((bf2f(a.x & 0xffffu) + bf2f(b.x & 0xffffu)) + bf2f(cc.x & 0xffffu)) + bf2f(d.x & 0xffffu);
                f[1] = ((bf2f(a.x >> 16) + bf2f(b.x >> 16)) + bf2f(cc.x >> 16)) + bf2f(d.x >> 16);
                f[2] = ((bf2f(a.y & 0xffffu) + bf2f(b.y & 0xffffu)) + bf2f(cc.y & 0xffffu)) + bf2f(d.y & 0xffffu);
                f[3] = ((bf2f(a.y >> 16) + bf2f(b.y >> 16)) + bf2f(cc.y >> 16)) + bf2f(d.y >> 16);
                v[j] = v[j] + g2v[j] * f;
            }
        }
        if (!fin) {
#pragma unroll
            for (int j = 0; j < 4; ++j) { v2u o; o.x = pk2(v[j][0], v[j][1]); o.y = pk2(v[j][2], v[j][3]); *(v2u*)(X + (size_t)r * DM + (lane + 64 * j) * 4) = o; }
        }
        float ss = 0.f;
#pragma unroll
        for (int j = 0; j < 4; ++j) ss += (v[j][0] * v[j][0] + v[j][1] * v[j][1]) + (v[j][2] * v[j][2] + v[j][3] * v[j][3]);
        const float rstd = __builtin_amdgcn_rsqf(wave_sum(ss, lane) * (1.0f / DM) + EPS);
        if (fin) {
#pragma unroll
            for (int j = 0; j < 4; ++j) *(f32x4*)(C.out + (size_t)r * DM + (lane + 64 * j) * 4) = v[j] * rstd * gn[j];
        } else {
#pragma unroll
            for (int j = 0; j < 4; ++j) {
                const int c = (lane + 64 * j) * 4;
                const f32x4 h = v[j] * rstd * gn[j] * s1v[j] + s0v[j];
                *(unsigned*)(H8 + (size_t)r * DM + c) = pk4_fp8(h[0] * FP8_SH, h[1] * FP8_SH, h[2] * FP8_SH, h[3] * FP8_SH);
            }
        }
    }
}

DI void rope_cs(float (&c)[8], float (&s)[8], const float (&freq)[8], int lane, int t) {
    const int sub = lane & 7;
    const float pos = (sub >= 4) ? (float)(t & 63) : (float)(t >> 6);
#pragma unroll
    for (int e = 0; e < 8; ++e) { float rev = pos * freq[e]; rev -= floorf(rev); c[e] = __builtin_amdgcn_cosf(rev); s[e] = __builtin_amdgcn_sinf(rev); }
}
DI void rope_apply(float (&x)[8], const float (&c)[8], const float (&s)[8], int lane) {
    const bool second = (lane & 2) != 0;
#pragma unroll
    for (int e = 0; e < 8; ++e) { const float other = dx2(x[e]); x[e] = second ? (x[e] * c[e] + other * s[e]) : (x[e] * c[e] - other * s[e]); }
}
DI void phase_attn_prep(const Ctx& C, int l) {
    const int gw = C.bx * 8 + C.wave, NGW = C.G * 8, lane = C.lane;
    const bf16_t* P = (const bf16_t*)(C.ws + WS_P);
    bf16_t* QR = (bf16_t*)(C.ws + WS_QR); bf16_t* KR = (bf16_t*)(C.ws + WS_KR); bf16_t* VR = (bf16_t*)(C.ws + WS_VR);
    float gq[8], gk[8], freq[8];
#pragma unroll
    for (int e = 0; e < 8; ++e) { gq[e] = INP(I_BQG)[l * 64 + (lane & 7) * 8 + e]; gk[e] = INP(I_BKG)[l * 64 + (lane & 7) * 8 + e];
        freq[e] = __builtin_amdgcn_exp2f(-(float)((lane & 1) * 8 + e) * 0.83048202372184058696f) * 0.15915494309189533577f; }
    constexpr float C2 = 0.125f * 1.4426950408889634f;
    const int kl = lane & 15;
    v4u nq = {0u, 0u, 0u, 0u}, nk = nq, nv = nq;
    if (gw < MROWS) { const bf16_t* prow = P + (size_t)gw * PW; nq = *(const v4u*)(prow + C_BQ + lane * 8); nk = *(const v4u*)(prow + C_BK + kl * 8); nv = *(const v4u*)(prow + C_BV + kl * 8); }
    for (int r = gw; r < MROWS; r += NGW) {
        const bool lat = r < M_LAT;
        const int b = lat ? (r >> 12) : ((r - M_LAT) >> 8), t = lat ? (r & 4095) : ((r - M_LAT) & 255), kvpos = lat ? (CTXL + t) : t;
        const v4u cq = nq, ck = nk, cv = nv;
        if (r + NGW < MROWS) { const bf16_t* prow = P + (size_t)(r + NGW) * PW; nq = *(const v4u*)(prow + C_BQ + lane * 8); nk = *(const v4u*)(prow + C_BK + kl * 8); nv = *(const v4u*)(prow + C_BV + kl * 8); }
        float rc[8], rs[8];
        if (lat) rope_cs(rc, rs, freq, lane, t);
        float x[8];
        unpack8(cq, x);
        float ss = 0.f;
#pragma unroll
        for (int e = 0; e < 8; ++e) ss += x[e] * x[e];
        ss = sum8(ss);
        float rstd = __builtin_amdgcn_rsqf(ss * (1.0f / 64.0f) + EPS);
#pragma unroll
        for (int e = 0; e < 8; ++e) x[e] = x[e] * rstd * gq[e];
        if (lat) rope_apply(x, rc, rs, lane);
        { v4u o; o.x = pk2(x[0] * C2, x[1] * C2); o.y = pk2(x[2] * C2, x[3] * C2); o.z = pk2(x[4] * C2, x[5] * C2); o.w = pk2(x[6] * C2, x[7] * C2);
          *(v4u*)(QR + (size_t)r * 512 + lane * 8) = o; }
        unpack8(ck, x);
        ss = 0.f;
#pragma unroll
        for (int e = 0; e < 8; ++e) ss += x[e] * x[e];
        ss = sum8(ss);
        rstd = __builtin_amdgcn_rsqf(ss * (1.0f / 64.0f) + EPS);
#pragma unroll
        for (int e = 0; e < 8; ++e) x[e] = x[e] * rstd * gk[e];
        if (lat) rope_apply(x, rc, rs, lane);
        const size_t kvrow = ((size_t)b * KVLEN + kvpos) * 128;
        if (lane < 16) { v4u o; o.x = pk2(x[0], x[1]); o.y = pk2(x[2], x[3]); o.z = pk2(x[4], x[5]); o.w = pk2(x[6], x[7]); *(v4u*)(KR + kvrow + kl * 8) = o; }
        else if (lane < 32) { *(v4u*)(VR + kvrow + kl * 8) = cv; }
    }
}

constexpr int LDT = 72;
constexpr unsigned short BF16_ONE = 0x3F80;
DI int chunk_pos0(int c) { return (c < 512 ? (c & 63) : ((c - 512) & 3)) * 64; }
DI int chunk_len(int c) { return c < 512 ? SEQ : CTXL; }

struct ConvIn { v4u x0, xm, xp; };
DI void conv_load(ConvIn& r, const bf16_t* P, int row0, int t, int pos0, int seqlen, int col) {
    const bf16_t* p = P + (size_t)(row0 + t) * PW + col;
    r.x0 = *(const v4u*)p;
    r.xm = (v4u){0u, 0u, 0u, 0u}; r.xp = (v4u){0u, 0u, 0u, 0u};
    if (pos0 + t - 1 >= 0) r.xm = *(const v4u*)(p - PW);
    if (pos0 + t + 1 < seqlen) r.xp = *(const v4u*)(p + PW);
}
DI void conv_apply(const ConvIn& r, const LAS float* cwt, int c8, float (&y)[8]) {
    float xm[8], x0[8], xp[8]; unpack8(r.xm, xm); unpack8(r.x0, x0); unpack8(r.xp, xp);
#pragma unroll
    for (int hh = 0; hh < 2; ++hh) {
        const f32x4 w0 = *(const LAS f32x4*)(cwt + c8 + 4 * hh), w1 = *(const LAS f32x4*)(cwt + 64 + c8 + 4 * hh), w2 = *(const LAS f32x4*)(cwt + 128 + c8 + 4 * hh), bb = *(const LAS f32x4*)(cwt + 192 + c8 + 4 * hh);
#pragma unroll
        for (int e = 0; e < 4; ++e) y[4 * hh + e] = silu_f(xm[4 * hh + e] * w0[e] + x0[4 * hh + e] * w1[e] + xp[4 * hh + e] * w2[e] + bb[e]);
    }
}
DI void conv_table(const Ctx& C, LAS float* cwt, int l, int h) {
    const float* cw = INP(I_ACW) + (size_t)l * 3 * 512; const float* cb = INP(I_ACB) + (size_t)l * 512;
    const int qk = C.tid >> 8, row = (C.tid >> 6) & 3, ch = C.tid & 63, col = qk * 256 + h * 64 + ch;
    cwt[C.tid] = row < 3 ? cw[row * 512 + col] : cb[col];
}
DI v4u pack8f(const float (&y)[8], float sc) { v4u o; o.x = pk2(y[0] * sc, y[1] * sc); o.y = pk2(y[2] * sc, y[3] * sc); o.z = pk2(y[4] * sc, y[5] * sc); o.w = pk2(y[6] * sc, y[7] * sc); return o; }
DI void store_vt8(LAS bf16_t* VT, const v4u x, int col, int t) {
    LAS bf16_t* d = VT + col * LDT + t;
    d[0 * LDT] = (bf16_t)(x.x & 0xffffu); d[1 * LDT] = (bf16_t)(x.x >> 16); d[2 * LDT] = (bf16_t)(x.y & 0xffffu); d[3 * LDT] = (bf16_t)(x.y >> 16);
    d[4 * LDT] = (bf16_t)(x.z & 0xffffu); d[5 * LDT] = (bf16_t)(x.z >> 16); d[6 * LDT] = (bf16_t)(x.w & 0xffffu); d[7 * LDT] = (bf16_t)(x.w >> 16);
}
DI void store_ct(LAS bf16_t* CT, const f32x4 (&s)[4], int tid) {
#pragma unroll
    for (int q = 0; q < 4; ++q) {
        const int idx = tid * 4 + q * 2048, v = idx >> 6, d = idx & 63;
        v2u o; o.x = pk2(s[q][0], s[q][1]); o.y = pk2(s[q][2], s[q][3]);
        *(LAS v2u*)(CT + v * LDT + d) = o;
    }
}
template <int ACT, int HSLD> DI void head_out(const Ctx& C, const LAS float* HS, const v4u g0, const v4u g1, int row0, const float (&gain)[16], bf16_t* Y, int h) {
    const int t = C.tid >> 3, sub = C.tid & 7;
    float x[16]; float ss = 0.f;
#pragma unroll
    for (int q = 0; q < 4; ++q) { const f32x4 v = *(const LAS f32x4*)(HS + t * HSLD + sub * 16 + q * 4); x[4 * q] = v[0]; x[4 * q + 1] = v[1]; x[4 * q + 2] = v[2]; x[4 * q + 3] = v[3]; }
#pragma unroll
    for (int e = 0; e < 16; ++e) ss += x[e] * x[e];
    ss = sum8(ss);
    const float rstd = __builtin_amdgcn_rsqf(ss * (1.0f / 128.0f) + EPS);
    float ga[8], gb[8]; unpack8(g0, ga); unpack8(g1, gb);
    float o[16];
#pragma unroll
    for (int e = 0; e < 16; ++e) { const float gv = e < 8 ? ga[e] : gb[e - 8]; const float a = ACT == 0 ? sigmoid_f(gv) : silu_f(gv); o[e] = x[e] * rstd * gain[e] * a; }
    v4u w0, w1; w0.x = pk2(o[0], o[1]); w0.y = pk2(o[2], o[3]); w0.z = pk2(o[4], o[5]); w0.w = pk2(o[6], o[7]); w1.x = pk2(o[8], o[9]); w1.y = pk2(o[10], o[11]); w1.z = pk2(o[12], o[13]); w1.w = pk2(o[14], o[15]);
    bf16_t* yp = Y + (size_t)(row0 + t) * 1536 + h * 128 + sub * 16;
    *(v4u*)yp = w0; *(v4u*)(yp + 8) = w1;
}

DI unsigned char* rec_ptr(unsigned char* base, int c, int h, int dir) { return base + ((size_t)(c * 4 + h) * 2 + dir) * RECB; }
template <bool NVEC> DI void delta_store(const Ctx& C, const LAS bf16_t* KT, const LAS bf16_t* VT, unsigned char* rec) {
    const int part = C.wave & 3, fr = C.lane & 15, fq = C.lane >> 4;
    f32x4 acc[8];
#pragma unroll
    for (int nt = 0; nt < 8; ++nt) acc[nt] = (f32x4){0.f, 0.f, 0.f, 0.f};
    mma_tile<8, 2>(acc, KT + 16 * part * LDT, LDT, VT, LDT, C.lane);
    bf16_t* R = (bf16_t*)rec;
#pragma unroll
    for (int nt = 0; nt < 8; ++nt) { v2u o; o.x = pk2(acc[nt][0], acc[nt][1]); o.y = pk2(acc[nt][2], acc[nt][3]); *(v2u*)(R + (nt * 16 + fr) * 64 + 16 * part + fq * 4) = o; }
    if (NVEC) {
        f32x4 an[1]; an[0] = (f32x4){0.f, 0.f, 0.f, 0.f};
        mma_tile<1, 2>(an, KT + 16 * part * LDT, LDT, VT + 128 * LDT, LDT, C.lane);
        if (fr == 0) { float* nf = (float*)(rec + REC_VEC) + 16 * part + fq * 4; nf[0] = an[0][0]; nf[1] = an[0][1]; nf[2] = an[0][2]; nf[3] = an[0][3]; }
    }
}
DI void store_ct16(LAS bf16_t* CT, const v4u a, const v4u b, int tid) {
    { const int idx = tid * 8; *(LAS v4u*)(CT + (idx >> 6) * LDT + (idx & 63)) = a; }
    { const int idx = tid * 8 + 4096; *(LAS v4u*)(CT + (idx >> 6) * LDT + (idx & 63)) = b; }
}
constexpr int MC_QS = 0, MC_KS = 9216, MC_VT = 18432, MC_CT0 = 39168, MC_CT1 = 59904, MC_SB0 = 80640, MC_SB1 = 89856, MC_HS = 99072, MC_VEC = 132864, MC_CWT = 134912;
static_assert(MC_CWT + 2048 <= RING_BYTES, "mLSTM (c) LDS map");
constexpr int MA_VT = 0, MA_KT0 = 20736, MA_KT1 = 29952, MA_VEC = 39168, MA_CWT = 40192;
struct MARegs { ConvIn k; v4u v0, v1; float gi, gf; };
struct MCRegs { ConvIn q, k; v4u v0, v1, og0, og1, s0a, s0b, s1a, s1b; float gi, gf, aux; };
DI void mlstm_a_load(const Ctx& C, int c, int h, MARegs& R) {
    const bf16_t* P = (const bf16_t*)(C.ws + WS_P);
    const int row0 = c * 64, t = C.lane, c8 = C.wave * 8;
    conv_load(R.k, P, row0, t, chunk_pos0(c), chunk_len(c), C_AQK + 256 + h * 64 + c8);
    const bf16_t* pv = P + (size_t)(row0 + t) * PW + C_AV + h * 128 + c8;
    R.v0 = *(const v4u*)pv; R.v1 = *(const v4u*)(pv + 64);
    R.gi = 0.f; R.gf = 0.f;
    if (C.wave < 2) { const int dir = C.wave, tt = dir ? 63 - C.lane : C.lane; const bf16_t* prow = P + (size_t)(row0 + tt) * PW; R.gi = bf2f(prow[C_AI + dir * 4 + h]); R.gf = bf2f(prow[C_AF + dir * 4 + h]); }
}
DI void mlstm_a_unit(const Ctx& C0, int l, int c, int h, MARegs& R, bool has_next, int cn, int hn) {
    Ctx C = C0; { int t_ = C0.tid; asm volatile("" : "+v"(t_)); C.tid = t_; C.lane = t_ & 63; }
    LAS unsigned char* L = C.lds + RING_OFF;
    LAS bf16_t* VT = (LAS bf16_t*)(L + MA_VT); LAS bf16_t* KT0 = (LAS bf16_t*)(L + MA_KT0); LAS bf16_t* KT1 = (LAS bf16_t*)(L + MA_KT1); LAS float* VEC = (LAS float*)(L + MA_VEC);
    unsigned char* rec0 = rec_ptr(C.ws + WS_STA, c, h, 0);
    const int t = C.lane, c8 = C.wave * 8;
    __syncthreads();
    if (C.wave < 2) {
        const int dir = C.wave, tt = dir ? 63 - C.lane : C.lane;
        const float* gb = INP(I_AGB) + l * 16;
        const float iv = R.gi + gb[dir * 4 + h], fv = logsigmoid_f(R.gf + gb[8 + dir * 4 + h]);
        const float b = wave_incl_sum(fv, C.lane);
        const float B = rl_f(b, 63);
        const float a = B - b + iv;
        const float Ml = wave_max(a, C.lane);
        VEC[dir * 64 + tt] = __expf(a - Ml);
        if (C.lane == 0) { float* sf = (float*)(rec0 + dir * RECB + REC_VEC); sf[64] = B; sf[65] = Ml; }
    }
    float y[8]; conv_apply(R.k, (const LAS float*)(L + MA_CWT) + 256, c8, y);
    store_vt8(VT, R.v0, c8, t); store_vt8(VT, R.v1, 64 + c8, t);
    if (C.tid < 64) VT[128 * LDT + C.tid] = BF16_ONE;
    asm volatile("" ::: "memory"); __builtin_amdgcn_sched_barrier(0);
    if (has_next) mlstm_a_load(C, cn, hn, R);
    asm volatile("" ::: "memory"); __builtin_amdgcn_sched_barrier(0);
    __syncthreads();
    {
        const float w0 = VEC[t] * 0.125f, w1 = VEC[64 + t] * 0.125f;
#pragma unroll
        for (int e = 0; e < 8; ++e) { const unsigned pw = pk2(y[e] * w0, y[e] * w1); KT0[(c8 + e) * LDT + t] = (bf16_t)pw; KT1[(c8 + e) * LDT + t] = (bf16_t)(pw >> 16); }
    }
    __syncthreads();
    delta_store<true>(C, (C.wave >> 2) ? KT1 : KT0, VT, rec0 + (C.wave >> 2) * RECB);
}
DI void mlstm_a_phase(const Ctx& C, int l) {
    LAS float* cwt = (LAS float*)(C.lds + RING_OFF + MA_CWT);
    int htab = -1; MARegs R;
    int u = C.bx; if (u < NCHUNK * 4) mlstm_a_load(C, u >> 2, u & 3, R);
    for (; u < NCHUNK * 4; u += C.G) {
        const int h = u & 3, un = u + C.G;
        if (h != htab) { __syncthreads(); conv_table(C, cwt, l, h); htab = h; }
        mlstm_a_unit(C, l, u >> 2, h, R, un < NCHUNK * 4, un >> 2, un & 3);
    }
}
DI void mlstm_c_load(const Ctx& C, int c, int h, MCRegs& R) {
    const bf16_t* P = (const bf16_t*)(C.ws + WS_P);
    const int row0 = c * 64, t = C.lane, c8 = C.wave * 8, pos0 = chunk_pos0(c), len = chunk_len(c);
    conv_load(R.q, P, row0, t, pos0, len, C_AQK + h * 64 + c8);
    conv_load(R.k, P, row0, t, pos0, len, C_AQK + 256 + h * 64 + c8);
    const bf16_t* pr = P + (size_t)(row0 + t) * PW;
    R.v0 = *(const v4u*)(pr + C_AV + h * 128 + c8); R.v1 = *(const v4u*)(pr + C_AV + h * 128 + 64 + c8);
    { const bf16_t* po = P + (size_t)(row0 + (C.tid >> 3)) * PW + C_AO + h * 128 + (C.tid & 7) * 16; R.og0 = *(const v4u*)po; R.og1 = *(const v4u*)(po + 8); }
    const unsigned char* rec0 = rec_ptr(C.ws + WS_STA, c, h, 0);
    R.s0a = *(const v4u*)(rec0 + C.tid * 16); R.s0b = *(const v4u*)(rec0 + 8192 + C.tid * 16); R.s1a = *(const v4u*)(rec0 + RECB + C.tid * 16); R.s1b = *(const v4u*)(rec0 + RECB + 8192 + C.tid * 16);
    R.gi = 0.f; R.gf = 0.f; R.aux = 0.f;
    if (C.wave < 2) { const int dir = C.wave, tt = dir ? 63 - C.lane : C.lane; const bf16_t* prow = P + (size_t)(row0 + tt) * PW; R.gi = bf2f(prow[C_AI + dir * 4 + h]); R.gf = bf2f(prow[C_AF + dir * 4 + h]); R.aux = ((const float*)(rec0 + dir * RECB + REC_VEC))[66]; }
    else if (C.wave < 4) R.aux = ((const float*)(rec0 + (C.wave - 2) * RECB + REC_VEC))[C.lane];
}
DI void mlstm_c_unit(const Ctx& C0, int l, int c, int h, MCRegs& R, const float (&gain)[16], bool has_next, int cn, int hn) {
    Ctx C = C0; { int t_ = C0.tid; asm volatile("" : "+v"(t_)); C.tid = t_; C.lane = t_ & 63; }
    LAS unsigned char* L = C.lds + RING_OFF;
    LAS bf16_t* QS = (LAS bf16_t*)(L + MC_QS); LAS bf16_t* KS = (LAS bf16_t*)(L + MC_KS); LAS bf16_t* VT = (LAS bf16_t*)(L + MC_VT);
    LAS bf16_t* CT0 = (LAS bf16_t*)(L + MC_CT0); LAS bf16_t* CT1 = (LAS bf16_t*)(L + MC_CT1); LAS bf16_t* SB0 = (LAS bf16_t*)(L + MC_SB0); LAS bf16_t* SB1 = (LAS bf16_t*)(L + MC_SB1);
    LAS float* HS = (LAS float*)(L + MC_HS); LAS float* VEC = (LAS float*)(L + MC_VEC); const LAS float* cwt = (const LAS float*)(L + MC_CWT);
    const int row0 = c * 64;
    const float aux = R.aux;
    __syncthreads();
    if (C.wave < 2) {
        const int dir = C.wave, tt = dir ? 63 - C.lane : C.lane;
        const float* gb = INP(I_AGB) + l * 16;
        const float iv = R.gi + gb[dir * 4 + h], fv = logsigmoid_f(R.gf + gb[8 + dir * 4 + h]);
        const float b = wave_incl_sum(fv, C.lane);
        const float g = iv - b;
        const float cm = wave_incl_max(g, C.lane);
        const float m0 = aux;
        const float mm = fmaxf(m0, cm);
        LAS float* V = VEC + dir * 256;
        V[tt] = g; V[64 + tt] = mm; V[128 + tt] = __expf(m0 - mm); V[192 + tt] = __expf(-(b + mm));
    } else if (C.wave < 4) { (C.wave == 3 ? CT1 : CT0)[128 * LDT + C.lane] = (bf16_t)f2bf(aux); }
    else if (C.wave == 4) VT[128 * LDT + C.lane] = BF16_ONE;
    {
        const int t = C.lane, c8 = C.wave * 8;
        float y[8];
        conv_apply(R.q, cwt, c8, y);
        *(LAS v4u*)(QS + t * LDT + c8) = pack8f(y, 1.0f);
        conv_apply(R.k, cwt + 256, c8, y);
        *(LAS v4u*)(KS + t * LDT + c8) = pack8f(y, 0.125f);
        store_vt8(VT, R.v0, c8, t); store_vt8(VT, R.v1, 64 + c8, t);
    }
    store_ct16(CT0, R.s0a, R.s0b, C.tid); store_ct16(CT1, R.s1a, R.s1b, C.tid);
    const v4u og0 = R.og0, og1 = R.og1;
    asm volatile("" ::: "memory"); __builtin_amdgcn_sched_barrier(0);
    if (has_next) mlstm_c_load(C, cn, hn, R);
    asm volatile("" ::: "memory"); __builtin_amdgcn_sched_barrier(0);
    __syncthreads();
    {
        const int mt = C.wave & 3, nh = C.wave >> 2, fr = C.lane & 15, fq = C.lane >> 4;
        f32x4 acc[2]; acc[0] = (f32x4){0.f, 0.f, 0.f, 0.f}; acc[1] = acc[0];
        mma_tile<2, 2>(acc, QS + 16 * mt * LDT, LDT, KS + 32 * nh * LDT, LDT, C.lane);
#pragma unroll
        for (int nt = 0; nt < 2; ++nt)
#pragma unroll
            for (int i = 0; i < 4; ++i) {
                const int j = 16 * mt + fq * 4 + i, s2 = 32 * nh + nt * 16 + fr;
                const float v = acc[nt][i];
                const float d0 = __expf(VEC[s2] - VEC[64 + j]), d1 = __expf(VEC[256 + s2] - VEC[256 + 64 + j]);
                const unsigned pw = pk2(s2 <= j ? v * d0 : 0.f, s2 >= j ? v * d1 : 0.f);
                SB0[j * LDT + s2] = (bf16_t)pw; SB1[j * LDT + s2] = (bf16_t)(pw >> 16);
            }
    }
    __syncthreads();
    {
        const int mt = C.wave & 3, vh = C.wave >> 2, fr = C.lane & 15, fq = C.lane >> 4;
        f32x4 hsum[4];
#pragma unroll
        for (int nt = 0; nt < 4; ++nt) hsum[nt] = (f32x4){0.f, 0.f, 0.f, 0.f};
#pragma unroll
        for (int dir = 0; dir < 2; ++dir) {
            const LAS bf16_t* CT = dir ? CT1 : CT0; const LAS bf16_t* SB = dir ? SB1 : SB0; const LAS float* V = VEC + dir * 256;
            f32x4 acc[4], den[1];
#pragma unroll
            for (int nt = 0; nt < 4; ++nt) acc[nt] = (f32x4){0.f, 0.f, 0.f, 0.f};
            den[0] = (f32x4){0.f, 0.f, 0.f, 0.f};
            mma_tile<4, 2>(acc, QS + 16 * mt * LDT, LDT, CT + 64 * vh * LDT, LDT, C.lane);
            mma_tile<1, 2>(den, QS + 16 * mt * LDT, LDT, CT + 128 * LDT, LDT, C.lane);
#pragma unroll
            for (int i = 0; i < 4; ++i) { const float w = V[128 + 16 * mt + fq * 4 + i]; den[0][i] *= w;
#pragma unroll
                for (int nt = 0; nt < 4; ++nt) acc[nt][i] *= w; }
            mma_tile<4, 2>(acc, SB + 16 * mt * LDT, LDT, VT + 64 * vh * LDT, LDT, C.lane);
            mma_tile<1, 2>(den, SB + 16 * mt * LDT, LDT, VT + 128 * LDT, LDT, C.lane);
#pragma unroll
            for (int i = 0; i < 4; ++i) {
                const float dn = lx_f(den[0][i], C.lane & 48);
                const float inv = __builtin_amdgcn_rcpf(fmaxf(fabsf(dn), V[192 + 16 * mt + fq * 4 + i]));
#pragma unroll
                for (int nt = 0; nt < 4; ++nt) hsum[nt][i] += acc[nt][i] * inv;
            }
        }
#pragma unroll
        for (int i = 0; i < 4; ++i)
#pragma unroll
            for (int nt = 0; nt < 4; ++nt) HS[(16 * mt + fq * 4 + i) * 132 + 64 * vh + nt * 16 + fr] = hsum[nt][i];
    }
    __syncthreads();
    head_out<0, 132>(C, HS, og0, og1, row0, gain, (bf16_t*)(C.ws + WS_YA), h);
}
DI void load_gain16(float (&gain)[16], const float* g, int h, int tid) {
    asm volatile("" : "+v"(tid));
#pragma unroll
    for (int q = 0; q < 4; ++q) { const f32x4 v = *(const f32x4*)(g + h * 128 + (tid & 7) * 16 + 4 * q); gain[4 * q] = v[0]; gain[4 * q + 1] = v[1]; gain[4 * q + 2] = v[2]; gain[4 * q + 3] = v[3]; }
}
DI void mlstm_c_phase(const Ctx& C, int l) {
    LAS float* cwt = (LAS float*)(C.lds + RING_OFF + MC_CWT);
    int htab = -1; MCRegs R; float gain[16];
    const int NU = (l == DEPTH - 1 ? 512 : NCHUNK) * 4;
    int u = C.bx; if (u < NU) mlstm_c_load(C, u >> 2, u & 3, R);
    for (; u < NU; u += C.G) {
        const int h = u & 3, un = u + C.G;
        if (h != htab) { __syncthreads(); conv_table(C, cwt, l, h); load_gain16(gain, INP(I_ANG) + (size_t)l * 512, h, C.tid); htab = h; }
        mlstm_c_unit(C, l, u >> 2, h, R, gain, un < NU, un >> 2, un & 3);
    }
}

constexpr int LAP = 68;
constexpr int GA_LA0 = 0, GA_LA1 = 17408, GA_VT = 34816, GA_KT0 = 53248, GA_KT1 = 62464, GA_LOW = 71680, GA_WUT0 = 76800, GA_WUT1 = 81920;
constexpr int GC_QS0 = 0, GC_QS1 = 9216, GC_VT = 18432, GC_CT0 = 36864, GC_CT1 = 55296, GC_SB0 = 73728, GC_SB1 = 82944, GC_KS0 = 92160, GC_KS1 = 101376, GC_LA0 = 110592, GC_LA1 = 128000, GC_HS = 92160;
constexpr int GC_LOW = GC_CT0, GC_WUT0 = 145408, GC_WUT1 = 145408 + 5120;
static_assert(GC_WUT1 + 5120 <= RING_BYTES && GC_HS + 64 * 128 * 4 <= GC_LA1, "GLA (c) LDS map");
constexpr int LWD = 40;
struct GARegs { v4u low, k, v0, v1; };
struct GCRegs { v4u low, q, k, v0, v1, og0, og1; };
DI void gla_wut_table(const Ctx& C, LAS bf16_t* WUT0, LAS bf16_t* WUT1, int l, int h) {
    const int dir = C.tid >> 8, dk = (C.tid >> 2) & 63, ig = C.tid & 3;
    float w[8];
    const bool live = (ig >> 1) == dir;
    const float* wu = INP(I_CWUP) + ((size_t)(l * 2 + dir) * 16 + (ig & 1) * 8) * 256 + h * 64 + dk;
#pragma unroll
    for (int e = 0; e < 8; ++e) w[e] = live ? wu[e * 256] : 0.f;
    *(LAS v4u*)((dir ? WUT1 : WUT0) + dk * LWD + ig * 8) = pack8f(w, 1.0f);
}
DI void gla_logdecay(const Ctx& C, const v4u lowreg, const float (&bu)[4], LAS float* LA0, LAS float* LA1, LAS bf16_t* LOW, const LAS bf16_t* WUT0, const LAS bf16_t* WUT1) {
    { const int t = C.tid >> 3, part = C.tid & 7; if (part < 4) *(LAS v4u*)(LOW + t * LWD + part * 8) = lowreg; }
    __syncthreads();
    {
        const int dir = C.wave >> 2, mt = C.wave & 3, fr = C.lane & 15, fq = C.lane >> 4;
        f32x4 acc[4];
#pragma unroll
        for (int nt = 0; nt < 4; ++nt) acc[nt] = (f32x4){0.f, 0.f, 0.f, 0.f};
        mma_tile<4, 1>(acc, LOW + 16 * mt * LWD, LWD, dir ? WUT1 : WUT0, LWD, C.lane);
        LAS float* LA = dir ? LA1 : LA0;
#pragma unroll
        for (int nt = 0; nt < 4; ++nt)
#pragma unroll
            for (int i = 0; i < 4; ++i) LA[(16 * mt + fq * 4 + i) * LAP + nt * 16 + fr] = logsigmoid_f(acc[nt][i] + bu[nt]) * (1.0f / 16.0f);
    }
    __syncthreads();
    if (C.wave < 2) {
        LAS float* LA = C.wave ? LA1 : LA0;
        float a[64];
#pragma unroll
        for (int q = 0; q < 64; ++q) a[q] = LA[(C.wave ? 63 - q : q) * LAP + C.lane];
#pragma unroll
        for (int q = 1; q < 64; ++q) a[q] += a[q - 1];
#pragma unroll
        for (int q = 0; q < 64; ++q) LA[(C.wave ? 63 - q : q) * LAP + C.lane] = a[q];
    }
    __syncthreads();
}
DI void gla_bias4(float (&bu)[4], const Ctx& C, int l, int h) {
    int ln = C.lane; asm volatile("" : "+v"(ln));
    const float* b = INP(I_CBUP) + (size_t)(l * 2 + (C.wave >> 2)) * 256 + h * 64 + (ln & 15);
#pragma unroll
    for (int nt = 0; nt < 4; ++nt) bu[nt] = b[nt * 16];
}
DI void gla_a_load(const Ctx& C, int c, int h, GARegs& R) {
    const bf16_t* P = (const bf16_t*)(C.ws + WS_P);
    const int t = C.lane, c8 = C.wave * 8;
    const bf16_t* pr = P + (size_t)(c * 64 + t) * PW;
    R.low = *(const v4u*)(P + (size_t)(c * 64 + (C.tid >> 3)) * PW + C_CA + (C.tid & 3) * 8);
    R.k = *(const v4u*)(pr + C_CK + h * 64 + c8);
    R.v0 = *(const v4u*)(pr + C_CV + h * 128 + c8); R.v1 = *(const v4u*)(pr + C_CV + h * 128 + 64 + c8);
}
DI void gla_a_unit(const Ctx& C0, int c, int h, GARegs& R, const float (&bu)[4], bool has_next, int cn, int hn) {
    Ctx C = C0; { int t_ = C0.tid; asm volatile("" : "+v"(t_)); C.tid = t_; C.lane = t_ & 63; }
    LAS unsigned char* L = C.lds + RING_OFF;
    LAS float* LA0 = (LAS float*)(L + GA_LA0); LAS float* LA1 = (LAS float*)(L + GA_LA1);
    LAS bf16_t* VT = (LAS bf16_t*)(L + GA_VT); LAS bf16_t* KT0 = (LAS bf16_t*)(L + GA_KT0); LAS bf16_t* KT1 = (LAS bf16_t*)(L + GA_KT1);
    unsigned char* rec0 = rec_ptr(C.ws + WS_STC, c, h, 0);
    const int t = C.lane, c8 = C.wave * 8;
    __syncthreads();
    store_vt8(VT, R.v0, c8, t); store_vt8(VT, R.v1, 64 + c8, t);
    const v4u kreg = R.k;
    gla_logdecay(C, R.low, bu, LA0, LA1, (LAS bf16_t*)(L + GA_LOW), (const LAS bf16_t*)(L + GA_WUT0), (const LAS bf16_t*)(L + GA_WUT1));
    asm volatile("" ::: "memory"); __builtin_amdgcn_sched_barrier(0);
    if (has_next) gla_a_load(C, cn, hn, R);
    asm volatile("" ::: "memory"); __builtin_amdgcn_sched_barrier(0);
    {
        float k[8]; unpack8(kreg, k);
        float l0[8], l1[8], t0[8], t1[8];
        { const f32x4 a0 = *(const LAS f32x4*)(LA0 + t * LAP + c8), a1 = *(const LAS f32x4*)(LA0 + t * LAP + c8 + 4), b0 = *(const LAS f32x4*)(LA1 + t * LAP + c8), b1 = *(const LAS f32x4*)(LA1 + t * LAP + c8 + 4);
          const f32x4 e0 = *(const LAS f32x4*)(LA0 + 63 * LAP + c8), e1 = *(const LAS f32x4*)(LA0 + 63 * LAP + c8 + 4), f0 = *(const LAS f32x4*)(LA1 + c8), f1 = *(const LAS f32x4*)(LA1 + c8 + 4);
#pragma unroll
          for (int e = 0; e < 4; ++e) { l0[e] = a0[e]; l0[4 + e] = a1[e]; l1[e] = b0[e]; l1[4 + e] = b1[e]; t0[e] = e0[e]; t0[4 + e] = e1[e]; t1[e] = f0[e]; t1[4 + e] = f1[e]; } }
#pragma unroll
        for (int e = 0; e < 8; ++e) {
            const unsigned pw = pk2(k[e] * __expf(t0[e] - l0[e]), k[e] * __expf(t1[e] - l1[e]));
            KT0[(c8 + e) * LDT + t] = (bf16_t)pw; KT1[(c8 + e) * LDT + t] = (bf16_t)(pw >> 16);
        }
        if (C.tid < 64) ((float*)(rec0 + REC_VEC))[C.tid] = __expf(LA0[63 * LAP + C.tid]);
        else if (C.tid < 128) ((float*)(rec0 + RECB + REC_VEC))[C.tid - 64] = __expf(LA1[C.tid - 64]);
    }
    __syncthreads();
    delta_store<false>(C, (C.wave >> 2) ? KT1 : KT0, VT, rec0 + (C.wave >> 2) * RECB);
}
DI void gla_a_phase(const Ctx& C, int l) {
    LAS unsigned char* L = C.lds + RING_OFF;
    int htab = -1; GARegs R; float bu[4];
    int u = C.bx + (C.G >> 1); if (u >= C.G) u -= C.G;
    if (u < NCHUNK * 4) gla_a_load(C, u >> 2, u & 3, R);
    for (; u < NCHUNK * 4; u += C.G) {
        const int h = u & 3, un = u + C.G;
        if (h != htab) { __syncthreads(); gla_wut_table(C, (LAS bf16_t*)(L + GA_WUT0), (LAS bf16_t*)(L + GA_WUT1), l, h); gla_bias4(bu, C, l, h); htab = h; }
        gla_a_unit(C, u >> 2, h, R, bu, un < NCHUNK * 4, un >> 2, un & 3);
    }
}
DI void gla_c_load(const Ctx& C, int c, int h, GCRegs& R) {
    const bf16_t* P = (const bf16_t*)(C.ws + WS_P);
    const int t = C.lane, c8 = C.wave * 8;
    const bf16_t* pr = P + (size_t)(c * 64 + t) * PW;
    R.low = *(const v4u*)(P + (size_t)(c * 64 + (C.tid >> 3)) * PW + C_CA + (C.tid & 3) * 8);
    R.q = *(const v4u*)(pr + C_CQ + h * 64 + c8); R.k = *(const v4u*)(pr + C_CK + h * 64 + c8);
    R.v0 = *(const v4u*)(pr + C_CV + h * 128 + c8); R.v1 = *(const v4u*)(pr + C_CV + h * 128 + 64 + c8);
    { const bf16_t* po = P + (size_t)(c * 64 + (C.tid >> 3)) * PW + C_CR + h * 128 + (C.tid & 7) * 16; R.og0 = *(const v4u*)po; R.og1 = *(const v4u*)(po + 8); }
}
DI void gla_c_unit(const Ctx& C0, int c, int h, GCRegs& R, const float (&bu)[4], const float (&gain)[16], bool has_next, int cn, int hn) {
    Ctx C = C0; { int t_ = C0.tid; asm volatile("" : "+v"(t_)); C.tid = t_; C.lane = t_ & 63; }
    LAS unsigned char* L = C.lds + RING_OFF;
    LAS bf16_t* QS0 = (LAS bf16_t*)(L + GC_QS0); LAS bf16_t* QS1 = (LAS bf16_t*)(L + GC_QS1); LAS bf16_t* KS0 = (LAS bf16_t*)(L + GC_KS0); LAS bf16_t* KS1 = (LAS bf16_t*)(L + GC_KS1);
    LAS bf16_t* VT = (LAS bf16_t*)(L + GC_VT); LAS bf16_t* CT0 = (LAS bf16_t*)(L + GC_CT0); LAS bf16_t* CT1 = (LAS bf16_t*)(L + GC_CT1);
    LAS bf16_t* SB0 = (LAS bf16_t*)(L + GC_SB0); LAS bf16_t* SB1 = (LAS bf16_t*)(L + GC_SB1);
    LAS float* LA0 = (LAS float*)(L + GC_LA0); LAS float* LA1 = (LAS float*)(L + GC_LA1); LAS float* HS = (LAS float*)(L + GC_HS);
    const int t = C.lane, c8 = C.wave * 8;
    const unsigned char* rec0 = rec_ptr(C.ws + WS_STC, c, h, 0);
    const v4u s1a = *(const v4u*)(rec0 + RECB + C.tid * 16), s1b = *(const v4u*)(rec0 + RECB + 8192 + C.tid * 16);
    __syncthreads();
    store_vt8(VT, R.v0, c8, t); store_vt8(VT, R.v1, 64 + c8, t);
    const v4u s0a = *(const v4u*)(rec0 + C.tid * 16), s0b = *(const v4u*)(rec0 + 8192 + C.tid * 16);
    store_ct16(CT1, s1a, s1b, C.tid);
    gla_logdecay(C, R.low, bu, LA0, LA1, (LAS bf16_t*)(L + GC_LOW), (const LAS bf16_t*)(L + GC_WUT0), (const LAS bf16_t*)(L + GC_WUT1));
    {
        float q[8], k[8], a[8], b[8];
        unpack8(R.q, q); unpack8(R.k, k);
        float lb[8];
        { const f32x4 x0 = *(const LAS f32x4*)(LA0 + t * LAP + c8), x1 = *(const LAS f32x4*)(LA0 + t * LAP + c8 + 4);
#pragma unroll
          for (int e = 0; e < 4; ++e) { lb[e] = x0[e]; lb[4 + e] = x1[e]; } }
#pragma unroll
        for (int e = 0; e < 8; ++e) { const float bb = lb[e]; a[e] = q[e] * 0.125f * __expf(bb); b[e] = k[e] * __expf(-bb); }
        *(LAS v4u*)(QS0 + t * LDT + c8) = pack8f(a, 1.0f); *(LAS v4u*)(KS0 + t * LDT + c8) = pack8f(b, 1.0f);
        { const f32x4 x0 = *(const LAS f32x4*)(LA1 + t * LAP + c8), x1 = *(const LAS f32x4*)(LA1 + t * LAP + c8 + 4);
#pragma unroll
          for (int e = 0; e < 4; ++e) { lb[e] = x0[e]; lb[4 + e] = x1[e]; } }
#pragma unroll
        for (int e = 0; e < 8; ++e) { const float bb = lb[e]; a[e] = q[e] * 0.125f * __expf(bb); b[e] = k[e] * __expf(-bb); }
        *(LAS v4u*)(QS1 + t * LDT + c8) = pack8f(a, 1.0f); *(LAS v4u*)(KS1 + t * LDT + c8) = pack8f(b, 1.0f);
    }
    store_ct16(CT0, s0a, s0b, C.tid);
    const v4u og0 = R.og0, og1 = R.og1;
    asm volatile("" ::: "memory"); __builtin_amdgcn_sched_barrier(0);
    if (has_next) gla_c_load(C, cn, hn, R);
    asm volatile("" ::: "memory"); __builtin_amdgcn_sched_barrier(0);
    __syncthreads();
    {
        const int mt = C.wave & 3, nh = C.wave >> 2, fr = C.lane & 15, fq = C.lane >> 4;
#pragma unroll
        for (int dir = 0; dir < 2; ++dir) {
            f32x4 acc[2]; acc[0] = (f32x4){0.f, 0.f, 0.f, 0.f}; acc[1] = acc[0];
            mma_tile<2, 2>(acc, (dir ? QS1 : QS0) + 16 * mt * LDT, LDT, (dir ? KS1 : KS0) + 32 * nh * LDT, LDT, C.lane);
            LAS bf16_t* SB = dir ? SB1 : SB0;
#pragma unroll
            for (int nt = 0; nt < 2; ++nt)
#pragma unroll
                for (int i = 0; i < 4; ++i) { const int j = 16 * mt + fq * 4 + i, s2 = 32 * nh + nt * 16 + fr; const bool keep = dir ? (s2 >= j) : (s2 <= j); SB[j * LDT + s2] = (bf16_t)f2bf(keep ? acc[nt][i] : 0.f); }
        }
    }
    __syncthreads();
    {
        const int mt = C.wave & 3, vh = C.wave >> 2, fr = C.lane & 15, fq = C.lane >> 4;
        f32x4 acc[4];
#pragma unroll
        for (int nt = 0; nt < 4; ++nt) acc[nt] = (f32x4){0.f, 0.f, 0.f, 0.f};
        mma_tile<4, 2>(acc, QS0 + 16 * mt * LDT, LDT, CT0 + 64 * vh * LDT, LDT, C.lane);
        mma_tile<4, 2>(acc, SB0 + 16 * mt * LDT, LDT, VT + 64 * vh * LDT, LDT, C.lane);
        mma_tile<4, 2>(acc, QS1 + 16 * mt * LDT, LDT, CT1 + 64 * vh * LDT, LDT, C.lane);
        mma_tile<4, 2>(acc, SB1 + 16 * mt * LDT, LDT, VT + 64 * vh * LDT, LDT, C.lane);
#pragma unroll
        for (int i = 0; i < 4; ++i)
#pragma unroll
            for (int nt = 0; nt < 4; ++nt) HS[(16 * mt + fq * 4 + i) * 128 + 64 * vh + nt * 16 + fr] = acc[nt][i];
    }
    __syncthreads();
    head_out<1, 128>(C, HS, og0, og1, c * 64, gain, (bf16_t*)(C.ws + WS_YA) + 1024, h);
}
DI void gla_c_phase(const Ctx& C, int l) {
    LAS unsigned char* L = C.lds + RING_OFF;
    int htab = -1; GCRegs R; float bu[4], gain[16];
    const int NU = (l == DEPTH - 1 ? 512 : NCHUNK) * 4;
    int u = C.bx + (C.G >> 1); if (u >= C.G) u -= C.G;
    if (u < NU) gla_c_load(C, u >> 2, u & 3, R);
    for (; u < NU; u += C.G) {
        const int h = u & 3, un = u + C.G;
        if (h != htab) { __syncthreads(); gla_wut_table(C, (LAS bf16_t*)(L + GC_WUT0), (LAS bf16_t*)(L + GC_WUT1), l, h); gla_bias4(bu, C, l, h); load_gain16(gain, INP(I_CNG) + (size_t)l * 512, h, C.tid); htab = h; }
        gla_c_unit(C, u >> 2, h, R, bu, gain, un < NU, un >> 2, un & 3);
    }
}

DI int chain_chunk(int b, int dir, int n) { return n < 4 ? 512 + 4 * b + (dir ? 3 - n : n) : 64 * b + (dir ? 67 - n : n - 4); }
DI void unpack8s(const v4u x, float (&f)[8]) { unpack8(x, f); }
#ifndef PROBE_SKIP
#define PROBE_SKIP 0
#endif
DI void scan_b_units(const Ctx& C, bool probe = false) {
    for (int u = C.bx; u < 256; u += C.G) {
        const int mixer = u >> 7, item = (u & 127) * 2 + (C.wave >> 2), chain = item >> 2, slab = item & 3;
        const int b = chain >> 3, h = (chain >> 1) & 3, dir = chain & 1, tl = C.tid & 255, elem = slab * 2048 + tl * 8;
        unsigned char* base = C.ws + (probe ? WS_A2 + (size_t)mixer * ((size_t)NCHUNK * 8 * RECB) : (mixer ? WS_STC : WS_STA));
        float zz = 0.f; asm volatile("" : "+v"(zz));
        float st[8];
#pragma unroll
        for (int e = 0; e < 8; ++e) st[e] = zz;
        if (mixer == 0) {
            const bool nthr = (slab == 0 && tl < 64), mthr = (slab == 0 && tl == 0);
            float m = 0.f, nst = 0.f;
            v4u d[8]; float sB[8], sM[8], dn[8];
#define SB_LOAD_M(q, n) do { const unsigned char* r2 = rec_ptr(base, chain_chunk(b, dir, (n)), h, dir); const float* r2f = (const float*)(r2 + REC_VEC); d[q] = *(const v4u*)(r2 + elem * 2); sB[q] = r2f[64]; sM[q] = r2f[65]; dn[q] = nthr ? r2f[tl] : 0.f; } while (0)
#define SB_STEP_M(q, n, PF) do { unsigned char* rec = rec_ptr(base, chain_chunk(b, dir, (n)), h, dir); float* rf = (float*)(rec + REC_VEC); \
                float dd[8]; unpack8(d[q], dd); const float B = sB[q], Ml = sM[q], dnn = dn[q]; \
                if (!(probe && PROBE_SKIP == 7)) { *(v4u*)(rec + elem * 2) = pack8f(st, 1.0f); if (nthr) rf[tl] = nst; if (mthr) rf[66] = m; } \
                if (PF) SB_LOAD_M(q, (n) + 8); \
                const float mn = fmaxf(B + m, Ml), dec = __expf(B + m - mn), sc = __expf(Ml - mn); \
                _Pragma("unroll") for (int e = 0; e < 8; ++e) st[e] = st[e] * dec + dd[e] * sc; \
                nst = nst * dec + dnn * sc; m = mn; } while (0)
#pragma unroll
            for (int q = 0; q < 8; ++q) SB_LOAD_M(q, q);
            for (int n0 = 0; n0 < 56; n0 += 8) {
#pragma unroll
                for (int q = 0; q < 8; ++q) SB_STEP_M(q, n0 + q, true);
            }
#pragma unroll
            for (int q = 0; q < 8; ++q) SB_STEP_M(q, 56 + q, q < 4);
#pragma unroll
            for (int q = 0; q < 4; ++q) SB_STEP_M(q, 64 + q, false);
#undef SB_LOAD_M
#undef SB_STEP_M
        } else {
            v4u d[8]; f32x4 dca[8], dcb[8];
#define SB_LOAD_G(q, n) do { const unsigned char* r2 = rec_ptr(base, chain_chunk(b, dir, (n)), h, dir); const float* r2f = (const float*)(r2 + REC_VEC) + (elem & 63); d[q] = *(const v4u*)(r2 + elem * 2); dca[q] = *(const f32x4*)r2f; dcb[q] = *(const f32x4*)(r2f + 4); } while (0)
#define SB_STEP_G(q, n, PF) do { unsigned char* rec = rec_ptr(base, chain_chunk(b, dir, (n)), h, dir); \
                float dd[8]; unpack8(d[q], dd); const f32x4 da = dca[q], db = dcb[q]; \
                if (!(probe && PROBE_SKIP == 7)) *(v4u*)(rec + elem * 2) = pack8f(st, 1.0f); \
                if (PF) SB_LOAD_G(q, (n) + 8); \
                _Pragma("unroll") for (int e = 0; e < 4; ++e) { st[e] = st[e] * da[e] + dd[e]; st[4 + e] = st[4 + e] * db[e] + dd[4 + e]; } } while (0)
#pragma unroll
            for (int q = 0; q < 8; ++q) SB_LOAD_G(q, q);
            for (int n0 = 0; n0 < 56; n0 += 8) {
#pragma unroll
                for (int q = 0; q < 8; ++q) SB_STEP_G(q, n0 + q, true);
            }
#pragma unroll
            for (int q = 0; q < 8; ++q) SB_STEP_G(q, 56 + q, q < 4);
#pragma unroll
            for (int q = 0; q < 4; ++q) SB_STEP_G(q, 64 + q, false);
#undef SB_LOAD_G
#undef SB_STEP_G
        }
    }
}

constexpr int RH_HT = 0, RH_LD = 1028, RH_PART = 16 * RH_LD * 4, RH_PLD = 33;
constexpr int RL_CNT = 131584;
static_assert(RH_PART + 8 * 16 * RH_PLD * 4 <= RL_CNT && RL_CNT + 3 * 32 * 4 + 2 * 512 * 4 <= RING_BYTES, "router LDS map");
DI void phase_norm2_router(const Ctx& C, int l) {
    const int lane = C.lane, w = C.wave;
    const bf16_t* X = (const bf16_t*)(C.ws + WS_X); unsigned char* H8 = (unsigned char*)(C.ws + WS_H);
    const bf16_t* U = (const bf16_t*)(C.ws + WS_U);
    const float* MOD = (const float*)(C.ws + WS_MOD);
    int* TOKE = (int*)(C.ws + WS_TOKE); int* TOKP = (int*)(C.ws + WS_TOKP); float* TOKW = (float*)(C.ws + WS_TOKW);
    LAS float* HT = (LAS float*)(C.lds + RING_OFF + RH_HT); LAS float* PART = (LAS float*)(C.lds + RING_OFF + RH_PART); LAS int* cnt = (LAS int*)(C.lds + RING_OFF + RL_CNT);
    __syncthreads();
    if (C.tid < 32) cnt[C.tid] = 0;
    float Wreg[2][8][4];
    {
        const float* Wr = INP(I_WR) + (size_t)l * DM * NEXP + (size_t)(128 * w + 4 * (lane >> 4)) * NEXP + (lane & 15);
#pragma unroll
        for (int tl = 0; tl < 2; ++tl)
#pragma unroll
            for (int j = 0; j < 8; ++j)
#pragma unroll
                for (int m = 0; m < 4; ++m) Wreg[tl][j][m] = Wr[(size_t)(16 * j + m) * NEXP + 16 * tl];
    }
    f32x4 gn[4];
#pragma unroll
    for (int j = 0; j < 4; ++j) gn[j] = *(const f32x4*)(INP(I_GN2) + (size_t)l * DM + (lane + 64 * j) * 4);
    const float brl = INP(I_BR)[l * NEXP + (lane & 31)];
    const int ntiles = (l == DEPTH - 1 ? M_LAT : MROWS) / 16;
    v2u xr[2][4], ur[2][4];
    if (C.bx < ntiles) {
#pragma unroll
        for (int q = 0; q < 2; ++q)
#pragma unroll
            for (int j = 0; j < 4; ++j) { const size_t o = (size_t)(C.bx * 16 + 2 * w + q) * DM + (lane + 64 * j) * 4; xr[q][j] = *(const v2u*)(X + o); ur[q][j] = *(const v2u*)(U + o); }
    }
    for (int tile = C.bx; tile < ntiles; tile += C.G) {
        const int r0 = tile * 16 + 2 * w, mi = r0 < M_LAT ? (r0 >> 12) : 8;
        const float* sh = MOD + ((size_t)l * 9 + mi) * 6144 + 3 * DM; const float* sc = sh + DM; const float* g1 = sh - DM;
        f32x4 h[2][4]; float ss[2] = {0.f, 0.f};
#pragma unroll
        for (int q = 0; q < 2; ++q)
#pragma unroll
            for (int j = 0; j < 4; ++j) { const int c = (lane + 64 * j) * 4; const v2u uu = ur[q][j], xx = xr[q][j]; const f32x4 gg = *(const f32x4*)(g1 + c);
                h[q][j] = (f32x4){bf2f(xx.x & 0xffffu), bf2f(xx.x >> 16), bf2f(xx.y & 0xffffu), bf2f(xx.y >> 16)} + gg * (f32x4){bf2f(uu.x & 0xffffu), bf2f(uu.x >> 16), bf2f(uu.y & 0xffffu), bf2f(uu.y >> 16)};
                ss[q] += (h[q][j][0] * h[q][j][0] + h[q][j][1] * h[q][j][1]) + (h[q][j][2] * h[q][j][2] + h[q][j][3] * h[q][j][3]); }
        if (tile + C.G < ntiles) {
#pragma unroll
            for (int q = 0; q < 2; ++q)
#pragma unroll
                for (int j = 0; j < 4; ++j) { const size_t o = (size_t)((tile + C.G) * 16 + 2 * w + q) * DM + (lane + 64 * j) * 4; xr[q][j] = *(const v2u*)(X + o); ur[q][j] = *(const v2u*)(U + o); }
        }
#pragma unroll
        for (int q = 0; q < 2; ++q) {
            const float rstd = __builtin_amdgcn_rsqf(wave_sum(ss[q], lane) * (1.0f / DM) + EPS);
#pragma unroll
            for (int j = 0; j < 4; ++j) {
                const int c = (lane + 64 * j) * 4;
                const f32x4 s1 = *(const f32x4*)(sc + c), s0 = *(const f32x4*)(sh + c);
                const f32x4 hh = h[q][j] * rstd * gn[j] * (s1 + 1.0f) + s0;
                *(unsigned*)(H8 + (size_t)(r0 + q) * DM + c) = pk4_fp8(hh[0] * FP8_SH, hh[1] * FP8_SH, hh[2] * FP8_SH, hh[3] * FP8_SH);
                *(LAS f32x4*)(HT + (2 * w + q) * RH_LD + c) = hh;
            }
        }
        __syncthreads();
        {
            f32x4 acc0 = (f32x4){0.f, 0.f, 0.f, 0.f}, acc1 = acc0;
            const LAS float* ap = HT + (lane & 15) * RH_LD + 128 * w + 4 * (lane >> 4);
#pragma unroll
            for (int j = 0; j < 8; ++j) {
                const f32x4 a = *(const LAS f32x4*)(ap + 16 * j);
#pragma unroll
                for (int m = 0; m < 4; ++m) { acc0 = __builtin_amdgcn_mfma_f32_16x16x4f32(a[m], Wreg[0][j][m], acc0, 0, 0, 0); acc1 = __builtin_amdgcn_mfma_f32_16x16x4f32(a[m], Wreg[1][j][m], acc1, 0, 0, 0); }
            }
            LAS float* pp = PART + (w * 16 + 4 * (lane >> 4)) * RH_PLD + (lane & 15);
#pragma unroll
            for (int i = 0; i < 4; ++i) { pp[i * RH_PLD] = acc0[i]; pp[i * RH_PLD + 16] = acc1[i]; }
        }
        __syncthreads();
        {
            const int rowl = 2 * w + (lane >> 5), mye = lane & 31, myrow = tile * 16 + rowl;
            float my = brl;
#pragma unroll
            for (int ww = 0; ww < 8; ++ww) my += PART[(ww * 16 + rowl) * RH_PLD + mye];
            float tv[4]; int ti[4];
            {
                const bool hi2 = lane >= 32; int rank = 0;
#pragma unroll
                for (int j = 0; j < 32; ++j) {
                    const float oa = __int_as_float(__builtin_amdgcn_readlane(__float_as_int(my), j)), ob = __int_as_float(__builtin_amdgcn_readlane(__float_as_int(my), 32 + j));
                    const float o = hi2 ? ob : oa;
                    rank += (o > my || (o == my && j < mye)) ? 1 : 0;
                }
#pragma unroll
                for (int k = 0; k < 4; ++k) {
                    const unsigned long long bal = __ballot(rank == k);
                    const int ia = __builtin_ctz((unsigned)bal), ib = __builtin_ctz((unsigned)(bal >> 32));
                    const float va = __int_as_float(__builtin_amdgcn_readlane(__float_as_int(my), ia)), vb = __int_as_float(__builtin_amdgcn_readlane(__float_as_int(my), 32 + ib));
                    tv[k] = hi2 ? vb : va; ti[k] = hi2 ? ib : ia;
                }
            }
            const float e1 = __expf(tv[1] - tv[0]), e2 = __expf(tv[2] - tv[0]), e3 = __expf(tv[3] - tv[0]);
            const float inv = __builtin_amdgcn_rcpf(((1.0f + e1) + e2) + e3);
            if (mye < 4) {
                const int ek = mye == 0 ? ti[0] : mye == 1 ? ti[1] : mye == 2 ? ti[2] : ti[3];
                const float wk = (mye == 0 ? 1.0f : mye == 1 ? e1 : mye == 2 ? e2 : e3) * inv;
                const int pos = atomicAdd((int*)(cnt + ek), 1);
                const size_t o = (size_t)myrow * 4 + mye;
                TOKE[o] = ek; TOKP[o] = pos; TOKW[o] = wk;
            }
        }
    }
    __syncthreads();
    if (C.tid < 32) ((int*)(C.ws + WS_BLKCNT))[C.bx * 32 + C.tid] = cnt[C.tid];
}

DI void phase_gather(const Ctx& C, int l) {
    const int lane = C.lane;
    const unsigned char* H8 = (const unsigned char*)(C.ws + WS_H); unsigned char* XG = (unsigned char*)(C.ws + WS_XG);
    const int* TOKE = (const int*)(C.ws + WS_TOKE); int* TOKP = (int*)(C.ws + WS_TOKP); const float* TOKW = (const float*)(C.ws + WS_TOKW);
    float* SLOTW = (float*)(C.ws + WS_SLOTW); int* META = (int*)(C.ws + WS_MOEMETA);
    const int* BLKCNT = (const int*)(C.ws + WS_BLKCNT);
    LAS int* base = (LAS int*)(C.lds + RING_OFF + RL_CNT + 128); LAS int* tot = (LAS int*)(C.lds + RING_OFF + RL_CNT + 256);
    __syncthreads();
    {
        LAS int* pt = (LAS int*)(C.lds + RING_OFF + RL_CNT + 384); LAS int* pp = pt + 512;
        const int e = C.tid & 31, cq = C.tid >> 5;
        int t = 0, pre = 0;
#pragma unroll 16
        for (int b = cq; b < C.G; b += 16) { const int c = BLKCNT[b * 32 + e]; pre += (b < C.bx) ? c : 0; t += c; }
        pt[cq * 32 + e] = t; pp[cq * 32 + e] = pre;
        __syncthreads();
        if (C.tid < 32) { int ts = 0, ps = 0;
#pragma unroll
            for (int q = 0; q < 16; ++q) { ts += pt[q * 32 + C.tid]; ps += pp[q * 32 + C.tid]; }
            tot[C.tid] = ts; base[C.tid] = ps; }
    }
    __syncthreads();
    LAS int* toff = (LAS int*)(C.lds + RING_OFF + RL_CNT + 384);
    if (C.tid == 0) {
        int off = 0;
#pragma unroll 1
        for (int e = 0; e < NEXP; ++e) { const int padded = (tot[e] + 255) & ~255; base[e] += off; toff[e] = off >> 8; off += padded; }
        toff[NEXP] = off >> 8;
        if (C.bx == 0) META[0] = off >> 8;
    }
    __syncthreads();
    if (C.bx == 0) {
        const int nt = toff[NEXP];
        for (int t = C.tid; t < nt; t += 512) { int e = 0;
#pragma unroll
            for (int q = 1; q < NEXP; ++q) e += (t >= toff[q]) ? 1 : 0;
            META[16 + t] = e; }
    }
    const int ntiles = (l == DEPTH - 1 ? M_LAT : MROWS) / 16;
    int4 e4[2], p4[2]; f32x4 w4[2]; v4u a[2];
    if (C.bx < ntiles) {
#pragma unroll
        for (int q = 0; q < 2; ++q) { const int r = C.bx * 16 + 2 * C.wave + q;
            e4[q] = *(const int4*)(TOKE + (size_t)r * 4); p4[q] = *(const int4*)(TOKP + (size_t)r * 4); w4[q] = *(const f32x4*)(TOKW + (size_t)r * 4); a[q] = *(const v4u*)(H8 + (size_t)r * DM + lane * 16); }
    }
    for (int tile = C.bx; tile < ntiles; tile += C.G) {
        int4 ce[2], cp[2]; f32x4 cw[2]; v4u ca[2];
#pragma unroll
        for (int q = 0; q < 2; ++q) { ce[q] = e4[q]; cp[q] = p4[q]; cw[q] = w4[q]; ca[q] = a[q]; }
        if (tile + C.G < ntiles) {
#pragma unroll
            for (int q = 0; q < 2; ++q) { const int r = (tile + C.G) * 16 + 2 * C.wave + q;
                e4[q] = *(const int4*)(TOKE + (size_t)r * 4); p4[q] = *(const int4*)(TOKP + (size_t)r * 4); w4[q] = *(const f32x4*)(TOKW + (size_t)r * 4); a[q] = *(const v4u*)(H8 + (size_t)r * DM + lane * 16); }
        }
#pragma unroll
        for (int q = 0; q < 2; ++q) {
            const int r = tile * 16 + 2 * C.wave + q;
            const int s0 = base[ce[q].x] + cp[q].x, s1 = base[ce[q].y] + cp[q].y, s2 = base[ce[q].z] + cp[q].z, s3 = base[ce[q].w] + cp[q].w;
            *(v4u*)(XG + (size_t)s0 * DM + lane * 16) = ca[q]; *(v4u*)(XG + (size_t)s1 * DM + lane * 16) = ca[q]; *(v4u*)(XG + (size_t)s2 * DM + lane * 16) = ca[q]; *(v4u*)(XG + (size_t)s3 * DM + lane * 16) = ca[q];
            if (lane == 0) { *(int4*)(TOKP + (size_t)r * 4) = make_int4(s0, s1, s2, s3); SLOTW[s0] = cw[q][0]; SLOTW[s1] = cw[q][1]; SLOTW[s2] = cw[q][2]; SLOTW[s3] = cw[q][3]; }
        }
    }
}

DI void phase_attention(const Ctx& C, char* lds_generic, bool with_ctx) {
    typedef attn_body::bf16 abf;
    const abf* QR = (const abf*)(C.ws + WS_QR); const abf* KR = (const abf*)(C.ws + WS_KR); const abf* VR = (const abf*)(C.ws + WS_VR); abf* YB = (abf*)(C.ws + WS_YA) + 512;
    const int vcu = (C.G % 8 == 0) ? (C.bx % 8) * (C.G / 8) + C.bx / 8 : C.bx;
    const int per = (1024 + C.G - 1) / C.G;
    for (int i = 0; i < per; ++i) {
        const int idx = vcu * per + i; if (idx >= 1024) break;
        const int grp = idx >> 6, b = grp >> 1, kvh = grp & 1, hq = kvh * 4 + ((idx >> 4) & 3), qb = idx & 15;
        attn_body::attn_unit<8>((long)b * SEQ + qb * 256, hq, KVLEN / 64, QR, KR + (size_t)b * KVLEN * 128 + kvh * 64, VR + (size_t)b * KVLEN * 128 + kvh * 64, YB, lds_generic, C.wave);
    }
    for (int idx = C.bx; with_ctx && idx < 64; idx += C.G) {
        const int b = idx >> 3, hq = idx & 7;
        attn_body::attn_unit<8>((long)M_LAT + b * CTXL, hq, CTXL / 64, QR, KR + (size_t)b * KVLEN * 128 + (hq >> 2) * 64, VR + (size_t)b * KVLEN * 128 + (hq >> 2) * 64, YB, lds_generic, C.wave);
    }
}

constexpr int NPH = 11;
constexpr int N_PHASES = 1 + DEPTH * NPH + 1;
struct KArgs { const float* in[N_IN]; float* out; unsigned char* ws; int ph_lo, ph_hi; };
static_assert(sizeof(KArgs) == N_IN * 8 + 8 + 8 + 8, "no padding bytes in the argument struct");

__global__ void __launch_bounds__(512, 2) mk_fwd(KArgs args) {
    extern __shared__ __attribute__((aligned(16))) unsigned char lds[];
    Ctx C;
    C.lds = (LAS unsigned char*)lds; C.ws = args.ws; C.in = args.in; C.out = args.out;
    C.tid = threadIdx.x; C.lane = C.tid & 63; C.wave = __builtin_amdgcn_readfirstlane(C.tid >> 6); C.G = gridDim.x; C.bx = blockIdx.x;
    for (int u = C.tid; u < (LDS_BYTES - LDSCTL_OFF) / 4; u += 512) ((LAS unsigned*)(C.lds + LDSCTL_OFF))[u] = 0u;
    __syncthreads();
    if ((unsigned)(uintptr_t)C.lds != 0u) __builtin_trap();
    if (C.tid == 0) { LAS unsigned* pw = (LAS unsigned*)(C.lds + MISC_OFF + 64); pw[0] = (unsigned)(uintptr_t)args.ws; pw[1] = (unsigned)((uintptr_t)args.ws >> 32); pw[2] = (unsigned)(uintptr_t)args.out; pw[3] = (unsigned)((uintptr_t)args.out >> 32); }
    __syncthreads();
#if MK_ONE_LAUNCH
    constexpr int lo = 0, hi = N_PHASES;
#else
    const int lo = args.ph_lo, hi = args.ph_hi;
#endif
    gu32* ctl = (gu32*)(C.ws + WS_CTL);
    XcdBarrier bar; bar.bar = (unsigned*)ctl + CW_BAR; bar.x = 0; bar.st = (volatile LAS unsigned*)(C.lds + MISC_OFF) + 8;
    if (hi - lo > 1) bar = xcd_barrier_post((unsigned*)ctl + CW_BAR, (volatile LAS unsigned*)(C.lds + MISC_OFF) + 8);
    bar.x = (unsigned)__builtin_amdgcn_readfirstlane((int)bar.x);
#define IN(k) (lo <= (k) && (k) < hi)
#ifndef PH_MASK
#define PH_MASK 0x1fff
#endif
#define ENAB(k) (((PH_MASK) >> (k)) & 1)
#ifndef DUP_MASK
#define DUP_MASK 0
#endif
#ifndef PROBE_SKIP
#define PROBE_SKIP 0
#endif
#define REPS(k) _Pragma("unroll 1") for (int rep_ = 0; rep_ < 1 + (((DUP_MASK) >> (k)) & 1); ++rep_)
#define SEAM(k) do { if (IN(k) && IN((k) + 1)) { XcdBarrier b2_ = bar; asm volatile("" : "+s"(b2_.x)); xcd_barrier(b2_); if ((DUP_MASK) & 0x2000) xcd_barrier(b2_); } } while (0)
    PG8_LAS unsigned char* glds = (PG8_LAS unsigned char*)(C.lds + RING_OFF);

    if (ENAB(0) && IN(0)) REPS(0) p0_prologue(launder(C));
    SEAM(0);
    for (int l = 0; l < DEPTH; ++l) {
        const int p = 1 + l * NPH;
        if (ENAB(1) && IN(p + 0)) REPS(1) phase_norm1(launder(C), l, rep_ ? 0.0f : 1.0f);
        SEAM(p + 0);
        if (ENAB(2) && IN(p + 1)) REPS(2) {
            const Ctx Cg = launder(C); unsigned char* const ws = Cg.ws;
            pg8::Gemm g{(const bf16_t*)(ws + WS_H), (const bf16_t*)(ws + WS_WTIN + (size_t)l * PW * DM), MROWS, PW, DM / 2, 0};
            pg8::StaticOrder S; S.init(MROWS, PW, C.G, C.bx);
            pg8::EpiStoreBf16 E{(bf16_t*)(ws + WS_P), PW, C_GATE, 1.0f / (FP8_SH * FP8_SW), rep_ ? PROBE_SKIP : 0};
#ifdef STAGGER_US
            { const unsigned long long t0_ = __builtin_amdgcn_s_memrealtime(), dl_ = (unsigned long long)(((C.bx >> 3) & 3) * STAGGER_US * 25);
              while (__builtin_amdgcn_s_memrealtime() - t0_ < dl_) __builtin_amdgcn_s_sleep(8); }
#endif
            pg8::gemm_phase<pg8::EpiStoreBf16, pg8::StaticOrder, true, true, true>(glds, g, S, E, C.wave);
        }
        SEAM(p + 1);
        if (ENAB(3) && IN(p + 2)) REPS(3) {
            if (!(rep_ && ((DUP_MASK) & 0x200000))) phase_attn_prep(launder(C), l);
            if (!(rep_ && ((DUP_MASK) & 0x400000))) mlstm_a_phase(launder(C), l);
            if (!(rep_ && ((DUP_MASK) & 0x800000))) gla_a_phase(launder(C), l);
        }
        SEAM(p + 2);
        if (ENAB(4) && IN(p + 3)) {
            scan_b_units(launder(C));
            if ((DUP_MASK) & 0x10000) { __syncthreads(); scan_b_units(launder(C), true); }
            __syncthreads();
            REPS(4) phase_attention(launder(C), (char*)lds + RING_OFF, l < DEPTH - 1);
        }
        SEAM(p + 3);
        if (ENAB(5) && IN(p + 4)) REPS(5) {
            if (!(rep_ && ((DUP_MASK) & 0x100000))) mlstm_c_phase(launder(C), l);
            if (!(rep_ && ((DUP_MASK) & 0x80000))) gla_c_phase(launder(C), l);
        }
        SEAM(p + 4);
        if (ENAB(6) && IN(p + 5)) REPS(6) {
            const Ctx Cg = launder(C); unsigned char* const ws = Cg.ws;
            const int Meff = (l == DEPTH - 1) ? M_LAT : MROWS;
            pg8::Gemm g{(const bf16_t*)(ws + WS_YA), (const bf16_t*)(ws + WS_WTBR) + (size_t)l * DM * 1536, Meff, DM, 1536, 0};
            pg8::StaticOrder S; S.init(Meff, DM, C.G, C.bx);
            pg8::EpiBranch E{(bf16_t*)(ws + WS_MRG), (const unsigned char*)(ws + WS_P) + 2 * C_GATE, PW * 2};
            pg8::gemm_phase<pg8::EpiBranch, pg8::StaticOrder, true, true>(glds, g, S, E, C.wave);
        }
        SEAM(p + 5);
        if (ENAB(7) && IN(p + 6)) REPS(7) {
            const Ctx Cg = launder(C); unsigned char* const ws = Cg.ws;
            const int Meff = (l == DEPTH - 1) ? M_LAT : MROWS;
            pg8::Gemm g{(const bf16_t*)(ws + WS_MRG), (const bf16_t*)(ws + WS_WTOUT) + (size_t)l * DM * DM, Meff, DM, DM, 0};
            pg8::StaticOrder S; S.init(Meff, DM, C.G, C.bx);
            pg8::EpiResid E{(bf16_t*)(ws + WS_U), rep_ ? PROBE_SKIP : 0};
            pg8::gemm_phase<pg8::EpiResid, pg8::StaticOrder, true, true>(glds, g, S, E, C.wave);
        }
        SEAM(p + 6);
        if ((DUP_MASK) & 0x20000) {
            const Ctx Cg = launder(C); v4u* q = (v4u*)(Cg.ws + WS_P) + (size_t)C.bx * 131072 + Cg.tid; const v4u val = {1u, 2u, 3u, (unsigned)l};
#pragma unroll 4
            for (int i = 0; i < 256; ++i) q[i * 512] = val;
        }
        if ((DUP_MASK) & 0x40000) {
            const Ctx Cg = launder(C); const v4u* q = (const v4u*)(Cg.ws + WS_P) + (size_t)C.bx * 131072 + Cg.tid; v4u a = {0u, 0u, 0u, 0u};
#pragma unroll 16
            for (int i = 0; i < 256; ++i) { const v4u t = q[i * 512]; a.x ^= t.x; a.y ^= t.y; a.z ^= t.z; a.w ^= t.w; }
            if ((a.x ^ a.y ^ a.z ^ a.w) == 0x12345u) ((unsigned*)(Cg.ws + WS_P))[Cg.tid] = a.x;
        }
        if (ENAB(8) && IN(p + 7)) REPS(8) phase_norm2_router(launder(C), l);
        SEAM(p + 7);
        if (ENAB(9) && IN(p + 8)) REPS(9) phase_gather(launder(C), l);
        SEAM(p + 8);
        if (ENAB(10) && IN(p + 9)) REPS(10) {
            const Ctx Cg = launder(C); unsigned char* const ws = Cg.ws; const int* const META = (const int*)(ws + WS_MOEMETA);
            const int nM = __builtin_amdgcn_readfirstlane(META[0]);
            pg8::Gemm g{(const bf16_t*)(ws + WS_XG), (const bf16_t*)(ws + WS_WTE1 + (size_t)l * NEXP * 2048 * DM), nM * 256, 2048, DM / 2, (size_t)2048 * DM};
            pg8::StaticOrder S; S.init(nM * 256, 2048, C.G, C.bx, META + 16);
            pg8::EpiSwiglu E{(unsigned char*)(ws + WS_A2), INP(I_BE1) + (size_t)l * NEXP * 2048, 1.0f / (FP8_SH * FP8_SW), FP8_SA, rep_ ? PROBE_SKIP : 0};
            pg8::gemm_phase<pg8::EpiSwiglu, pg8::StaticOrder, true, true, true>(glds, g, S, E, C.wave);
        }
        SEAM(p + 9);
        if (ENAB(11) && IN(p + 10)) REPS(11) {
            const Ctx Cg = launder(C); unsigned char* const ws = Cg.ws; const int* const META = (const int*)(ws + WS_MOEMETA);
            const int nM = __builtin_amdgcn_readfirstlane(META[0]);
            pg8::Gemm g{(const bf16_t*)(ws + WS_A2), (const bf16_t*)(ws + WS_WTE2 + (size_t)l * NEXP * DM * DFF), nM * 256, DM, DFF / 2, (size_t)DM * DFF};
            pg8::StaticOrder S; S.init(nM * 256, DM, C.G, C.bx, META + 16);
            pg8::EpiMoeOut E{(bf16_t*)(ws + WS_YS), INP(I_BE2) + (size_t)l * NEXP * DM, (const float*)(ws + WS_SLOTW), 1.0f / (FP8_SA * FP8_SW), rep_ ? PROBE_SKIP : 0};
            pg8::gemm_phase<pg8::EpiMoeOut, pg8::StaticOrder, true, true, true>(glds, g, S, E, C.wave);
        }
        SEAM(p + 10);
    }
    if (ENAB(12) && IN(1 + DEPTH * NPH)) phase_norm1(launder(C), DEPTH, 1.0f);
#undef IN
#undef SEAM
}

extern "C" void kernel_launch(void* const* d_in, const int* in_sizes, int n_in, void* d_out, int out_size, void* d_ws, size_t ws_size, hipStream_t stream) {
    static int grid = 0;
    if (grid == 0) {
        if (n_in != N_IN || out_size != M_LAT * DM || ws_size < WS_END) { fprintf(stderr, "kernel_launch: unexpected shapes: n_in %d out %d ws %zu (need %zu); nothing launched\n", n_in, out_size, ws_size, (size_t)WS_END); grid = -1; return; }
        int dev = 0, cus = 0, per_cu = 0;
        if (hipGetDevice(&dev) != hipSuccess || hipDeviceGetAttribute(&cus, hipDeviceAttributeMultiprocessorCount, dev) != hipSuccess) { grid = -1; return; }
        if (hipFuncSetAttribute((const void*)mk_fwd, hipFuncAttributeMaxDynamicSharedMemorySize, LDS_BYTES) != hipSuccess) { fprintf(stderr, "kernel_launch: hipFuncSetAttribute failed\n"); grid = -1; return; }
        if (hipOccupancyMaxActiveBlocksPerMultiprocessor(&per_cu, (const void*)mk_fwd, 512, LDS_BYTES) != hipSuccess || per_cu < 1) fprintf(stderr, "kernel_launch: note: occupancy query reports %d\n", per_cu);
        (void)hipGetLastError();
        grid = cus;
    }
    if (grid < 0) return;
    (void)in_sizes;
    if (hipMemsetAsync((char*)d_ws + WS_CTL, 0, CTL_ZERO_BYTES, stream) != hipSuccess) return;
    KArgs a{};
    for (int i = 0; i < N_IN; ++i) a.in[i] = (const float*)d_in[i];
    a.out = (float*)d_out; a.ws = (unsigned char*)d_ws;
#if MK_ONE_LAUNCH
    a.ph_lo = 0; a.ph_hi = N_PHASES;
    hipLaunchKernelGGL(mk_fwd, dim3(grid), dim3(512), LDS_BYTES, stream, a);
#else
    for (int p = 0; p < N_PHASES; ++p) { a.ph_lo = p; a.ph_hi = p + 1; hipLaunchKernelGGL(mk_fwd, dim3(grid), dim3(512), LDS_BYTES, stream, a); }
#endif
}
```

```cpp
#include <hip/hip_runtime.h>
#include <hip/hip_bf16.h>
#include <cstdio>
#include <cstdint>

#ifndef MK_ONE_LAUNCH
#define MK_ONE_LAUNCH 1
#endif

#define DI __device__ __forceinline__
#define GAS __attribute__((address_space(1)))
#define LAS __attribute__((address_space(3)))

constexpr int DM = 1024, NBATCH = 8, SEQ = 4096, DEPTH = 4, CTXL = 256;
constexpr int M_LAT = NBATCH * SEQ, M_CTX = NBATCH * CTXL, MROWS = M_LAT + M_CTX;
constexpr int IN_W = 6960, PW = 7168;
constexpr int NCHUNK = MROWS / 64;
constexpr int KVLEN = CTXL + SEQ;
constexpr int NEXP = 32, TOPK = 4, DFF = 1024;
constexpr int MOE_ROWS_MAX = MROWS * TOPK + NEXP * 256;
constexpr float EPS = 1e-6f;
constexpr int C_AQK = 0, C_AV = 512, C_AI = 1024, C_AF = 1032, C_AO = 1040, C_BQ = 1552, C_BK = 2064, C_BV = 2192, C_CQ = 2320, C_CK = 2576, C_CV = 2832, C_CA = 3344, C_CR = 3376, C_GATE = 3888;
static_assert(C_GATE + 3 * DM == IN_W, "split");
enum { I_X = 0, I_C, I_CTX, I_CCTX, I_WADA, I_BADA, I_GN1, I_WIN, I_ACW, I_ACB, I_AGB, I_ANG, I_BQG, I_BKG, I_CWUP, I_CBUP, I_CNG, I_WBR, I_WOUT, I_GN2, I_WR, I_BR, I_WE1, I_BE1, I_WE2, I_BE2, I_GF, N_IN };

constexpr size_t al256(size_t x) { return (x + 255) & ~(size_t)255; }
constexpr size_t WS_CTL = 0, CTL_ZERO_BYTES = 1u << 20;
constexpr size_t WS_MOD = WS_CTL + CTL_ZERO_BYTES;
constexpr size_t WS_BLKCNT = WS_MOD + al256((size_t)DEPTH * 9 * 6 * DM * 4);
constexpr size_t WS_MOEMETA = WS_BLKCNT + al256(1024 * 32 * 4);
constexpr size_t WS_TOKE = WS_MOEMETA + 4096;
constexpr size_t WS_TOKP = WS_TOKE + (size_t)MROWS * 16;
constexpr size_t WS_TOKW = WS_TOKP + (size_t)MROWS * 16;
constexpr size_t WS_SLOTW = WS_TOKW + (size_t)MROWS * 16;
constexpr size_t WS_WTIN = WS_SLOTW + al256((size_t)MOE_ROWS_MAX * 4);
constexpr size_t WS_WTBR = WS_WTIN + (size_t)DEPTH * PW * DM * 2;
constexpr size_t WS_WTOUT = WS_WTBR + (size_t)DEPTH * 3 * DM * 512 * 2;
constexpr size_t WS_WTE1 = WS_WTOUT + (size_t)DEPTH * DM * DM * 2;
constexpr size_t WS_WTE2 = WS_WTE1 + (size_t)DEPTH * NEXP * 2 * DFF * DM * 2;
constexpr size_t WS_X = WS_WTE2 + (size_t)DEPTH * NEXP * DM * DFF * 2;
constexpr size_t WS_H = WS_X + (size_t)MROWS * DM * 4;
constexpr size_t WS_P = WS_H + (size_t)MROWS * DM * 2;
constexpr size_t WS_QR = WS_P + (size_t)MROWS * PW * 2;
constexpr size_t WS_KR = WS_QR + (size_t)MROWS * 512 * 2;
constexpr size_t WS_VR = WS_KR + (size_t)NBATCH * KVLEN * 128 * 2;
constexpr size_t WS_YA = WS_VR + (size_t)NBATCH * KVLEN * 128 * 2;
constexpr size_t WS_YB = WS_YA + (size_t)MROWS * 512 * 2;
constexpr size_t WS_YC = WS_YB + (size_t)MROWS * 512 * 2;
constexpr size_t WS_MRG = WS_YC + (size_t)MROWS * 512 * 2;
constexpr int RECB = 16896, REC_VEC = 16384;
constexpr size_t WS_STA = WS_MRG + (size_t)MROWS * DM * 2;
constexpr size_t WS_STC = WS_STA + (size_t)NCHUNK * 8 * RECB;
constexpr size_t WS_XG = WS_STC + (size_t)NCHUNK * 8 * RECB;
constexpr size_t WS_A2 = WS_XG + (size_t)MOE_ROWS_MAX * DM * 2;
constexpr size_t WS_YS = WS_A2 + (size_t)MOE_ROWS_MAX * DFF * 2;
constexpr size_t WS_U = WS_YS + (size_t)MOE_ROWS_MAX * DM * 2;
constexpr size_t WS_END = WS_U + (size_t)MROWS * DM * 2;
constexpr int CW_BAR = 4096;

constexpr int RING_OFF = 0, RING_BYTES = 155648;
constexpr int LDSCTL_OFF = RING_BYTES, MISC_OFF = LDSCTL_OFF + 320;
constexpr int LDS_BYTES = 156672;

typedef unsigned short bf16_t;
typedef unsigned v4u __attribute__((ext_vector_type(4)));
typedef unsigned v2u __attribute__((ext_vector_type(2)));
typedef float f32x4 __attribute__((ext_vector_type(4)));
typedef short bf16x8 __attribute__((ext_vector_type(8)));

DI float bf2f(unsigned h) { return __uint_as_float(h << 16); }
typedef float f32x2_h __attribute__((ext_vector_type(2))); typedef __bf16 bf16x2_h __attribute__((ext_vector_type(2)));
DI unsigned pk2(float lo, float hi) { const f32x2_h v = {lo, hi}; return __builtin_bit_cast(unsigned, __builtin_convertvector(v, bf16x2_h)); }
DI unsigned f2bf(float f) { return pk2(f, f) & 0xffffu; }
DI void unpack8(const v4u v, float (&o)[8]) { o[0] = bf2f(v.x & 0xffffu); o[1] = bf2f(v.x >> 16); o[2] = bf2f(v.y & 0xffffu); o[3] = bf2f(v.y >> 16); o[4] = bf2f(v.z & 0xffffu); o[5] = bf2f(v.z >> 16); o[6] = bf2f(v.w & 0xffffu); o[7] = bf2f(v.w >> 16); }
constexpr float FP8_SH = 8.0f, FP8_SW = 512.0f, FP8_SA = 4.0f;
DI float clamp448(float x) { return fminf(fmaxf(x, -448.0f), 448.0f); }
DI unsigned pk4_fp8(float a, float b, float c, float d) { unsigned w = __float_as_uint(a);   w = __builtin_amdgcn_cvt_pk_fp8_f32(clamp448(a), clamp448(b), w, false); w = __builtin_amdgcn_cvt_pk_fp8_f32(clamp448(c), clamp448(d), w, true); return w; }
DI float sigmoid_f(float x) { return __builtin_amdgcn_rcpf(1.f + __expf(-x)); }
DI float silu_f(float x) { return x * sigmoid_f(x); }
DI float logsigmoid_f(float x) { return fminf(x, 0.f) - __logf(1.f + __expf(-fabsf(x))); }
namespace pg8 {
#define PG8_LAS __attribute__((address_space(3)))
typedef unsigned short bf16_t;
typedef short bf16x8 __attribute__((ext_vector_type(8)));
typedef float f32x4 __attribute__((ext_vector_type(4)));
typedef unsigned u32x4 __attribute__((ext_vector_type(4)));
typedef int v4i_t __attribute__((ext_vector_type(4)));
typedef unsigned u32x2 __attribute__((ext_vector_type(2)));
constexpr int BM = 256, BK = 64, HALF = 128, HTB = HALF * BK * 2  , STAGE_BYTES = 8 * HTB, NXCD = 8, WGM = 8;

__host__ __device__ __forceinline__ int lds_byte(int r, int c) { const int st = (r >> 4) * 2 + (c >> 5), rr = r & 15, cc = c & 31, ob = rr * 64 + cc * 2; return st * 1024 + (ob ^ (((ob >> 9) & 1) << 5)); }
__host__ __device__ __forceinline__ void stage_rc(int b, int& R, int& C) { const int st = b / 1024, sb = b % 1024, swz = sb ^ (((sb >> 9) & 1) << 5); R = (st >> 1) * 16 + swz / 64; C = (st & 1) * 32 + (swz % 64) / 2; }
__host__ __device__ __forceinline__ int perm32(int rho) { const int n = rho >> 4, i = rho & 15; return 8 * (i >> 2) + 4 * n + (i & 3); }

struct Unit { int pm, pn, e; };
struct Gemm { const bf16_t* A; const bf16_t* Bt; int M, N, K; size_t bstride; };

struct StaticOrder {
    int nM, nN, nwg, G, c; const int* tile_e;
    __host__ __device__ void init(int M, int N, int G_, int c_, const int* te = nullptr) { nM = M / BM; nN = N / BM; nwg = nM * nN; G = G_; c = c_; tile_e = te; }
    __device__ __forceinline__ bool next(int i, Unit& u) const {
        const long L = (long)i * G + c; if (L >= nwg) return false;
        int wgid = (int)L; { const int q = nwg / NXCD, r = nwg % NXCD, xcd = wgid % NXCD, off = wgid / NXCD; wgid = (xcd < r ? xcd * (q + 1) : r * (q + 1) + (xcd - r) * q) + off; }
        const int nig = WGM * nN, gid = wgid / nig, fm = gid * WGM, gsz = (nM - fm) < WGM ? (nM - fm) : WGM;
        u.pm = fm + ((wgid % nig) % gsz); u.pn = (wgid % nig) / gsz; u.e = tile_e ? __builtin_amdgcn_readfirstlane(tile_e[u.pm]) : 0; return true;
    }
    __device__ __forceinline__ void a_ready(const Unit&) const {}
    __device__ __forceinline__ void done(const Unit&) const {}
};

__device__ __forceinline__ unsigned cvt_pk_bf16(float lo, float hi) { unsigned r; asm volatile("v_cvt_pk_bf16_f32 %0, %1, %2" : "=v"(r) : "v"(lo), "v"(hi)); return r; }
__device__ __forceinline__ u32x4 pack8(const f32x4 a, const f32x4 b) { u32x4 w; w.x = cvt_pk_bf16(a[0], a[1]); w.y = cvt_pk_bf16(a[2], a[3]); w.z = cvt_pk_bf16(b[0], b[1]); w.w = cvt_pk_bf16(b[2], b[3]); return w; }
__device__ __forceinline__ float bfl(unsigned v) { return __uint_as_float(v << 16); }
__device__ __forceinline__ float bfh(unsigned v) { return __uint_as_float(v & 0xffff0000u); }
__device__ __forceinline__ float sigm(float x) { return __builtin_amdgcn_rcpf(1.f + __expf(-x)); }

#ifndef AUX_B
#define AUX_B 0
#endif
#ifndef AUX_F
#define AUX_F 0
#endif
#ifndef AUX_G
#define AUX_G 0
#endif
#ifndef AUX_J
#define AUX_J 0
#endif
#ifndef AUX_K
#define AUX_K 0
#endif
__device__ __forceinline__ __amdgpu_buffer_rsrc_t mk_rs(const void* p) {
    unsigned lo = (unsigned)__builtin_amdgcn_readfirstlane((int)(unsigned)(uintptr_t)p), hi = (unsigned)__builtin_amdgcn_readfirstlane((int)(unsigned)((uintptr_t)p >> 32)); asm volatile("" : "+s"(lo), "+s"(hi));
    return __builtin_amdgcn_make_buffer_rsrc((void*)(((uintptr_t)hi << 32) | (uintptr_t)lo), 0, -1, 0x00020000); }
template <int AUX> __device__ __forceinline__ void st16(__amdgpu_buffer_rsrc_t rs, unsigned off, u32x4 v) { __builtin_amdgcn_raw_buffer_store_b128(v, rs, off, 0, AUX); }
template <int AUX> __device__ __forceinline__ void st8(__amdgpu_buffer_rsrc_t rs, unsigned off, u32x2 v) { __builtin_amdgcn_raw_buffer_store_b64(v, rs, off, 0, AUX); }
__device__ __forceinline__ void st16p(void* p, u32x4 v) { if (AUX_B == 16) asm volatile("global_store_dwordx4 %0, %1, off sc1\n\ts_nop 1" :: "v"(p), "v"(v) : "memory"); else *(u32x4*)p = v; }
__device__ __forceinline__ void st8p(void* p, u32x2 v) { if (AUX_B == 16) asm volatile("global_store_dwordx2 %0, %1, off sc1\n\ts_nop 1" :: "v"(p), "v"(v) : "memory"); else *(u32x2*)p = v; }
struct NoState {};
struct EpiStoreBf16 {
    static constexpr bool PERM = true, AFTER_DRAIN = false, HOOK = false; static constexpr int NST = 16; typedef NoState State;
    bf16_t* O; int ldc, sig_from; float inv; int probe_skip;
    __device__ __forceinline__ unsigned q8(float raw, float c2) const { const float e = __builtin_amdgcn_exp2f(raw * c2); return (unsigned)fmaxf(__builtin_rintf(__builtin_amdgcn_rcpf(__builtin_fmaf(e, 1.0f / 255.0f, 1.0f / 255.0f))), 1.0f); }
    __device__ __forceinline__ void operator()(const f32x4 (&acc)[2][2][4][2], const Unit& u, int wr, int wc, int fr, int fq, NoState&) const {
        const int row0 = u.pm * BM + wr * 64 + fr, col0 = u.pn * BM + wc * 32 + 8 * fq;
        if (probe_skip == 2) return;
#pragma unroll
        for (int bj = 0; bj < 2; ++bj) {
            const int col = col0 + bj * HALF; const bool sg = col >= sig_from;
#pragma unroll
            for (int ai = 0; ai < 2; ++ai)
#pragma unroll
                for (int m = 0; m < 4; ++m) {
                    const f32x4 a = acc[ai][bj][m][0] * inv, b = acc[ai][bj][m][1] * inv;
                    bf16_t* rowp = O + (size_t)(row0 + ai * HALF + m * 16) * ldc;
                    if (probe_skip == 1 && (a[0] + b[3]) != 12345.678f) continue;
                    if (probe_skip == 4 && (ai + m + bj) != 0 && (a[0] + b[3]) != 12345.678f) continue;
                    if (probe_skip == 3) { *(u32x4*)((unsigned char*)O + ((size_t)1 << 31) + (size_t)(u.pm * 28 + u.pn) * 131072 + (size_t)((((ai * 4 + m) * 2 + bj) * 8 + (wr * 4 + wc)) * 1024 + (fr + 16 * fq) * 16)) = pack8(a, b); continue; }
                    if (sg) { const f32x4 ra = acc[ai][bj][m][0], rb = acc[ai][bj][m][1]; const float c2 = inv * -1.4426950408889634f;
                        u32x2 w; w.x = q8(ra[0], c2) | (q8(ra[1], c2) << 8) | (q8(ra[2], c2) << 16) | (q8(ra[3], c2) << 24); w.y = q8(rb[0], c2) | (q8(rb[1], c2) << 8) | (q8(rb[2], c2) << 16) | (q8(rb[3], c2) << 24);
                        st8p((unsigned char*)(rowp + sig_from) + (col - sig_from), w); }
                    else st16p(rowp + col, pack8(a, b)); }
        }
    }
};
struct EpiBranch {
    static constexpr bool PERM = true, AFTER_DRAIN = false, HOOK = true; static constexpr int NST = 16; typedef NoState State;
    bf16_t* MRG; const unsigned char* gates; int ldg;
    static __device__ __forceinline__ float ub(unsigned v, int k) { return (float)((v >> (8 * k)) & 0xffu); }
    __device__ __forceinline__ void hook(f32x4 (&acc)[2][2][4][2], const Unit& u, int seg, int wr, int wc, int lane, NoState&) const {
        const int fr = lane & 15, fq = lane >> 4;
        const int row0 = u.pm * BM + wr * 64 + fr, col0 = u.pn * BM + wc * 32 + 8 * fq;
        const unsigned char* gp = gates + seg * 1024 + col0;
        u32x2 gb[2][4][2], ga[2][4][2];
#pragma unroll
        for (int ai = 0; ai < 2; ++ai)
#pragma unroll
            for (int m = 0; m < 4; ++m) { const size_t ro = (size_t)(row0 + ai * HALF + m * 16) * ldg;
#pragma unroll
                for (int bj = 0; bj < 2; ++bj) { gb[ai][m][bj] = *(const u32x2*)(gp + ro + bj * HALF); ga[ai][m][bj] = *(const u32x2*)(gp + ro - 1024 + bj * HALF); } }
        __builtin_amdgcn_sched_barrier(0);
#pragma unroll
        for (int ai = 0; ai < 2; ++ai)
#pragma unroll
            for (int m = 0; m < 4; ++m)
#pragma unroll
                for (int bj = 0; bj < 2; ++bj) {
                    const u32x2 b_ = gb[ai][m][bj], a_ = ga[ai][m][bj];
                    f32x4& a = acc[ai][bj][m][0]; f32x4& b = acc[ai][bj][m][1];
#pragma unroll
                    for (int k = 0; k < 4; ++k) { a[k] *= ub(a_.x, k) * __builtin_amdgcn_rcpf(ub(b_.x, k)); b[k] *= ub(a_.y, k) * __builtin_amdgcn_rcpf(ub(b_.y, k)); }
                }
    }
    __device__ __forceinline__ void operator()(const f32x4 (&acc)[2][2][4][2], const Unit& u, int wr, int wc, int fr, int fq, NoState&) const {
        const int row0 = u.pm * BM + wr * 64 + fr, col0 = u.pn * BM + wc * 32 + 8 * fq;
        u32x2 gv[2][4][2];
#pragma unroll
        for (int ai = 0; ai < 2; ++ai)
#pragma unroll
            for (int m = 0; m < 4; ++m)
#pragma unroll
                for (int bj = 0; bj < 2; ++bj) gv[ai][m][bj] = *(const u32x2*)(gates + (size_t)(row0 + ai * HALF + m * 16) * ldg + 2048 + col0 + bj * HALF);
        __builtin_amdgcn_sched_barrier(0);
        const __amdgpu_buffer_rsrc_t rsM = mk_rs(MRG);
#pragma unroll
        for (int ai = 0; ai < 2; ++ai)
#pragma unroll
            for (int m = 0; m < 4; ++m) { const size_t row = (size_t)(row0 + ai * HALF + m * 16);
#pragma unroll
                for (int bj = 0; bj < 2; ++bj) {
                    const u32x2 g_ = gv[ai][m][bj];
                    f32x4 a = acc[ai][bj][m][0], b = acc[ai][bj][m][1];
#pragma unroll
                    for (int k = 0; k < 4; ++k) { a[k] *= ub(g_.x, k) * (1.0f / 255.0f); b[k] *= ub(g_.y, k) * (1.0f / 255.0f); }
                    st16<AUX_F>(rsM, (unsigned)row * 2048u + (unsigned)(col0 + bj * HALF) * 2u, pack8(a, b)); } }
    }
};
struct EpiResid {
    static constexpr bool PERM = true, AFTER_DRAIN = false, HOOK = false; static constexpr int NST = 16; typedef NoState State;
    bf16_t* U; int probe_skip;
    __device__ __forceinline__ void operator()(const f32x4 (&acc)[2][2][4][2], const Unit& u, int wr, int wc, int fr, int fq, NoState&) const {
        const int row0 = u.pm * BM + wr * 64 + fr, col0 = u.pn * BM + wc * 32 + 8 * fq;
        if (probe_skip == 2) return;
        const __amdgpu_buffer_rsrc_t rsU = mk_rs(U);
#pragma unroll
        for (int ai = 0; ai < 2; ++ai)
#pragma unroll
            for (int m = 0; m < 4; ++m) { const unsigned rowb = (unsigned)(row0 + ai * HALF + m * 16) * 2048u + (unsigned)col0 * 2u;
#pragma unroll
                for (int bj = 0; bj < 2; ++bj) st16<AUX_G>(rsU, rowb + bj * HALF * 2, pack8(acc[ai][bj][m][0], acc[ai][bj][m][1])); }
    }
};
__device__ __forceinline__ float clamp448(float x) { return fminf(fmaxf(x, -448.0f), 448.0f); }
__device__ __forceinline__ unsigned pk4_fp8(float a, float b, float c, float d) { unsigned w = __float_as_uint(a);   w = __builtin_amdgcn_cvt_pk_fp8_f32(clamp448(a), clamp448(b), w, false); w = __builtin_amdgcn_cvt_pk_fp8_f32(clamp448(c), clamp448(d), w, true); return w; }
__device__ __forceinline__ unsigned pk4_fp8_nc(float a, float b, float c, float d) { unsigned w = __float_as_uint(a); w = __builtin_amdgcn_cvt_pk_fp8_f32(a, b, w, false); w = __builtin_amdgcn_cvt_pk_fp8_f32(c, d, w, true); return w; }
struct EpiSwiglu {
    static constexpr bool PERM = true, AFTER_DRAIN = false, HOOK = false; static constexpr int NST = 8; typedef NoState State;
    unsigned char* A2; const float* b1; float inv, oscale; int probe_skip;
    __device__ __forceinline__ void operator()(const f32x4 (&acc)[2][2][4][2], const Unit& u, int wr, int wc, int fr, int fq, NoState&) const {
        asm volatile("" ::: "memory");
        if (probe_skip == 2) return;
        const int row0 = u.pm * BM + wr * 64 + fr, j0 = u.pn * HALF + wc * 32 + 8 * fq;
        const float* bp = b1 + (size_t)u.e * 2048 + 2 * j0;
        const __amdgpu_buffer_rsrc_t rsA2 = mk_rs(A2);
        float bg[8], bu[8];
#pragma unroll
        for (int q = 0; q < 4; ++q) { const f32x4 t = *(const f32x4*)(bp + 4 * q); bg[2 * q] = t[0]; bu[2 * q] = t[1]; bg[2 * q + 1] = t[2]; bu[2 * q + 1] = t[3]; }
#pragma unroll
        for (int ai = 0; ai < 2; ++ai)
#pragma unroll
            for (int m = 0; m < 4; ++m) {
                float o[8];
#pragma unroll
                for (int e = 0; e < 8; ++e) {
                    float g = acc[ai][0][m][e >> 2][e & 3] * inv + bg[e], up = acc[ai][1][m][e >> 2][e & 3] * inv + bu[e];
                    g = fminf(g, 7.0f); up = fminf(fmaxf(up, -7.0f), 7.0f);
                    o[e] = __builtin_fmaf(up, oscale, oscale) * (g * __builtin_amdgcn_rcpf(1.0f + __builtin_amdgcn_exp2f(g * (-1.702f * 1.4426950408889634f)))); }
                u32x2 w; w.x = pk4_fp8_nc(o[0], o[1], o[2], o[3]); w.y = pk4_fp8_nc(o[4], o[5], o[6], o[7]);
                st8<AUX_J>(rsA2, (unsigned)(row0 + ai * HALF + m * 16) * 1024u + (unsigned)j0, w); }
    }
};
struct EpiMoeOut {
    static constexpr bool PERM = true, AFTER_DRAIN = false, HOOK = false; static constexpr int NST = 16; typedef NoState State;
    bf16_t* YS; const float* b2; const float* slotw; float inv; int probe_skip;
    __device__ __forceinline__ void operator()(const f32x4 (&acc)[2][2][4][2], const Unit& u, int wr, int wc, int fr, int fq, NoState&) const {
        const int row0 = u.pm * BM + wr * 64 + fr, col0 = u.pn * BM + wc * 32 + 8 * fq;
        if (probe_skip == 2) return;
        if (probe_skip == 5) { const __amdgpu_buffer_rsrc_t rsZ = mk_rs((const unsigned char*)YS - WS_YS + WS_MRG);
#pragma unroll
            for (int ai = 0; ai < 2; ++ai)
#pragma unroll
                for (int m = 0; m < 4; ++m) { const unsigned row = (unsigned)(row0 + ai * HALF + m * 16) % 34816u;
#pragma unroll
                    for (int bj = 0; bj < 2; ++bj) st16<0>(rsZ, row * 2048u + (unsigned)(col0 + bj * HALF) * 2u, pack8(acc[ai][bj][m][0] * inv, acc[ai][bj][m][1] * inv)); }
            return; }
        const float* bp = b2 + (size_t)u.e * 1024 + col0;
        const __amdgpu_buffer_rsrc_t rsY = mk_rs(YS);
        f32x4 bv[2][2];
#pragma unroll
        for (int bj = 0; bj < 2; ++bj)
#pragma unroll
            for (int n = 0; n < 2; ++n) bv[bj][n] = *(const f32x4*)(bp + bj * HALF + 4 * n);
#pragma unroll
        for (int ai = 0; ai < 2; ++ai)
#pragma unroll
            for (int m = 0; m < 4; ++m) { const size_t row = (size_t)(row0 + ai * HALF + m * 16); const float w = slotw[row];
#pragma unroll
                for (int bj = 0; bj < 2; ++bj) st16<AUX_K>(rsY, (unsigned)row * 2048u + (unsigned)(col0 + bj * HALF) * 2u, pack8((acc[ai][bj][m][0] * inv + bv[bj][0]) * w, (acc[ai][bj][m][1] * inv + bv[bj][1]) * w)); }
    }
};

template <class Epi, class Sched, bool ALIGN_EPI = false, bool SP2 = false, bool F8 = false>
__device__ __forceinline__ void gemm_phase(PG8_LAS unsigned char* lds, const Gemm g, const Sched& S, const Epi& E, int wave_index) {
    unsigned msk_ = ~0u; asm volatile("" : "+s"(msk_)); const int tid_ = (wave_index << 6) | (int)__builtin_amdgcn_mbcnt_hi(msk_, __builtin_amdgcn_mbcnt_lo(msk_, 0u));
    const int tid = tid_, wid = __builtin_amdgcn_readfirstlane(tid >> 6), lane = tid & 63, wr = wid >> 2, wc = wid & 3, fr = lane & 15, fq = lane >> 4;
    const int K = g.K, nt = K / BK;
    unsigned voffA[2], voffB[2];
#pragma unroll
    for (int i = 0; i < 2; ++i) { int R, C; stage_rc(tid * 16 + i * 8192, R, C); const int Rb = Epi::PERM ? ((R & ~31) + perm32(R & 31)) : R;
        voffA[i] = (unsigned)(R * K + C) * 2u; voffB[i] = (unsigned)(Rb * K + C) * 2u; }
    const unsigned kstep = (unsigned)(BK * 2);
    const unsigned hstep = (unsigned)HALF * (unsigned)K * 2u;
    const unsigned tstep = 2u * hstep;
    const unsigned ldsw = (unsigned)wid * 1024u;
    const int aoff = lds_byte(wr * 64 + fr, fq * 8), boff = lds_byte(wc * 32 + fr, fq * 8);
#define PG8_SA(b, h) (((b) * 2 + (h)) * HTB)
#define PG8_SB(b, h) ((4 + (b) * 2 + (h)) * HTB)
#define PG8_RS_voffA rsA
#define PG8_RS_voffB rsB
#define PG8_STAGE(bufoff, gbase, voff) do { _Pragma("unroll") for (int _i = 0; _i < 2; ++_i) \
        __builtin_amdgcn_raw_ptr_buffer_load_lds(PG8_RS_##voff, (PG8_LAS void*)(lds + (bufoff) + ldsw + _i * 8192), 16, (voff)[_i], (gbase), 0, 0); } while (0)
#define PG8_LDA(dst, b, h) do { _Pragma("unroll") for (int m = 0; m < 4; ++m) _Pragma("unroll") for (int k = 0; k < 2; ++k) dst[m][k] = *(const PG8_LAS bf16x8*)(lds + PG8_SA(b, h) + aoff + m * 2048 + k * 1024); } while (0)
#define PG8_LDB(dst, b, h) do { _Pragma("unroll") for (int n = 0; n < 2; ++n) _Pragma("unroll") for (int k = 0; k < 2; ++k) dst[n][k] = *(const PG8_LAS bf16x8*)(lds + PG8_SB(b, h) + boff + n * 2048 + k * 1024); } while (0)
#define PG8_CAT(x) __builtin_shufflevector(__builtin_bit_cast(v4i_t, (x)[0]), __builtin_bit_cast(v4i_t, (x)[1]), 0, 1, 2, 3, 4, 5, 6, 7)
#define PG8_MMA(ai, bj, At, Bt) do { __builtin_amdgcn_s_setprio(1); _Pragma("unroll") for (int m = 0; m < 4; ++m) _Pragma("unroll") for (int n = 0; n < 2; ++n) { \
        if constexpr (F8) acc[ai][bj][m][n] = __builtin_amdgcn_mfma_scale_f32_16x16x128_f8f6f4(PG8_CAT(Bt[n]), PG8_CAT(At[m]), acc[ai][bj][m][n], 0, 0, 0, 0x7f7f7f7f, 0, 0x7f7f7f7f); \
        else { _Pragma("unroll") for (int k = 0; k < 2; ++k) acc[ai][bj][m][n] = __builtin_amdgcn_mfma_f32_16x16x32_bf16(Bt[n][k], At[m][k], acc[ai][bj][m][n], 0, 0, 0); } } __builtin_amdgcn_s_setprio(0); } while (0)
#define PG8_WAIT_V(n) asm volatile("s_waitcnt vmcnt(" #n ")" ::: "memory")
#define PG8_WAIT_L(n) asm volatile("s_waitcnt lgkmcnt(" #n ")" ::: "memory")
#define PG8_BAR __builtin_amdgcn_s_barrier()
#define PG8_SCHED __builtin_amdgcn_sched_barrier(0)
    Unit cur, nxt; int ui = 0;
    typename Epi::State est;
    if (!S.next(0, cur)) return;
    f32x4 acc[2][2][4][2];
#pragma unroll
    for (int a = 0; a < 2; ++a)
#pragma unroll
        for (int b = 0; b < 2; ++b)
#pragma unroll
            for (int m = 0; m < 4; ++m)
#pragma unroll
                for (int n = 0; n < 2; ++n) { f32x4 z_; asm volatile("v_mov_b32 %0, 0\n\tv_mov_b32 %1, 0\n\tv_mov_b32 %2, 0\n\tv_mov_b32 %3, 0" : "=v"(z_[0]), "=v"(z_[1]), "=v"(z_[2]), "=v"(z_[3])); acc[a][b][m][n] = z_; }
    bf16x8 At[4][2], B0[2][2], B1[2][2];
    const __amdgpu_buffer_rsrc_t rsA = __builtin_amdgcn_make_buffer_rsrc((void*)g.A, 0, -1, 0x00020000), rsB = __builtin_amdgcn_make_buffer_rsrc((void*)g.Bt, 0, -1, 0x00020000);
    unsigned cA = (unsigned)cur.pm * tstep, cB = (unsigned)cur.e * (unsigned)g.bstride + (unsigned)cur.pn * tstep;
    S.a_ready(cur);
    if constexpr (SP2) {
        PG8_STAGE(PG8_SB(0, 0), cB, voffB); PG8_STAGE(PG8_SB(0, 1), cB + hstep, voffB); PG8_STAGE(PG8_SA(0, 0), cA, voffA); PG8_STAGE(PG8_SA(0, 1), cA + hstep, voffA);
        PG8_STAGE(PG8_SB(1, 0), cB + kstep, voffB); PG8_STAGE(PG8_SA(1, 0), cA + kstep, voffA); PG8_STAGE(PG8_SB(1, 1), cB + hstep + kstep, voffB);
        if (wr == 1) PG8_BAR;
        PG8_WAIT_V(6); PG8_BAR;
        PG8_BAR;
    } else {
        PG8_STAGE(PG8_SB(0, 0), cB, voffB); PG8_STAGE(PG8_SA(0, 0), cA, voffA); PG8_STAGE(PG8_SB(0, 1), cB + hstep, voffB); PG8_STAGE(PG8_SA(0, 1), cA + hstep, voffA);
        if (wr == 1) PG8_BAR;
        PG8_WAIT_V(4); PG8_BAR;
        PG8_STAGE(PG8_SB(1, 0), cB + kstep, voffB); PG8_STAGE(PG8_SA(1, 0), cA + kstep, voffA); PG8_STAGE(PG8_SB(1, 1), cB + hstep + kstep, voffB);
        PG8_WAIT_V(6); PG8_BAR;
    }
    for (;;) {
        const bool has_next = S.next(ui + 1, nxt);
        const unsigned nA = has_next ? (unsigned)nxt.pm * tstep : cA, nB = has_next ? (unsigned)nxt.e * (unsigned)g.bstride + (unsigned)nxt.pn * tstep : cB;
#pragma clang loop unroll(disable)
        for (int t = 0; t < nt; t += 2) {
            if constexpr (Epi::HOOK) { if (t > 0 && (t & 7) == 0) { if (wr == 0) PG8_BAR; E.hook(acc, cur, t >> 3, wr, wc, lane, est); if (wr == 1) PG8_BAR; } }
            const bool last = (t == nt - 2);
            const unsigned a1 = cA + (unsigned)(t + 1) * kstep;
            const unsigned a2 = last ? nA : cA + (unsigned)(t + 2) * kstep, b2 = last ? nB : cB + (unsigned)(t + 2) * kstep;
            const unsigned a3 = a2 + kstep, b3 = b2 + kstep;
            if (last && has_next) S.a_ready(nxt);
            if constexpr (SP2) {
            PG8_LDB(B0, 0, 0); PG8_LDB(B1, 0, 1); PG8_SCHED; PG8_LDA(At, 0, 0); PG8_STAGE(PG8_SA(1, 1), a1 + hstep, voffA);
            PG8_WAIT_V(8); PG8_WAIT_L(0); PG8_BAR; PG8_MMA(0, 0, At, B0); PG8_MMA(0, 1, At, B1); PG8_BAR; PG8_SCHED;
            PG8_LDA(At, 0, 1); PG8_STAGE(PG8_SB(0, 0), b2, voffB); PG8_STAGE(PG8_SB(0, 1), b2 + hstep, voffB); PG8_STAGE(PG8_SA(0, 0), a2, voffA);
            PG8_WAIT_V(8); PG8_WAIT_L(0); PG8_BAR; PG8_MMA(1, 0, At, B0); PG8_MMA(1, 1, At, B1); PG8_BAR; PG8_SCHED;
            PG8_LDB(B0, 1, 0); PG8_LDB(B1, 1, 1); PG8_SCHED; PG8_LDA(At, 1, 0); PG8_STAGE(PG8_SA(0, 1), a2 + hstep, voffA);
            PG8_WAIT_V(8); PG8_WAIT_L(0); PG8_BAR; PG8_MMA(0, 0, At, B0); PG8_MMA(0, 1, At, B1); PG8_BAR; PG8_SCHED;
            PG8_LDA(At, 1, 1); PG8_STAGE(PG8_SB(1, 0), b3, voffB); PG8_STAGE(PG8_SB(1, 1), b3 + hstep, voffB); PG8_STAGE(PG8_SA(1, 0), a3, voffA);
            PG8_WAIT_V(8); PG8_WAIT_L(0); PG8_BAR; PG8_MMA(1, 0, At, B0); PG8_MMA(1, 1, At, B1); PG8_BAR; PG8_SCHED;
            } else {
            PG8_LDB(B0, 0, 0); PG8_SCHED; PG8_LDA(At, 0, 0); PG8_STAGE(PG8_SA(1, 1), a1 + hstep, voffA);
            PG8_WAIT_L(8); PG8_BAR; PG8_WAIT_L(0); PG8_MMA(0, 0, At, B0); PG8_BAR; PG8_SCHED;
            PG8_LDB(B1, 0, 1); PG8_STAGE(PG8_SB(0, 0), b2, voffB);
            PG8_BAR; PG8_WAIT_L(0); PG8_MMA(0, 1, At, B1); PG8_BAR;
            PG8_LDA(At, 0, 1); PG8_STAGE(PG8_SA(0, 0), a2, voffA);
            PG8_BAR; PG8_WAIT_L(0); PG8_MMA(1, 0, At, B0); PG8_BAR; PG8_SCHED;
            PG8_STAGE(PG8_SB(0, 1), b2 + hstep, voffB);
            PG8_WAIT_V(6); PG8_BAR; PG8_MMA(1, 1, At, B1); PG8_BAR;
            PG8_LDB(B0, 1, 0); PG8_SCHED; PG8_LDA(At, 1, 0); PG8_STAGE(PG8_SA(0, 1), a2 + hstep, voffA);
            PG8_WAIT_L(8); PG8_BAR; PG8_WAIT_L(0); PG8_MMA(0, 0, At, B0); PG8_BAR; PG8_SCHED;
            PG8_LDB(B1, 1, 1); PG8_STAGE(PG8_SB(1, 0), b3, voffB);
            PG8_BAR; PG8_WAIT_L(0); PG8_MMA(0, 1, At, B1); PG8_BAR;
            PG8_LDA(At, 1, 1); PG8_STAGE(PG8_SA(1, 0), a3, voffA);
            PG8_BAR; PG8_WAIT_L(0); PG8_MMA(1, 0, At, B0); PG8_BAR; PG8_SCHED;
            PG8_STAGE(PG8_SB(1, 1), b3 + hstep, voffB);
            PG8_WAIT_V(6); PG8_BAR; PG8_MMA(1, 1, At, B1); PG8_BAR;
            }
        }
        if constexpr (ALIGN_EPI) { if (wr == 0) PG8_BAR; }
        if constexpr (!Epi::AFTER_DRAIN) { unsigned m2_ = ~0u; asm volatile("" : "+s"(m2_)); const int le_ = (int)__builtin_amdgcn_mbcnt_hi(m2_, __builtin_amdgcn_mbcnt_lo(m2_, 0u));
            E(acc, cur, wr, wc, le_ & 15, le_ >> 4, est); S.done(cur); }
        if (!has_next) break;
#pragma unroll
        for (int a = 0; a < 2; ++a)
#pragma unroll
            for (int b = 0; b < 2; ++b)
#pragma unroll
                for (int m = 0; m < 4; ++m)
#pragma unroll
                    for (int n = 0; n < 2; ++n) { f32x4 z_; asm volatile("v_mov_b32 %0, 0\n\tv_mov_b32 %1, 0\n\tv_mov_b32 %2, 0\n\tv_mov_b32 %3, 0" : "=v"(z_[0]), "=v"(z_[1]), "=v"(z_[2]), "=v"(z_[3])); acc[a][b][m][n] = z_; }
        cur = nxt; cA = nA; cB = nB; ++ui;
        if constexpr (ALIGN_EPI) { if (wr == 1) PG8_BAR; }
    }
    PG8_WAIT_V(0);
    if constexpr (!ALIGN_EPI) { if (wr == 0) PG8_BAR; }
    PG8_BAR;
    if constexpr (Epi::AFTER_DRAIN) { E.fused(acc, cur, wr, wc, fr, fq, lds, wid, lane); S.done(cur); }
#undef PG8_SA
#undef PG8_SB
#undef PG8_STAGE
#undef PG8_RS_voffA
#undef PG8_RS_voffB
#undef PG8_LDA
#undef PG8_LDB
#undef PG8_MMA
#undef PG8_CAT
#undef PG8_WAIT_V
#undef PG8_WAIT_L
#undef PG8_BAR
#undef PG8_SCHED
}
}
namespace attn_body {
using bf16=__hip_bfloat16;
using bf16x8=__attribute__((ext_vector_type(8)))short;
using s16x4=__attribute__((ext_vector_type(4)))short;
using f32x16=__attribute__((ext_vector_type(16)))float;
using u32x4=__attribute__((ext_vector_type(4)))unsigned;
constexpr int D=64,QP=512,KP=128,OP=1536;
constexpr int NW=8,QBLK=32,QB=QBLK*NW,KVBLK=64;
constexpr int ATTN_UNIT_ROWS=QB;
__device__ __forceinline__ int crow(int r,int hi){return (r&3)+8*(r>>2)+4*hi;}
#define SBAR() __builtin_amdgcn_sched_barrier(0)
__device__ __forceinline__ void cmask(f32x16&p0,f32x16&p1,int jb,int qrel,int hi){
  const float NEG=-INFINITY; int kb=64*jb+4*hi;
  #pragma unroll
  for(int r=0;r<16;++r){int kv=kb+(r&3)+8*(r>>2); if(kv>qrel)p0[r]=NEG; if(kv+32>qrel)p1[r]=NEG;}
}

constexpr int NSLOT=3, SLOTB=8192;
constexpr int LDS_K=0, LDS_V=NSLOT*SLOTB, LDS_WS=2*NSLOT*SLOTB, LDS_OST=LDS_WS+NW*64*4, LDS_BYTES=LDS_OST+NW*4096;
constexpr float C2=0.125f*1.4426950408889634f;
__device__ __forceinline__ void glds16(const void*gsrc,unsigned lds_dst){unsigned keep;
  asm volatile("s_mov_b32 %0, m0\n\ts_mov_b32 m0, %2\n\ts_nop 0\n\tglobal_load_lds_dwordx4 %1, off\n\ts_mov_b32 m0, %0":"=&s"(keep):"v"(gsrc),"s"(lds_dst):"memory");}
__device__ __forceinline__ float max3f(float a,float b,float c){float r;asm("v_max3_f32 %0, %1, %2, %3":"=v"(r):"v"(a),"v"(b),"v"(c));return r;}
__device__ __forceinline__ float max2f(float a,float b){float r;asm("v_max_f32_e32 %0, %1, %2":"=v"(r):"v"(a),"v"(b));return r;}
__device__ __forceinline__ float fadd_s(float a,float b){float r;asm("v_add_f32_e32 %0, %1, %2":"=v"(r):"v"(a),"v"(b));return r;}
__device__ __forceinline__ float fsub_s(float a,float b){float r;asm("v_sub_f32_e32 %0, %1, %2":"=v"(r):"v"(a),"v"(b));return r;}
typedef float f32x2_t __attribute__((ext_vector_type(2))); typedef __bf16 bf16x2_t __attribute__((ext_vector_type(2)));
__device__ __forceinline__ unsigned cvtpk_s(float lo,float hi){f32x2_t v={lo,hi};bf16x2_t b=__builtin_convertvector(v,bf16x2_t);return __builtin_bit_cast(unsigned,b);}
#define WAIT_BAR(N) asm volatile("s_waitcnt vmcnt(" #N ") lgkmcnt(0)\n\ts_barrier":::"memory")

__device__ __forceinline__ void qkt(f32x16&p0,f32x16&p1,const char*Kslot,const bf16x8*qr,const f32x16&negm,int r32,int hi){
  const char*kb=Kslot+hi*1024+r32*16;
  #pragma unroll
  for(int d0=0;d0<4;++d0){
    const bf16x8 b0=*reinterpret_cast<const bf16x8*>(kb+d0*2048);
    const bf16x8 b1=*reinterpret_cast<const bf16x8*>(kb+d0*2048+512);
    if(d0==0){p0=__builtin_amdgcn_mfma_f32_32x32x16_bf16(b0,qr[0],negm,0,0,0);p1=__builtin_amdgcn_mfma_f32_32x32x16_bf16(b1,qr[0],negm,0,0,0);}
    else{p0=__builtin_amdgcn_mfma_f32_32x32x16_bf16(b0,qr[d0],p0,0,0,0);p1=__builtin_amdgcn_mfma_f32_32x32x16_bf16(b1,qr[d0],p1,0,0,0);}}
}
typedef __attribute__((address_space(3))) const char* lds_cptr;
typedef short v4i16_t __attribute__((ext_vector_type(4)));
__device__ __forceinline__ void kload8(bf16x8*kf,lds_cptr kp){
  kf[0]=*(const __attribute__((address_space(3))) bf16x8*)(kp);      kf[1]=*(const __attribute__((address_space(3))) bf16x8*)(kp+512);
  kf[2]=*(const __attribute__((address_space(3))) bf16x8*)(kp+2048); kf[3]=*(const __attribute__((address_space(3))) bf16x8*)(kp+2560);
  kf[4]=*(const __attribute__((address_space(3))) bf16x8*)(kp+4096); kf[5]=*(const __attribute__((address_space(3))) bf16x8*)(kp+4608);
  kf[6]=*(const __attribute__((address_space(3))) bf16x8*)(kp+6144); kf[7]=*(const __attribute__((address_space(3))) bf16x8*)(kp+6656);
}
__device__ __forceinline__ void kload2(bf16x8*kf,lds_cptr kp,int j){ kf[2*j]=*(const __attribute__((address_space(3))) bf16x8*)(kp+j*2048); kf[2*j+1]=*(const __attribute__((address_space(3))) bf16x8*)(kp+j*2048+512); }
__device__ __forceinline__ s16x4 vtr(lds_cptr p){ return __builtin_bit_cast(s16x4,__builtin_amdgcn_ds_read_tr16_b64_v4i16((__attribute__((address_space(3))) v4i16_t*)p)); }
__device__ __forceinline__ float rowmax(const f32x16&p0,const f32x16&p1){
  float a=max3f(p0[0],p0[1],p1[0]),b=max3f(p0[2],p0[3],p1[1]);a=max3f(a,p1[2],p1[3]);
  #pragma unroll
  for(int r=4;r<16;r+=4){a=max3f(a,p0[r],p0[r+1]);b=max3f(b,p0[r+2],p0[r+3]);a=max3f(a,p1[r],p1[r+1]);b=max3f(b,p1[r+2],p1[r+3]);}
  const float m=max2f(a,b);
  auto rr=__builtin_amdgcn_permlane32_swap(__float_as_uint(m),__float_as_uint(m),false,false);
  return max2f(__uint_as_float(rr[0]),__uint_as_float(rr[1]));
}
__device__ __forceinline__ void pv(f32x16*o,int vb,bf16x8 pa0,bf16x8 pa1,bf16x8 pa2,bf16x8 pa3){
  #pragma unroll
  for(int d0=0;d0<2;++d0){s16x4 lo[4],hi[4];
    #pragma unroll
    for(int ks=0;ks<4;++ks){
      asm volatile("ds_read_b64_tr_b16 %0,%1 offset:%c2":"=&v"(lo[ks]):"v"(vb),"i"(d0*4096+ks*1024):"memory");
      asm volatile("ds_read_b64_tr_b16 %0,%1 offset:%c2":"=&v"(hi[ks]):"v"(vb),"i"(d0*4096+ks*1024+512):"memory");}
    asm volatile("s_waitcnt lgkmcnt(0)":::"memory");SBAR();
    #define PK(k) (bf16x8){lo[k][0],lo[k][1],lo[k][2],lo[k][3],hi[k][0],hi[k][1],hi[k][2],hi[k][3]}
    o[d0]=__builtin_amdgcn_mfma_f32_32x32x16_bf16(pa0,PK(0),o[d0],0,0,0);
    o[d0]=__builtin_amdgcn_mfma_f32_32x32x16_bf16(pa1,PK(1),o[d0],0,0,0);
    o[d0]=__builtin_amdgcn_mfma_f32_32x32x16_bf16(pa2,PK(2),o[d0],0,0,0);
    o[d0]=__builtin_amdgcn_mfma_f32_32x32x16_bf16(pa3,PK(3),o[d0],0,0,0);
    #undef PK
  }
}

#ifndef ATTN_STORE16
#define ATTN_STORE16(p,v) (*(u32x4*)(p)=(v))
#endif
template<int THRL> __device__ __forceinline__ void attn_unit(long qrow0,int h,int NT,const bf16*Q,const bf16*__restrict__ Kh,const bf16*__restrict__ Vh,bf16*O,char*shm,int wave_index){
  unsigned msk_=~0u; asm volatile("":"+s"(msk_)); const int tid=(wave_index<<6)|(int)__builtin_amdgcn_mbcnt_hi(msk_,__builtin_amdgcn_mbcnt_lo(msk_,0u)),lane=tid&63,r32=lane&31,hi=lane>>5; const int wid=__builtin_amdgcn_readfirstlane(tid>>6);
  const bf16*Qw=Q+(qrow0+wid*QBLK)*QP+h*D;
  const unsigned lds0=(unsigned)(uintptr_t)shm;
  float*wsf=(float*)(shm+LDS_WS)+wid*64;
  const bf16*ksrc=Kh+(long)lane*KP+wid*8;
  const bf16*vsrc=Vh+(long)(16*(wid&3)+(lane>>2))*KP+(wid>>2)*32+(lane&3)*8;
  const unsigned kdst=lds0+LDS_K+wid*1024, vdst=lds0+LDS_V+wid*1024;
  #define DMA_K(t,slot) glds16(ksrc+(long)(t)*KVBLK*KP,(unsigned)__builtin_amdgcn_readfirstlane(kdst+(slot)))
  #define DMA_V(t,slot) glds16(vsrc+(long)(t)*KVBLK*KP,(unsigned)__builtin_amdgcn_readfirstlane(vdst+(slot)))
  const int vb0=(int)(lds0+LDS_V)+((lane>>4)&1)*32+(lane&3)*8+(4*hi+((lane&15)>>2))*64;
  const char*Kbase=shm+LDS_K; bf16x8 kf[8];
  const lds_cptr shm3=(lds_cptr)shm; const lds_cptr kp0=shm3+LDS_K+hi*1024+r32*16; const lds_cptr vp0=shm3+LDS_V+((lane>>4)&1)*32+(lane&3)*8+(4*hi+((lane&15)>>2))*64;
  DMA_K(0,0);DMA_V(0,0);DMA_K(1,SLOTB);
  bf16x8 qr[4];
  #pragma unroll
  for(int d0=0;d0<4;++d0)qr[d0]=*reinterpret_cast<const bf16x8*>(&Qw[(long)r32*QP+d0*16+hi*8]);
  float mhat=0.f,l_reg=0.f;f32x16 o[2],negm; { float zz=0.f; asm volatile("":"+v"(zz));
    _Pragma("unroll") for(int r=0;r<16;++r){o[0][r]=zz;o[1][r]=zz;negm[r]=zz;} } asm volatile("":"+v"(negm));
  #define CMASK(P0,P1,t) do{}while(0)
  bool resc=false;
  #define START(P0,P1) do{ const float rm=rowmax(P0,P1); resc=false; \
    { const float dl=rm; mhat=fadd_s(mhat,dl); \
      _Pragma("unroll") for(int r=0;r<16;++r){P0[r]=fsub_s(P0[r],dl);P1[r]=fsub_s(P1[r],dl);} \
      _Pragma("unroll") for(int r=0;r<16;++r)negm[r]=-mhat; asm volatile("":"+v"(negm)); } \
    _Pragma("unroll") for(int r=0;r<16;++r)P0[r]=__builtin_amdgcn_exp2f(P0[r]); }while(0)
  #define RESC() do{ if(resc){ asm volatile("s_waitcnt lgkmcnt(0)":::"memory"); \
      _Pragma("unroll") for(int d_=0;d_<2;++d_) _Pragma("unroll") for(int r=0;r<16;++r)o[d_][r]*=wsf[crow(r,hi)]; } }while(0)
  f32x16 pA0,pA1,pB0,pB1;
  int sl_prev=0,sl_cur=0,sl_next=SLOTB;
  #define ROT() do{sl_prev=sl_cur;sl_cur=sl_next;sl_next=(sl_next==(NSLOT-1)*SLOTB)?0:sl_next+SLOTB;}while(0)
  DMA_K(2,2*SLOTB);
  WAIT_BAR(3);
  qkt(pA0,pA1,Kbase,qr,negm,r32,hi);asm volatile("s_nop 15\n\ts_nop 7":"+v"(pA0),"+v"(pA1));CMASK(pA0,pA1,0);
  START(pA0,pA1);
  _Pragma("unroll") for(int r=0;r<16;++r)pA1[r]=__builtin_amdgcn_exp2f(pA1[r]);
  WAIT_BAR(0);
  DMA_K(3,0);DMA_V(1,SLOTB);
  ROT();
  kload8(kf,kp0+sl_cur);
  WAIT_BAR(2);
  s16x4 vlo[8],vhi[8]; u32x4 pw0,pw1,pw2,pw3;
  #define PKW(P,B) cvtpk_s(P[B],P[B+1])
  #define PAF(k) __builtin_bit_cast(bf16x8,pw##k)
  #define VFR(i) (bf16x8){vlo[i][0],vlo[i][1],vlo[i][2],vlo[i][3],vhi[i][0],vhi[i][1],vhi[i][2],vhi[i][3]}
  #define PIN(x) asm volatile("":"+v"(x))
  #define MX3(a,b,c) __builtin_fmaxf(__builtin_fmaxf((a),(b)),(c))
  #define GAPA(MF,A0,A1,A2,A3,W0,W1,PW) do{ MF; sacc+=A0; sacc+=A1; sacc+=A2; sacc+=A3; PIN(sacc); W0; W1; PIN(PW); SBAR(); }while(0)
  #define EX(v) __builtin_amdgcn_exp2f(v)
  #define GAPB(MF,X,B) do{ MF; X[B]=EX(X[B]); X[B+1]=EX(X[B+1]); X[B+2]=EX(X[B+2]); X[B+3]=EX(X[B+3]); PIN(X); SBAR(); }while(0)
  #define VRD(i) do{ vlo[i]=vtr(vp_+(((i)>>2)*4096+((i)&3)*1024)); vhi[i]=vtr(vp_+(((i)>>2)*4096+((i)&3)*1024+512)); }while(0)
  #define KRD(G,j) do{ if(G){ kload2(kf,kp0+sl_next,j); SBAR(); } }while(0)
  #define STEP(C0,C1,P0,P1,t,GK,GV,GL) do{ SBAR(); \
    const lds_cptr vp_=vp0+sl_prev; \
    VRD(0); SBAR(); float sacc=(P0[0]+P0[1]); \
    GAPA(C0=__builtin_amdgcn_mfma_f32_32x32x16_bf16(kf[0],qr[0],negm,0,0,0), P0[2],P0[3],P0[4],P0[5],     pw0[0]=PKW(P0,0), pw0[1]=PKW(P0,2), pw0); \
    VRD(4); SBAR(); GAPA(C1=__builtin_amdgcn_mfma_f32_32x32x16_bf16(kf[1],qr[0],negm,0,0,0), P0[6],P0[7],P0[8],P0[9],     pw0[2]=PKW(P0,4), pw0[3]=PKW(P0,6), pw0); \
    VRD(1); SBAR(); GAPA(C0=__builtin_amdgcn_mfma_f32_32x32x16_bf16(kf[2],qr[1],C0,0,0,0),   P0[10],P0[11],P0[12],P0[13], pw1[0]=PKW(P0,8), pw1[1]=PKW(P0,10), pw1); \
    VRD(5); SBAR(); GAPA(C1=__builtin_amdgcn_mfma_f32_32x32x16_bf16(kf[3],qr[1],C1,0,0,0),   P0[14],P0[15],P1[0],P1[1],   pw1[2]=PKW(P0,12),pw1[3]=PKW(P0,14), pw1); \
    VRD(2); SBAR(); GAPA(C0=__builtin_amdgcn_mfma_f32_32x32x16_bf16(kf[4],qr[2],C0,0,0,0),   P1[2],P1[3],P1[4],P1[5],     pw2[0]=PKW(P1,0), pw2[1]=PKW(P1,2), pw2); \
    VRD(6); SBAR(); GAPA(C1=__builtin_amdgcn_mfma_f32_32x32x16_bf16(kf[5],qr[2],C1,0,0,0),   P1[6],P1[7],P1[8],P1[9],     pw2[2]=PKW(P1,4), pw2[3]=PKW(P1,6), pw2); \
    VRD(3); SBAR(); GAPA(C0=__builtin_amdgcn_mfma_f32_32x32x16_bf16(kf[6],qr[3],C0,0,0,0),   P1[10],P1[11],P1[12],P1[13], pw3[0]=PKW(P1,8), pw3[1]=PKW(P1,10), pw3); \
    VRD(7); SBAR(); GAPA(C1=__builtin_amdgcn_mfma_f32_32x32x16_bf16(kf[7],qr[3],C1,0,0,0),   P1[14],P1[15],0.f,0.f,       pw3[2]=PKW(P1,12),pw3[3]=PKW(P1,14), pw3); \
    l_reg+=sacc; \
    if(GK){DMA_K((t)+3,sl_cur);} if(GV){DMA_V((t)+1,sl_next);} \
    CMASK(C0,C1,t); \
    { float a=MX3(C0[0],C0[1],C1[0]),b=MX3(C0[2],C0[3],C1[1]); a=MX3(a,C1[2],C1[3]); \
      _Pragma("unroll") for(int r=4;r<16;r+=4){a=MX3(a,C0[r],C0[r+1]);b=MX3(b,C0[r+2],C0[r+3]);a=MX3(a,C1[r],C1[r+1]);b=MX3(b,C1[r+2],C1[r+3]);} \
      float rm=__builtin_fmaxf(a,b); { auto rr=__builtin_amdgcn_permlane32_swap(__float_as_uint(rm),__float_as_uint(rm),false,false); rm=__builtin_fmaxf(__uint_as_float(rr[0]),__uint_as_float(rr[1])); } \
      resc=false; \
      if(__builtin_expect(__any(rm>(float)THRL),0)){ const float dl=__builtin_fmaxf(rm,0.f); mhat+=dl; \
        _Pragma("unroll") for(int r=0;r<16;++r){C0[r]-=dl;C1[r]-=dl;} \
        _Pragma("unroll") for(int r=0;r<16;++r)negm[r]=-mhat; asm volatile("":"+v"(negm)); \
        const float f=__builtin_amdgcn_exp2f(-dl); l_reg*=f; if(hi==0)wsf[r32]=f; resc=true; } } \
    SBAR(); \
    GAPB(o[0]=__builtin_amdgcn_mfma_f32_32x32x16_bf16(PAF(0),VFR(0),o[0],0,0,0), C0,0); \
    GAPB(o[1]=__builtin_amdgcn_mfma_f32_32x32x16_bf16(PAF(0),VFR(4),o[1],0,0,0), C0,4); \
    KRD(GL,0); GAPB(o[0]=__builtin_amdgcn_mfma_f32_32x32x16_bf16(PAF(1),VFR(1),o[0],0,0,0), C0,8); \
    KRD(GL,1); GAPB(o[1]=__builtin_amdgcn_mfma_f32_32x32x16_bf16(PAF(1),VFR(5),o[1],0,0,0), C0,12); \
    KRD(GL,2); GAPB(o[0]=__builtin_amdgcn_mfma_f32_32x32x16_bf16(PAF(2),VFR(2),o[0],0,0,0), C1,0); \
    KRD(GL,3); GAPB(o[1]=__builtin_amdgcn_mfma_f32_32x32x16_bf16(PAF(2),VFR(6),o[1],0,0,0), C1,4); \
    GAPB(o[0]=__builtin_amdgcn_mfma_f32_32x32x16_bf16(PAF(3),VFR(3),o[0],0,0,0), C1,8); \
    GAPB(o[1]=__builtin_amdgcn_mfma_f32_32x32x16_bf16(PAF(3),VFR(7),o[1],0,0,0), C1,12); \
    }while(0)
  int t=1;
  #undef CMASK
  #define CMASK(P0,P1,t) do{}while(0)
  for(;t+5<NT;t+=2){
    STEP(pB0,pB1,pA0,pA1,t,true,true,true);     WAIT_BAR(2); RESC(); ROT();
    STEP(pA0,pA1,pB0,pB1,t+1,true,true,true);   WAIT_BAR(2); RESC(); ROT();
  }
  #undef CMASK
  #define CMASK(P0,P1,t) do{}while(0)
  #define ENDW(tt) do{ if((tt)+3<NT){WAIT_BAR(2);} else if((tt)+2<NT){WAIT_BAR(1);} else {WAIT_BAR(0);} }while(0)
  for(;t+1<NT;t+=2){
    STEP(pB0,pB1,pA0,pA1,t,(t+3<NT),(t+1<NT),(t+1<NT));       ENDW(t);   RESC(); ROT();
    STEP(pA0,pA1,pB0,pB1,t+1,(t+4<NT),(t+2<NT),(t+2<NT));     ENDW(t+1); RESC(); ROT();
  }
  STEP(pB0,pB1,pA0,pA1,NT-1,false,false,false); RESC();
  { float sacc=pB0[0]+pB0[1]; _Pragma("unroll") for(int r=2;r<16;++r)sacc+=pB0[r]; _Pragma("unroll") for(int r=0;r<16;++r)sacc+=pB1[r]; l_reg+=sacc;
    pw0=(u32x4){PKW(pB0,0),PKW(pB0,2),PKW(pB0,4),PKW(pB0,6)};pw1=(u32x4){PKW(pB0,8),PKW(pB0,10),PKW(pB0,12),PKW(pB0,14)};pw2=(u32x4){PKW(pB1,0),PKW(pB1,2),PKW(pB1,4),PKW(pB1,6)};pw3=(u32x4){PKW(pB1,8),PKW(pB1,10),PKW(pB1,12),PKW(pB1,14)};
    SBAR(); pv(o,vb0+sl_cur,PAF(0),PAF(1),PAF(2),PAF(3)); }
  #undef PKW
  #undef PAF
  #undef VFR
  #undef PIN
  #undef MX3
  #undef GAPA
  #undef GAPB
  #undef EX
  #undef VRD
  #undef KRD
  #undef STEP
  #undef ENDW
  {auto rr=__builtin_amdgcn_permlane32_swap(__float_as_uint(l_reg),__float_as_uint(l_reg),false,false);l_reg=__uint_as_float(rr[0])+__uint_as_float(rr[1]);}
  if(hi==0)wsf[32+r32]=l_reg;asm volatile("s_waitcnt lgkmcnt(0)":::"memory");
  float rli[16];
  #pragma unroll
  for(int r=0;r<16;++r)rli[r]=__builtin_amdgcn_rcpf(wsf[32+crow(r,hi)]);
  bf16*Ow=O+(qrow0+wid*QBLK)*OP+h*D;
  { bf16*stg=(bf16*)(shm+LDS_OST)+wid*2048;
    #pragma unroll
    for(int r=0;r<16;++r){const int orow=crow(r,hi);
      #pragma unroll
      for(int d0=0;d0<2;++d0)stg[orow*64+d0*32+r32]=__float2bfloat16(o[d0][r]*rli[r]);}
    asm volatile("s_waitcnt lgkmcnt(0)":::"memory");
    #pragma unroll
    for(int i=0;i<4;++i){const int row=i*8+(lane>>3),ch=lane&7; const u32x4 v=*(const u32x4*)(stg+row*64+ch*8); ATTN_STORE16(Ow+(long)row*OP+ch*8,v);} }
  asm volatile("s_waitcnt lgkmcnt(0)\n\ts_barrier":::"memory");
  #undef DMA_K
  #undef DMA_V
  #undef CMASK
  #undef START
  #undef RESC
  #undef ROT
}
constexpr int ATTN_LDS_BYTES=LDS_BYTES;
#undef SBAR
#undef WAIT_BAR
}
typedef GAS unsigned gu32;
typedef GAS unsigned long long gu64;
#define RLX_AGENT __ATOMIC_RELAXED, __HIP_MEMORY_SCOPE_AGENT
#define LDS_WAIT() asm volatile("s_waitcnt lgkmcnt(0)" ::: "memory")
#define VM_WAIT() asm volatile("s_waitcnt vmcnt(0)" ::: "memory")
__device__ __forceinline__ unsigned long long rt() { return __builtin_amdgcn_s_memrealtime(); }

#define XB_TMO      128
#define XB_XCNT(j)  (256  + 64 * (j))
#define XB_XSUB(j)  (1280 + 64 * (j))
#define XB_XGEN(j)  (2304 + 64 * (j))
#define XB_TOP      3328
#define XB_TOPGEN   3392
#define XCD_BAR_WORDS 3456
#define XB_SPIN_CAP (1u << 18)

__device__ __forceinline__ unsigned xb_ld(unsigned* p)              { return __hip_atomic_load(p, __ATOMIC_RELAXED, __HIP_MEMORY_SCOPE_AGENT); }
__device__ __forceinline__ unsigned xb_add(unsigned* p, unsigned v) { return __hip_atomic_fetch_add(p, v, __ATOMIC_RELAXED, __HIP_MEMORY_SCOPE_AGENT); }
__device__ __forceinline__ unsigned xb_xcc_id() { return (unsigned)__builtin_amdgcn_s_getreg((3 << 11) | 20) & 0xFu; }
#define XB_SPIN(cond, bar) do { unsigned _sp = 0; while (cond) { __builtin_amdgcn_s_sleep(1); \
    if ((++_sp & 255u) == 0u) { if (xb_ld(&(bar)[XB_TMO])) break; if (_sp > XB_SPIN_CAP) { atomicAdd(&(bar)[XB_TMO], 1u); break; } } } } while (0)

struct XcdBarrier {
    unsigned* bar; unsigned x;
    volatile LAS unsigned* st;
};

__device__ __forceinline__ XcdBarrier xcd_barrier_post(unsigned* bar, volatile LAS unsigned* st) {
    XcdBarrier b; b.bar = bar; b.x = xb_xcc_id(); b.st = st;
    if (threadIdx.x == 0) (void)xb_add(&bar[XB_XCNT(b.x)], 1u);
    return b;
}
__device__ __forceinline__ void xcd_barrier_complete(unsigned* bar, unsigned x, unsigned& nloc, unsigned& nx) {
    const unsigned G = gridDim.x * gridDim.y * gridDim.z;
    unsigned sum, cnt, mine, sp = 0u;
    for (;;) {
        sum = 0u; cnt = 0u; mine = 0u;
#pragma unroll
        for (unsigned j = 0; j < 16; ++j) { const unsigned c = xb_ld(&bar[XB_XCNT(j)]); sum += c; cnt += (c > 0u) ? 1u : 0u; mine = (j == x) ? c : mine; }
        if (sum == G) break;
        __builtin_amdgcn_s_sleep(1);
        if ((++sp & 255u) == 0u) { if (xb_ld(&bar[XB_TMO])) break; if (sp > XB_SPIN_CAP) { atomicAdd(&bar[XB_TMO], 1u); break; } }
    }
    nloc = mine > 0u ? mine : 1u; nx = cnt > 0u ? cnt : 1u;
}

__device__ __forceinline__ void xcd_barrier(const XcdBarrier& b) {
    asm volatile("s_waitcnt vmcnt(0)" ::: "memory");
    __syncthreads();
    if (threadIdx.x == 0) {
        unsigned zb_; asm volatile("v_mov_b32 %0, 0" : "=v"(zb_));
        unsigned* bar = (unsigned*)((unsigned char*)b.bar + zb_);
        __builtin_amdgcn_s_waitcnt(0);
        unsigned nloc = b.st[0], nx = b.st[1];
        if (nloc == 0u) { xcd_barrier_complete(bar, b.x, nloc, nx); b.st[0] = nloc; b.st[1] = nx; }
        const unsigned old = xb_add(&bar[XB_XSUB(b.x)], 1u);
        const unsigned gen = old / nloc;
        if (old + 1u == (gen + 1u) * nloc) {
            __builtin_amdgcn_fence(__ATOMIC_RELEASE, "agent");
            asm volatile("s_waitcnt vmcnt(0)" ::: "memory");
            const unsigned og = xb_add(&bar[XB_TOP], 1u);
            const unsigned tg = og / nx;
            if (og + 1u == (tg + 1u) * nx) xb_add(&bar[XB_TOPGEN], 1u);
            else XB_SPIN(xb_ld(&bar[XB_TOPGEN]) == tg, bar);
            __builtin_amdgcn_fence(__ATOMIC_ACQUIRE, "agent");
            xb_add(&bar[XB_XGEN(b.x)], 1u);
            asm volatile("s_waitcnt vmcnt(0)" ::: "memory");
        } else {
            XB_SPIN(xb_ld(&bar[XB_XGEN(b.x)]) == gen, bar);
            __builtin_amdgcn_fence(__ATOMIC_ACQUIRE, "agent");
            asm volatile("s_waitcnt vmcnt(0)" ::: "memory");
        }
    }
    __syncthreads();
}

DI float lx_f(float v, int src) { return __builtin_bit_cast(float, __builtin_amdgcn_ds_bpermute(src << 2, __builtin_bit_cast(int, v))); }
DI int lx_i(int v, int src) { return __builtin_amdgcn_ds_bpermute(src << 2, v); }
template <int CTRL> DI float dppf(float v) { return __builtin_bit_cast(float, __builtin_amdgcn_update_dpp(0, __builtin_bit_cast(int, v), CTRL, 0xf, 0xf, false)); }
DI float dx1(float v) { return dppf<0xB1>(v); }
DI float dx2(float v) { return dppf<0x4E>(v); }
DI float sum8(float v) { v += dx1(v); v += dx2(v); v += dppf<0x141>(v); return v; }
DI float wave_sum(float v, int lane) {
    (void)lane; v = sum8(v); v += dppf<0x140>(v);
    const float a = __builtin_bit_cast(float, __builtin_amdgcn_readlane(__builtin_bit_cast(int, v), 0)), b = __builtin_bit_cast(float, __builtin_amdgcn_readlane(__builtin_bit_cast(int, v), 16));
    const float c = __builtin_bit_cast(float, __builtin_amdgcn_readlane(__builtin_bit_cast(int, v), 32)), d = __builtin_bit_cast(float, __builtin_amdgcn_readlane(__builtin_bit_cast(int, v), 48));
    return (a + b) + (c + d);
}
DI float wave_max(float v, int lane) {
#pragma unroll
    for (int o = 1; o < 64; o <<= 1) v = fmaxf(v, lx_f(v, lane ^ o));
    return v;
}
DI float wave_incl_sum(float v, int lane) {
#pragma unroll
    for (int o = 1; o < 64; o <<= 1) { const float t = lx_f(v, lane - o); if (lane >= o) v += t; }
    return v;
}
DI float wave_incl_max(float v, int lane) {
#pragma unroll
    for (int o = 1; o < 64; o <<= 1) { const float t = lx_f(v, lane - o); if (lane >= o) v = fmaxf(v, t); }
    return v;
}
template <int NT, int KS> DI void mma_tile(f32x4 (&acc)[NT], const LAS bf16_t* A, int lda, const LAS bf16_t* Bt, int ldb, int lane) {
    const int fr = lane & 15, fq = lane >> 4;
#pragma unroll
    for (int ks = 0; ks < KS; ++ks) {
        const bf16x8 a = *(const LAS bf16x8*)(A + fr * lda + ks * 32 + fq * 8);
#pragma unroll
        for (int nt = 0; nt < NT; ++nt) {
            const bf16x8 b = *(const LAS bf16x8*)(Bt + (nt * 16 + fr) * ldb + ks * 32 + fq * 8);
            acc[nt] = __builtin_amdgcn_mfma_f32_16x16x32_bf16(a, b, acc[nt], 0, 0, 0);
        }
    }
}

struct Ctx {
    LAS unsigned char* lds;
    unsigned char* ws;
    const float* const* in;
    float* out;
    int tid, lane, wave, G, bx;
};
#define INP(k) ((const float*)(const GAS float*)C.in[k])
DI unsigned char* opaque_ptr(unsigned char* q) { unsigned lo = (unsigned)(uintptr_t)q, hi = (unsigned)((uintptr_t)q >> 32); lo = (unsigned)__builtin_amdgcn_readfirstlane((int)lo); hi = (unsigned)__builtin_amdgcn_readfirstlane((int)hi);
    asm volatile("" : "+s"(lo), "+s"(hi)); return (unsigned char*)(GAS unsigned char*)(((uintptr_t)hi << 32) | (uintptr_t)lo); }
DI Ctx launder(const Ctx& C0) { Ctx C = C0; unsigned m = ~0u; asm volatile("" : "+s"(m));
    { const LAS unsigned* pw = (const LAS unsigned*)(unsigned)(MISC_OFF + 64);
      unsigned w0 = pw[0], w1 = pw[1], o0 = pw[2], o1 = pw[3]; asm volatile("" : "+v"(w0), "+v"(w1), "+v"(o0), "+v"(o1));
      w0 = (unsigned)__builtin_amdgcn_readfirstlane((int)w0); w1 = (unsigned)__builtin_amdgcn_readfirstlane((int)w1); o0 = (unsigned)__builtin_amdgcn_readfirstlane((int)o0); o1 = (unsigned)__builtin_amdgcn_readfirstlane((int)o1);
      C.ws = (unsigned char*)(GAS unsigned char*)(((uintptr_t)w1 << 32) | (uintptr_t)w0); C.out = (float*)(GAS float*)(((uintptr_t)o1 << 32) | (uintptr_t)o0); }
    C.lane = (int)__builtin_amdgcn_mbcnt_hi(m, __builtin_amdgcn_mbcnt_lo(m, 0u)); C.tid = (C0.wave << 6) | C.lane; return C; }

struct MapId { DI int operator()(int c) const { return c; } };
struct MapTile { DI int operator()(int c) const { const int t = c & 255; return (c & ~255) + 128 * ((t >> 5) & 1) + 32 * (t >> 6) + (t & 31); } };
struct MapE1 { DI int operator()(int c) const { const int j = c >> 1; return (j >> 7) * 256 + (c & 1) * 128 + (j & 127); } };
template <class Map> DI void tr_item(const float* W, int K, int N, bf16_t* WT, LAS float* scr, int kb, int nb, int lane, Map map, int ldw) {
    const int k0 = 64 * kb, n0 = 64 * nb;
    const bool nv = (n0 + lane) < N;
    const float* src = W + (size_t)k0 * N + n0 + lane;
#pragma unroll 8
    for (int i = 0; i < 64; ++i) scr[i * 65 + lane] = nv ? src[(size_t)i * N] : 0.f;
    LDS_WAIT(); asm volatile("" ::: "memory");
    const int c = lane & 7;
#pragma unroll
    for (int j = 0; j < 8; ++j) {
        const int n = (lane >> 3) + 8 * j;
        if (n0 + n < N) {
            const LAS float* s = scr + (8 * c) * 65 + n;
            v4u o; o.x = pk2(s[0], s[65]); o.y = pk2(s[130], s[195]); o.z = pk2(s[260], s[325]); o.w = pk2(s[390], s[455]);
            *(v4u*)(WT + (size_t)map(n0 + n) * ldw + k0 + 8 * c) = o;
        }
    }
    LDS_WAIT(); asm volatile("" ::: "memory");
}
template <bool EDGE, class Map> DI void tr_item8_(const float* W, int K, int N, unsigned char* WT, LAS float* scr, int k0, int n0, int lane, Map map, float scale) {
    const bool nv = !EDGE || (n0 + lane) < N;
    const float* src = W + (size_t)k0 * N + n0 + (nv ? lane : 0);
    { float t[64];
#pragma unroll
        for (int i = 0; i < 64; ++i) t[i] = src[(size_t)i * N];
        __builtin_amdgcn_sched_barrier(0);
#pragma unroll
        for (int i = 0; i < 64; ++i) scr[i * 65 + lane] = t[i]; }
    LDS_WAIT(); asm volatile("" ::: "memory");
    const int c = lane & 3;
#pragma unroll
    for (int j = 0; j < 4; ++j) {
        const int n = (lane >> 2) + 16 * j;
        const LAS float* s = scr + (16 * c) * 65 + n;
        v4u o;
        o.x = pk4_fp8(s[0] * scale, s[65] * scale, s[130] * scale, s[195] * scale); o.y = pk4_fp8(s[260] * scale, s[325] * scale, s[390] * scale, s[455] * scale);
        o.z = pk4_fp8(s[520] * scale, s[585] * scale, s[650] * scale, s[715] * scale); o.w = pk4_fp8(s[780] * scale, s[845] * scale, s[910] * scale, s[975] * scale);
        if (!EDGE || n0 + n < N) *(v4u*)(WT + (size_t)map(n0 + n) * K + k0 + 16 * c) = o;
    }
    LDS_WAIT(); asm volatile("" ::: "memory");
}
template <class Map> DI void tr_item8(const float* W, int K, int N, unsigned char* WT, LAS float* scr, int kb, int nb, int lane, Map map, float scale) {
    if (64 * nb + 64 <= N) tr_item8_<false>(W, K, N, WT, scr, 64 * kb, 64 * nb, lane, map, scale); else tr_item8_<true>(W, K, N, WT, scr, 64 * kb, 64 * nb, lane, map, scale);
}
struct It8 { const float* src; unsigned char* dst; int N, K, k0, n0; bool e1, edge; };
DI void ld8(const It8& d, float (&t)[64], int lane) {
    const bool nv = !d.edge || (d.n0 + lane) < d.N;
    const float* s = d.src + (size_t)d.k0 * d.N + d.n0 + (nv ? lane : 0);
#pragma unroll
    for (int i = 0; i < 64; ++i) t[i] = s[(size_t)i * d.N];
}
DI void st8i(const It8& d, const float (&t)[64], LAS float* scr, int lane, float scale) {
#pragma unroll
    for (int i = 0; i < 64; ++i) scr[i * 65 + lane] = t[i];
    LDS_WAIT(); asm volatile("" ::: "memory");
    const int c = lane & 3;
#pragma unroll
    for (int j = 0; j < 4; ++j) {
        const int n = (lane >> 2) + 16 * j;
        const LAS float* s = scr + (16 * c) * 65 + n;
        v4u o;
        o.x = pk4_fp8(s[0] * scale, s[65] * scale, s[130] * scale, s[195] * scale); o.y = pk4_fp8(s[260] * scale, s[325] * scale, s[390] * scale, s[455] * scale);
        o.z = pk4_fp8(s[520] * scale, s[585] * scale, s[650] * scale, s[715] * scale); o.w = pk4_fp8(s[780] * scale, s[845] * scale, s[910] * scale, s[975] * scale);
        const int col = d.n0 + n, row = d.e1 ? MapE1()(col) : col;
        if (!d.edge || col < d.N) *(v4u*)(d.dst + (size_t)row * d.K + d.k0 + 16 * c) = o;
    }
    LDS_WAIT(); asm volatile("" ::: "memory");
}
DI void p0_prologue(const Ctx& C) {
    __syncthreads();
    {
        LAS float* sc = (LAS float*)(C.lds + RING_OFF);
        LAS float* red = (LAS float*)(C.lds + RING_OFF + 9 * 1024 * 4);
        for (int i = C.tid; i < 9 * 1024; i += 512) { const float v = (i < 8192) ? INP(I_C)[i] : INP(I_CCTX)[i - 8192]; sc[i] = silu_f(v); }
        __syncthreads();
        float* MOD = (float*)(C.ws + WS_MOD);
        for (int u = C.bx; u < DEPTH * 96; u += C.G) {
            const int l = u / 96, cg = u % 96, ci = C.tid & 63, kg = C.tid >> 6;
            const float* w = INP(I_WADA) + ((size_t)l * 1024 + kg * 128) * 6144 + cg * 64 + ci;
            float s[9];
#pragma unroll
            for (int b = 0; b < 9; ++b) s[b] = 0.f;
#pragma unroll 16
            for (int k = 0; k < 128; ++k) { const float wv = w[(size_t)k * 6144];
#pragma unroll
                for (int b = 0; b < 9; ++b) s[b] += sc[b * 1024 + kg * 128 + k] * wv; }
#pragma unroll
            for (int b = 0; b < 9; ++b) red[(kg * 9 + b) * 64 + ci] = s[b];
            __syncthreads();
            for (int o = C.tid; o < 9 * 64; o += 512) { const int b = o >> 6, c2 = o & 63; float t = 0.f;
#pragma unroll
                for (int g = 0; g < 8; ++g) t += red[(g * 9 + b) * 64 + c2];
                MOD[((size_t)l * 9 + b) * 6144 + cg * 64 + c2] = t + INP(I_BADA)[l * 6144 + cg * 64 + c2]; }
            __syncthreads();
        }
    }
    {
        LAS float* scr = (LAS float*)(C.lds + RING_OFF + C.wave * 16640);
        const int gw = C.bx * 8 + C.wave, NGW = C.G * 8;
        constexpr int IT_IN = 16 * 109, IT_BR = 8 * 16, IT_OUT = 16 * 16, IT_E1 = 16 * 32, IT_E2 = 16 * 16;
        constexpr int N0 = DEPTH * IT_IN, N1 = N0 + DEPTH * 3 * IT_BR, N2 = N1 + DEPTH * IT_OUT, N3 = N2 + DEPTH * NEXP * IT_E1, N4 = N3 + DEPTH * NEXP * IT_E2;
        for (int it = N0 + gw; it < N2; it += NGW) {
            if (it < N1) { const int q = it - N0, m = q / IT_BR, r = q % IT_BR; tr_item(INP(I_WBR) + (size_t)m * 512 * DM, 512, DM, (bf16_t*)(C.ws + WS_WTBR) + (size_t)(m / 3) * DM * 1536 + (m % 3) * 512, scr, r / 16, r % 16, C.lane, MapId(), 1536); }
            else { const int q = it - N1, m = q / IT_OUT, r = q % IT_OUT; tr_item(INP(I_WOUT) + (size_t)m * DM * DM, DM, DM, (bf16_t*)(C.ws + WS_WTOUT) + (size_t)m * DM * DM, scr, r / 16, r % 16, C.lane, MapId(), DM); }
        }
        constexpr int NJ = N0 + (N4 - N2);
        auto dec8 = [&](int j) -> It8 { It8 d;
            if (j < N0) { const int m = j / IT_IN, r = j % IT_IN; d.src = INP(I_WIN) + (size_t)m * DM * IN_W; d.dst = (unsigned char*)(C.ws + WS_WTIN) + (size_t)m * PW * DM; d.N = IN_W; d.K = DM; d.k0 = 64 * (r / 109); d.n0 = 64 * (r % 109); d.e1 = false; d.edge = (d.n0 + 64 > IN_W); }
            else { const int it = j - N0 + N2;
                if (it < N3) { const int q = it - N2, m = q / IT_E1, r = q % IT_E1; d.src = INP(I_WE1) + (size_t)m * DM * 2048; d.dst = (unsigned char*)(C.ws + WS_WTE1) + (size_t)m * 2048 * DM; d.N = 2048; d.K = DM; d.k0 = 64 * (r / 32); d.n0 = 64 * (r % 32); d.e1 = true; d.edge = false; }
                else { const int q = it - N3, m = q / IT_E2, r = q % IT_E2; d.src = INP(I_WE2) + (size_t)m * DFF * DM; d.dst = (unsigned char*)(C.ws + WS_WTE2) + (size_t)m * DM * DFF; d.N = DM; d.K = DFF; d.k0 = 64 * (r / 16); d.n0 = 64 * (r % 16); d.e1 = false; d.edge = false; } }
            return d; };
        It8 d0, d1; float t0[64], t1[64];
        int j = gw;
        if (j < NJ) { d0 = dec8(j); ld8(d0, t0, C.lane); }
        for (; j < NJ; j += 2 * NGW) {
            const int j1 = j + NGW, j2 = j1 + NGW;
            if (j1 < NJ) { d1 = dec8(j1); ld8(d1, t1, C.lane); }
            st8i(d0, t0, scr, C.lane, FP8_SW);
            if (j2 < NJ) { d0 = dec8(j2); ld8(d0, t0, C.lane); }
            if (j1 < NJ) st8i(d1, t1, scr, C.lane, FP8_SW);
        }
    }
}

DI void phase_norm1(const Ctx& C, int l, float pscale) {
    const int gw = C.bx * 8 + C.wave, NGW = C.G * 8, lane = C.lane;
    bf16_t* X = (bf16_t*)(C.ws + WS_X); unsigned char* H8 = (unsigned char*)(C.ws + WS_H);
    const float* MOD = (const float*)(C.ws + WS_MOD);
    const int* TOKP = (const int*)(C.ws + WS_TOKP); const bf16_t* YS = (const bf16_t*)(C.ws + WS_YS); const bf16_t* U = (const bf16_t*)(C.ws + WS_U);
    const bool fin = (l == DEPTH);
    const int nrows = fin ? M_LAT : MROWS;
    const int rpw = (nrows + NGW - 1) / NGW, rbeg = gw * rpw, rend = (rbeg + rpw < nrows) ? rbeg + rpw : nrows;
    f32x4 gn[4];
#pragma unroll
    for (int j = 0; j < 4; ++j) gn[j] = *(const f32x4*)((fin ? INP(I_GF) : INP(I_GN1) + (size_t)l * DM) + (lane + 64 * j) * 4);
    int mi_cur = -1; f32x4 g2v[4], g1v[4], s1v[4], s0v[4];
    int4 sl = make_int4(0, 0, 0, 0); v2u xr[4];
    if (rbeg < rend) {
        if (l > 0) { sl = *(const int4*)(TOKP + (size_t)rbeg * 4);
#pragma unroll
            for (int j = 0; j < 4; ++j) xr[j] = *(const v2u*)(X + (size_t)rbeg * DM + (lane + 64 * j) * 4); }
    }
    for (int r = rbeg; r < rend; ++r) {
        const int mi = r < M_LAT ? (r >> 12) : 8;
        if (mi != mi_cur) {
            mi_cur = mi;
#pragma unroll
            for (int j = 0; j < 4; ++j) { const int c = (lane + 64 * j) * 4;
                g2v[j] = (l > 0) ? *(const f32x4*)(MOD + ((size_t)(l - 1) * 9 + mi) * 6144 + 5 * DM + c) * pscale : (f32x4){0.f, 0.f, 0.f, 0.f};
                g1v[j] = (l > 0) ? *(const f32x4*)(MOD + ((size_t)(l - 1) * 9 + mi) * 6144 + 2 * DM + c) * pscale : (f32x4){0.f, 0.f, 0.f, 0.f};
                if (!fin) { s0v[j] = *(const f32x4*)(MOD + ((size_t)l * 9 + mi) * 6144 + c); s1v[j] = *(const f32x4*)(MOD + ((size_t)l * 9 + mi) * 6144 + DM + c) + 1.0f; } }
        }
        f32x4 v[4];
        if (l == 0) {
            const float* src = r < M_LAT ? INP(I_X) + (size_t)r * DM : INP(I_CTX) + (size_t)(r - M_LAT) * DM;
#pragma unroll
            for (int j = 0; j < 4; ++j) v[j] = *(const f32x4*)(src + (lane + 64 * j) * 4);
        } else {
            const bf16_t* y0 = YS + (size_t)sl.x * DM; const bf16_t* y1 = YS + (size_t)sl.y * DM; const bf16_t* y2 = YS + (size_t)sl.z * DM; const bf16_t* y3 = YS + (size_t)sl.w * DM;
            v2u ya[4], yb[4], yc[4], yd[4];
#pragma unroll
            for (int j = 0; j < 4; ++j) { const int c = (lane + 64 * j) * 4; ya[j] = *(const v2u*)(y0 + c); yb[j] = *(const v2u*)(y1 + c); yc[j] = *(const v2u*)(y2 + c); yd[j] = *(const v2u*)(y3 + c); }
#pragma unroll
            for (int j = 0; j < 4; ++j) { const v2u uu = *(const v2u*)(U + (size_t)r * DM + (lane + 64 * j) * 4); const v2u xx = xr[j]; v[j] = (f32x4){bf2f(xx.x & 0xffffu), bf2f(xx.x >> 16), bf2f(xx.y & 0xffffu), bf2f(xx.y >> 16)} + g1v[j] * (f32x4){bf2f(uu.x & 0xffffu), bf2f(uu.x >> 16), bf2f(uu.y & 0xffffu), bf2f(uu.y >> 16)}; }
            if (r + 1 < rend) { sl = *(const int4*)(TOKP + (size_t)(r + 1) * 4);
#pragma unroll
                for (int j = 0; j < 4; ++j) xr[j] = *(const v2u*)(X + (size_t)(r + 1) * DM + (lane + 64 * j) * 4); }
#pragma unroll
            for (int j = 0; j < 4; ++j) {
                const v2u a = ya[j], b = yb[j], cc = yc[j], d = yd[j];
                f32x4 f;
                f[0] = ((bf2f(a.x & 0xffffu) + bf2f(b.x & 0xffffu)) + bf2f(cc.x & 0xffffu)) + bf2f(d.x & 0xffffu);
                f[1] = ((bf2f(a.x >> 16) + bf2f(b.x >> 16)) + bf2f(cc.x >> 16)) + bf2f(d.x >> 16);
                f[2] = ((bf2f(a.y & 0xffffu) + bf2f(b.y & 0xffffu)) + bf2f(cc.y & 0xffffu)) + bf2f(d.y & 0xffffu);
                f[3] = ((bf2f(a.y >> 16) + bf2f(b.y >> 16)) + bf2f(cc.y >> 16)) + bf2f(d.y >> 16);
                v[j] = v[j] + g2v[j] * f;
            }
        }
        if (!fin) {
#pragma unroll
            for (int j = 0; j < 4; ++j) { v2u o; o.x = pk2(v[j][0], v[j][1]); o.y = pk2(v[j][2], v[j][3]); *(v2u*)(X + (size_t)r * DM + (lane + 64 * j) * 4) = o; }
        }
        float ss = 0.f;
#pragma unroll
        for (int j = 0; j < 4; ++j) ss += (v[j][0] * v[j][0] + v[j][1] * v[j][1]) + (v[j][2] * v[j][2] + v[j][3] * v[j][3]);
        const float rstd = __builtin_amdgcn_rsqf(wave_sum(ss, lane) * (1.0f / DM) + EPS);
        if (fin) {
#pragma unroll
            for (int j = 0; j < 4; ++j) *(f32x4*)(C.out + (size_t)r * DM + (lane + 64 * j) * 4) = v[j] * rstd * gn[j];
        } else {
#pragma unroll
            for (int j = 0; j < 4; ++j) {
                const int c = (lane + 64 * j) * 4;
                const f32x4 h = v[j] * rstd * gn[j] * s1v[j] + s0v[j];
                *(unsigned*)(H8 + (size_t)r * DM + c) = pk4_fp8(h[0] * FP8_SH, h[1] * FP8_SH, h[2] * FP8_SH, h[3] * FP8_SH);
            }
        }
    }
}

DI void rope_cs(float (&c)[8], float (&s)[8], const float (&freq)[8], int lane, int t) {
    const int sub = lane & 7;
    const float pos = (sub >= 4) ? (float)(t & 63) : (float)(t >> 6);
#pragma unroll
    for (int e = 0; e < 8; ++e) { float rev = pos * freq[e]; rev -= floorf(rev); c[e] = __builtin_amdgcn_cosf(rev); s[e] = __builtin_amdgcn_sinf(rev); }
}
DI void rope_apply(float (&x)[8], const float (&c)[8], const float (&s)[8], int lane) {
    const bool second = (lane & 2) != 0;
#pragma unroll
    for (int e = 0; e < 8; ++e) { const float other = dx2(x[e]); x[e] = second ? (x[e] * c[e] + other * s[e]) : (x[e] * c[e] - other * s[e]); }
}
DI void phase_attn_prep(const Ctx& C, int l) {
    const int gw = C.bx * 8 + C.wave, NGW = C.G * 8, lane = C.lane;
    const bf16_t* P = (const bf16_t*)(C.ws + WS_P);
    bf16_t* QR = (bf16_t*)(C.ws + WS_QR); bf16_t* KR = (bf16_t*)(C.ws + WS_KR); bf16_t* VR = (bf16_t*)(C.ws + WS_VR);
    float gq[8], gk[8], freq[8];
#pragma unroll
    for (int e = 0; e < 8; ++e) { gq[e] = INP(I_BQG)[l * 64 + (lane & 7) * 8 + e]; gk[e] = INP(I_BKG)[l * 64 + (lane & 7) * 8 + e];
        freq[e] = __builtin_amdgcn_exp2f(-(float)((lane & 1) * 8 + e) * 0.83048202372184058696f) * 0.15915494309189533577f; }
    constexpr float C2 = 0.125f * 1.4426950408889634f;
    const int kl = lane & 15;
    v4u nq = {0u, 0u, 0u, 0u}, nk = nq, nv = nq;
    if (gw < MROWS) { const bf16_t* prow = P + (size_t)gw * PW; nq = *(const v4u*)(prow + C_BQ + lane * 8); nk = *(const v4u*)(prow + C_BK + kl * 8); nv = *(const v4u*)(prow + C_BV + kl * 8); }
    for (int r = gw; r < MROWS; r += NGW) {
        const bool lat = r < M_LAT;
        const int b = lat ? (r >> 12) : ((r - M_LAT) >> 8), t = lat ? (r & 4095) : ((r - M_LAT) & 255), kvpos = lat ? (CTXL + t) : t;
        const v4u cq = nq, ck = nk, cv = nv;
        if (r + NGW < MROWS) { const bf16_t* prow = P + (size_t)(r + NGW) * PW; nq = *(const v4u*)(prow + C_BQ + lane * 8); nk = *(const v4u*)(prow + C_BK + kl * 8); nv = *(const v4u*)(prow + C_BV + kl * 8); }
        float rc[8], rs[8];
        if (lat) rope_cs(rc, rs, freq, lane, t);
        float x[8];
        unpack8(cq, x);
        float ss = 0.f;
#pragma unroll
        for (int e = 0; e < 8; ++e) ss += x[e] * x[e];
        ss = sum8(ss);
        float rstd = __builtin_amdgcn_rsqf(ss * (1.0f / 64.0f) + EPS);
#pragma unroll
        for (int e = 0; e < 8; ++e) x[e] = x[e] * rstd * gq[e];
        if (lat) rope_apply(x, rc, rs, lane);
        { v4u o; o.x = pk2(x[0] * C2, x[1] * C2); o.y = pk2(x[2] * C2, x[3] * C2); o.z = pk2(x[4] * C2, x[5] * C2); o.w = pk2(x[6] * C2, x[7] * C2);
          *(v4u*)(QR + (size_t)r * 512 + lane * 8) = o; }
        unpack8(ck, x);
        ss = 0.f;
#pragma unroll
        for (int e = 0; e < 8; ++e) ss += x[e] * x[e];
        ss = sum8(ss);
        rstd = __builtin_amdgcn_rsqf(ss * (1.0f / 64.0f) + EPS);
#pragma unroll
        for (int e = 0; e < 8; ++e) x[e] = x[e] * rstd * gk[e];
        if (lat) rope_apply(x, rc, rs, lane);
        const size_t kvrow = ((size_t)b * KVLEN + kvpos) * 128;
        if (lane < 16) { v4u o; o.x = pk2(x[0], x[1]); o.y = pk2(x[2], x[3]); o.z = pk2(x[4], x[5]); o.w = pk2(x[6], x[7]); *(v4u*)(KR + kvrow + kl * 8) = o; }
        else if (lane < 32) { *(v4u*)(VR + kvrow + kl * 8) = cv; }
    }
}

constexpr int LDT = 72;
constexpr unsigned short BF16_ONE = 0x3F80;
DI int chunk_pos0(int c) { return (c < 512 ? (c & 63) : ((c - 512) & 3)) * 64; }
DI int chunk_len(int c) { return c < 512 ? SEQ : CTXL; }

struct ConvIn { v4u x0, xm, xp; };
DI void conv_load(ConvIn& r, const bf16_t* P, int row0, int t, int pos0, int seqlen, int col) {
    const bf16_t* p = P + (size_t)(row0 + t) * PW + col;
    r.x0 = *(const v4u*)p;
    r.xm = (v4u){0u, 0u, 0u, 0u}; r.xp = (v4u){0u, 0u, 0u, 0u};
    if (pos0 + t - 1 >= 0) r.xm = *(const v4u*)(p - PW);
    if (pos0 + t + 1 < seqlen) r.xp = *(const v4u*)(p + PW);
}
DI void conv_apply(const ConvIn& r, const LAS float* cwt, int c8, float (&y)[8]) {
    float xm[8], x0[8], xp[8]; unpack8(r.xm, xm); unpack8(r.x0, x0); unpack8(r.xp, xp);
#pragma unroll
    for (int hh = 0; hh < 2; ++hh) {
        const f32x4 w0 = *(const LAS f32x4*)(cwt + c8 + 4 * hh), w1 = *(const LAS f32x4*)(cwt + 64 + c8 + 4 * hh), w2 = *(const LAS f32x4*)(cwt + 128 + c8 + 4 * hh), bb = *(const LAS f32x4*)(cwt + 192 + c8 + 4 * hh);
#pragma unroll
        for (int e = 0; e < 4; ++e) y[4 * hh + e] = silu_f(xm[4 * hh + e] * w0[e] + x0[4 * hh + e] * w1[e] + xp[4 * hh + e] * w2[e] + bb[e]);
    }
}
DI void conv_table(const Ctx& C, LAS float* cwt, int l, int h) {
    const float* cw = INP(I_ACW) + (size_t)l * 3 * 512; const float* cb = INP(I_ACB) + (size_t)l * 512;
    const int qk = C.tid >> 8, row = (C.tid >> 6) & 3, ch = C.tid & 63, col = qk * 256 + h * 64 + ch;
    cwt[C.tid] = row < 3 ? cw[row * 512 + col] : cb[col];
}
DI v4u pack8f(const float (&y)[8], float sc) { v4u o; o.x = pk2(y[0] * sc, y[1] * sc); o.y = pk2(y[2] * sc, y[3] * sc); o.z = pk2(y[4] * sc, y[5] * sc); o.w = pk2(y[6] * sc, y[7] * sc); return o; }
DI void store_vt8(LAS bf16_t* VT, const v4u x, int col, int t) {
    LAS bf16_t* d = VT + col * LDT + t;
    d[0 * LDT] = (bf16_t)(x.x & 0xffffu); d[1 * LDT] = (bf16_t)(x.x >> 16); d[2 * LDT] = (bf16_t)(x.y & 0xffffu); d[3 * LDT] = (bf16_t)(x.y >> 16);
    d[4 * LDT] = (bf16_t)(x.z & 0xffffu); d[5 * LDT] = (bf16_t)(x.z >> 16); d[6 * LDT] = (bf16_t)(x.w & 0xffffu); d[7 * LDT] = (bf16_t)(x.w >> 16);
}
DI void store_ct(LAS bf16_t* CT, const f32x4 (&s)[4], int tid) {
#pragma unroll
    for (int q = 0; q < 4; ++q) {
        const int idx = tid * 4 + q * 2048, v = idx >> 6, d = idx & 63;
        v2u o; o.x = pk2(s[q][0], s[q][1]); o.y = pk2(s[q][2], s[q][3]);
        *(LAS v2u*)(CT + v * LDT + d) = o;
    }
}
template <int ACT, int HSLD> DI void head_out(const Ctx& C, const LAS float* HS, const v4u g0, const v4u g1, int row0, const float (&gain)[16], bf16_t* Y, int h) {
    const int t = C.tid >> 3, sub = C.tid & 7;
    float x[16]; float ss = 0.f;
#pragma unroll
    for (int q = 0; q < 4; ++q) { const f32x4 v = *(const LAS f32x4*)(HS + t * HSLD + sub * 16 + q * 4); x[4 * q] = v[0]; x[4 * q + 1] = v[1]; x[4 * q + 2] = v[2]; x[4 * q + 3] = v[3]; }
#pragma unroll
    for (int e = 0; e < 16; ++e) ss += x[e] * x[e];
    ss = sum8(ss);
    const float rstd = __builtin_amdgcn_rsqf(ss * (1.0f / 128.0f) + EPS);
    float ga[8], gb[8]; unpack8(g0, ga); unpack8(g1, gb);
    float o[16];
#pragma unroll
    for (int e = 0; e < 16; ++e) { const float gv = e < 8 ? ga[e] : gb[e - 8]; const float a = ACT == 0 ? sigmoid_f(gv) : silu_f(gv); o[e] = x[e] * rstd * gain[e] * a; }
    v4u w0, w1; w0.x = pk2(o[0], o[1]); w0.y = pk2(o[2], o[3]); w0.z = pk2(o[4], o[5]); w0.w = pk2(o[6], o[7]); w1.x = pk2(o[8], o[9]); w1.y = pk2(o[10], o[11]); w1.z = pk2(o[12], o[13]); w1.w = pk2(o[14], o[15]);
    bf16_t* yp = Y + (size_t)(row0 + t) * 1536 + h * 128 + sub * 16;
    *(v4u*)yp = w0; *(v4u*)(yp + 8) = w1;
}

DI unsigned char* rec_ptr(unsigned char* base, int c, int h, int dir) { return base + ((size_t)(c * 4 + h) * 2 + dir) * RECB; }
template <bool NVEC> DI void delta_store(const Ctx& C, const LAS bf16_t* KT, const LAS bf16_t* VT, unsigned char* rec) {
    const int part = C.wave & 3, fr = C.lane & 15, fq = C.lane >> 4;
    f32x4 acc[8];
#pragma unroll
    for (int nt = 0; nt < 8; ++nt) acc[nt] = (f32x4){0.f, 0.f, 0.f, 0.f};
    mma_tile<8, 2>(acc, KT + 16 * part * LDT, LDT, VT, LDT, C.lane);
    bf16_t* R = (bf16_t*)rec;
#pragma unroll
    for (int nt = 0; nt < 8; ++nt) { v2u o; o.x = pk2(acc[nt][0], acc[nt][1]); o.y = pk2(acc[nt][2], acc[nt][3]); *(v2u*)(R + (nt * 16 + fr) * 64 + 16 * part + fq * 4) = o; }
    if (NVEC) {
        f32x4 an[1]; an[0] = (f32x4){0.f, 0.f, 0.f, 0.f};
        mma_tile<1, 2>(an, KT + 16 * part * LDT, LDT, VT + 128 * LDT, LDT, C.lane);
        if (fr == 0) { float* nf = (float*)(rec + REC_VEC) + 16 * part + fq * 4; nf[0] = an[0][0]; nf[1] = an[0][1]; nf[2] = an[0][2]; nf[3] = an[0][3]; }
    }
}
DI void store_ct16(LAS bf16_t* CT, const v4u a, const v4u b, int tid) {
    { const int idx = tid * 8; *(LAS v4u*)(CT + (idx >> 6) * LDT + (idx & 63)) = a; }
    { const int idx = tid * 8 + 4096; *(LAS v4u*)(CT + (idx >> 6) * LDT + (idx & 63)) = b; }
}
constexpr int MC_QS = 0, MC_KS = 9216, MC_VT = 18432, MC_CT0 = 39168, MC_CT1 = 59904, MC_SB0 = 80640, MC_SB1 = 89856, MC_HS = 99072, MC_VEC = 132864, MC_CWT = 134912;
static_assert(MC_CWT + 2048 <= RING_BYTES, "mLSTM (c) LDS map");
constexpr int MA_VT = 0, MA_KT0 = 20736, MA_KT1 = 29952, MA_VEC = 39168, MA_CWT = 40192;
struct MARegs { ConvIn k; v4u v0, v1; float gi, gf; };
struct MCRegs { ConvIn q, k; v4u v0, v1, og0, og1, s0a, s0b, s1a, s1b; float gi, gf, aux; };
DI void mlstm_a_load(const Ctx& C, int c, int h, MARegs& R) {
    const bf16_t* P = (const bf16_t*)(C.ws + WS_P);
    const int row0 = c * 64, t = C.lane, c8 = C.wave * 8;
    conv_load(R.k, P, row0, t, chunk_pos0(c), chunk_len(c), C_AQK + 256 + h * 64 + c8);
    const bf16_t* pv = P + (size_t)(row0 + t) * PW + C_AV + h * 128 + c8;
    R.v0 = *(const v4u*)pv; R.v1 = *(const v4u*)(pv + 64);
    R.gi = 0.f; R.gf = 0.f;
    if (C.wave < 2) { const int dir = C.wave, tt = dir ? 63 - C.lane : C.lane; const bf16_t* prow = P + (size_t)(row0 + tt) * PW; R.gi = bf2f(prow[C_AI + dir * 4 + h]); R.gf = bf2f(prow[C_AF + dir * 4 + h]); }
}
DI void mlstm_a_unit(const Ctx& C0, int l, int c, int h, MARegs& R, bool has_next, int cn, int hn) {
    Ctx C = C0; { int t_ = C0.tid; asm volatile("" : "+v"(t_)); C.tid = t_; C.lane = t_ & 63; }
    LAS unsigned char* L = C.lds + RING_OFF;
    LAS bf16_t* VT = (LAS bf16_t*)(L + MA_VT); LAS bf16_t* KT0 = (LAS bf16_t*)(L + MA_KT0); LAS bf16_t* KT1 = (LAS bf16_t*)(L + MA_KT1); LAS float* VEC = (LAS float*)(L + MA_VEC);
    unsigned char* rec0 = rec_ptr(C.ws + WS_STA, c, h, 0);
    const int t = C.lane, c8 = C.wave * 8;
    __syncthreads();
    if (C.wave < 2) {
        const int dir = C.wave, tt = dir ? 63 - C.lane : C.lane;
        const float* gb = INP(I_AGB) + l * 16;
        const float iv = R.gi + gb[dir * 4 + h], fv = logsigmoid_f(R.gf + gb[8 + dir * 4 + h]);
        const float b = wave_incl_sum(fv, C.lane);
        const float B = lx_f(b, 63);
        const float a = B - b + iv;
        const float Ml = wave_max(a, C.lane);
        VEC[dir * 64 + tt] = __expf(a - Ml);
        if (C.lane == 0) { float* sf = (float*)(rec0 + dir * RECB + REC_VEC); sf[64] = B; sf[65] = Ml; }
    }
    float y[8]; conv_apply(R.k, (const LAS float*)(L + MA_CWT) + 256, c8, y);
    store_vt8(VT, R.v0, c8, t); store_vt8(VT, R.v1, 64 + c8, t);
    if (C.tid < 64) VT[128 * LDT + C.tid] = BF16_ONE;
    asm volatile("" ::: "memory"); __builtin_amdgcn_sched_barrier(0);
    if (has_next) mlstm_a_load(C, cn, hn, R);
    asm volatile("" ::: "memory"); __builtin_amdgcn_sched_barrier(0);
    __syncthreads();
    {
        const float w0 = VEC[t] * 0.125f, w1 = VEC[64 + t] * 0.125f;
#pragma unroll
        for (int e = 0; e < 8; ++e) { const unsigned pw = pk2(y[e] * w0, y[e] * w1); KT0[(c8 + e) * LDT + t] = (bf16_t)pw; KT1[(c8 + e) * LDT + t] = (bf16_t)(pw >> 16); }
    }
    __syncthreads();
    delta_store<true>(C, (C.wave >> 2) ? KT1 : KT0, VT, rec0 + (C.wave >> 2) * RECB);
}
DI void mlstm_a_phase(const Ctx& C, int l) {
    LAS float* cwt = (LAS float*)(C.lds + RING_OFF + MA_CWT);
    int htab = -1; MARegs R;
    int u = C.bx; if (u < NCHUNK * 4) mlstm_a_load(C, u >> 2, u & 3, R);
    for (; u < NCHUNK * 4; u += C.G) {
        const int h = u & 3, un = u + C.G;
        if (h != htab) { __syncthreads(); conv_table(C, cwt, l, h); htab = h; }
        mlstm_a_unit(C, l, u >> 2, h, R, un < NCHUNK * 4, un >> 2, un & 3);
    }
}
DI void mlstm_c_load(const Ctx& C, int c, int h, MCRegs& R) {
    const bf16_t* P = (const bf16_t*)(C.ws + WS_P);
    const int row0 = c * 64, t = C.lane, c8 = C.wave * 8, pos0 = chunk_pos0(c), len = chunk_len(c);
    conv_load(R.q, P, row0, t, pos0, len, C_AQK + h * 64 + c8);
    conv_load(R.k, P, row0, t, pos0, len, C_AQK + 256 + h * 64 + c8);
    const bf16_t* pr = P + (size_t)(row0 + t) * PW;
    R.v0 = *(const v4u*)(pr + C_AV + h * 128 + c8); R.v1 = *(const v4u*)(pr + C_AV + h * 128 + 64 + c8);
    { const bf16_t* po = P + (size_t)(row0 + (C.tid >> 3)) * PW + C_AO + h * 128 + (C.tid & 7) * 16; R.og0 = *(const v4u*)po; R.og1 = *(const v4u*)(po + 8); }
    const unsigned char* rec0 = rec_ptr(C.ws + WS_STA, c, h, 0);
    R.s0a = *(const v4u*)(rec0 + C.tid * 16); R.s0b = *(const v4u*)(rec0 + 8192 + C.tid * 16); R.s1a = *(const v4u*)(rec0 + RECB + C.tid * 16); R.s1b = *(const v4u*)(rec0 + RECB + 8192 + C.tid * 16);
    R.gi = 0.f; R.gf = 0.f; R.aux = 0.f;
    if (C.wave < 2) { const int dir = C.wave, tt = dir ? 63 - C.lane : C.lane; const bf16_t* prow = P + (size_t)(row0 + tt) * PW; R.gi = bf2f(prow[C_AI + dir * 4 + h]); R.gf = bf2f(prow[C_AF + dir * 4 + h]); R.aux = ((const float*)(rec0 + dir * RECB + REC_VEC))[66]; }
    else if (C.wave < 4) R.aux = ((const float*)(rec0 + (C.wave - 2) * RECB + REC_VEC))[C.lane];
}
DI void mlstm_c_unit(const Ctx& C0, int l, int c, int h, MCRegs& R, const float (&gain)[16], bool has_next, int cn, int hn) {
    Ctx C = C0; { int t_ = C0.tid; asm volatile("" : "+v"(t_)); C.tid = t_; C.lane = t_ & 63; }
    LAS unsigned char* L = C.lds + RING_OFF;
    LAS bf16_t* QS = (LAS bf16_t*)(L + MC_QS); LAS bf16_t* KS = (LAS bf16_t*)(L + MC_KS); LAS bf16_t* VT = (LAS bf16_t*)(L + MC_VT);
    LAS bf16_t* CT0 = (LAS bf16_t*)(L + MC_CT0); LAS bf16_t* CT1 = (LAS bf16_t*)(L + MC_CT1); LAS bf16_t* SB0 = (LAS bf16_t*)(L + MC_SB0); LAS bf16_t* SB1 = (LAS bf16_t*)(L + MC_SB1);
    LAS float* HS = (LAS float*)(L + MC_HS); LAS float* VEC = (LAS float*)(L + MC_VEC); const LAS float* cwt = (const LAS float*)(L + MC_CWT);
    const int row0 = c * 64;
    const float aux = R.aux;
    __syncthreads();
    if (C.wave < 2) {
        const int dir = C.wave, tt = dir ? 63 - C.lane : C.lane;
        const float* gb = INP(I_AGB) + l * 16;
        const float iv = R.gi + gb[dir * 4 + h], fv = logsigmoid_f(R.gf + gb[8 + dir * 4 + h]);
        const float b = wave_incl_sum(fv, C.lane);
        const float g = iv - b;
        const float cm = wave_incl_max(g, C.lane);
        const float m0 = aux;
        const float mm = fmaxf(m0, cm);
        LAS float* V = VEC + dir * 256;
        V[tt] = g; V[64 + tt] = mm; V[128 + tt] = __expf(m0 - mm); V[192 + tt] = __expf(-(b + mm));
    } else if (C.wave < 4) { (C.wave == 3 ? CT1 : CT0)[128 * LDT + C.lane] = (bf16_t)f2bf(aux); }
    else if (C.wave == 4) VT[128 * LDT + C.lane] = BF16_ONE;
    {
        const int t = C.lane, c8 = C.wave * 8;
        float y[8];
        conv_apply(R.q, cwt, c8, y);
        *(LAS v4u*)(QS + t * LDT + c8) = pack8f(y, 1.0f);
        conv_apply(R.k, cwt + 256, c8, y);
        *(LAS v4u*)(KS + t * LDT + c8) = pack8f(y, 0.125f);
        store_vt8(VT, R.v0, c8, t); store_vt8(VT, R.v1, 64 + c8, t);
    }
    store_ct16(CT0, R.s0a, R.s0b, C.tid); store_ct16(CT1, R.s1a, R.s1b, C.tid);
    const v4u og0 = R.og0, og1 = R.og1;
    asm volatile("" ::: "memory"); __builtin_amdgcn_sched_barrier(0);
    if (has_next) mlstm_c_load(C, cn, hn, R);
    asm volatile("" ::: "memory"); __builtin_amdgcn_sched_barrier(0);
    __syncthreads();
    {
        const int mt = C.wave & 3, nh = C.wave >> 2, fr = C.lane & 15, fq = C.lane >> 4;
        f32x4 acc[2]; acc[0] = (f32x4){0.f, 0.f, 0.f, 0.f}; acc[1] = acc[0];
        mma_tile<2, 2>(acc, QS + 16 * mt * LDT, LDT, KS + 32 * nh * LDT, LDT, C.lane);
#pragma unroll
        for (int nt = 0; nt < 2; ++nt)
#pragma unroll
            for (int i = 0; i < 4; ++i) {
                const int j = 16 * mt + fq * 4 + i, s2 = 32 * nh + nt * 16 + fr;
                const float v = acc[nt][i];
                const float d0 = __expf(VEC[s2] - VEC[64 + j]), d1 = __expf(VEC[256 + s2] - VEC[256 + 64 + j]);
                const unsigned pw = pk2(s2 <= j ? v * d0 : 0.f, s2 >= j ? v * d1 : 0.f);
                SB0[j * LDT + s2] = (bf16_t)pw; SB1[j * LDT + s2] = (bf16_t)(pw >> 16);
            }
    }
    __syncthreads();
    {
        const int mt = C.wave & 3, vh = C.wave >> 2, fr = C.lane & 15, fq = C.lane >> 4;
        f32x4 hsum[4];
#pragma unroll
        for (int nt = 0; nt < 4; ++nt) hsum[nt] = (f32x4){0.f, 0.f, 0.f, 0.f};
#pragma unroll
        for (int dir = 0; dir < 2; ++dir) {
            const LAS bf16_t* CT = dir ? CT1 : CT0; const LAS bf16_t* SB = dir ? SB1 : SB0; const LAS float* V = VEC + dir * 256;
            f32x4 acc[4], den[1];
#pragma unroll
            for (int nt = 0; nt < 4; ++nt) acc[nt] = (f32x4){0.f, 0.f, 0.f, 0.f};
            den[0] = (f32x4){0.f, 0.f, 0.f, 0.f};
            mma_tile<4, 2>(acc, QS + 16 * mt * LDT, LDT, CT + 64 * vh * LDT, LDT, C.lane);
            mma_tile<1, 2>(den, QS + 16 * mt * LDT, LDT, CT + 128 * LDT, LDT, C.lane);
#pragma unroll
            for (int i = 0; i < 4; ++i) { const float w = V[128 + 16 * mt + fq * 4 + i]; den[0][i] *= w;
#pragma unroll
                for (int nt = 0; nt < 4; ++nt) acc[nt][i] *= w; }
            mma_tile<4, 2>(acc, SB + 16 * mt * LDT, LDT, VT + 64 * vh * LDT, LDT, C.lane);
            mma_tile<1, 2>(den, SB + 16 * mt * LDT, LDT, VT + 128 * LDT, LDT, C.lane);
#pragma unroll
            for (int i = 0; i < 4; ++i) {
                const float dn = lx_f(den[0][i], C.lane & 48);
                const float inv = __builtin_amdgcn_rcpf(fmaxf(fabsf(dn), V[192 + 16 * mt + fq * 4 + i]));
#pragma unroll
                for (int nt = 0; nt < 4; ++nt) hsum[nt][i] += acc[nt][i] * inv;
            }
        }
#pragma unroll
        for (int i = 0; i < 4; ++i)
#pragma unroll
            for (int nt = 0; nt < 4; ++nt) HS[(16 * mt + fq * 4 + i) * 132 + 64 * vh + nt * 16 + fr] = hsum[nt][i];
    }
    __syncthreads();
    head_out<0, 132>(C, HS, og0, og1, row0, gain, (bf16_t*)(C.ws + WS_YA), h);
}
DI void load_gain16(float (&gain)[16], const float* g, int h, int tid) {
    asm volatile("" : "+v"(tid));
#pragma unroll
    for (int q = 0; q < 4; ++q) { const f32x4 v = *(const f32x4*)(g + h * 128 + (tid & 7) * 16 + 4 * q); gain[4 * q] = v[0]; gain[4 * q + 1] = v[1]; gain[4 * q + 2] = v[2]; gain[4 * q + 3] = v[3]; }
}
DI void mlstm_c_phase(const Ctx& C, int l) {
    LAS float* cwt = (LAS float*)(C.lds + RING_OFF + MC_CWT);
    int htab = -1; MCRegs R; float gain[16];
    const int NU = (l == DEPTH - 1 ? 512 : NCHUNK) * 4;
    int u = C.bx; if (u < NU) mlstm_c_load(C, u >> 2, u & 3, R);
    for (; u < NU; u += C.G) {
        const int h = u & 3, un = u + C.G;
        if (h != htab) { __syncthreads(); conv_table(C, cwt, l, h); load_gain16(gain, INP(I_ANG) + (size_t)l * 512, h, C.tid); htab = h; }
        mlstm_c_unit(C, l, u >> 2, h, R, gain, un < NU, un >> 2, un & 3);
    }
}

constexpr int LAP = 68;
constexpr int GA_LA0 = 0, GA_LA1 = 17408, GA_VT = 34816, GA_KT0 = 53248, GA_KT1 = 62464, GA_LOW = 71680, GA_WUT0 = 76800, GA_WUT1 = 81920;
constexpr int GC_QS0 = 0, GC_QS1 = 9216, GC_VT = 18432, GC_CT0 = 36864, GC_CT1 = 55296, GC_SB0 = 73728, GC_SB1 = 82944, GC_KS0 = 92160, GC_KS1 = 101376, GC_LA0 = 110592, GC_LA1 = 128000, GC_HS = 92160;
constexpr int GC_LOW = GC_CT0, GC_WUT0 = 145408, GC_WUT1 = 145408 + 5120;
static_assert(GC_WUT1 + 5120 <= RING_BYTES && GC_HS + 64 * 128 * 4 <= GC_LA1, "GLA (c) LDS map");
constexpr int LWD = 40;
struct GARegs { v4u low, k, v0, v1; };
struct GCRegs { v4u low, q, k, v0, v1, og0, og1; };
DI void gla_wut_table(const Ctx& C, LAS bf16_t* WUT0, LAS bf16_t* WUT1, int l, int h) {
    const int dir = C.tid >> 8, dk = (C.tid >> 2) & 63, ig = C.tid & 3;
    float w[8];
    const bool live = (ig >> 1) == dir;
    const float* wu = INP(I_CWUP) + ((size_t)(l * 2 + dir) * 16 + (ig & 1) * 8) * 256 + h * 64 + dk;
#pragma unroll
    for (int e = 0; e < 8; ++e) w[e] = live ? wu[e * 256] : 0.f;
    *(LAS v4u*)((dir ? WUT1 : WUT0) + dk * LWD + ig * 8) = pack8f(w, 1.0f);
}
DI void gla_logdecay(const Ctx& C, const v4u lowreg, const float (&bu)[4], LAS float* LA0, LAS float* LA1, LAS bf16_t* LOW, const LAS bf16_t* WUT0, const LAS bf16_t* WUT1) {
    { const int t = C.tid >> 3, part = C.tid & 7; if (part < 4) *(LAS v4u*)(LOW + t * LWD + part * 8) = lowreg; }
    __syncthreads();
    {
        const int dir = C.wave >> 2, mt = C.wave & 3, fr = C.lane & 15, fq = C.lane >> 4;
        f32x4 acc[4];
#pragma unroll
        for (int nt = 0; nt < 4; ++nt) acc[nt] = (f32x4){0.f, 0.f, 0.f, 0.f};
        mma_tile<4, 1>(acc, LOW + 16 * mt * LWD, LWD, dir ? WUT1 : WUT0, LWD, C.lane);
        LAS float* LA = dir ? LA1 : LA0;
#pragma unroll
        for (int nt = 0; nt < 4; ++nt)
#pragma unroll
            for (int i = 0; i < 4; ++i) LA[(16 * mt + fq * 4 + i) * LAP + nt * 16 + fr] = logsigmoid_f(acc[nt][i] + bu[nt]) * (1.0f / 16.0f);
    }
    __syncthreads();
    if (C.wave < 2) {
        LAS float* LA = C.wave ? LA1 : LA0;
        float a[64];
#pragma unroll
        for (int q = 0; q < 64; ++q) a[q] = LA[(C.wave ? 63 - q : q) * LAP + C.lane];
#pragma unroll
        for (int q = 1; q < 64; ++q) a[q] += a[q - 1];
#pragma unroll
        for (int q = 0; q < 64; ++q) LA[(C.wave ? 63 - q : q) * LAP + C.lane] = a[q];
    }
    __syncthreads();
}
DI void gla_bias4(float (&bu)[4], const Ctx& C, int l, int h) {
    int ln = C.lane; asm volatile("" : "+v"(ln));
    const float* b = INP(I_CBUP) + (size_t)(l * 2 + (C.wave >> 2)) * 256 + h * 64 + (ln & 15);
#pragma unroll
    for (int nt = 0; nt < 4; ++nt) bu[nt] = b[nt * 16];
}
DI void gla_a_load(const Ctx& C, int c, int h, GARegs& R) {
    const bf16_t* P = (const bf16_t*)(C.ws + WS_P);
    const int t = C.lane, c8 = C.wave * 8;
    const bf16_t* pr = P + (size_t)(c * 64 + t) * PW;
    R.low = *(const v4u*)(P + (size_t)(c * 64 + (C.tid >> 3)) * PW + C_CA + (C.tid & 3) * 8);
    R.k = *(const v4u*)(pr + C_CK + h * 64 + c8);
    R.v0 = *(const v4u*)(pr + C_CV + h * 128 + c8); R.v1 = *(const v4u*)(pr + C_CV + h * 128 + 64 + c8);
}
DI void gla_a_unit(const Ctx& C0, int c, int h, GARegs& R, const float (&bu)[4], bool has_next, int cn, int hn) {
    Ctx C = C0; { int t_ = C0.tid; asm volatile("" : "+v"(t_)); C.tid = t_; C.lane = t_ & 63; }
    LAS unsigned char* L = C.lds + RING_OFF;
    LAS float* LA0 = (LAS float*)(L + GA_LA0); LAS float* LA1 = (LAS float*)(L + GA_LA1);
    LAS bf16_t* VT = (LAS bf16_t*)(L + GA_VT); LAS bf16_t* KT0 = (LAS bf16_t*)(L + GA_KT0); LAS bf16_t* KT1 = (LAS bf16_t*)(L + GA_KT1);
    unsigned char* rec0 = rec_ptr(C.ws + WS_STC, c, h, 0);
    const int t = C.lane, c8 = C.wave * 8;
    __syncthreads();
    store_vt8(VT, R.v0, c8, t); store_vt8(VT, R.v1, 64 + c8, t);
    const v4u kreg = R.k;
    gla_logdecay(C, R.low, bu, LA0, LA1, (LAS bf16_t*)(L + GA_LOW), (const LAS bf16_t*)(L + GA_WUT0), (const LAS bf16_t*)(L + GA_WUT1));
    asm volatile("" ::: "memory"); __builtin_amdgcn_sched_barrier(0);
    if (has_next) gla_a_load(C, cn, hn, R);
    asm volatile("" ::: "memory"); __builtin_amdgcn_sched_barrier(0);
    {
        float k[8]; unpack8(kreg, k);
        float l0[8], l1[8], t0[8], t1[8];
        { const f32x4 a0 = *(const LAS f32x4*)(LA0 + t * LAP + c8), a1 = *(const LAS f32x4*)(LA0 + t * LAP + c8 + 4), b0 = *(const LAS f32x4*)(LA1 + t * LAP + c8), b1 = *(const LAS f32x4*)(LA1 + t * LAP + c8 + 4);
          const f32x4 e0 = *(const LAS f32x4*)(LA0 + 63 * LAP + c8), e1 = *(const LAS f32x4*)(LA0 + 63 * LAP + c8 + 4), f0 = *(const LAS f32x4*)(LA1 + c8), f1 = *(const LAS f32x4*)(LA1 + c8 + 4);
#pragma unroll
          for (int e = 0; e < 4; ++e) { l0[e] = a0[e]; l0[4 + e] = a1[e]; l1[e] = b0[e]; l1[4 + e] = b1[e]; t0[e] = e0[e]; t0[4 + e] = e1[e]; t1[e] = f0[e]; t1[4 + e] = f1[e]; } }
#pragma unroll
        for (int e = 0; e < 8; ++e) {
            const unsigned pw = pk2(k[e] * __expf(t0[e] - l0[e]), k[e] * __expf(t1[e] - l1[e]));
            KT0[(c8 + e) * LDT + t] = (bf16_t)pw; KT1[(c8 + e) * LDT + t] = (bf16_t)(pw >> 16);
        }
        if (C.tid < 64) ((float*)(rec0 + REC_VEC))[C.tid] = __expf(LA0[63 * LAP + C.tid]);
        else if (C.tid < 128) ((float*)(rec0 + RECB + REC_VEC))[C.tid - 64] = __expf(LA1[C.tid - 64]);
    }
    __syncthreads();
    delta_store<false>(C, (C.wave >> 2) ? KT1 : KT0, VT, rec0 + (C.wave >> 2) * RECB);
}
DI void gla_a_phase(const Ctx& C, int l) {
    LAS unsigned char* L = C.lds + RING_OFF;
    int htab = -1; GARegs R; float bu[4];
    int u = C.bx + (C.G >> 1); if (u >= C.G) u -= C.G;
    if (u < NCHUNK * 4) gla_a_load(C, u >> 2, u & 3, R);
    for (; u < NCHUNK * 4; u += C.G) {
        const int h = u & 3, un = u + C.G;
        if (h != htab) { __syncthreads(); gla_wut_table(C, (LAS bf16_t*)(L + GA_WUT0), (LAS bf16_t*)(L + GA_WUT1), l, h); gla_bias4(bu, C, l, h); htab = h; }
        gla_a_unit(C, u >> 2, h, R, bu, un < NCHUNK * 4, un >> 2, un & 3);
    }
}
DI void gla_c_load(const Ctx& C, int c, int h, GCRegs& R) {
    const bf16_t* P = (const bf16_t*)(C.ws + WS_P);
    const int t = C.lane, c8 = C.wave * 8;
    const bf16_t* pr = P + (size_t)(c * 64 + t) * PW;
    R.low = *(const v4u*)(P + (size_t)(c * 64 + (C.tid >> 3)) * PW + C_CA + (C.tid & 3) * 8);
    R.q = *(const v4u*)(pr + C_CQ + h * 64 + c8); R.k = *(const v4u*)(pr + C_CK + h * 64 + c8);
    R.v0 = *(const v4u*)(pr + C_CV + h * 128 + c8); R.v1 = *(const v4u*)(pr + C_CV + h * 128 + 64 + c8);
    { const bf16_t* po = P + (size_t)(c * 64 + (C.tid >> 3)) * PW + C_CR + h * 128 + (C.tid & 7) * 16; R.og0 = *(const v4u*)po; R.og1 = *(const v4u*)(po + 8); }
}
DI void gla_c_unit(const Ctx& C0, int c, int h, GCRegs& R, const float (&bu)[4], const float (&gain)[16], bool has_next, int cn, int hn) {
    Ctx C = C0; { int t_ = C0.tid; asm volatile("" : "+v"(t_)); C.tid = t_; C.lane = t_ & 63; }
    LAS unsigned char* L = C.lds + RING_OFF;
    LAS bf16_t* QS0 = (LAS bf16_t*)(L + GC_QS0); LAS bf16_t* QS1 = (LAS bf16_t*)(L + GC_QS1); LAS bf16_t* KS0 = (LAS bf16_t*)(L + GC_KS0); LAS bf16_t* KS1 = (LAS bf16_t*)(L + GC_KS1);
    LAS bf16_t* VT = (LAS bf16_t*)(L + GC_VT); LAS bf16_t* CT0 = (LAS bf16_t*)(L + GC_CT0); LAS bf16_t* CT1 = (LAS bf16_t*)(L + GC_CT1);
    LAS bf16_t* SB0 = (LAS bf16_t*)(L + GC_SB0); LAS bf16_t* SB1 = (LAS bf16_t*)(L + GC_SB1);
    LAS float* LA0 = (LAS float*)(L + GC_LA0); LAS float* LA1 = (LAS float*)(L + GC_LA1); LAS float* HS = (LAS float*)(L + GC_HS);
    const int t = C.lane, c8 = C.wave * 8;
    const unsigned char* rec0 = rec_ptr(C.ws + WS_STC, c, h, 0);
    const v4u s1a = *(const v4u*)(rec0 + RECB + C.tid * 16), s1b = *(const v4u*)(rec0 + RECB + 8192 + C.tid * 16);
    __syncthreads();
    store_vt8(VT, R.v0, c8, t); store_vt8(VT, R.v1, 64 + c8, t);
    const v4u s0a = *(const v4u*)(rec0 + C.tid * 16), s0b = *(const v4u*)(rec0 + 8192 + C.tid * 16);
    store_ct16(CT1, s1a, s1b, C.tid);
    gla_logdecay(C, R.low, bu, LA0, LA1, (LAS bf16_t*)(L + GC_LOW), (const LAS bf16_t*)(L + GC_WUT0), (const LAS bf16_t*)(L + GC_WUT1));
    {
        float q[8], k[8], a[8], b[8];
        unpack8(R.q, q); unpack8(R.k, k);
        float lb[8];
        { const f32x4 x0 = *(const LAS f32x4*)(LA0 + t * LAP + c8), x1 = *(const LAS f32x4*)(LA0 + t * LAP + c8 + 4);
#pragma unroll
          for (int e = 0; e < 4; ++e) { lb[e] = x0[e]; lb[4 + e] = x1[e]; } }
#pragma unroll
        for (int e = 0; e < 8; ++e) { const float bb = lb[e]; a[e] = q[e] * 0.125f * __expf(bb); b[e] = k[e] * __expf(-bb); }
        *(LAS v4u*)(QS0 + t * LDT + c8) = pack8f(a, 1.0f); *(LAS v4u*)(KS0 + t * LDT + c8) = pack8f(b, 1.0f);
        { const f32x4 x0 = *(const LAS f32x4*)(LA1 + t * LAP + c8), x1 = *(const LAS f32x4*)(LA1 + t * LAP + c8 + 4);
#pragma unroll
          for (int e = 0; e < 4; ++e) { lb[e] = x0[e]; lb[4 + e] = x1[e]; } }
#pragma unroll
        for (int e = 0; e < 8; ++e) { const float bb = lb[e]; a[e] = q[e] * 0.125f * __expf(bb); b[e] = k[e] * __expf(-bb); }
        *(LAS v4u*)(QS1 + t * LDT + c8) = pack8f(a, 1.0f); *(LAS v4u*)(KS1 + t * LDT + c8) = pack8f(b, 1.0f);
    }
    store_ct16(CT0, s0a, s0b, C.tid);
    const v4u og0 = R.og0, og1 = R.og1;
    asm volatile("" ::: "memory"); __builtin_amdgcn_sched_barrier(0);
    if (has_next) gla_c_load(C, cn, hn, R);
    asm volatile("" ::: "memory"); __builtin_amdgcn_sched_barrier(0);
    __syncthreads();
    {
        const int mt = C.wave & 3, nh = C.wave >> 2, fr = C.lane & 15, fq = C.lane >> 4;
#pragma unroll
        for (int dir = 0; dir < 2; ++dir) {
            f32x4 acc[2]; acc[0] = (f32x4){0.f, 0.f, 0.f, 0.f}; acc[1] = acc[0];
            mma_tile<2, 2>(acc, (dir ? QS1 : QS0) + 16 * mt * LDT, LDT, (dir ? KS1 : KS0) + 32 * nh * LDT, LDT, C.lane);
            LAS bf16_t* SB = dir ? SB1 : SB0;
#pragma unroll
            for (int nt = 0; nt < 2; ++nt)
#pragma unroll
                for (int i = 0; i < 4; ++i) { const int j = 16 * mt + fq * 4 + i, s2 = 32 * nh + nt * 16 + fr; const bool keep = dir ? (s2 >= j) : (s2 <= j); SB[j * LDT + s2] = (bf16_t)f2bf(keep ? acc[nt][i] : 0.f); }
        }
    }
    __syncthreads();
    {
        const int mt = C.wave & 3, vh = C.wave >> 2, fr = C.lane & 15, fq = C.lane >> 4;
        f32x4 acc[4];
#pragma unroll
        for (int nt = 0; nt < 4; ++nt) acc[nt] = (f32x4){0.f, 0.f, 0.f, 0.f};
        mma_tile<4, 2>(acc, QS0 + 16 * mt * LDT, LDT, CT0 + 64 * vh * LDT, LDT, C.lane);
        mma_tile<4, 2>(acc, SB0 + 16 * mt * LDT, LDT, VT + 64 * vh * LDT, LDT, C.lane);
        mma_tile<4, 2>(acc, QS1 + 16 * mt * LDT, LDT, CT1 + 64 * vh * LDT, LDT, C.lane);
        mma_tile<4, 2>(acc, SB1 + 16 * mt * LDT, LDT, VT + 64 * vh * LDT, LDT, C.lane);
#pragma unroll
        for (int i = 0; i < 4; ++i)
#pragma unroll
            for (int nt = 0; nt < 4; ++nt) HS[(16 * mt + fq * 4 + i) * 128 + 64 * vh + nt * 16 + fr] = acc[nt][i];
    }
    __syncthreads();
    head_out<1, 128>(C, HS, og0, og1, c * 64, gain, (bf16_t*)(C.ws + WS_YA) + 1024, h);
}
DI void gla_c_phase(const Ctx& C, int l) {
    LAS unsigned char* L = C.lds + RING_OFF;
    int htab = -1; GCRegs R; float bu[4], gain[16];
    const int NU = (l == DEPTH - 1 ? 512 : NCHUNK) * 4;
    int u = C.bx + (C.G >> 1); if (u >= C.G) u -= C.G;
    if (u < NU) gla_c_load(C, u >> 2, u & 3, R);
    for (; u < NU; u += C.G) {
        const int h = u & 3, un = u + C.G;
        if (h != htab) { __syncthreads(); gla_wut_table(C, (LAS bf16_t*)(L + GC_WUT0), (LAS bf16_t*)(L + GC_WUT1), l, h); gla_bias4(bu, C, l, h); load_gain16(gain, INP(I_CNG) + (size_t)l * 512, h, C.tid); htab = h; }
        gla_c_unit(C, u >> 2, h, R, bu, gain, un < NU, un >> 2, un & 3);
    }
}

DI int chain_chunk(int b, int dir, int n) { return n < 4 ? 512 + 4 * b + (dir ? 3 - n : n) : 64 * b + (dir ? 67 - n : n - 4); }
DI void unpack8s(const v4u x, float (&f)[8]) { unpack8(x, f); }
#ifndef PROBE_SKIP
#define PROBE_SKIP 0
#endif
DI void scan_b_units(const Ctx& C, bool probe = false) {
    for (int u = C.bx; u < 256; u += C.G) {
        const int mixer = u >> 7, item = (u & 127) * 2 + (C.wave >> 2), chain = item >> 2, slab = item & 3;
        const int b = chain >> 3, h = (chain >> 1) & 3, dir = chain & 1, tl = C.tid & 255, elem = slab * 2048 + tl * 8;
        unsigned char* base = C.ws + (probe ? WS_A2 + (size_t)mixer * ((size_t)NCHUNK * 8 * RECB) : (mixer ? WS_STC : WS_STA));
        float zz = 0.f; asm volatile("" : "+v"(zz));
        float st[8];
#pragma unroll
        for (int e = 0; e < 8; ++e) st[e] = zz;
        if (mixer == 0) {
            const bool nthr = (slab == 0 && tl < 64), mthr = (slab == 0 && tl == 0);
            float m = 0.f, nst = 0.f;
            v4u d[8]; float sB[8], sM[8], dn[8];
#define SB_LOAD_M(q, n) do { const unsigned char* r2 = rec_ptr(base, chain_chunk(b, dir, (n)), h, dir); const float* r2f = (const float*)(r2 + REC_VEC); d[q] = *(const v4u*)(r2 + elem * 2); sB[q] = r2f[64]; sM[q] = r2f[65]; dn[q] = nthr ? r2f[tl] : 0.f; } while (0)
#define SB_STEP_M(q, n, PF) do { unsigned char* rec = rec_ptr(base, chain_chunk(b, dir, (n)), h, dir); float* rf = (float*)(rec + REC_VEC); \
                float dd[8]; unpack8(d[q], dd); const float B = sB[q], Ml = sM[q], dnn = dn[q]; \
                if (!(probe && PROBE_SKIP == 7)) { *(v4u*)(rec + elem * 2) = pack8f(st, 1.0f); if (nthr) rf[tl] = nst; if (mthr) rf[66] = m; } \
                if (PF) SB_LOAD_M(q, (n) + 8); \
                const float mn = fmaxf(B + m, Ml), dec = __expf(B + m - mn), sc = __expf(Ml - mn); \
                _Pragma("unroll") for (int e = 0; e < 8; ++e) st[e] = st[e] * dec + dd[e] * sc; \
                nst = nst * dec + dnn * sc; m = mn; } while (0)
#pragma unroll
            for (int q = 0; q < 8; ++q) SB_LOAD_M(q, q);
            for (int n0 = 0; n0 < 56; n0 += 8) {
#pragma unroll
                for (int q = 0; q < 8; ++q) SB_STEP_M(q, n0 + q, true);
            }
#pragma unroll
            for (int q = 0; q < 8; ++q) SB_STEP_M(q, 56 + q, q < 4);
#pragma unroll
            for (int q = 0; q < 4; ++q) SB_STEP_M(q, 64 + q, false);
#undef SB_LOAD_M
#undef SB_STEP_M
        } else {
            v4u d[8]; f32x4 dca[8], dcb[8];
#define SB_LOAD_G(q, n) do { const unsigned char* r2 = rec_ptr(base, chain_chunk(b, dir, (n)), h, dir); const float* r2f = (const float*)(r2 + REC_VEC) + (elem & 63); d[q] = *(const v4u*)(r2 + elem * 2); dca[q] = *(const f32x4*)r2f; dcb[q] = *(const f32x4*)(r2f + 4); } while (0)
#define SB_STEP_G(q, n, PF) do { unsigned char* rec = rec_ptr(base, chain_chunk(b, dir, (n)), h, dir); \
                float dd[8]; unpack8(d[q], dd); const f32x4 da = dca[q], db = dcb[q]; \
                if (!(probe && PROBE_SKIP == 7)) *(v4u*)(rec + elem * 2) = pack8f(st, 1.0f); \
                if (PF) SB_LOAD_G(q, (n) + 8); \
                _Pragma("unroll") for (int e = 0; e < 4; ++e) { st[e] = st[e] * da[e] + dd[e]; st[4 + e] = st[4 + e] * db[e] + dd[4 + e]; } } while (0)
#pragma unroll
            for (int q = 0; q < 8; ++q) SB_LOAD_G(q, q);
            for (int n0 = 0; n0 < 56; n0 += 8) {
#pragma unroll
                for (int q = 0; q < 8; ++q) SB_STEP_G(q, n0 + q, true);
            }
#pragma unroll
            for (int q = 0; q < 8; ++q) SB_STEP_G(q, 56 + q, q < 4);
#pragma unroll
            for (int q = 0; q < 4; ++q) SB_STEP_G(q, 64 + q, false);
#undef SB_LOAD_G
#undef SB_STEP_G
        }
    }
}

constexpr int RH_HT = 0, RH_LD = 1028, RH_PART = 16 * RH_LD * 4, RH_PLD = 33;
constexpr int RL_CNT = 131584;
static_assert(RH_PART + 8 * 16 * RH_PLD * 4 <= RL_CNT && RL_CNT + 3 * 32 * 4 + 2 * 512 * 4 <= RING_BYTES, "router LDS map");
DI void phase_norm2_router(const Ctx& C, int l) {
    const int lane = C.lane, w = C.wave;
    const bf16_t* X = (const bf16_t*)(C.ws + WS_X); unsigned char* H8 = (unsigned char*)(C.ws + WS_H);
    const bf16_t* U = (const bf16_t*)(C.ws + WS_U);
    const float* MOD = (const float*)(C.ws + WS_MOD);
    int* TOKE = (int*)(C.ws + WS_TOKE); int* TOKP = (int*)(C.ws + WS_TOKP); float* TOKW = (float*)(C.ws + WS_TOKW);
    LAS float* HT = (LAS float*)(C.lds + RING_OFF + RH_HT); LAS float* PART = (LAS float*)(C.lds + RING_OFF + RH_PART); LAS int* cnt = (LAS int*)(C.lds + RING_OFF + RL_CNT);
    __syncthreads();
    if (C.tid < 32) cnt[C.tid] = 0;
    float Wreg[2][8][4];
    {
        const float* Wr = INP(I_WR) + (size_t)l * DM * NEXP + (size_t)(128 * w + 4 * (lane >> 4)) * NEXP + (lane & 15);
#pragma unroll
        for (int tl = 0; tl < 2; ++tl)
#pragma unroll
            for (int j = 0; j < 8; ++j)
#pragma unroll
                for (int m = 0; m < 4; ++m) Wreg[tl][j][m] = Wr[(size_t)(16 * j + m) * NEXP + 16 * tl];
    }
    f32x4 gn[4];
#pragma unroll
    for (int j = 0; j < 4; ++j) gn[j] = *(const f32x4*)(INP(I_GN2) + (size_t)l * DM + (lane + 64 * j) * 4);
    const float brl = INP(I_BR)[l * NEXP + (lane & 31)];
    const int ntiles = (l == DEPTH - 1 ? M_LAT : MROWS) / 16;
    v2u xr[2][4], ur[2][4];
    if (C.bx < ntiles) {
#pragma unroll
        for (int q = 0; q < 2; ++q)
#pragma unroll
            for (int j = 0; j < 4; ++j) { const size_t o = (size_t)(C.bx * 16 + 2 * w + q) * DM + (lane + 64 * j) * 4; xr[q][j] = *(const v2u*)(X + o); ur[q][j] = *(const v2u*)(U + o); }
    }
    for (int tile = C.bx; tile < ntiles; tile += C.G) {
        const int r0 = tile * 16 + 2 * w, mi = r0 < M_LAT ? (r0 >> 12) : 8;
        const float* sh = MOD + ((size_t)l * 9 + mi) * 6144 + 3 * DM; const float* sc = sh + DM; const float* g1 = sh - DM;
        f32x4 h[2][4]; float ss[2] = {0.f, 0.f};
#pragma unroll
        for (int q = 0; q < 2; ++q)
#pragma unroll
            for (int j = 0; j < 4; ++j) { const int c = (lane + 64 * j) * 4; const v2u uu = ur[q][j], xx = xr[q][j]; const f32x4 gg = *(const f32x4*)(g1 + c);
                h[q][j] = (f32x4){bf2f(xx.x & 0xffffu), bf2f(xx.x >> 16), bf2f(xx.y & 0xffffu), bf2f(xx.y >> 16)} + gg * (f32x4){bf2f(uu.x & 0xffffu), bf2f(uu.x >> 16), bf2f(uu.y & 0xffffu), bf2f(uu.y >> 16)};
                ss[q] += (h[q][j][0] * h[q][j][0] + h[q][j][1] * h[q][j][1]) + (h[q][j][2] * h[q][j][2] + h[q][j][3] * h[q][j][3]); }
        if (tile + C.G < ntiles) {
#pragma unroll
            for (int q = 0; q < 2; ++q)
#pragma unroll
                for (int j = 0; j < 4; ++j) { const size_t o = (size_t)((tile + C.G) * 16 + 2 * w + q) * DM + (lane + 64 * j) * 4; xr[q][j] = *(const v2u*)(X + o); ur[q][j] = *(const v2u*)(U + o); }
        }
#pragma unroll
        for (int q = 0; q < 2; ++q) {
            const float rstd = __builtin_amdgcn_rsqf(wave_sum(ss[q], lane) * (1.0f / DM) + EPS);
#pragma unroll
            for (int j = 0; j < 4; ++j) {
                const int c = (lane + 64 * j) * 4;
                const f32x4 s1 = *(const f32x4*)(sc + c), s0 = *(const f32x4*)(sh + c);
                const f32x4 hh = h[q][j] * rstd * gn[j] * (s1 + 1.0f) + s0;
                *(unsigned*)(H8 + (size_t)(r0 + q) * DM + c) = pk4_fp8(hh[0] * FP8_SH, hh[1] * FP8_SH, hh[2] * FP8_SH, hh[3] * FP8_SH);
                *(LAS f32x4*)(HT + (2 * w + q) * RH_LD + c) = hh;
            }
        }
        __syncthreads();
        {
            f32x4 acc0 = (f32x4){0.f, 0.f, 0.f, 0.f}, acc1 = acc0;
            const LAS float* ap = HT + (lane & 15) * RH_LD + 128 * w + 4 * (lane >> 4);
#pragma unroll
            for (int j = 0; j < 8; ++j) {
                const f32x4 a = *(const LAS f32x4*)(ap + 16 * j);
#pragma unroll
                for (int m = 0; m < 4; ++m) { acc0 = __builtin_amdgcn_mfma_f32_16x16x4f32(a[m], Wreg[0][j][m], acc0, 0, 0, 0); acc1 = __builtin_amdgcn_mfma_f32_16x16x4f32(a[m], Wreg[1][j][m], acc1, 0, 0, 0); }
            }
            LAS float* pp = PART + (w * 16 + 4 * (lane >> 4)) * RH_PLD + (lane & 15);
#pragma unroll
            for (int i = 0; i < 4; ++i) { pp[i * RH_PLD] = acc0[i]; pp[i * RH_PLD + 16] = acc1[i]; }
        }
        __syncthreads();
        {
            const int rowl = 2 * w + (lane >> 5), mye = lane & 31, myrow = tile * 16 + rowl;
            float my = brl;
#pragma unroll
            for (int ww = 0; ww < 8; ++ww) my += PART[(ww * 16 + rowl) * RH_PLD + mye];
            float tv[4]; int ti[4];
            {
                const bool hi2 = lane >= 32; int rank = 0;
#pragma unroll
                for (int j = 0; j < 32; ++j) {
                    const float oa = __int_as_float(__builtin_amdgcn_readlane(__float_as_int(my), j)), ob = __int_as_float(__builtin_amdgcn_readlane(__float_as_int(my), 32 + j));
                    const float o = hi2 ? ob : oa;
                    rank += (o > my || (o == my && j < mye)) ? 1 : 0;
                }
#pragma unroll
                for (int k = 0; k < 4; ++k) {
                    const unsigned long long bal = __ballot(rank == k);
                    const int ia = __builtin_ctz((unsigned)bal), ib = __builtin_ctz((unsigned)(bal >> 32));
                    const float va = __int_as_float(__builtin_amdgcn_readlane(__float_as_int(my), ia)), vb = __int_as_float(__builtin_amdgcn_readlane(__float_as_int(my), 32 + ib));
                    tv[k] = hi2 ? vb : va; ti[k] = hi2 ? ib : ia;
                }
            }
            const float e1 = __expf(tv[1] - tv[0]), e2 = __expf(tv[2] - tv[0]), e3 = __expf(tv[3] - tv[0]);
            const float inv = __builtin_amdgcn_rcpf(((1.0f + e1) + e2) + e3);
            if (mye < 4) {
                const int ek = mye == 0 ? ti[0] : mye == 1 ? ti[1] : mye == 2 ? ti[2] : ti[3];
                const float wk = (mye == 0 ? 1.0f : mye == 1 ? e1 : mye == 2 ? e2 : e3) * inv;
                const int pos = atomicAdd((int*)(cnt + ek), 1);
                const size_t o = (size_t)myrow * 4 + mye;
                TOKE[o] = ek; TOKP[o] = pos; TOKW[o] = wk;
            }
        }
    }
    __syncthreads();
    if (C.tid < 32) ((int*)(C.ws + WS_BLKCNT))[C.bx * 32 + C.tid] = cnt[C.tid];
}

DI void phase_gather(const Ctx& C, int l) {
    const int lane = C.lane;
    const unsigned char* H8 = (const unsigned char*)(C.ws + WS_H); unsigned char* XG = (unsigned char*)(C.ws + WS_XG);
    const int* TOKE = (const int*)(C.ws + WS_TOKE); int* TOKP = (int*)(C.ws + WS_TOKP); const float* TOKW = (const float*)(C.ws + WS_TOKW);
    float* SLOTW = (float*)(C.ws + WS_SLOTW); int* META = (int*)(C.ws + WS_MOEMETA);
    const int* BLKCNT = (const int*)(C.ws + WS_BLKCNT);
    LAS int* base = (LAS int*)(C.lds + RING_OFF + RL_CNT + 128); LAS int* tot = (LAS int*)(C.lds + RING_OFF + RL_CNT + 256);
    __syncthreads();
    {
        LAS int* pt = (LAS int*)(C.lds + RING_OFF + RL_CNT + 384); LAS int* pp = pt + 512;
        const int e = C.tid & 31, cq = C.tid >> 5;
        int t = 0, pre = 0;
#pragma unroll 16
        for (int b = cq; b < C.G; b += 16) { const int c = BLKCNT[b * 32 + e]; pre += (b < C.bx) ? c : 0; t += c; }
        pt[cq * 32 + e] = t; pp[cq * 32 + e] = pre;
        __syncthreads();
        if (C.tid < 32) { int ts = 0, ps = 0;
#pragma unroll
            for (int q = 0; q < 16; ++q) { ts += pt[q * 32 + C.tid]; ps += pp[q * 32 + C.tid]; }
            tot[C.tid] = ts; base[C.tid] = ps; }
    }
    __syncthreads();
    LAS int* toff = (LAS int*)(C.lds + RING_OFF + RL_CNT + 384);
    if (C.tid == 0) {
        int off = 0;
#pragma unroll 1
        for (int e = 0; e < NEXP; ++e) { const int padded = (tot[e] + 255) & ~255; base[e] += off; toff[e] = off >> 8; off += padded; }
        toff[NEXP] = off >> 8;
        if (C.bx == 0) META[0] = off >> 8;
    }
    __syncthreads();
    if (C.bx == 0) {
        const int nt = toff[NEXP];
        for (int t = C.tid; t < nt; t += 512) { int e = 0;
#pragma unroll
            for (int q = 1; q < NEXP; ++q) e += (t >= toff[q]) ? 1 : 0;
            META[16 + t] = e; }
    }
    const int ntiles = (l == DEPTH - 1 ? M_LAT : MROWS) / 16;
    int4 e4[2], p4[2]; f32x4 w4[2]; v4u a[2];
    if (C.bx < ntiles) {
#pragma unroll
        for (int q = 0; q < 2; ++q) { const int r = C.bx * 16 + 2 * C.wave + q;
            e4[q] = *(const int4*)(TOKE + (size_t)r * 4); p4[q] = *(const int4*)(TOKP + (size_t)r * 4); w4[q] = *(const f32x4*)(TOKW + (size_t)r * 4); a[q] = *(const v4u*)(H8 + (size_t)r * DM + lane * 16); }
    }
    for (int tile = C.bx; tile < ntiles; tile += C.G) {
        int4 ce[2], cp[2]; f32x4 cw[2]; v4u ca[2];
#pragma unroll
        for (int q = 0; q < 2; ++q) { ce[q] = e4[q]; cp[q] = p4[q]; cw[q] = w4[q]; ca[q] = a[q]; }
        if (tile + C.G < ntiles) {
#pragma unroll
            for (int q = 0; q < 2; ++q) { const int r = (tile + C.G) * 16 + 2 * C.wave + q;
                e4[q] = *(const int4*)(TOKE + (size_t)r * 4); p4[q] = *(const int4*)(TOKP + (size_t)r * 4); w4[q] = *(const f32x4*)(TOKW + (size_t)r * 4); a[q] = *(const v4u*)(H8 + (size_t)r * DM + lane * 16); }
        }
#pragma unroll
        for (int q = 0; q < 2; ++q) {
            const int r = tile * 16 + 2 * C.wave + q;
            const int s0 = base[ce[q].x] + cp[q].x, s1 = base[ce[q].y] + cp[q].y, s2 = base[ce[q].z] + cp[q].z, s3 = base[ce[q].w] + cp[q].w;
            *(v4u*)(XG + (size_t)s0 * DM + lane * 16) = ca[q]; *(v4u*)(XG + (size_t)s1 * DM + lane * 16) = ca[q]; *(v4u*)(XG + (size_t)s2 * DM + lane * 16) = ca[q]; *(v4u*)(XG + (size_t)s3 * DM + lane * 16) = ca[q];
            if (lane == 0) { *(int4*)(TOKP + (size_t)r * 4) = make_int4(s0, s1, s2, s3); SLOTW[s0] = cw[q][0]; SLOTW[s1] = cw[q][1]; SLOTW[s2] = cw[q][2]; SLOTW[s3] = cw[q][3]; }
        }
    }
}

DI void phase_attention(const Ctx& C, char* lds_generic, bool with_ctx) {
    typedef attn_body::bf16 abf;
    const abf* QR = (const abf*)(C.ws + WS_QR); const abf* KR = (const abf*)(C.ws + WS_KR); const abf* VR = (const abf*)(C.ws + WS_VR); abf* YB = (abf*)(C.ws + WS_YA) + 512;
    const int vcu = (C.G % 8 == 0) ? (C.bx % 8) * (C.G / 8) + C.bx / 8 : C.bx;
    const int per = (1024 + C.G - 1) / C.G;
    for (int i = 0; i < per; ++i) {
        const int idx = vcu * per + i; if (idx >= 1024) break;
        const int grp = idx >> 6, b = grp >> 1, kvh = grp & 1, hq = kvh * 4 + ((idx >> 4) & 3), qb = idx & 15;
        attn_body::attn_unit<8>((long)b * SEQ + qb * 256, hq, KVLEN / 64, QR, KR + (size_t)b * KVLEN * 128 + kvh * 64, VR + (size_t)b * KVLEN * 128 + kvh * 64, YB, lds_generic, C.wave);
    }
    for (int idx = C.bx; with_ctx && idx < 64; idx += C.G) {
        const int b = idx >> 3, hq = idx & 7;
        attn_body::attn_unit<8>((long)M_LAT + b * CTXL, hq, CTXL / 64, QR, KR + (size_t)b * KVLEN * 128 + (hq >> 2) * 64, VR + (size_t)b * KVLEN * 128 + (hq >> 2) * 64, YB, lds_generic, C.wave);
    }
}

constexpr int NPH = 11;
constexpr int N_PHASES = 1 + DEPTH * NPH + 1;
struct KArgs { const float* in[N_IN]; float* out; unsigned char* ws; int ph_lo, ph_hi; };
static_assert(sizeof(KArgs) == N_IN * 8 + 8 + 8 + 8, "no padding bytes in the argument struct");

__global__ void __launch_bounds__(512, 2) mk_fwd(KArgs args) {
    extern __shared__ __attribute__((aligned(16))) unsigned char lds[];
    Ctx C;
    C.lds = (LAS unsigned char*)lds; C.ws = args.ws; C.in = args.in; C.out = args.out;
    C.tid = threadIdx.x; C.lane = C.tid & 63; C.wave = __builtin_amdgcn_readfirstlane(C.tid >> 6); C.G = gridDim.x; C.bx = blockIdx.x;
    for (int u = C.tid; u < (LDS_BYTES - LDSCTL_OFF) / 4; u += 512) ((LAS unsigned*)(C.lds + LDSCTL_OFF))[u] = 0u;
    __syncthreads();
    if ((unsigned)(uintptr_t)C.lds != 0u) __builtin_trap();
    if (C.tid == 0) { LAS unsigned* pw = (LAS unsigned*)(C.lds + MISC_OFF + 64); pw[0] = (unsigned)(uintptr_t)args.ws; pw[1] = (unsigned)((uintptr_t)args.ws >> 32); pw[2] = (unsigned)(uintptr_t)args.out; pw[3] = (unsigned)((uintptr_t)args.out >> 32); }
    __syncthreads();
#if MK_ONE_LAUNCH
    constexpr int lo = 0, hi = N_PHASES;
#else
    const int lo = args.ph_lo, hi = args.ph_hi;
#endif
    gu32* ctl = (gu32*)(C.ws + WS_CTL);
    XcdBarrier bar; bar.bar = (unsigned*)ctl + CW_BAR; bar.x = 0; bar.st = (volatile LAS unsigned*)(C.lds + MISC_OFF) + 8;
    if (hi - lo > 1) bar = xcd_barrier_post((unsigned*)ctl + CW_BAR, (volatile LAS unsigned*)(C.lds + MISC_OFF) + 8);
    bar.x = (unsigned)__builtin_amdgcn_readfirstlane((int)bar.x);
#define IN(k) (lo <= (k) && (k) < hi)
#ifndef PH_MASK
#define PH_MASK 0x1fff
#endif
#define ENAB(k) (((PH_MASK) >> (k)) & 1)
#ifndef DUP_MASK
#define DUP_MASK 0
#endif
#ifndef PROBE_SKIP
#define PROBE_SKIP 0
#endif
#define REPS(k) _Pragma("unroll 1") for (int rep_ = 0; rep_ < 1 + (((DUP_MASK) >> (k)) & 1); ++rep_)
#define SEAM(k) do { if (IN(k) && IN((k) + 1)) { XcdBarrier b2_ = bar; asm volatile("" : "+s"(b2_.x)); xcd_barrier(b2_); if ((DUP_MASK) & 0x2000) xcd_barrier(b2_); } } while (0)
    PG8_LAS unsigned char* glds = (PG8_LAS unsigned char*)(C.lds + RING_OFF);

    if (ENAB(0) && IN(0)) REPS(0) p0_prologue(launder(C));
    SEAM(0);
    for (int l = 0; l < DEPTH; ++l) {
        const int p = 1 + l * NPH;
        if (ENAB(1) && IN(p + 0)) REPS(1) phase_norm1(launder(C), l, rep_ ? 0.0f : 1.0f);
        SEAM(p + 0);
        if (ENAB(2) && IN(p + 1)) REPS(2) {
            const Ctx Cg = launder(C); unsigned char* const ws = Cg.ws;
            pg8::Gemm g{(const bf16_t*)(ws + WS_H), (const bf16_t*)(ws + WS_WTIN + (size_t)l * PW * DM), MROWS, PW, DM / 2, 0};
            pg8::StaticOrder S; S.init(MROWS, PW, C.G, C.bx);
            pg8::EpiStoreBf16 E{(bf16_t*)(ws + WS_P), PW, C_GATE, 1.0f / (FP8_SH * FP8_SW), rep_ ? PROBE_SKIP : 0};
#ifdef STAGGER_US
            { const unsigned long long t0_ = __builtin_amdgcn_s_memrealtime(), dl_ = (unsigned long long)(((C.bx >> 3) & 3) * STAGGER_US * 25);
              while (__builtin_amdgcn_s_memrealtime() - t0_ < dl_) __builtin_amdgcn_s_sleep(8); }
#endif
            pg8::gemm_phase<pg8::EpiStoreBf16, pg8::StaticOrder, true, true, true>(glds, g, S, E, C.wave);
        }
        SEAM(p + 1);
        if (ENAB(3) && IN(p + 2)) REPS(3) {
            if (!(rep_ && ((DUP_MASK) & 0x200000))) phase_attn_prep(launder(C), l);
            if (!(rep_ && ((DUP_MASK) & 0x400000))) mlstm_a_phase(launder(C), l);
            if (!(rep_ && ((DUP_MASK) & 0x800000))) gla_a_phase(launder(C), l);
        }
        SEAM(p + 2);
        if (ENAB(4) && IN(p + 3)) {
            scan_b_units(launder(C));
            if ((DUP_MASK) & 0x10000) { __syncthreads(); scan_b_units(launder(C), true); }
            __syncthreads();
            REPS(4) phase_attention(launder(C), (char*)lds + RING_OFF, l < DEPTH - 1);
        }
        SEAM(p + 3);
        if (ENAB(5) && IN(p + 4)) REPS(5) {
            if (!(rep_ && ((DUP_MASK) & 0x100000))) mlstm_c_phase(launder(C), l);
            if (!(rep_ && ((DUP_MASK) & 0x80000))) gla_c_phase(launder(C), l);
        }
        SEAM(p + 4);
        if (ENAB(6) && IN(p + 5)) REPS(6) {
            const Ctx Cg = launder(C); unsigned char* const ws = Cg.ws;
            const int Meff = (l == DEPTH - 1) ? M_LAT : MROWS;
            pg8::Gemm g{(const bf16_t*)(ws + WS_YA), (const bf16_t*)(ws + WS_WTBR) + (size_t)l * DM * 1536, Meff, DM, 1536, 0};
            pg8::StaticOrder S; S.init(Meff, DM, C.G, C.bx);
            pg8::EpiBranch E{(bf16_t*)(ws + WS_MRG), (const unsigned char*)(ws + WS_P) + 2 * C_GATE, PW * 2};
            pg8::gemm_phase<pg8::EpiBranch, pg8::StaticOrder, true, true>(glds, g, S, E, C.wave);
        }
        SEAM(p + 5);
        if (ENAB(7) && IN(p + 6)) REPS(7) {
            const Ctx Cg = launder(C); unsigned char* const ws = Cg.ws;
            const int Meff = (l == DEPTH - 1) ? M_LAT : MROWS;
            pg8::Gemm g{(const bf16_t*)(ws + WS_MRG), (const bf16_t*)(ws + WS_WTOUT) + (size_t)l * DM * DM, Meff, DM, DM, 0};
            pg8::StaticOrder S; S.init(Meff, DM, C.G, C.bx);
            pg8::EpiResid E{(bf16_t*)(ws + WS_U), rep_ ? PROBE_SKIP : 0};
            pg8::gemm_phase<pg8::EpiResid, pg8::StaticOrder, true, true>(glds, g, S, E, C.wave);
        }
        SEAM(p + 6);
        if ((DUP_MASK) & 0x20000) {
            const Ctx Cg = launder(C); v4u* q = (v4u*)(Cg.ws + WS_P) + (size_t)C.bx * 131072 + Cg.tid; const v4u val = {1u, 2u, 3u, (unsigned)l};
#pragma unroll 4
            for (int i = 0; i < 256; ++i) q[i * 512] = val;
        }
        if ((DUP_MASK) & 0x40000) {
            const Ctx Cg = launder(C); const v4u* q = (const v4u*)(Cg.ws + WS_P) + (size_t)C.bx * 131072 + Cg.tid; v4u a = {0u, 0u, 0u, 0u};
#pragma unroll 16
            for (int i = 0; i < 256; ++i) { const v4u t = q[i * 512]; a.x ^= t.x; a.y ^= t.y; a.z ^= t.z; a.w ^= t.w; }
            if ((a.x ^ a.y ^ a.z ^ a.w) == 0x12345u) ((unsigned*)(Cg.ws + WS_P))[Cg.tid] = a.x;
        }
        if (ENAB(8) && IN(p + 7)) REPS(8) phase_norm2_router(launder(C), l);
        SEAM(p + 7);
        if (ENAB(9) && IN(p + 8)) REPS(9) phase_gather(launder(C), l);
        SEAM(p + 8);
        if (ENAB(10) && IN(p + 9)) REPS(10) {
            const Ctx Cg = launder(C); unsigned char* const ws = Cg.ws; const int* const META = (const int*)(ws + WS_MOEMETA);
            const int nM = __builtin_amdgcn_readfirstlane(META[0]);
            pg8::Gemm g{(const bf16_t*)(ws + WS_XG), (const bf16_t*)(ws + WS_WTE1 + (size_t)l * NEXP * 2048 * DM), nM * 256, 2048, DM / 2, (size_t)2048 * DM};
            pg8::StaticOrder S; S.init(nM * 256, 2048, C.G, C.bx, META + 16);
            pg8::EpiSwiglu E{(unsigned char*)(ws + WS_A2), INP(I_BE1) + (size_t)l * NEXP * 2048, 1.0f / (FP8_SH * FP8_SW), FP8_SA, rep_ ? PROBE_SKIP : 0};
            pg8::gemm_phase<pg8::EpiSwiglu, pg8::StaticOrder, true, true, true>(glds, g, S, E, C.wave);
        }
        SEAM(p + 9);
        if (ENAB(11) && IN(p + 10)) REPS(11) {
            const Ctx Cg = launder(C); unsigned char* const ws = Cg.ws; const int* const META = (const int*)(ws + WS_MOEMETA);
            const int nM = __builtin_amdgcn_readfirstlane(META[0]);
            pg8::Gemm g{(const bf16_t*)(ws + WS_A2), (const bf16_t*)(ws + WS_WTE2 + (size_t)l * NEXP * DM * DFF), nM * 256, DM, DFF / 2, (size_t)DM * DFF};
            pg8::StaticOrder S; S.init(nM * 256, DM, C.G, C.bx, META + 16);
            pg8::EpiMoeOut E{(bf16_t*)(ws + WS_YS), INP(I_BE2) + (size_t)l * NEXP * DM, (const float*)(ws + WS_SLOTW), 1.0f / (FP8_SA * FP8_SW), rep_ ? PROBE_SKIP : 0};
            pg8::gemm_phase<pg8::EpiMoeOut, pg8::StaticOrder, true, true, true>(glds, g, S, E, C.wave);
        }
        SEAM(p + 10);
    }
    if (ENAB(12) && IN(1 + DEPTH * NPH)) phase_norm1(launder(C), DEPTH, 1.0f);
#undef IN
#undef SEAM
}

extern "C" void kernel_launch(void* const* d_in, const int* in_sizes, int n_in, void* d_out, int out_size, void* d_ws, size_t ws_size, hipStream_t stream) {
    static int grid = 0;
    if (grid == 0) {
        if (n_in != N_IN || out_size != M_LAT * DM || ws_size < WS_END) { fprintf(stderr, "kernel_launch: unexpected shapes: n_in %d out %d ws %zu (need %zu); nothing launched\n", n_in, out_size, ws_size, (size_t)WS_END); grid = -1; return; }
        int dev = 0, cus = 0, per_cu = 0;
        if (hipGetDevice(&dev) != hipSuccess || hipDeviceGetAttribute(&cus, hipDeviceAttributeMultiprocessorCount, dev) != hipSuccess) { grid = -1; return; }
        if (hipFuncSetAttribute((const void*)mk_fwd, hipFuncAttributeMaxDynamicSharedMemorySize, LDS_BYTES) != hipSuccess) { fprintf(stderr, "kernel_launch: hipFuncSetAttribute failed\n"); grid = -1; return; }
        if (hipOccupancyMaxActiveBlocksPerMultiprocessor(&per_cu, (const void*)mk_fwd, 512, LDS_BYTES) != hipSuccess || per_cu < 1) fprintf(stderr, "kernel_launch: note: occupancy query reports %d\n", per_cu);
        (void)hipGetLastError();
        grid = cus;
    }
    if (grid < 0) return;
    (void)in_sizes;
    if (hipMemsetAsync((char*)d_ws + WS_CTL, 0, CTL_ZERO_BYTES, stream) != hipSuccess) return;
    KArgs a{};
    for (int i = 0; i < N_IN; ++i) a.in[i] = (const float*)d_in[i];
    a.out = (float*)d_out; a.ws = (unsigned char*)d_ws;
#if MK_ONE_LAUNCH
    a.ph_lo = 0; a.ph_hi = N_PHASES;
    hipLaunchKernelGGL(mk_fwd, dim3(grid), dim3(512), LDS_BYTES, stream, a);
#else
    for (int p = 0; p < N_PHASES; ++p) { a.ph_lo = p; a.ph_hi = p + 1; hipLaunchKernelGGL(mk_fwd, dim3(grid), dim3(512), LDS_BYTES, stream, a); }
#endif
}
```

```cpp
#include <hip/hip_runtime.h>
#include <hip/hip_bf16.h>
#include <cstdio>
#include <cstdint>

#ifndef MK_ONE_LAUNCH
#define MK_ONE_LAUNCH 1
#endif

#define DI __device__ __forceinline__
#define GAS __attribute__((address_space(1)))
#define LAS __attribute__((address_space(3)))

constexpr int DM = 1024, NBATCH = 8, SEQ = 4096, DEPTH = 4, CTXL = 256;
constexpr int M_LAT = NBATCH * SEQ, M_CTX = NBATCH * CTXL, MROWS = M_LAT + M_CTX;
constexpr int IN_W = 6960, PW = 7168;
constexpr int NCHUNK = MROWS / 64;
constexpr int KVLEN = CTXL + SEQ;
constexpr int NEXP = 32, TOPK = 4, DFF = 1024;
constexpr int MOE_ROWS_MAX = MROWS * TOPK + NEXP * 256;
constexpr float EPS = 1e-6f;
constexpr int C_AQK = 0, C_AV = 512, C_AI = 1024, C_AF = 1032, C_AO = 1040, C_BQ = 1552, C_BK = 2064, C_BV = 2192, C_CQ = 2320, C_CK = 2576, C_CV = 2832, C_CA = 3344, C_CR = 3376, C_GATE = 3888;
static_assert(C_GATE + 3 * DM == IN_W, "split");
enum { I_X = 0, I_C, I_CTX, I_CCTX, I_WADA, I_BADA, I_GN1, I_WIN, I_ACW, I_ACB, I_AGB, I_ANG, I_BQG, I_BKG, I_CWUP, I_CBUP, I_CNG, I_WBR, I_WOUT, I_GN2, I_WR, I_BR, I_WE1, I_BE1, I_WE2, I_BE2, I_GF, N_IN };

constexpr size_t al256(size_t x) { return (x + 255) & ~(size_t)255; }
constexpr size_t WS_CTL = 0, CTL_ZERO_BYTES = 1u << 20;
constexpr size_t WS_MOD = WS_CTL + CTL_ZERO_BYTES;
constexpr size_t WS_BLKCNT = WS_MOD + al256((size_t)DEPTH * 9 * 6 * DM * 4);
constexpr size_t WS_MOEMETA = WS_BLKCNT + al256(1024 * 32 * 4);
constexpr size_t WS_TOKE = WS_MOEMETA + 4096;
constexpr size_t WS_TOKP = WS_TOKE + (size_t)MROWS * 16;
constexpr size_t WS_TOKW = WS_TOKP + (size_t)MROWS * 16;
constexpr size_t WS_SLOTW = WS_TOKW + (size_t)MROWS * 16;
constexpr size_t WS_WTIN = WS_SLOTW + al256((size_t)MOE_ROWS_MAX * 4);
constexpr size_t WS_WTBR = WS_WTIN + (size_t)DEPTH * PW * DM * 2;
constexpr size_t WS_WTOUT = WS_WTBR + (size_t)DEPTH * 3 * DM * 512 * 2;
constexpr size_t WS_WTE1 = WS_WTOUT + (size_t)DEPTH * DM * DM * 2;
constexpr size_t WS_WTE2 = WS_WTE1 + (size_t)DEPTH * NEXP * 2 * DFF * DM * 2;
constexpr size_t WS_X = WS_WTE2 + (size_t)DEPTH * NEXP * DM * DFF * 2;
constexpr size_t WS_H = WS_X + (size_t)MROWS * DM * 4;
constexpr size_t WS_P = WS_H + (size_t)MROWS * DM * 2;
constexpr size_t WS_QR = WS_P + (size_t)MROWS * PW * 2;
constexpr size_t WS_KR = WS_QR + (size_t)MROWS * 512 * 2;
constexpr size_t WS_VR = WS_KR + (size_t)NBATCH * KVLEN * 128 * 2;
constexpr size_t WS_YA = WS_VR + (size_t)NBATCH * KVLEN * 128 * 2;
constexpr size_t WS_YB = WS_YA + (size_t)MROWS * 512 * 2;
constexpr size_t WS_YC = WS_YB + (size_t)MROWS * 512 * 2;
constexpr size_t WS_MRG = WS_YC + (size_t)MROWS * 512 * 2;
constexpr int RECB = 16896, REC_VEC = 16384;
constexpr size_t WS_STA = WS_MRG + (size_t)MROWS * DM * 2;
constexpr size_t WS_STC = WS_STA + (size_t)NCHUNK * 8 * RECB;
constexpr size_t WS_XG = WS_STC + (size_t)NCHUNK * 8 * RECB;
constexpr size_t WS_A2 = WS_XG + (size_t)MOE_ROWS_MAX * DM * 2;
constexpr size_t WS_YS = WS_A2 + (size_t)MOE_ROWS_MAX * DFF * 2;
constexpr size_t WS_U = WS_YS + (size_t)MOE_ROWS_MAX * DM * 2;
constexpr size_t WS_END = WS_U + (size_t)MROWS * DM * 2;
constexpr int CW_BAR = 4096;

constexpr int RING_OFF = 0, RING_BYTES = 155648;
constexpr int LDSCTL_OFF = RING_BYTES, MISC_OFF = LDSCTL_OFF + 320;
constexpr int LDS_BYTES = 156672;

typedef unsigned short bf16_t;
typedef unsigned v4u __attribute__((ext_vector_type(4)));
typedef unsigned v2u __attribute__((ext_vector_type(2)));
typedef float f32x4 __attribute__((ext_vector_type(4)));
typedef short bf16x8 __attribute__((ext_vector_type(8)));

DI float bf2f(unsigned h) { return __uint_as_float(h << 16); }
typedef float f32x2_h __attribute__((ext_vector_type(2))); typedef __bf16 bf16x2_h __attribute__((ext_vector_type(2)));
DI unsigned pk2(float lo, float hi) { const f32x2_h v = {lo, hi}; return __builtin_bit_cast(unsigned, __builtin_convertvector(v, bf16x2_h)); }
DI unsigned f2bf(float f) { return pk2(f, f) & 0xffffu; }
DI void unpack8(const v4u v, float (&o)[8]) { o[0] = bf2f(v.x & 0xffffu); o[1] = bf2f(v.x >> 16); o[2] = bf2f(v.y & 0xffffu); o[3] = bf2f(v.y >> 16); o[4] = bf2f(v.z & 0xffffu); o[5] = bf2f(v.z >> 16); o[6] = bf2f(v.w & 0xffffu); o[7] = bf2f(v.w >> 16); }
constexpr float FP8_SH = 8.0f, FP8_SW = 512.0f, FP8_SA = 4.0f;
DI float clamp448(float x) { return fminf(fmaxf(x, -448.0f), 448.0f); }
DI unsigned pk4_fp8(float a, float b, float c, float d) { unsigned w = __float_as_uint(a);   w = __builtin_amdgcn_cvt_pk_fp8_f32(clamp448(a), clamp448(b), w, false); w = __builtin_amdgcn_cvt_pk_fp8_f32(clamp448(c), clamp448(d), w, true); return w; }
DI float sigmoid_f(float x) { return __builtin_amdgcn_rcpf(1.f + __expf(-x)); }
DI float silu_f(float x) { return x * sigmoid_f(x); }
DI float logsigmoid_f(float x) { return fminf(x, 0.f) - __logf(1.f + __expf(-fabsf(x))); }
namespace pg8 {
#define PG8_LAS __attribute__((address_space(3)))
typedef unsigned short bf16_t;
typedef short bf16x8 __attribute__((ext_vector_type(8)));
typedef float f32x4 __attribute__((ext_vector_type(4)));
typedef unsigned u32x4 __attribute__((ext_vector_type(4)));
typedef int v4i_t __attribute__((ext_vector_type(4)));
typedef unsigned u32x2 __attribute__((ext_vector_type(2)));
constexpr int BM = 256, BK = 64, HALF = 128, HTB = HALF * BK * 2  , STAGE_BYTES = 8 * HTB, NXCD = 8, WGM = 8;

__host__ __device__ __forceinline__ int lds_byte(int r, int c) { const int st = (r >> 4) * 2 + (c >> 5), rr = r & 15, cc = c & 31, ob = rr * 64 + cc * 2; return st * 1024 + (ob ^ (((ob >> 9) & 1) << 5)); }
__host__ __device__ __forceinline__ void stage_rc(int b, int& R, int& C) { const int st = b / 1024, sb = b % 1024, swz = sb ^ (((sb >> 9) & 1) << 5); R = (st >> 1) * 16 + swz / 64; C = (st & 1) * 32 + (swz % 64) / 2; }
__host__ __device__ __forceinline__ int perm32(int rho) { const int n = rho >> 4, i = rho & 15; return 8 * (i >> 2) + 4 * n + (i & 3); }

struct Unit { int pm, pn, e; };
struct Gemm { const bf16_t* A; const bf16_t* Bt; int M, N, K; size_t bstride; };

struct StaticOrder {
    int nM, nN, nwg, G, c; const int* tile_e;
    __host__ __device__ void init(int M, int N, int G_, int c_, const int* te = nullptr) { nM = M / BM; nN = N / BM; nwg = nM * nN; G = G_; c = c_; tile_e = te; }
    __device__ __forceinline__ bool next(int i, Unit& u) const {
        const long L = (long)i * G + c; if (L >= nwg) return false;
        int wgid = (int)L; { const int q = nwg / NXCD, r = nwg % NXCD, xcd = wgid % NXCD, off = wgid / NXCD; wgid = (xcd < r ? xcd * (q + 1) : r * (q + 1) + (xcd - r) * q) + off; }
        const int nig = WGM * nN, gid = wgid / nig, fm = gid * WGM, gsz = (nM - fm) < WGM ? (nM - fm) : WGM;
        u.pm = fm + ((wgid % nig) % gsz); u.pn = (wgid % nig) / gsz; u.e = tile_e ? __builtin_amdgcn_readfirstlane(tile_e[u.pm]) : 0; return true;
    }
    __device__ __forceinline__ void a_ready(const Unit&) const {}
    __device__ __forceinline__ void done(const Unit&) const {}
};

__device__ __forceinline__ unsigned cvt_pk_bf16(float lo, float hi) { unsigned r; asm volatile("v_cvt_pk_bf16_f32 %0, %1, %2" : "=v"(r) : "v"(lo), "v"(hi)); return r; }
__device__ __forceinline__ u32x4 pack8(const f32x4 a, const f32x4 b) { u32x4 w; w.x = cvt_pk_bf16(a[0], a[1]); w.y = cvt_pk_bf16(a[2], a[3]); w.z = cvt_pk_bf16(b[0], b[1]); w.w = cvt_pk_bf16(b[2], b[3]); return w; }
__device__ __forceinline__ float bfl(unsigned v) { return __uint_as_float(v << 16); }
__device__ __forceinline__ float bfh(unsigned v) { return __uint_as_float(v & 0xffff0000u); }
__device__ __forceinline__ float sigm(float x) { return __builtin_amdgcn_rcpf(1.f + __expf(-x)); }

#ifndef AUX_B
#define AUX_B 0
#endif
#ifndef AUX_F
#define AUX_F 16
#endif
#ifndef AUX_G
#define AUX_G 0
#endif
#ifndef AUX_J
#define AUX_J 0
#endif
#ifndef AUX_K
#define AUX_K 0
#endif
__device__ __forceinline__ __amdgpu_buffer_rsrc_t mk_rs(const void* p) {
    unsigned lo = (unsigned)__builtin_amdgcn_readfirstlane((int)(unsigned)(uintptr_t)p), hi = (unsigned)__builtin_amdgcn_readfirstlane((int)(unsigned)((uintptr_t)p >> 32)); asm volatile("" : "+s"(lo), "+s"(hi));
    return __builtin_amdgcn_make_buffer_rsrc((void*)(((uintptr_t)hi << 32) | (uintptr_t)lo), 0, -1, 0x00020000); }
template <int AUX> __device__ __forceinline__ void st16(__amdgpu_buffer_rsrc_t rs, unsigned off, u32x4 v) { __builtin_amdgcn_raw_buffer_store_b128(v, rs, off, 0, AUX); }
template <int AUX> __device__ __forceinline__ void st8(__amdgpu_buffer_rsrc_t rs, unsigned off, u32x2 v) { __builtin_amdgcn_raw_buffer_store_b64(v, rs, off, 0, AUX); }
__device__ __forceinline__ void st16p(void* p, u32x4 v) { if (AUX_B == 16) asm volatile("global_store_dwordx4 %0, %1, off sc1\n\ts_nop 1" :: "v"(p), "v"(v) : "memory"); else *(u32x4*)p = v; }
__device__ __forceinline__ void st8p(void* p, u32x2 v) { if (AUX_B == 16) asm volatile("global_store_dwordx2 %0, %1, off sc1\n\ts_nop 1" :: "v"(p), "v"(v) : "memory"); else *(u32x2*)p = v; }
struct NoState {};
struct EpiStoreBf16 {
    static constexpr bool PERM = true, AFTER_DRAIN = false, HOOK = false; static constexpr int NST = 16; typedef NoState State;
    bf16_t* O; int ldc, sig_from; float inv; int probe_skip;
    __device__ __forceinline__ unsigned q8(float raw, float c2) const { const float e = __builtin_amdgcn_exp2f(raw * c2); return (unsigned)fmaxf(__builtin_rintf(__builtin_amdgcn_rcpf(__builtin_fmaf(e, 1.0f / 255.0f, 1.0f / 255.0f))), 1.0f); }
    __device__ __forceinline__ void operator()(const f32x4 (&acc)[2][2][4][2], const Unit& u, int wr, int wc, int fr, int fq, NoState&) const {
        const int row0 = u.pm * BM + wr * 64 + fr, col0 = u.pn * BM + wc * 32 + 8 * fq;
        if (probe_skip == 2) return;
#pragma unroll
        for (int bj = 0; bj < 2; ++bj) {
            const int col = col0 + bj * HALF; const bool sg = col >= sig_from;
#pragma unroll
            for (int ai = 0; ai < 2; ++ai)
#pragma unroll
                for (int m = 0; m < 4; ++m) {
                    const f32x4 a = acc[ai][bj][m][0] * inv, b = acc[ai][bj][m][1] * inv;
                    bf16_t* rowp = O + (size_t)(row0 + ai * HALF + m * 16) * ldc;
                    if (probe_skip == 1 && (a[0] + b[3]) != 12345.678f) continue;
                    if (probe_skip == 4 && (ai + m + bj) != 0 && (a[0] + b[3]) != 12345.678f) continue;
                    if (probe_skip == 3) { *(u32x4*)((unsigned char*)O + ((size_t)1 << 31) + (size_t)(u.pm * 28 + u.pn) * 131072 + (size_t)((((ai * 4 + m) * 2 + bj) * 8 + (wr * 4 + wc)) * 1024 + (fr + 16 * fq) * 16)) = pack8(a, b); continue; }
                    if (sg) { const f32x4 ra = acc[ai][bj][m][0], rb = acc[ai][bj][m][1]; const float c2 = inv * -1.4426950408889634f;
                        u32x2 w; w.x = q8(ra[0], c2) | (q8(ra[1], c2) << 8) | (q8(ra[2], c2) << 16) | (q8(ra[3], c2) << 24); w.y = q8(rb[0], c2) | (q8(rb[1], c2) << 8) | (q8(rb[2], c2) << 16) | (q8(rb[3], c2) << 24);
                        st8p((unsigned char*)(rowp + sig_from) + (col - sig_from), w); }
                    else st16p(rowp + col, pack8(a, b)); }
        }
    }
};
struct EpiBranch {
    static constexpr bool PERM = true, AFTER_DRAIN = false, HOOK = true; static constexpr int NST = 16; typedef NoState State;
    bf16_t* MRG; const unsigned char* gates; int ldg;
    static __device__ __forceinline__ float ub(unsigned v, int k) { return (float)((v >> (8 * k)) & 0xffu); }
    __device__ __forceinline__ void hook(f32x4 (&acc)[2][2][4][2], const Unit& u, int seg, int wr, int wc, int lane, NoState&) const {
        const int fr = lane & 15, fq = lane >> 4;
        const int row0 = u.pm * BM + wr * 64 + fr, col0 = u.pn * BM + wc * 32 + 8 * fq;
        const unsigned char* gp = gates + seg * 1024 + col0;
        u32x2 gb[2][4][2], ga[2][4][2];
#pragma unroll
        for (int ai = 0; ai < 2; ++ai)
#pragma unroll
            for (int m = 0; m < 4; ++m) { const size_t ro = (size_t)(row0 + ai * HALF + m * 16) * ldg;
#pragma unroll
                for (int bj = 0; bj < 2; ++bj) { gb[ai][m][bj] = *(const u32x2*)(gp + ro + bj * HALF); ga[ai][m][bj] = *(const u32x2*)(gp + ro - 1024 + bj * HALF); } }
        __builtin_amdgcn_sched_barrier(0);
#pragma unroll
        for (int ai = 0; ai < 2; ++ai)
#pragma unroll
            for (int m = 0; m < 4; ++m)
#pragma unroll
                for (int bj = 0; bj < 2; ++bj) {
                    const u32x2 b_ = gb[ai][m][bj], a_ = ga[ai][m][bj];
                    f32x4& a = acc[ai][bj][m][0]; f32x4& b = acc[ai][bj][m][1];
#pragma unroll
                    for (int k = 0; k < 4; ++k) { a[k] *= ub(a_.x, k) * __builtin_amdgcn_rcpf(ub(b_.x, k)); b[k] *= ub(a_.y, k) * __builtin_amdgcn_rcpf(ub(b_.y, k)); }
                }
    }
    __device__ __forceinline__ void operator()(const f32x4 (&acc)[2][2][4][2], const Unit& u, int wr, int wc, int fr, int fq, NoState&) const {
        const int row0 = u.pm * BM + wr * 64 + fr, col0 = u.pn * BM + wc * 32 + 8 * fq;
        u32x2 gv[2][4][2];
#pragma unroll
        for (int ai = 0; ai < 2; ++ai)
#pragma unroll
            for (int m = 0; m < 4; ++m)
#pragma unroll
                for (int bj = 0; bj < 2; ++bj) gv[ai][m][bj] = *(const u32x2*)(gates + (size_t)(row0 + ai * HALF + m * 16) * ldg + 2048 + col0 + bj * HALF);
        __builtin_amdgcn_sched_barrier(0);
        const __amdgpu_buffer_rsrc_t rsM = mk_rs(MRG);
#pragma unroll
        for (int ai = 0; ai < 2; ++ai)
#pragma unroll
            for (int m = 0; m < 4; ++m) { const size_t row = (size_t)(row0 + ai * HALF + m * 16);
#pragma unroll
                for (int bj = 0; bj < 2; ++bj) {
                    const u32x2 g_ = gv[ai][m][bj];
                    f32x4 a = acc[ai][bj][m][0], b = acc[ai][bj][m][1];
#pragma unroll
                    for (int k = 0; k < 4; ++k) { a[k] *= ub(g_.x, k) * (1.0f / 255.0f); b[k] *= ub(g_.y, k) * (1.0f / 255.0f); }
                    st16<AUX_F>(rsM, (unsigned)row * 2048u + (unsigned)(col0 + bj * HALF) * 2u, pack8(a, b)); } }
    }
};
struct EpiResid {
    static constexpr bool PERM = true, AFTER_DRAIN = false, HOOK = false; static constexpr int NST = 16; typedef NoState State;
    bf16_t* U; int probe_skip;
    __device__ __forceinline__ void operator()(const f32x4 (&acc)[2][2][4][2], const Unit& u, int wr, int wc, int fr, int fq, NoState&) const {
        const int row0 = u.pm * BM + wr * 64 + fr, col0 = u.pn * BM + wc * 32 + 8 * fq;
        if (probe_skip == 2) return;
        const __amdgpu_buffer_rsrc_t rsU = mk_rs(U);
#pragma unroll
        for (int ai = 0; ai < 2; ++ai)
#pragma unroll
            for (int m = 0; m < 4; ++m) { const unsigned rowb = (unsigned)(row0 + ai * HALF + m * 16) * 2048u + (unsigned)col0 * 2u;
#pragma unroll
                for (int bj = 0; bj < 2; ++bj) st16<AUX_G>(rsU, rowb + bj * HALF * 2, pack8(acc[ai][bj][m][0], acc[ai][bj][m][1])); }
    }
};
__device__ __forceinline__ float clamp448(float x) { return fminf(fmaxf(x, -448.0f), 448.0f); }
__device__ __forceinline__ unsigned pk4_fp8(float a, float b, float c, float d) { unsigned w = __float_as_uint(a);   w = __builtin_amdgcn_cvt_pk_fp8_f32(clamp448(a), clamp448(b), w, false); w = __builtin_amdgcn_cvt_pk_fp8_f32(clamp448(c), clamp448(d), w, true); return w; }
__device__ __forceinline__ unsigned pk4_fp8_nc(float a, float b, float c, float d) { unsigned w = __float_as_uint(a); w = __builtin_amdgcn_cvt_pk_fp8_f32(a, b, w, false); w = __builtin_amdgcn_cvt_pk_fp8_f32(c, d, w, true); return w; }
struct EpiSwiglu {
    static constexpr bool PERM = true, AFTER_DRAIN = false, HOOK = false; static constexpr int NST = 8; typedef NoState State;
    unsigned char* A2; const float* b1; float inv, oscale; int probe_skip;
    __device__ __forceinline__ void operator()(const f32x4 (&acc)[2][2][4][2], const Unit& u, int wr, int wc, int fr, int fq, NoState&) const {
        asm volatile("" ::: "memory");
        if (probe_skip == 2) return;
        const int row0 = u.pm * BM + wr * 64 + fr, j0 = u.pn * HALF + wc * 32 + 8 * fq;
        const float* bp = b1 + (size_t)u.e * 2048 + 2 * j0;
        const __amdgpu_buffer_rsrc_t rsA2 = mk_rs(A2);
        float bg[8], bu[8];
#pragma unroll
        for (int q = 0; q < 4; ++q) { const f32x4 t = *(const f32x4*)(bp + 4 * q); bg[2 * q] = t[0]; bu[2 * q] = t[1]; bg[2 * q + 1] = t[2]; bu[2 * q + 1] = t[3]; }
#pragma unroll
        for (int ai = 0; ai < 2; ++ai)
#pragma unroll
            for (int m = 0; m < 4; ++m) {
                float o[8];
#pragma unroll
                for (int e = 0; e < 8; ++e) {
                    float g = acc[ai][0][m][e >> 2][e & 3] * inv + bg[e], up = acc[ai][1][m][e >> 2][e & 3] * inv + bu[e];
                    g = fminf(g, 7.0f); up = fminf(fmaxf(up, -7.0f), 7.0f);
                    o[e] = __builtin_fmaf(up, oscale, oscale) * (g * __builtin_amdgcn_rcpf(1.0f + __builtin_amdgcn_exp2f(g * (-1.702f * 1.4426950408889634f)))); }
                u32x2 w; w.x = pk4_fp8_nc(o[0], o[1], o[2], o[3]); w.y = pk4_fp8_nc(o[4], o[5], o[6], o[7]);
                st8<AUX_J>(rsA2, (unsigned)(row0 + ai * HALF + m * 16) * 1024u + (unsigned)j0, w); }
    }
};
struct EpiMoeOut {
    static constexpr bool PERM = true, AFTER_DRAIN = false, HOOK = false; static constexpr int NST = 16; typedef NoState State;
    bf16_t* YS; const float* b2; const float* slotw; float inv; int probe_skip;
    __device__ __forceinline__ void operator()(const f32x4 (&acc)[2][2][4][2], const Unit& u, int wr, int wc, int fr, int fq, NoState&) const {
        const int row0 = u.pm * BM + wr * 64 + fr, col0 = u.pn * BM + wc * 32 + 8 * fq;
        if (probe_skip == 2) return;
        if (probe_skip == 5) { const __amdgpu_buffer_rsrc_t rsZ = mk_rs((const unsigned char*)YS - WS_YS + WS_MRG);
#pragma unroll
            for (int ai = 0; ai < 2; ++ai)
#pragma unroll
                for (int m = 0; m < 4; ++m) { const unsigned row = (unsigned)(row0 + ai * HALF + m * 16) % 34816u;
#pragma unroll
                    for (int bj = 0; bj < 2; ++bj) st16<0>(rsZ, row * 2048u + (unsigned)(col0 + bj * HALF) * 2u, pack8(acc[ai][bj][m][0] * inv, acc[ai][bj][m][1] * inv)); }
            return; }
        const float* bp = b2 + (size_t)u.e * 1024 + col0;
        const __amdgpu_buffer_rsrc_t rsY = mk_rs(YS);
        f32x4 bv[2][2];
#pragma unroll
        for (int bj = 0; bj < 2; ++bj)
#pragma unroll
            for (int n = 0; n < 2; ++n) bv[bj][n] = *(const f32x4*)(bp + bj * HALF + 4 * n);
#pragma unroll
        for (int ai = 0; ai < 2; ++ai)
#pragma unroll
            for (int m = 0; m < 4; ++m) { const size_t row = (size_t)(row0 + ai * HALF + m * 16); const float w = slotw[row];
#pragma unroll
                for (int bj = 0; bj < 2; ++bj) st16<AUX_K>(rsY, (unsigned)row * 2048u + (unsigned)(col0 + bj * HALF) * 2u, pack8((acc[ai][bj][m][0] * inv + bv[bj][0]) * w, (acc[ai][bj][m][1] * inv + bv[bj][1]) * w)); }
    }
};

template <class Epi, class Sched, bool ALIGN_EPI = false, bool SP2 = false, bool F8 = false>
__device__ __forceinline__ void gemm_phase(PG8_LAS unsigned char* lds, const Gemm g, const Sched& S, const Epi& E, int wave_index) {
    unsigned msk_ = ~0u; asm volatile("" : "+s"(msk_)); const int tid_ = (wave_index << 6) | (int)__builtin_amdgcn_mbcnt_hi(msk_, __builtin_amdgcn_mbcnt_lo(msk_, 0u));
    const int tid = tid_, wid = __builtin_amdgcn_readfirstlane(tid >> 6), lane = tid & 63, wr = wid >> 2, wc = wid & 3, fr = lane & 15, fq = lane >> 4;
    const int K = g.K, nt = K / BK;
    unsigned voffA[2], voffB[2];
#pragma unroll
    for (int i = 0; i < 2; ++i) { int R, C; stage_rc(tid * 16 + i * 8192, R, C); const int Rb = Epi::PERM ? ((R & ~31) + perm32(R & 31)) : R;
        voffA[i] = (unsigned)(R * K + C) * 2u; voffB[i] = (unsigned)(Rb * K + C) * 2u; }
    const unsigned kstep = (unsigned)(BK * 2);
    const unsigned hstep = (unsigned)HALF * (unsigned)K * 2u;
    const unsigned tstep = 2u * hstep;
    const unsigned ldsw = (unsigned)wid * 1024u;
    const int aoff = lds_byte(wr * 64 + fr, fq * 8), boff = lds_byte(wc * 32 + fr, fq * 8);
#define PG8_SA(b, h) (((b) * 2 + (h)) * HTB)
#define PG8_SB(b, h) ((4 + (b) * 2 + (h)) * HTB)
#define PG8_RS_voffA rsA
#define PG8_RS_voffB rsB
#define PG8_STAGE(bufoff, gbase, voff) do { _Pragma("unroll") for (int _i = 0; _i < 2; ++_i) \
        __builtin_amdgcn_raw_ptr_buffer_load_lds(PG8_RS_##voff, (PG8_LAS void*)(lds + (bufoff) + ldsw + _i * 8192), 16, (voff)[_i], (gbase), 0, 0); } while (0)
#define PG8_LDA(dst, b, h) do { _Pragma("unroll") for (int m = 0; m < 4; ++m) _Pragma("unroll") for (int k = 0; k < 2; ++k) dst[m][k] = *(const PG8_LAS bf16x8*)(lds + PG8_SA(b, h) + aoff + m * 2048 + k * 1024); } while (0)
#define PG8_LDB(dst, b, h) do { _Pragma("unroll") for (int n = 0; n < 2; ++n) _Pragma("unroll") for (int k = 0; k < 2; ++k) dst[n][k] = *(const PG8_LAS bf16x8*)(lds + PG8_SB(b, h) + boff + n * 2048 + k * 1024); } while (0)
#define PG8_CAT(x) __builtin_shufflevector(__builtin_bit_cast(v4i_t, (x)[0]), __builtin_bit_cast(v4i_t, (x)[1]), 0, 1, 2, 3, 4, 5, 6, 7)
#define PG8_MMA(ai, bj, At, Bt) do { __builtin_amdgcn_s_setprio(1); _Pragma("unroll") for (int m = 0; m < 4; ++m) _Pragma("unroll") for (int n = 0; n < 2; ++n) { \
        if constexpr (F8) acc[ai][bj][m][n] = __builtin_amdgcn_mfma_scale_f32_16x16x128_f8f6f4(PG8_CAT(Bt[n]), PG8_CAT(At[m]), acc[ai][bj][m][n], 0, 0, 0, 0x7f7f7f7f, 0, 0x7f7f7f7f); \
        else { _Pragma("unroll") for (int k = 0; k < 2; ++k) acc[ai][bj][m][n] = __builtin_amdgcn_mfma_f32_16x16x32_bf16(Bt[n][k], At[m][k], acc[ai][bj][m][n], 0, 0, 0); } } __builtin_amdgcn_s_setprio(0); } while (0)
#define PG8_WAIT_V(n) asm volatile("s_waitcnt vmcnt(" #n ")" ::: "memory")
#define PG8_WAIT_L(n) asm volatile("s_waitcnt lgkmcnt(" #n ")" ::: "memory")
#define PG8_BAR __builtin_amdgcn_s_barrier()
#define PG8_SCHED __builtin_amdgcn_sched_barrier(0)
    Unit cur, nxt; int ui = 0;
    typename Epi::State est;
    if (!S.next(0, cur)) return;
    f32x4 acc[2][2][4][2];
#pragma unroll
    for (int a = 0; a < 2; ++a)
#pragma unroll
        for (int b = 0; b < 2; ++b)
#pragma unroll
            for (int m = 0; m < 4; ++m)
#pragma unroll
                for (int n = 0; n < 2; ++n) { f32x4 z_; asm volatile("v_mov_b32 %0, 0\n\tv_mov_b32 %1, 0\n\tv_mov_b32 %2, 0\n\tv_mov_b32 %3, 0" : "=v"(z_[0]), "=v"(z_[1]), "=v"(z_[2]), "=v"(z_[3])); acc[a][b][m][n] = z_; }
    bf16x8 At[4][2], B0[2][2], B1[2][2];
    const __amdgpu_buffer_rsrc_t rsA = __builtin_amdgcn_make_buffer_rsrc((void*)g.A, 0, -1, 0x00020000), rsB = __builtin_amdgcn_make_buffer_rsrc((void*)g.Bt, 0, -1, 0x00020000);
    unsigned cA = (unsigned)cur.pm * tstep, cB = (unsigned)cur.e * (unsigned)g.bstride + (unsigned)cur.pn * tstep;
    S.a_ready(cur);
    if constexpr (SP2) {
        PG8_STAGE(PG8_SB(0, 0), cB, voffB); PG8_STAGE(PG8_SB(0, 1), cB + hstep, voffB); PG8_STAGE(PG8_SA(0, 0), cA, voffA); PG8_STAGE(PG8_SA(0, 1), cA + hstep, voffA);
        if (wr == 1) PG8_BAR;
        PG8_WAIT_V(2); PG8_BAR;
        PG8_STAGE(PG8_SB(1, 0), cB + kstep, voffB); PG8_STAGE(PG8_SA(1, 0), cA + kstep, voffA); PG8_STAGE(PG8_SB(1, 1), cB + hstep + kstep, voffB);
        PG8_WAIT_V(6); PG8_BAR;
    } else {
        PG8_STAGE(PG8_SB(0, 0), cB, voffB); PG8_STAGE(PG8_SA(0, 0), cA, voffA); PG8_STAGE(PG8_SB(0, 1), cB + hstep, voffB); PG8_STAGE(PG8_SA(0, 1), cA + hstep, voffA);
        if (wr == 1) PG8_BAR;
        PG8_WAIT_V(4); PG8_BAR;
        PG8_STAGE(PG8_SB(1, 0), cB + kstep, voffB); PG8_STAGE(PG8_SA(1, 0), cA + kstep, voffA); PG8_STAGE(PG8_SB(1, 1), cB + hstep + kstep, voffB);
        PG8_WAIT_V(6); PG8_BAR;
    }
    for (;;) {
        const bool has_next = S.next(ui + 1, nxt);
        const unsigned nA = has_next ? (unsigned)nxt.pm * tstep : cA, nB = has_next ? (unsigned)nxt.e * (unsigned)g.bstride + (unsigned)nxt.pn * tstep : cB;
#pragma clang loop unroll(disable)
        for (int t = 0; t < nt; t += 2) {
            if constexpr (Epi::HOOK) { if (t > 0 && (t & 7) == 0) { if (wr == 0) PG8_BAR; E.hook(acc, cur, t >> 3, wr, wc, lane, est); if (wr == 1) PG8_BAR; } }
            const bool last = (t == nt - 2);
            const unsigned a1 = cA + (unsigned)(t + 1) * kstep;
            const unsigned a2 = last ? nA : cA + (unsigned)(t + 2) * kstep, b2 = last ? nB : cB + (unsigned)(t + 2) * kstep;
            const unsigned a3 = a2 + kstep, b3 = b2 + kstep;
            if (last && has_next) S.a_ready(nxt);
            if constexpr (SP2) {
            PG8_LDB(B0, 0, 0); PG8_LDB(B1, 0, 1); PG8_SCHED; PG8_LDA(At, 0, 0); PG8_STAGE(PG8_SA(1, 1), a1 + hstep, voffA);
            PG8_WAIT_V(8); PG8_WAIT_L(0); PG8_BAR; PG8_MMA(0, 0, At, B0); PG8_MMA(0, 1, At, B1); PG8_BAR; PG8_SCHED;
            PG8_LDA(At, 0, 1); PG8_STAGE(PG8_SB(0, 0), b2, voffB); PG8_STAGE(PG8_SB(0, 1), b2 + hstep, voffB); PG8_STAGE(PG8_SA(0, 0), a2, voffA);
            PG8_WAIT_V(8); PG8_WAIT_L(0); PG8_BAR; PG8_MMA(1, 0, At, B0); PG8_MMA(1, 1, At, B1); PG8_BAR; PG8_SCHED;
            PG8_LDB(B0, 1, 0); PG8_LDB(B1, 1, 1); PG8_SCHED; PG8_LDA(At, 1, 0); PG8_STAGE(PG8_SA(0, 1), a2 + hstep, voffA);
            PG8_WAIT_V(8); PG8_WAIT_L(0); PG8_BAR; PG8_MMA(0, 0, At, B0); PG8_MMA(0, 1, At, B1); PG8_BAR; PG8_SCHED;
            PG8_LDA(At, 1, 1); PG8_STAGE(PG8_SB(1, 0), b3, voffB); PG8_STAGE(PG8_SB(1, 1), b3 + hstep, voffB); PG8_STAGE(PG8_SA(1, 0), a3, voffA);
            PG8_WAIT_V(8); PG8_WAIT_L(0); PG8_BAR; PG8_MMA(1, 0, At, B0); PG8_MMA(1, 1, At, B1); PG8_BAR; PG8_SCHED;
            } else {
            PG8_LDB(B0, 0, 0); PG8_SCHED; PG8_LDA(At, 0, 0); PG8_STAGE(PG8_SA(1, 1), a1 + hstep, voffA);
            PG8_WAIT_L(8); PG8_BAR; PG8_WAIT_L(0); PG8_MMA(0, 0, At, B0); PG8_BAR; PG8_SCHED;
            PG8_LDB(B1, 0, 1); PG8_STAGE(PG8_SB(0, 0), b2, voffB);
            PG8_BAR; PG8_WAIT_L(0); PG8_MMA(0, 1, At, B1); PG8_BAR;
            PG8_LDA(At, 0, 1); PG8_STAGE(PG8_SA(0, 0), a2, voffA);
            PG8_BAR; PG8_WAIT_L(0); PG8_MMA(1, 0, At, B0); PG8_BAR; PG8_SCHED;
            PG8_STAGE(PG8_SB(0, 1), b2 + hstep, voffB);
            PG8_WAIT_V(6); PG8_BAR; PG8_MMA(1, 1, At, B1); PG8_BAR;
            PG8_LDB(B0, 1, 0); PG8_SCHED; PG8_LDA(At, 1, 0); PG8_STAGE(PG8_SA(0, 1), a2 + hstep, voffA);
            PG8_WAIT_L(8); PG8_BAR; PG8_WAIT_L(0); PG8_MMA(0, 0, At, B0); PG8_BAR; PG8_SCHED;
            PG8_LDB(B1, 1, 1); PG8_STAGE(PG8_SB(1, 0), b3, voffB);
            PG8_BAR; PG8_WAIT_L(0); PG8_MMA(0, 1, At, B1); PG8_BAR;
            PG8_LDA(At, 1, 1); PG8_STAGE(PG8_SA(1, 0), a3, voffA);
            PG8_BAR; PG8_WAIT_L(0); PG8_MMA(1, 0, At, B0); PG8_BAR; PG8_SCHED;
            PG8_STAGE(PG8_SB(1, 1), b3 + hstep, voffB);
            PG8_WAIT_V(6); PG8_BAR; PG8_MMA(1, 1, At, B1); PG8_BAR;
            }
        }
        if constexpr (ALIGN_EPI) { if (wr == 0) PG8_BAR; }
        if constexpr (!Epi::AFTER_DRAIN) { unsigned m2_ = ~0u; asm volatile("" : "+s"(m2_)); const int le_ = (int)__builtin_amdgcn_mbcnt_hi(m2_, __builtin_amdgcn_mbcnt_lo(m2_, 0u));
            E(acc, cur, wr, wc, le_ & 15, le_ >> 4, est); S.done(cur); }
        if (!has_next) break;
#pragma unroll
        for (int a = 0; a < 2; ++a)
#pragma unroll
            for (int b = 0; b < 2; ++b)
#pragma unroll
                for (int m = 0; m < 4; ++m)
#pragma unroll
                    for (int n = 0; n < 2; ++n) { f32x4 z_; asm volatile("v_mov_b32 %0, 0\n\tv_mov_b32 %1, 0\n\tv_mov_b32 %2, 0\n\tv_mov_b32 %3, 0" : "=v"(z_[0]), "=v"(z_[1]), "=v"(z_[2]), "=v"(z_[3])); acc[a][b][m][n] = z_; }
        cur = nxt; cA = nA; cB = nB; ++ui;
        if constexpr (ALIGN_EPI) { if (wr == 1) PG8_BAR; }
    }
    PG8_WAIT_V(0);
    if constexpr (!ALIGN_EPI) { if (wr == 0) PG8_BAR; }
    PG8_BAR;
    if constexpr (Epi::AFTER_DRAIN) { E.fused(acc, cur, wr, wc, fr, fq, lds, wid, lane); S.done(cur); }
#undef PG8_SA
#undef PG8_SB
#undef PG8_STAGE
#undef PG8_RS_voffA
#undef PG8_RS_voffB
#undef PG8_LDA
#undef PG8_LDB
#undef PG8_MMA
#undef PG8_CAT
#undef PG8_WAIT_V
#undef PG8_WAIT_L
#undef PG8_BAR
#undef PG8_SCHED
}
}
namespace attn_body {
using bf16=__hip_bfloat16;
using bf16x8=__attribute__((ext_vector_type(8)))short;
using s16x4=__attribute__((ext_vector_type(4)))short;
using f32x16=__attribute__((ext_vector_type(16)))float;
using u32x4=__attribute__((ext_vector_type(4)))unsigned;
constexpr int D=64,QP=512,KP=128,OP=1536;
constexpr int NW=8,QBLK=32,QB=QBLK*NW,KVBLK=64;
constexpr int ATTN_UNIT_ROWS=QB;
__device__ __forceinline__ int crow(int r,int hi){return (r&3)+8*(r>>2)+4*hi;}
#define SBAR() __builtin_amdgcn_sched_barrier(0)
__device__ __forceinline__ void cmask(f32x16&p0,f32x16&p1,int jb,int qrel,int hi){
  const float NEG=-INFINITY; int kb=64*jb+4*hi;
  #pragma unroll
  for(int r=0;r<16;++r){int kv=kb+(r&3)+8*(r>>2); if(kv>qrel)p0[r]=NEG; if(kv+32>qrel)p1[r]=NEG;}
}

constexpr int NSLOT=3, SLOTB=8192;
constexpr int LDS_K=0, LDS_V=NSLOT*SLOTB, LDS_WS=2*NSLOT*SLOTB, LDS_OST=LDS_WS+NW*64*4, LDS_BYTES=LDS_OST+NW*4096;
constexpr float C2=0.125f*1.4426950408889634f;
__device__ __forceinline__ void glds16(const void*gsrc,unsigned lds_dst){unsigned keep;
  asm volatile("s_mov_b32 %0, m0\n\ts_mov_b32 m0, %2\n\ts_nop 0\n\tglobal_load_lds_dwordx4 %1, off\n\ts_mov_b32 m0, %0":"=&s"(keep):"v"(gsrc),"s"(lds_dst):"memory");}
__device__ __forceinline__ float max3f(float a,float b,float c){float r;asm("v_max3_f32 %0, %1, %2, %3":"=v"(r):"v"(a),"v"(b),"v"(c));return r;}
__device__ __forceinline__ float max2f(float a,float b){float r;asm("v_max_f32_e32 %0, %1, %2":"=v"(r):"v"(a),"v"(b));return r;}
__device__ __forceinline__ float fadd_s(float a,float b){float r;asm("v_add_f32_e32 %0, %1, %2":"=v"(r):"v"(a),"v"(b));return r;}
__device__ __forceinline__ float fsub_s(float a,float b){float r;asm("v_sub_f32_e32 %0, %1, %2":"=v"(r):"v"(a),"v"(b));return r;}
typedef float f32x2_t __attribute__((ext_vector_type(2))); typedef __bf16 bf16x2_t __attribute__((ext_vector_type(2)));
__device__ __forceinline__ unsigned cvtpk_s(float lo,float hi){f32x2_t v={lo,hi};bf16x2_t b=__builtin_convertvector(v,bf16x2_t);return __builtin_bit_cast(unsigned,b);}
#define WAIT_BAR(N) asm volatile("s_waitcnt vmcnt(" #N ") lgkmcnt(0)\n\ts_barrier":::"memory")

__device__ __forceinline__ void qkt(f32x16&p0,f32x16&p1,const char*Kslot,const bf16x8*qr,const f32x16&negm,int r32,int hi){
  const char*kb=Kslot+hi*1024+r32*16;
  #pragma unroll
  for(int d0=0;d0<4;++d0){
    const bf16x8 b0=*reinterpret_cast<const bf16x8*>(kb+d0*2048);
    const bf16x8 b1=*reinterpret_cast<const bf16x8*>(kb+d0*2048+512);
    if(d0==0){p0=__builtin_amdgcn_mfma_f32_32x32x16_bf16(b0,qr[0],negm,0,0,0);p1=__builtin_amdgcn_mfma_f32_32x32x16_bf16(b1,qr[0],negm,0,0,0);}
    else{p0=__builtin_amdgcn_mfma_f32_32x32x16_bf16(b0,qr[d0],p0,0,0,0);p1=__builtin_amdgcn_mfma_f32_32x32x16_bf16(b1,qr[d0],p1,0,0,0);}}
}
typedef __attribute__((address_space(3))) const char* lds_cptr;
typedef short v4i16_t __attribute__((ext_vector_type(4)));
__device__ __forceinline__ void kload8(bf16x8*kf,lds_cptr kp){
  kf[0]=*(const __attribute__((address_space(3))) bf16x8*)(kp);      kf[1]=*(const __attribute__((address_space(3))) bf16x8*)(kp+512);
  kf[2]=*(const __attribute__((address_space(3))) bf16x8*)(kp+2048); kf[3]=*(const __attribute__((address_space(3))) bf16x8*)(kp+2560);
  kf[4]=*(const __attribute__((address_space(3))) bf16x8*)(kp+4096); kf[5]=*(const __attribute__((address_space(3))) bf16x8*)(kp+4608);
  kf[6]=*(const __attribute__((address_space(3))) bf16x8*)(kp+6144); kf[7]=*(const __attribute__((address_space(3))) bf16x8*)(kp+6656);
}
__device__ __forceinline__ void kload2(bf16x8*kf,lds_cptr kp,int j){ kf[2*j]=*(const __attribute__((address_space(3))) bf16x8*)(kp+j*2048); kf[2*j+1]=*(const __attribute__((address_space(3))) bf16x8*)(kp+j*2048+512); }
__device__ __forceinline__ s16x4 vtr(lds_cptr p){ return __builtin_bit_cast(s16x4,__builtin_amdgcn_ds_read_tr16_b64_v4i16((__attribute__((address_space(3))) v4i16_t*)p)); }
__device__ __forceinline__ float rowmax(const f32x16&p0,const f32x16&p1){
  float a=max3f(p0[0],p0[1],p1[0]),b=max3f(p0[2],p0[3],p1[1]);a=max3f(a,p1[2],p1[3]);
  #pragma unroll
  for(int r=4;r<16;r+=4){a=max3f(a,p0[r],p0[r+1]);b=max3f(b,p0[r+2],p0[r+3]);a=max3f(a,p1[r],p1[r+1]);b=max3f(b,p1[r+2],p1[r+3]);}
  const float m=max2f(a,b);
  auto rr=__builtin_amdgcn_permlane32_swap(__float_as_uint(m),__float_as_uint(m),false,false);
  return max2f(__uint_as_float(rr[0]),__uint_as_float(rr[1]));
}
__device__ __forceinline__ void pv(f32x16*o,int vb,bf16x8 pa0,bf16x8 pa1,bf16x8 pa2,bf16x8 pa3){
  #pragma unroll
  for(int d0=0;d0<2;++d0){s16x4 lo[4],hi[4];
    #pragma unroll
    for(int ks=0;ks<4;++ks){
      asm volatile("ds_read_b64_tr_b16 %0,%1 offset:%c2":"=&v"(lo[ks]):"v"(vb),"i"(d0*4096+ks*1024):"memory");
      asm volatile("ds_read_b64_tr_b16 %0,%1 offset:%c2":"=&v"(hi[ks]):"v"(vb),"i"(d0*4096+ks*1024+512):"memory");}
    asm volatile("s_waitcnt lgkmcnt(0)":::"memory");SBAR();
    #define PK(k) (bf16x8){lo[k][0],lo[k][1],lo[k][2],lo[k][3],hi[k][0],hi[k][1],hi[k][2],hi[k][3]}
    o[d0]=__builtin_amdgcn_mfma_f32_32x32x16_bf16(pa0,PK(0),o[d0],0,0,0);
    o[d0]=__builtin_amdgcn_mfma_f32_32x32x16_bf16(pa1,PK(1),o[d0],0,0,0);
    o[d0]=__builtin_amdgcn_mfma_f32_32x32x16_bf16(pa2,PK(2),o[d0],0,0,0);
    o[d0]=__builtin_amdgcn_mfma_f32_32x32x16_bf16(pa3,PK(3),o[d0],0,0,0);
    #undef PK
  }
}

#ifndef ATTN_STORE16
#define ATTN_STORE16(p,v) (*(u32x4*)(p)=(v))
#endif
template<int THRL> __device__ __forceinline__ void attn_unit(long qrow0,int h,int NT,const bf16*Q,const bf16*__restrict__ Kh,const bf16*__restrict__ Vh,bf16*O,char*shm,int wave_index){
  unsigned msk_=~0u; asm volatile("":"+s"(msk_)); const int tid=(wave_index<<6)|(int)__builtin_amdgcn_mbcnt_hi(msk_,__builtin_amdgcn_mbcnt_lo(msk_,0u)),lane=tid&63,r32=lane&31,hi=lane>>5; const int wid=__builtin_amdgcn_readfirstlane(tid>>6);
  const bf16*Qw=Q+(qrow0+wid*QBLK)*QP+h*D;
  const unsigned lds0=(unsigned)(uintptr_t)shm;
  float*wsf=(float*)(shm+LDS_WS)+wid*64;
  const bf16*ksrc=Kh+(long)lane*KP+wid*8;
  const bf16*vsrc=Vh+(long)(16*(wid&3)+(lane>>2))*KP+(wid>>2)*32+(lane&3)*8;
  const unsigned kdst=lds0+LDS_K+wid*1024, vdst=lds0+LDS_V+wid*1024;
  #define DMA_K(t,slot) glds16(ksrc+(long)(t)*KVBLK*KP,(unsigned)__builtin_amdgcn_readfirstlane(kdst+(slot)))
  #define DMA_V(t,slot) glds16(vsrc+(long)(t)*KVBLK*KP,(unsigned)__builtin_amdgcn_readfirstlane(vdst+(slot)))
  const int vb0=(int)(lds0+LDS_V)+((lane>>4)&1)*32+(lane&3)*8+(4*hi+((lane&15)>>2))*64;
  const char*Kbase=shm+LDS_K; bf16x8 kf[8];
  const lds_cptr shm3=(lds_cptr)shm; const lds_cptr kp0=shm3+LDS_K+hi*1024+r32*16; const lds_cptr vp0=shm3+LDS_V+((lane>>4)&1)*32+(lane&3)*8+(4*hi+((lane&15)>>2))*64;
  DMA_K(0,0);DMA_V(0,0);DMA_K(1,SLOTB);
  bf16x8 qr[4];
  #pragma unroll
  for(int d0=0;d0<4;++d0)qr[d0]=*reinterpret_cast<const bf16x8*>(&Qw[(long)r32*QP+d0*16+hi*8]);
  float mhat=0.f,l_reg=0.f;f32x16 o[2],negm; { float zz=0.f; asm volatile("":"+v"(zz));
    _Pragma("unroll") for(int r=0;r<16;++r){o[0][r]=zz;o[1][r]=zz;negm[r]=zz;} } asm volatile("":"+v"(negm));
  #define CMASK(P0,P1,t) do{}while(0)
  bool resc=false;
  #define START(P0,P1) do{ const float rm=rowmax(P0,P1); resc=false; \
    { const float dl=rm; mhat=fadd_s(mhat,dl); \
      _Pragma("unroll") for(int r=0;r<16;++r){P0[r]=fsub_s(P0[r],dl);P1[r]=fsub_s(P1[r],dl);} \
      _Pragma("unroll") for(int r=0;r<16;++r)negm[r]=-mhat; asm volatile("":"+v"(negm)); } \
    _Pragma("unroll") for(int r=0;r<16;++r)P0[r]=__builtin_amdgcn_exp2f(P0[r]); }while(0)
  #define RESC() do{ if(resc){ asm volatile("s_waitcnt lgkmcnt(0)":::"memory"); \
      _Pragma("unroll") for(int d_=0;d_<2;++d_) _Pragma("unroll") for(int r=0;r<16;++r)o[d_][r]*=wsf[crow(r,hi)]; } }while(0)
  f32x16 pA0,pA1,pB0,pB1;
  int sl_prev=0,sl_cur=0,sl_next=SLOTB;
  #define ROT() do{sl_prev=sl_cur;sl_cur=sl_next;sl_next=(sl_next==(NSLOT-1)*SLOTB)?0:sl_next+SLOTB;}while(0)
  DMA_K(2,2*SLOTB);
  WAIT_BAR(3);
  qkt(pA0,pA1,Kbase,qr,negm,r32,hi);asm volatile("s_nop 15\n\ts_nop 7":"+v"(pA0),"+v"(pA1));CMASK(pA0,pA1,0);
  START(pA0,pA1);
  _Pragma("unroll") for(int r=0;r<16;++r)pA1[r]=__builtin_amdgcn_exp2f(pA1[r]);
  WAIT_BAR(0);
  DMA_K(3,0);DMA_V(1,SLOTB);
  ROT();
  kload8(kf,kp0+sl_cur);
  WAIT_BAR(2);
  s16x4 vlo[8],vhi[8]; u32x4 pw0,pw1,pw2,pw3;
  #define PKW(P,B) cvtpk_s(P[B],P[B+1])
  #define PAF(k) __builtin_bit_cast(bf16x8,pw##k)
  #define VFR(i) (bf16x8){vlo[i][0],vlo[i][1],vlo[i][2],vlo[i][3],vhi[i][0],vhi[i][1],vhi[i][2],vhi[i][3]}
  #define PIN(x) asm volatile("":"+v"(x))
  #define MX3(a,b,c) __builtin_fmaxf(__builtin_fmaxf((a),(b)),(c))
  #define GAPA(MF,A0,A1,A2,A3,W0,W1,PW) do{ MF; sacc+=A0; sacc+=A1; sacc+=A2; sacc+=A3; PIN(sacc); W0; W1; PIN(PW); SBAR(); }while(0)
  #define EX(v) __builtin_amdgcn_exp2f(v)
  #define GAPB(MF,X,B) do{ MF; X[B]=EX(X[B]); X[B+1]=EX(X[B+1]); X[B+2]=EX(X[B+2]); X[B+3]=EX(X[B+3]); PIN(X); SBAR(); }while(0)
  #define VRD(i) do{ vlo[i]=vtr(vp_+(((i)>>2)*4096+((i)&3)*1024)); vhi[i]=vtr(vp_+(((i)>>2)*4096+((i)&3)*1024+512)); }while(0)
  #define KRD(G,j) do{ if(G){ kload2(kf,kp0+sl_next,j); SBAR(); } }while(0)
  #define STEP(C0,C1,P0,P1,t,GK,GV,GL) do{ SBAR(); \
    const lds_cptr vp_=vp0+sl_prev; \
    VRD(0); SBAR(); float sacc=(P0[0]+P0[1]); \
    GAPA(C0=__builtin_amdgcn_mfma_f32_32x32x16_bf16(kf[0],qr[0],negm,0,0,0), P0[2],P0[3],P0[4],P0[5],     pw0[0]=PKW(P0,0), pw0[1]=PKW(P0,2), pw0); \
    VRD(4); SBAR(); GAPA(C1=__builtin_amdgcn_mfma_f32_32x32x16_bf16(kf[1],qr[0],negm,0,0,0), P0[6],P0[7],P0[8],P0[9],     pw0[2]=PKW(P0,4), pw0[3]=PKW(P0,6), pw0); \
    VRD(1); SBAR(); GAPA(C0=__builtin_amdgcn_mfma_f32_32x32x16_bf16(kf[2],qr[1],C0,0,0,0),   P0[10],P0[11],P0[12],P0[13], pw1[0]=PKW(P0,8), pw1[1]=PKW(P0,10), pw1); \
    VRD(5); SBAR(); GAPA(C1=__builtin_amdgcn_mfma_f32_32x32x16_bf16(kf[3],qr[1],C1,0,0,0),   P0[14],P0[15],P1[0],P1[1],   pw1[2]=PKW(P0,12),pw1[3]=PKW(P0,14), pw1); \
    VRD(2); SBAR(); GAPA(C0=__builtin_amdgcn_mfma_f32_32x32x16_bf16(kf[4],qr[2],C0,0,0,0),   P1[2],P1[3],P1[4],P1[5],     pw2[0]=PKW(P1,0), pw2[1]=PKW(P1,2), pw2); \
    VRD(6); SBAR(); GAPA(C1=__builtin_amdgcn_mfma_f32_32x32x16_bf16(kf[5],qr[2],C1,0,0,0),   P1[6],P1[7],P1[8],P1[9],     pw2[2]=PKW(P1,4), pw2[3]=PKW(P1,6), pw2); \
    VRD(3); SBAR(); GAPA(C0=__builtin_amdgcn_mfma_f32_32x32x16_bf16(kf[6],qr[3],C0,0,0,0),   P1[10],P1[11],P1[12],P1[13], pw3[0]=PKW(P1,8), pw3[1]=PKW(P1,10), pw3); \
    VRD(7); SBAR(); GAPA(C1=__builtin_amdgcn_mfma_f32_32x32x16_bf16(kf[7],qr[3],C1,0,0,0),   P1[14],P1[15],0.f,0.f,       pw3[2]=PKW(P1,12),pw3[3]=PKW(P1,14), pw3); \
    l_reg+=sacc; \
    if(GK){DMA_K((t)+3,sl_cur);} if(GV){DMA_V((t)+1,sl_next);} \
    CMASK(C0,C1,t); \
    { float a=MX3(C0[0],C0[1],C1[0]),b=MX3(C0[2],C0[3],C1[1]); a=MX3(a,C1[2],C1[3]); \
      _Pragma("unroll") for(int r=4;r<16;r+=4){a=MX3(a,C0[r],C0[r+1]);b=MX3(b,C0[r+2],C0[r+3]);a=MX3(a,C1[r],C1[r+1]);b=MX3(b,C1[r+2],C1[r+3]);} \
      float rm=__builtin_fmaxf(a,b); { auto rr=__builtin_amdgcn_permlane32_swap(__float_as_uint(rm),__float_as_uint(rm),false,false); rm=__builtin_fmaxf(__uint_as_float(rr[0]),__uint_as_float(rr[1])); } \
      resc=false; \
      if(__builtin_expect(__any(rm>(float)THRL),0)){ const float dl=__builtin_fmaxf(rm,0.f); mhat+=dl; \
        _Pragma("unroll") for(int r=0;r<16;++r){C0[r]-=dl;C1[r]-=dl;} \
        _Pragma("unroll") for(int r=0;r<16;++r)negm[r]=-mhat; asm volatile("":"+v"(negm)); \
        const float f=__builtin_amdgcn_exp2f(-dl); l_reg*=f; if(hi==0)wsf[r32]=f; resc=true; } } \
    SBAR(); \
    GAPB(o[0]=__builtin_amdgcn_mfma_f32_32x32x16_bf16(PAF(0),VFR(0),o[0],0,0,0), C0,0); \
    GAPB(o[1]=__builtin_amdgcn_mfma_f32_32x32x16_bf16(PAF(0),VFR(4),o[1],0,0,0), C0,4); \
    KRD(GL,0); GAPB(o[0]=__builtin_amdgcn_mfma_f32_32x32x16_bf16(PAF(1),VFR(1),o[0],0,0,0), C0,8); \
    KRD(GL,1); GAPB(o[1]=__builtin_amdgcn_mfma_f32_32x32x16_bf16(PAF(1),VFR(5),o[1],0,0,0), C0,12); \
    KRD(GL,2); GAPB(o[0]=__builtin_amdgcn_mfma_f32_32x32x16_bf16(PAF(2),VFR(2),o[0],0,0,0), C1,0); \
    KRD(GL,3); GAPB(o[1]=__builtin_amdgcn_mfma_f32_32x32x16_bf16(PAF(2),VFR(6),o[1],0,0,0), C1,4); \
    GAPB(o[0]=__builtin_amdgcn_mfma_f32_32x32x16_bf16(PAF(3),VFR(3),o[0],0,0,0), C1,8); \
    GAPB(o[1]=__builtin_amdgcn_mfma_f32_32x32x16_bf16(PAF(3),VFR(7),o[1],0,0,0), C1,12); \
    }while(0)
  int t=1;
  #undef CMASK
  #define CMASK(P0,P1,t) do{}while(0)
  for(;t+5<NT;t+=2){
    STEP(pB0,pB1,pA0,pA1,t,true,true,true);     WAIT_BAR(2); RESC(); ROT();
    STEP(pA0,pA1,pB0,pB1,t+1,true,true,true);   WAIT_BAR(2); RESC(); ROT();
  }
  #undef CMASK
  #define CMASK(P0,P1,t) do{}while(0)
  #define ENDW(tt) do{ if((tt)+3<NT){WAIT_BAR(2);} else if((tt)+2<NT){WAIT_BAR(1);} else {WAIT_BAR(0);} }while(0)
  for(;t+1<NT;t+=2){
    STEP(pB0,pB1,pA0,pA1,t,(t+3<NT),(t+1<NT),(t+1<NT));       ENDW(t);   RESC(); ROT();
    STEP(pA0,pA1,pB0,pB1,t+1,(t+4<NT),(t+2<NT),(t+2<NT));     ENDW(t+1); RESC(); ROT();
  }
  STEP(pB0,pB1,pA0,pA1,NT-1,false,false,false); RESC();
  { float sacc=pB0[0]+pB0[1]; _Pragma("unroll") for(int r=2;r<16;++r)sacc+=pB0[r]; _Pragma("unroll") for(int r=0;r<16;++r)sacc+=pB1[r]; l_reg+=sacc;
    pw0=(u32x4){PKW(pB0,0),PKW(pB0,2),PKW(pB0,4),PKW(pB0,6)};pw1=(u32x4){PKW(pB0,8),PKW(pB0,10),PKW(pB0,12),PKW(pB0,14)};pw2=(u32x4){PKW(pB1,0),PKW(pB1,2),PKW(pB1,4),PKW(pB1,6)};pw3=(u32x4){PKW(pB1,8),PKW(pB1,10),PKW(pB1,12),PKW(pB1,14)};
    SBAR(); pv(o,vb0+sl_cur,PAF(0),PAF(1),PAF(2),PAF(3)); }
  #undef PKW
  #undef PAF
  #undef VFR
  #undef PIN
  #undef MX3
  #undef GAPA
  #undef GAPB
  #undef EX
  #undef VRD
  #undef KRD
  #undef STEP
  #undef ENDW
  {auto rr=__builtin_amdgcn_permlane32_swap(__float_as_uint(l_reg),__float_as_uint(l_reg),false,false);l_reg=__uint_as_float(rr[0])+__uint_as_float(rr[1]);}
  if(hi==0)wsf[32+r32]=l_reg;asm volatile("s_waitcnt lgkmcnt(0)":::"memory");
  float rli[16];
  #pragma unroll
  for(int r=0;r<16;++r)rli[r]=__builtin_amdgcn_rcpf(wsf[32+crow(r,hi)]);
  bf16*Ow=O+(qrow0+wid*QBLK)*OP+h*D;
  { bf16*stg=(bf16*)(shm+LDS_OST)+wid*2048;
    #pragma unroll
    for(int r=0;r<16;++r){const int orow=crow(r,hi);
      #pragma unroll
      for(int d0=0;d0<2;++d0)stg[orow*64+d0*32+r32]=__float2bfloat16(o[d0][r]*rli[r]);}
    asm volatile("s_waitcnt lgkmcnt(0)":::"memory");
    #pragma unroll
    for(int i=0;i<4;++i){const int row=i*8+(lane>>3),ch=lane&7; const u32x4 v=*(const u32x4*)(stg+row*64+ch*8); ATTN_STORE16(Ow+(long)row*OP+ch*8,v);} }
  asm volatile("s_waitcnt lgkmcnt(0)\n\ts_barrier":::"memory");
  #undef DMA_K
  #undef DMA_V
  #undef CMASK
  #undef START
  #undef RESC
  #undef ROT
}
constexpr int ATTN_LDS_BYTES=LDS_BYTES;
#undef SBAR
#undef WAIT_BAR
}
typedef GAS unsigned gu32;
typedef GAS unsigned long long gu64;
#define RLX_AGENT __ATOMIC_RELAXED, __HIP_MEMORY_SCOPE_AGENT
#define LDS_WAIT() asm volatile("s_waitcnt lgkmcnt(0)" ::: "memory")
#define VM_WAIT() asm volatile("s_waitcnt vmcnt(0)" ::: "memory")
__device__ __forceinline__ unsigned long long rt() { return __builtin_amdgcn_s_memrealtime(); }

#define XB_TMO      128
#define XB_XCNT(j)  (256  + 64 * (j))
#define XB_XSUB(j)  (1280 + 64 * (j))
#define XB_XGEN(j)  (2304 + 64 * (j))
#define XB_TOP      3328
#define XB_TOPGEN   3392
#define XCD_BAR_WORDS 3456
#define XB_SPIN_CAP (1u << 18)

__device__ __forceinline__ unsigned xb_ld(unsigned* p)              { return __hip_atomic_load(p, __ATOMIC_RELAXED, __HIP_MEMORY_SCOPE_AGENT); }
__device__ __forceinline__ unsigned xb_add(unsigned* p, unsigned v) { return __hip_atomic_fetch_add(p, v, __ATOMIC_RELAXED, __HIP_MEMORY_SCOPE_AGENT); }
__device__ __forceinline__ unsigned xb_xcc_id() { return (unsigned)__builtin_amdgcn_s_getreg((3 << 11) | 20) & 0xFu; }
#define XB_SPIN(cond, bar) do { unsigned _sp = 0; while (cond) { __builtin_amdgcn_s_sleep(1); \
    if ((++_sp & 255u) == 0u) { if (xb_ld(&(bar)[XB_TMO])) break; if (_sp > XB_SPIN_CAP) { atomicAdd(&(bar)[XB_TMO], 1u); break; } } } } while (0)

struct XcdBarrier {
    unsigned* bar; unsigned x;
    volatile LAS unsigned* st;
};

__device__ __forceinline__ XcdBarrier xcd_barrier_post(unsigned* bar, volatile LAS unsigned* st) {
    XcdBarrier b; b.bar = bar; b.x = xb_xcc_id(); b.st = st;
    if (threadIdx.x == 0) (void)xb_add(&bar[XB_XCNT(b.x)], 1u);
    return b;
}
__device__ __forceinline__ void xcd_barrier_complete(unsigned* bar, unsigned x, unsigned& nloc, unsigned& nx) {
    const unsigned G = gridDim.x * gridDim.y * gridDim.z;
    unsigned sum, cnt, mine, sp = 0u;
    for (;;) {
        sum = 0u; cnt = 0u; mine = 0u;
#pragma unroll
        for (unsigned j = 0; j < 16; ++j) { const unsigned c = xb_ld(&bar[XB_XCNT(j)]); sum += c; cnt += (c > 0u) ? 1u : 0u; mine = (j == x) ? c : mine; }
        if (sum == G) break;
        __builtin_amdgcn_s_sleep(1);
        if ((++sp & 255u) == 0u) { if (xb_ld(&bar[XB_TMO])) break; if (sp > XB_SPIN_CAP) { atomicAdd(&bar[XB_TMO], 1u); break; } }
    }
    nloc = mine > 0u ? mine : 1u; nx = cnt > 0u ? cnt : 1u;
}

__device__ __forceinline__ void xcd_barrier(const XcdBarrier& b) {
    asm volatile("s_waitcnt vmcnt(0)" ::: "memory");
    __syncthreads();
    if (threadIdx.x == 0) {
        unsigned zb_; asm volatile("v_mov_b32 %0, 0" : "=v"(zb_));
        unsigned* bar = (unsigned*)((unsigned char*)b.bar + zb_);
        __builtin_amdgcn_s_waitcnt(0);
        unsigned nloc = b.st[0], nx = b.st[1];
        if (nloc == 0u) { xcd_barrier_complete(bar, b.x, nloc, nx); b.st[0] = nloc; b.st[1] = nx; }
        const unsigned old = xb_add(&bar[XB_XSUB(b.x)], 1u);
        const unsigned gen = old / nloc;
        if (old + 1u == (gen + 1u) * nloc) {
            __builtin_amdgcn_fence(__ATOMIC_RELEASE, "agent");
            asm volatile("s_waitcnt vmcnt(0)" ::: "memory");
            const unsigned og = xb_add(&bar[XB_TOP], 1u);
            const unsigned tg = og / nx;
            if (og + 1u == (tg + 1u) * nx) xb_add(&bar[XB_TOPGEN], 1u);
            else XB_SPIN(xb_ld(&bar[XB_TOPGEN]) == tg, bar);
            __builtin_amdgcn_fence(__ATOMIC_ACQUIRE, "agent");
            xb_add(&bar[XB_XGEN(b.x)], 1u);
            asm volatile("s_waitcnt vmcnt(0)" ::: "memory");
        } else {
            XB_SPIN(xb_ld(&bar[XB_XGEN(b.x)]) == gen, bar);
            __builtin_amdgcn_fence(__ATOMIC_ACQUIRE, "agent");
            asm volatile("s_waitcnt vmcnt(0)" ::: "memory");
        }
    }
    __syncthreads();
}

DI float lx_f(float v, int src) { return __builtin_bit_cast(float, __builtin_amdgcn_ds_bpermute(src << 2, __builtin_bit_cast(int, v))); }
DI int lx_i(int v, int src) { return __builtin_amdgcn_ds_bpermute(src << 2, v); }
template <int CTRL> DI float dppf(float v) { return __builtin_bit_cast(float, __builtin_amdgcn_update_dpp(0, __builtin_bit_cast(int, v), CTRL, 0xf, 0xf, false)); }
DI float dx1(float v) { return dppf<0xB1>(v); }
DI float dx2(float v) { return dppf<0x4E>(v); }
DI float sum8(float v) { v += dx1(v); v += dx2(v); v += dppf<0x141>(v); return v; }
DI float wave_sum(float v, int lane) {
    (void)lane; v = sum8(v); v += dppf<0x140>(v);
    const float a = __builtin_bit_cast(float, __builtin_amdgcn_readlane(__builtin_bit_cast(int, v), 0)), b = __builtin_bit_cast(float, __builtin_amdgcn_readlane(__builtin_bit_cast(int, v), 16));
    const float c = __builtin_bit_cast(float, __builtin_amdgcn_readlane(__builtin_bit_cast(int, v), 32)), d = __builtin_bit_cast(float, __builtin_amdgcn_readlane(__builtin_bit_cast(int, v), 48));
    return (a + b) + (c + d);
}
DI float wave_max(float v, int lane) {
#pragma unroll
    for (int o = 1; o < 64; o <<= 1) v = fmaxf(v, lx_f(v, lane ^ o));
    return v;
}
DI float wave_incl_sum(float v, int lane) {
#pragma unroll
    for (int o = 1; o < 64; o <<= 1) { const float t = lx_f(v, lane - o); if (lane >= o) v += t; }
    return v;
}
DI float wave_incl_max(float v, int lane) {
#pragma unroll
    for (int o = 1; o < 64; o <<= 1) { const float t = lx_f(v, lane - o); if (lane >= o) v = fmaxf(v, t); }
    return v;
}
template <int NT, int KS> DI void mma_tile(f32x4 (&acc)[NT], const LAS bf16_t* A, int lda, const LAS bf16_t* Bt, int ldb, int lane) {
    const int fr = lane & 15, fq = lane >> 4;
#pragma unroll
    for (int ks = 0; ks < KS; ++ks) {
        const bf16x8 a = *(const LAS bf16x8*)(A + fr * lda + ks * 32 + fq * 8);
#pragma unroll
        for (int nt = 0; nt < NT; ++nt) {
            const bf16x8 b = *(const LAS bf16x8*)(Bt + (nt * 16 + fr) * ldb + ks * 32 + fq * 8);
            acc[nt] = __builtin_amdgcn_mfma_f32_16x16x32_bf16(a, b, acc[nt], 0, 0, 0);
        }
    }
}

struct Ctx {
    LAS unsigned char* lds;
    unsigned char* ws;
    const float* const* in;
    float* out;
    int tid, lane, wave, G, bx;
};
#define INP(k) ((const float*)(const GAS float*)C.in[k])
DI unsigned char* opaque_ptr(unsigned char* q) { unsigned lo = (unsigned)(uintptr_t)q, hi = (unsigned)((uintptr_t)q >> 32); lo = (unsigned)__builtin_amdgcn_readfirstlane((int)lo); hi = (unsigned)__builtin_amdgcn_readfirstlane((int)hi);
    asm volatile("" : "+s"(lo), "+s"(hi)); return (unsigned char*)(GAS unsigned char*)(((uintptr_t)hi << 32) | (uintptr_t)lo); }
DI Ctx launder(const Ctx& C0) { Ctx C = C0; unsigned m = ~0u; asm volatile("" : "+s"(m));
    { const LAS unsigned* pw = (const LAS unsigned*)(unsigned)(MISC_OFF + 64);
      unsigned w0 = pw[0], w1 = pw[1], o0 = pw[2], o1 = pw[3]; asm volatile("" : "+v"(w0), "+v"(w1), "+v"(o0), "+v"(o1));
      w0 = (unsigned)__builtin_amdgcn_readfirstlane((int)w0); w1 = (unsigned)__builtin_amdgcn_readfirstlane((int)w1); o0 = (unsigned)__builtin_amdgcn_readfirstlane((int)o0); o1 = (unsigned)__builtin_amdgcn_readfirstlane((int)o1);
      C.ws = (unsigned char*)(GAS unsigned char*)(((uintptr_t)w1 << 32) | (uintptr_t)w0); C.out = (float*)(GAS float*)(((uintptr_t)o1 << 32) | (uintptr_t)o0); }
    C.lane = (int)__builtin_amdgcn_mbcnt_hi(m, __builtin_amdgcn_mbcnt_lo(m, 0u)); C.tid = (C0.wave << 6) | C.lane; return C; }

struct MapId { DI int operator()(int c) const { return c; } };
struct MapTile { DI int operator()(int c) const { const int t = c & 255; return (c & ~255) + 128 * ((t >> 5) & 1) + 32 * (t >> 6) + (t & 31); } };
struct MapE1 { DI int operator()(int c) const { const int j = c >> 1; return (j >> 7) * 256 + (c & 1) * 128 + (j & 127); } };
template <class Map> DI void tr_item(const float* W, int K, int N, bf16_t* WT, LAS float* scr, int kb, int nb, int lane, Map map, int ldw) {
    const int k0 = 64 * kb, n0 = 64 * nb;
    const bool nv = (n0 + lane) < N;
    const float* src = W + (size_t)k0 * N + n0 + lane;
#pragma unroll 8
    for (int i = 0; i < 64; ++i) scr[i * 65 + lane] = nv ? src[(size_t)i * N] : 0.f;
    LDS_WAIT(); asm volatile("" ::: "memory");
    const int c = lane & 7;
#pragma unroll
    for (int j = 0; j < 8; ++j) {
        const int n = (lane >> 3) + 8 * j;
        if (n0 + n < N) {
            const LAS float* s = scr + (8 * c) * 65 + n;
            v4u o; o.x = pk2(s[0], s[65]); o.y = pk2(s[130], s[195]); o.z = pk2(s[260], s[325]); o.w = pk2(s[390], s[455]);
            *(v4u*)(WT + (size_t)map(n0 + n) * ldw + k0 + 8 * c) = o;
        }
    }
    LDS_WAIT(); asm volatile("" ::: "memory");
}
template <bool EDGE, class Map> DI void tr_item8_(const float* W, int K, int N, unsigned char* WT, LAS float* scr, int k0, int n0, int lane, Map map, float scale) {
    const bool nv = !EDGE || (n0 + lane) < N;
    const float* src = W + (size_t)k0 * N + n0 + (nv ? lane : 0);
    { float t[64];
#pragma unroll
        for (int i = 0; i < 64; ++i) t[i] = src[(size_t)i * N];
        __builtin_amdgcn_sched_barrier(0);
#pragma unroll
        for (int i = 0; i < 64; ++i) scr[i * 65 + lane] = t[i]; }
    LDS_WAIT(); asm volatile("" ::: "memory");
    const int c = lane & 3;
#pragma unroll
    for (int j = 0; j < 4; ++j) {
        const int n = (lane >> 2) + 16 * j;
        const LAS float* s = scr + (16 * c) * 65 + n;
        v4u o;
        o.x = pk4_fp8(s[0] * scale, s[65] * scale, s[130] * scale, s[195] * scale); o.y = pk4_fp8(s[260] * scale, s[325] * scale, s[390] * scale, s[455] * scale);
        o.z = pk4_fp8(s[520] * scale, s[585] * scale, s[650] * scale, s[715] * scale); o.w = pk4_fp8(s[780] * scale, s[845] * scale, s[910] * scale, s[975] * scale);
        if (!EDGE || n0 + n < N) *(v4u*)(WT + (size_t)map(n0 + n) * K + k0 + 16 * c) = o;
    }
    LDS_WAIT(); asm volatile("" ::: "memory");
}
template <class Map> DI void tr_item8(const float* W, int K, int N, unsigned char* WT, LAS float* scr, int kb, int nb, int lane, Map map, float scale) {
    if (64 * nb + 64 <= N) tr_item8_<false>(W, K, N, WT, scr, 64 * kb, 64 * nb, lane, map, scale); else tr_item8_<true>(W, K, N, WT, scr, 64 * kb, 64 * nb, lane, map, scale);
}
struct It8 { const float* src; unsigned char* dst; int N, K, k0, n0; bool e1, edge; };
DI void ld8(const It8& d, float (&t)[64], int lane) {
    const bool nv = !d.edge || (d.n0 + lane) < d.N;
    const float* s = d.src + (size_t)d.k0 * d.N + d.n0 + (nv ? lane : 0);
#pragma unroll
    for (int i = 0; i < 64; ++i) t[i] = s[(size_t)i * d.N];
}
DI void st8i(const It8& d, const float (&t)[64], LAS float* scr, int lane, float scale) {
#pragma unroll
    for (int i = 0; i < 64; ++i) scr[i * 65 + lane] = t[i];
    LDS_WAIT(); asm volatile("" ::: "memory");
    const int c = lane & 3;
#pragma unroll
    for (int j = 0; j < 4; ++j) {
        const int n = (lane >> 2) + 16 * j;
        const LAS float* s = scr + (16 * c) * 65 + n;
        v4u o;
        o.x = pk4_fp8(s[0] * scale, s[65] * scale, s[130] * scale, s[195] * scale); o.y = pk4_fp8(s[260] * scale, s[325] * scale, s[390] * scale, s[455] * scale);
        o.z = pk4_fp8(s[520] * scale, s[585] * scale, s[650] * scale, s[715] * scale); o.w = pk4_fp8(s[780] * scale, s[845] * scale, s[910] * scale, s[975] * scale);
        const int col = d.n0 + n, row = d.e1 ? MapE1()(col) : col;
        if (!d.edge || col < d.N) *(v4u*)(d.dst + (size_t)row * d.K + d.k0 + 16 * c) = o;
    }
    LDS_WAIT(); asm volatile("" ::: "memory");
}
DI void p0_prologue(const Ctx& C) {
    __syncthreads();
    {
        LAS float* sc = (LAS float*)(C.lds + RING_OFF);
        LAS float* red = (LAS float*)(C.lds + RING_OFF + 9 * 1024 * 4);
        for (int i = C.tid; i < 9 * 1024; i += 512) { const float v = (i < 8192) ? INP(I_C)[i] : INP(I_CCTX)[i - 8192]; sc[i] = silu_f(v); }
        __syncthreads();
        float* MOD = (float*)(C.ws + WS_MOD);
        for (int u = C.bx; u < DEPTH * 96; u += C.G) {
            const int l = u / 96, cg = u % 96, ci = C.tid & 63, kg = C.tid >> 6;
            const float* w = INP(I_WADA) + ((size_t)l * 1024 + kg * 128) * 6144 + cg * 64 + ci;
            float s[9];
#pragma unroll
            for (int b = 0; b < 9; ++b) s[b] = 0.f;
#pragma unroll 16
            for (int k = 0; k < 128; ++k) { const float wv = w[(size_t)k * 6144];
#pragma unroll
                for (int b = 0; b < 9; ++b) s[b] += sc[b * 1024 + kg * 128 + k] * wv; }
#pragma unroll
            for (int b = 0; b < 9; ++b) red[(kg * 9 + b) * 64 + ci] = s[b];
            __syncthreads();
            for (int o = C.tid; o < 9 * 64; o += 512) { const int b = o >> 6, c2 = o & 63; float t = 0.f;
#pragma unroll
                for (int g = 0; g < 8; ++g) t += red[(g * 9 + b) * 64 + c2];
                MOD[((size_t)l * 9 + b) * 6144 + cg * 64 + c2] = t + INP(I_BADA)[l * 6144 + cg * 64 + c2]; }
            __syncthreads();
        }
    }
    {
        LAS float* scr = (LAS float*)(C.lds + RING_OFF + C.wave * 16640);
        const int gw = C.bx * 8 + C.wave, NGW = C.G * 8;
        constexpr int IT_IN = 16 * 109, IT_BR = 8 * 16, IT_OUT = 16 * 16, IT_E1 = 16 * 32, IT_E2 = 16 * 16;
        constexpr int N0 = DEPTH * IT_IN, N1 = N0 + DEPTH * 3 * IT_BR, N2 = N1 + DEPTH * IT_OUT, N3 = N2 + DEPTH * NEXP * IT_E1, N4 = N3 + DEPTH * NEXP * IT_E2;
        for (int it = N0 + gw; it < N2; it += NGW) {
            if (it < N1) { const int q = it - N0, m = q / IT_BR, r = q % IT_BR; tr_item(INP(I_WBR) + (size_t)m * 512 * DM, 512, DM, (bf16_t*)(C.ws + WS_WTBR) + (size_t)(m / 3) * DM * 1536 + (m % 3) * 512, scr, r / 16, r % 16, C.lane, MapId(), 1536); }
            else { const int q = it - N1, m = q / IT_OUT, r = q % IT_OUT; tr_item(INP(I_WOUT) + (size_t)m * DM * DM, DM, DM, (bf16_t*)(C.ws + WS_WTOUT) + (size_t)m * DM * DM, scr, r / 16, r % 16, C.lane, MapId(), DM); }
        }
        constexpr int NJ = N0 + (N4 - N2);
        auto dec8 = [&](int j) -> It8 { It8 d;
            if (j < N0) { const int m = j / IT_IN, r = j % IT_IN; d.src = INP(I_WIN) + (size_t)m * DM * IN_W; d.dst = (unsigned char*)(C.ws + WS_WTIN) + (size_t)m * PW * DM; d.N = IN_W; d.K = DM; d.k0 = 64 * (r / 109); d.n0 = 64 * (r % 109); d.e1 = false; d.edge = (d.n0 + 64 > IN_W); }
            else { const int it = j - N0 + N2;
                if (it < N3) { const int q = it - N2, m = q / IT_E1, r = q % IT_E1; d.src = INP(I_WE1) + (size_t)m * DM * 2048; d.dst = (unsigned char*)(C.ws + WS_WTE1) + (size_t)m * 2048 * DM; d.N = 2048; d.K = DM; d.k0 = 64 * (r / 32); d.n0 = 64 * (r % 32); d.e1 = true; d.edge = false; }
                else { const int q = it - N3, m = q / IT_E2, r = q % IT_E2; d.src = INP(I_WE2) + (size_t)m * DFF * DM; d.dst = (unsigned char*)(C.ws + WS_WTE2) + (size_t)m * DM * DFF; d.N = DM; d.K = DFF; d.k0 = 64 * (r / 16); d.n0 = 64 * (r % 16); d.e1 = false; d.edge = false; } }
            return d; };
        It8 d0, d1; float t0[64], t1[64];
        int j = gw;
        if (j < NJ) { d0 = dec8(j); ld8(d0, t0, C.lane); }
        for (; j < NJ; j += 2 * NGW) {
            const int j1 = j + NGW, j2 = j1 + NGW;
            if (j1 < NJ) { d1 = dec8(j1); ld8(d1, t1, C.lane); }
            st8i(d0, t0, scr, C.lane, FP8_SW);
            if (j2 < NJ) { d0 = dec8(j2); ld8(d0, t0, C.lane); }
            if (j1 < NJ) st8i(d1, t1, scr, C.lane, FP8_SW);
        }
    }
}

DI void phase_norm1(const Ctx& C, int l, float pscale) {
    const int gw = C.bx * 8 + C.wave, NGW = C.G * 8, lane = C.lane;
    bf16_t* X = (bf16_t*)(C.ws + WS_X); unsigned char* H8 = (unsigned char*)(C.ws + WS_H);
    const float* MOD = (const float*)(C.ws + WS_MOD);
    const int* TOKP = (const int*)(C.ws + WS_TOKP); const bf16_t* YS = (const bf16_t*)(C.ws + WS_YS); const bf16_t* U = (const bf16_t*)(C.ws + WS_U);
    const bool fin = (l == DEPTH);
    const int nrows = fin ? M_LAT : MROWS;
    const int rpw = (nrows + NGW - 1) / NGW, rbeg = gw * rpw, rend = (rbeg + rpw < nrows) ? rbeg + rpw : nrows;
    f32x4 gn[4];
#pragma unroll
    for (int j = 0; j < 4; ++j) gn[j] = *(const f32x4*)((fin ? INP(I_GF) : INP(I_GN1) + (size_t)l * DM) + (lane + 64 * j) * 4);
    int mi_cur = -1; f32x4 g2v[4], g1v[4], s1v[4], s0v[4];
    int4 sl = make_int4(0, 0, 0, 0); v2u xr[4];
    if (rbeg < rend) {
        if (l > 0) { sl = *(const int4*)(TOKP + (size_t)rbeg * 4);
#pragma unroll
            for (int j = 0; j < 4; ++j) xr[j] = *(const v2u*)(X + (size_t)rbeg * DM + (lane + 64 * j) * 4); }
    }
    for (int r = rbeg; r < rend; ++r) {
        const int mi = r < M_LAT ? (r >> 12) : 8;
        if (mi != mi_cur) {
            mi_cur = mi;
#pragma unroll
            for (int j = 0; j < 4; ++j) { const int c = (lane + 64 * j) * 4;
                g2v[j] = (l > 0) ? *(const f32x4*)(MOD + ((size_t)(l - 1) * 9 + mi) * 6144 + 5 * DM + c) * pscale : (f32x4){0.f, 0.f, 0.f, 0.f};
                g1v[j] = (l > 0) ? *(const f32x4*)(MOD + ((size_t)(l - 1) * 9 + mi) * 6144 + 2 * DM + c) * pscale : (f32x4){0.f, 0.f, 0.f, 0.f};
                if (!fin) { s0v[j] = *(const f32x4*)(MOD + ((size_t)l * 9 + mi) * 6144 + c); s1v[j] = *(const f32x4*)(MOD + ((size_t)l * 9 + mi) * 6144 + DM + c) + 1.0f; } }
        }
        f32x4 v[4];
        if (l == 0) {
            const float* src = r < M_LAT ? INP(I_X) + (size_t)r * DM : INP(I_CTX) + (size_t)(r - M_LAT) * DM;
#pragma unroll
            for (int j = 0; j < 4; ++j) v[j] = *(const f32x4*)(src + (lane + 64 * j) * 4);
        } else {
            const bf16_t* y0 = YS + (size_t)sl.x * DM; const bf16_t* y1 = YS + (size_t)sl.y * DM; const bf16_t* y2 = YS + (size_t)sl.z * DM; const bf16_t* y3 = YS + (size_t)sl.w * DM;
            v2u ya[4], yb[4], yc[4], yd[4];
#pragma unroll
            for (int j = 0; j < 4; ++j) { const int c = (lane + 64 * j) * 4; ya[j] = *(const v2u*)(y0 + c); yb[j] = *(const v2u*)(y1 + c); yc[j] = *(const v2u*)(y2 + c); yd[j] = *(const v2u*)(y3 + c); }
#pragma unroll
            for (int j = 0; j < 4; ++j) { const v2u uu = *(const v2u*)(U + (size_t)r * DM + (lane + 64 * j) * 4); const v2u xx = xr[j]; v[j] = (f32x4){bf2f(xx.x & 0xffffu), bf2f(xx.x >> 16), bf2f(xx.y & 0xffffu), bf2f(xx.y >> 16)} + g1v[j] * (f32x4){bf2f(uu.x & 0xffffu), bf2f(uu.x >> 16), bf2f(uu.y & 0xffffu), bf2f(uu.y >> 16)}; }
            if (r + 1 < rend) { sl = *(const int4*)(TOKP + (size_t)(r + 1) * 4);
#pragma unroll
                for (int j = 0; j < 4; ++j) xr[j] = *(const v2u*)(X + (size_t)(r + 1) * DM + (lane + 64 * j) * 4); }
#pragma unroll
            for (int j = 0; j < 4; ++j) {
                const v2u a = ya[j], b = yb[j], cc = yc[j], d = yd[j];
                f32x4 f;
                f[0] = ((bf2f(a.x & 0xffffu) + bf2f(b.x & 0xffffu)) + bf2f(cc.x & 0xffffu)) + bf2f(d.x & 0xffffu);
                f[1] = ((bf2f(a.x >> 16) + bf2f(b.x >> 16)) + bf2f(cc.x >> 16)) + bf2f(d.x >> 16);
                f[2] = ((bf2f(a.y & 0xffffu) + bf2f(b.y & 0xffffu)) + bf2f(cc.y & 0xffffu)) + bf2f(d.y & 0xffffu);
                f[3] = ((bf2f(a.y >> 16) + bf2f(b.y >> 16)) + bf2f(cc.y >> 16)) + bf2f(d.y >> 16);
                v[j] = v[j] + g2v[j] * f;
            }
        }
        if (!fin) {
#pragma unroll
            for (int j = 0; j < 4; ++j) { v2u o; o.x = pk2(v[j][0], v[j][1]); o.y = pk2(v[j][2], v[j][3]); *(v2u*)(X + (size_t)r * DM + (lane + 64 * j) * 4) = o; }
        }
        float ss = 0.f;
#pragma unroll
        for (int j = 0; j < 4; ++j) ss += (v[j][0] * v[j][0] + v[j][1] * v[j][1]) + (v[j][2] * v[j][2] + v[j][3] * v[j][3]);
        const float rstd = __builtin_amdgcn_rsqf(wave_sum(ss, lane) * (1.0f / DM) + EPS);
        if (fin) {
#pragma unroll
            for (int j = 0; j < 4; ++j) *(f32x4*)(C.out + (size_t)r * DM + (lane + 64 * j) * 4) = v[j] * rstd * gn[j];
        } else {
#pragma unroll
            for (int j = 0; j < 4; ++j) {
                const int c = (lane + 64 * j) * 4;
                const f32x4 h = v[j] * rstd * gn[j] * s1v[j] + s0v[j];
                *(unsigned*)(H8 + (size_t)r * DM + c) = pk4_fp8(h[0] * FP8_SH, h[1] * FP8_SH, h[2] * FP8_SH, h[3] * FP8_SH);
            }
        }
    }
}

DI void rope_cs(float (&c)[8], float (&s)[8], const float (&freq)[8], int lane, int t) {
    const int sub = lane & 7;
    const float pos = (sub >= 4) ? (float)(t & 63) : (float)(t >> 6);
#pragma unroll
    for (int e = 0; e < 8; ++e) { float rev = pos * freq[e]; rev -= floorf(rev); c[e] = __builtin_amdgcn_cosf(rev); s[e] = __builtin_amdgcn_sinf(rev); }
}
DI void rope_apply(float (&x)[8], const float (&c)[8], const float (&s)[8], int lane) {
    const bool second = (lane & 2) != 0;
#pragma unroll
    for (int e = 0; e < 8; ++e) { const float other = dx2(x[e]); x[e] = second ? (x[e] * c[e] + other * s[e]) : (x[e] * c[e] - other * s[e]); }
}
DI void phase_attn_prep(const Ctx& C, int l) {
    const int gw = C.bx * 8 + C.wave, NGW = C.G * 8, lane = C.lane;
    const bf16_t* P = (const bf16_t*)(C.ws + WS_P);
    bf16_t* QR = (bf16_t*)(C.ws + WS_QR); bf16_t* KR = (bf16_t*)(C.ws + WS_KR); bf16_t* VR = (bf16_t*)(C.ws + WS_VR);
    float gq[8], gk[8], freq[8];
#pragma unroll
    for (int e = 0; e < 8; ++e) { gq[e] = INP(I_BQG)[l * 64 + (lane & 7) * 8 + e]; gk[e] = INP(I_BKG)[l * 64 + (lane & 7) * 8 + e];
        freq[e] = __builtin_amdgcn_exp2f(-(float)((lane & 1) * 8 + e) * 0.83048202372184058696f) * 0.15915494309189533577f; }
    constexpr float C2 = 0.125f * 1.4426950408889634f;
    const int kl = lane & 15;
    v4u nq = {0u, 0u, 0u, 0u}, nk = nq, nv = nq;
    if (gw < MROWS) { const bf16_t* prow = P + (size_t)gw * PW; nq = *(const v4u*)(prow + C_BQ + lane * 8); nk = *(const v4u*)(prow + C_BK + kl * 8); nv = *(const v4u*)(prow + C_BV + kl * 8); }
    for (int r = gw; r < MROWS; r += NGW) {
        const bool lat = r < M_LAT;
        const int b = lat ? (r >> 12) : ((r - M_LAT) >> 8), t = lat ? (r & 4095) : ((r - M_LAT) & 255), kvpos = lat ? (CTXL + t) : t;
        const v4u cq = nq, ck = nk, cv = nv;
        if (r + NGW < MROWS) { const bf16_t* prow = P + (size_t)(r + NGW) * PW; nq = *(const v4u*)(prow + C_BQ + lane * 8); nk = *(const v4u*)(prow + C_BK + kl * 8); nv = *(const v4u*)(prow + C_BV + kl * 8); }
        float rc[8], rs[8];
        if (lat) rope_cs(rc, rs, freq, lane, t);
        float x[8];
        unpack8(cq, x);
        float ss = 0.f;
#pragma unroll
        for (int e = 0; e < 8; ++e) ss += x[e] * x[e];
        ss = sum8(ss);
        float rstd = __builtin_amdgcn_rsqf(ss * (1.0f / 64.0f) + EPS);
#pragma unroll
        for (int e = 0; e < 8; ++e) x[e] = x[e] * rstd * gq[e];
        if (lat) rope_apply(x, rc, rs, lane);
        { v4u o; o.x = pk2(x[0] * C2, x[1] * C2); o.y = pk2(x[2] * C2, x[3] * C2); o.z = pk2(x[4] * C2, x[5] * C2); o.w = pk2(x[6] * C2, x[7] * C2);
          *(v4u*)(QR + (size_t)r * 512 + lane * 8) = o; }
        unpack8(ck, x);
        ss = 0.f;
#pragma unroll
        for (int e = 0; e < 8; ++e) ss += x[e] * x[e];
        ss = sum8(ss);
        rstd = __builtin_amdgcn_rsqf(ss * (1.0f / 64.0f) + EPS);
#pragma unroll
        for (int e = 0; e < 8; ++e) x[e] = x[e] * rstd * gk[e];
        if (lat) rope_apply(x, rc, rs, lane);
        const size_t kvrow = ((size_t)b * KVLEN + kvpos) * 128;
        if (lane < 16) { v4u o; o.x = pk2(x[0], x[1]); o.y = pk2(x[2], x[3]); o.z = pk2(x[4], x[5]); o.w = pk2(x[6], x[7]); *(v4u*)(KR + kvrow + kl * 8) = o; }
        else if (lane < 32) { *(v4u*)(VR + kvrow + kl * 8) = cv; }
    }
}

constexpr int LDT = 72;
constexpr unsigned short BF16_ONE = 0x3F80;
DI int chunk_pos0(int c) { return (c < 512 ? (c & 63) : ((c - 512) & 3)) * 64; }
DI int chunk_len(int c) { return c < 512 ? SEQ : CTXL; }

struct ConvIn { v4u x0, xm, xp; };
DI void conv_load(ConvIn& r, const bf16_t* P, int row0, int t, int pos0, int seqlen, int col) {
    const bf16_t* p = P + (size_t)(row0 + t) * PW + col;
    r.x0 = *(const v4u*)p;
    r.xm = (v4u){0u, 0u, 0u, 0u}; r.xp = (v4u){0u, 0u, 0u, 0u};
    if (pos0 + t - 1 >= 0) r.xm = *(const v4u*)(p - PW);
    if (pos0 + t + 1 < seqlen) r.xp = *(const v4u*)(p + PW);
}
DI void conv_apply(const ConvIn& r, const LAS float* cwt, int c8, float (&y)[8]) {
    float xm[8], x0[8], xp[8]; unpack8(r.xm, xm); unpack8(r.x0, x0); unpack8(r.xp, xp);
#pragma unroll
    for (int hh = 0; hh < 2; ++hh) {
        const f32x4 w0 = *(const LAS f32x4*)(cwt + c8 + 4 * hh), w1 = *(const LAS f32x4*)(cwt + 64 + c8 + 4 * hh), w2 = *(const LAS f32x4*)(cwt + 128 + c8 + 4 * hh), bb = *(const LAS f32x4*)(cwt + 192 + c8 + 4 * hh);
#pragma unroll
        for (int e = 0; e < 4; ++e) y[4 * hh + e] = silu_f(xm[4 * hh + e] * w0[e] + x0[4 * hh + e] * w1[e] + xp[4 * hh + e] * w2[e] + bb[e]);
    }
}
DI void conv_table(const Ctx& C, LAS float* cwt, int l, int h) {
    const float* cw = INP(I_ACW) + (size_t)l * 3 * 512; const float* cb = INP(I_ACB) + (size_t)l * 512;
    const int qk = C.tid >> 8, row = (C.tid >> 6) & 3, ch = C.tid & 63, col = qk * 256 + h * 64 + ch;
    cwt[C.tid] = row < 3 ? cw[row * 512 + col] : cb[col];
}
DI v4u pack8f(const float (&y)[8], float sc) { v4u o; o.x = pk2(y[0] * sc, y[1] * sc); o.y = pk2(y[2] * sc, y[3] * sc); o.z = pk2(y[4] * sc, y[5] * sc); o.w = pk2(y[6] * sc, y[7] * sc); return o; }
DI void store_vt8(LAS bf16_t* VT, const v4u x, int col, int t) {
    LAS bf16_t* d = VT + col * LDT + t;
    d[0 * LDT] = (bf16_t)(x.x & 0xffffu); d[1 * LDT] = (bf16_t)(x.x >> 16); d[2 * LDT] = (bf16_t)(x.y & 0xffffu); d[3 * LDT] = (bf16_t)(x.y >> 16);
    d[4 * LDT] = (bf16_t)(x.z & 0xffffu); d[5 * LDT] = (bf16_t)(x.z >> 16); d[6 * LDT] = (bf16_t)(x.w & 0xffffu); d[7 * LDT] = (bf16_t)(x.w >> 16);
}
DI void store_ct(LAS bf16_t* CT, const f32x4 (&s)[4], int tid) {
#pragma unroll
    for (int q = 0; q < 4; ++q) {
        const int idx = tid * 4 + q * 2048, v = idx >> 6, d = idx & 63;
        v2u o; o.x = pk2(s[q][0], s[q][1]); o.y = pk2(s[q][2], s[q][3]);
        *(LAS v2u*)(CT + v * LDT + d) = o;
    }
}
template <int ACT, int HSLD> DI void head_out(const Ctx& C, const LAS float* HS, const v4u g0, const v4u g1, int row0, const float (&gain)[16], bf16_t* Y, int h) {
    const int t = C.tid >> 3, sub = C.tid & 7;
    float x[16]; float ss = 0.f;
#pragma unroll
    for (int q = 0; q < 4; ++q) { const f32x4 v = *(const LAS f32x4*)(HS + t * HSLD + sub * 16 + q * 4); x[4 * q] = v[0]; x[4 * q + 1] = v[1]; x[4 * q + 2] = v[2]; x[4 * q + 3] = v[3]; }
#pragma unroll
    for (int e = 0; e < 16; ++e) ss += x[e] * x[e];
    ss = sum8(ss);
    const float rstd = __builtin_amdgcn_rsqf(ss * (1.0f / 128.0f) + EPS);
    float ga[8], gb[8]; unpack8(g0, ga); unpack8(g1, gb);
    float o[16];
#pragma unroll
    for (int e = 0; e < 16; ++e) { const float gv = e < 8 ? ga[e] : gb[e - 8]; const float a = ACT == 0 ? sigmoid_f(gv) : silu_f(gv); o[e] = x[e] * rstd * gain[e] * a; }
    v4u w0, w1; w0.x = pk2(o[0], o[1]); w0.y = pk2(o[2], o[3]); w0.z = pk2(o[4], o[5]); w0.w = pk2(o[6], o[7]); w1.x = pk2(o[8], o[9]); w1.y = pk2(o[10], o[11]); w1.z = pk2(o[12], o[13]); w1.w = pk2(o[14], o[15]);
    bf16_t* yp = Y + (size_t)(row0 + t) * 1536 + h * 128 + sub * 16;
    *(v4u*)yp = w0; *(v4u*)(yp + 8) = w1;
}

DI unsigned char* rec_ptr(unsigned char* base, int c, int h, int dir) { return base + ((size_t)(c * 4 + h) * 2 + dir) * RECB; }
template <bool NVEC> DI void delta_store(const Ctx& C, const LAS bf16_t* KT, const LAS bf16_t* VT, unsigned char* rec) {
    const int part = C.wave & 3, fr = C.lane & 15, fq = C.lane >> 4;
    f32x4 acc[8];
#pragma unroll
    for (int nt = 0; nt < 8; ++nt) acc[nt] = (f32x4){0.f, 0.f, 0.f, 0.f};
    mma_tile<8, 2>(acc, KT + 16 * part * LDT, LDT, VT, LDT, C.lane);
    bf16_t* R = (bf16_t*)rec;
#pragma unroll
    for (int nt = 0; nt < 8; ++nt) { v2u o; o.x = pk2(acc[nt][0], acc[nt][1]); o.y = pk2(acc[nt][2], acc[nt][3]); *(v2u*)(R + (nt * 16 + fr) * 64 + 16 * part + fq * 4) = o; }
    if (NVEC) {
        f32x4 an[1]; an[0] = (f32x4){0.f, 0.f, 0.f, 0.f};
        mma_tile<1, 2>(an, KT + 16 * part * LDT, LDT, VT + 128 * LDT, LDT, C.lane);
        if (fr == 0) { float* nf = (float*)(rec + REC_VEC) + 16 * part + fq * 4; nf[0] = an[0][0]; nf[1] = an[0][1]; nf[2] = an[0][2]; nf[3] = an[0][3]; }
    }
}
DI void store_ct16(LAS bf16_t* CT, const v4u a, const v4u b, int tid) {
    { const int idx = tid * 8; *(LAS v4u*)(CT + (idx >> 6) * LDT + (idx & 63)) = a; }
    { const int idx = tid * 8 + 4096; *(LAS v4u*)(CT + (idx >> 6) * LDT + (idx & 63)) = b; }
}
constexpr int MC_QS = 0, MC_KS = 9216, MC_VT = 18432, MC_CT0 = 39168, MC_CT1 = 59904, MC_SB0 = 80640, MC_SB1 = 89856, MC_HS = 99072, MC_VEC = 132864, MC_CWT = 134912;
static_assert(MC_CWT + 2048 <= RING_BYTES, "mLSTM (c) LDS map");
constexpr int MA_VT = 0, MA_KT0 = 20736, MA_KT1 = 29952, MA_VEC = 39168, MA_CWT = 40192;
struct MARegs { ConvIn k; v4u v0, v1; float gi, gf; };
struct MCRegs { ConvIn q, k; v4u v0, v1, og0, og1, s0a, s0b, s1a, s1b; float gi, gf, aux; };
DI void mlstm_a_load(const Ctx& C, int c, int h, MARegs& R) {
    const bf16_t* P = (const bf16_t*)(C.ws + WS_P);
    const int row0 = c * 64, t = C.lane, c8 = C.wave * 8;
    conv_load(R.k, P, row0, t, chunk_pos0(c), chunk_len(c), C_AQK + 256 + h * 64 + c8);
    const bf16_t* pv = P + (size_t)(row0 + t) * PW + C_AV + h * 128 + c8;
    R.v0 = *(const v4u*)pv; R.v1 = *(const v4u*)(pv + 64);
    R.gi = 0.f; R.gf = 0.f;
    if (C.wave < 2) { const int dir = C.wave, tt = dir ? 63 - C.lane : C.lane; const bf16_t* prow = P + (size_t)(row0 + tt) * PW; R.gi = bf2f(prow[C_AI + dir * 4 + h]); R.gf = bf2f(prow[C_AF + dir * 4 + h]); }
}
DI void mlstm_a_unit(const Ctx& C0, int l, int c, int h, MARegs& R, bool has_next, int cn, int hn) {
    Ctx C = C0; { int t_ = C0.tid; asm volatile("" : "+v"(t_)); C.tid = t_; C.lane = t_ & 63; }
    LAS unsigned char* L = C.lds + RING_OFF;
    LAS bf16_t* VT = (LAS bf16_t*)(L + MA_VT); LAS bf16_t* KT0 = (LAS bf16_t*)(L + MA_KT0); LAS bf16_t* KT1 = (LAS bf16_t*)(L + MA_KT1); LAS float* VEC = (LAS float*)(L + MA_VEC);
    unsigned char* rec0 = rec_ptr(C.ws + WS_STA, c, h, 0);
    const int t = C.lane, c8 = C.wave * 8;
    __syncthreads();
    if (C.wave < 2) {
        const int dir = C.wave, tt = dir ? 63 - C.lane : C.lane;
        const float* gb = INP(I_AGB) + l * 16;
        const float iv = R.gi + gb[dir * 4 + h], fv = logsigmoid_f(R.gf + gb[8 + dir * 4 + h]);
        const float b = wave_incl_sum(fv, C.lane);
        const float B = lx_f(b, 63);
        const float a = B - b + iv;
        const float Ml = wave_max(a, C.lane);
        VEC[dir * 64 + tt] = __expf(a - Ml);
        if (C.lane == 0) { float* sf = (float*)(rec0 + dir * RECB + REC_VEC); sf[64] = B; sf[65] = Ml; }
    }
    float y[8]; conv_apply(R.k, (const LAS float*)(L + MA_CWT) + 256, c8, y);
    store_vt8(VT, R.v0, c8, t); store_vt8(VT, R.v1, 64 + c8, t);
    if (C.tid < 64) VT[128 * LDT + C.tid] = BF16_ONE;
    asm volatile("" ::: "memory"); __builtin_amdgcn_sched_barrier(0);
    if (has_next) mlstm_a_load(C, cn, hn, R);
    asm volatile("" ::: "memory"); __builtin_amdgcn_sched_barrier(0);
    __syncthreads();
    {
        const float w0 = VEC[t] * 0.125f, w1 = VEC[64 + t] * 0.125f;
#pragma unroll
        for (int e = 0; e < 8; ++e) { const unsigned pw = pk2(y[e] * w0, y[e] * w1); KT0[(c8 + e) * LDT + t] = (bf16_t)pw; KT1[(c8 + e) * LDT + t] = (bf16_t)(pw >> 16); }
    }
    __syncthreads();
    delta_store<true>(C, (C.wave >> 2) ? KT1 : KT0, VT, rec0 + (C.wave >> 2) * RECB);
}
DI void mlstm_a_phase(const Ctx& C, int l) {
    LAS float* cwt = (LAS float*)(C.lds + RING_OFF + MA_CWT);
    int htab = -1; MARegs R;
    int u = C.bx; if (u < NCHUNK * 4) mlstm_a_load(C, u >> 2, u & 3, R);
    for (; u < NCHUNK * 4; u += C.G) {
        const int h = u & 3, un = u + C.G;
        if (h != htab) { __syncthreads(); conv_table(C, cwt, l, h); htab = h; }
        mlstm_a_unit(C, l, u >> 2, h, R, un < NCHUNK * 4, un >> 2, un & 3);
    }
}
DI void mlstm_c_load(const Ctx& C, int c, int h, MCRegs& R) {
    const bf16_t* P = (const bf16_t*)(C.ws + WS_P);
    const int row0 = c * 64, t = C.lane, c8 = C.wave * 8, pos0 = chunk_pos0(c), len = chunk_len(c);
    conv_load(R.q, P, row0, t, pos0, len, C_AQK + h * 64 + c8);
    conv_load(R.k, P, row0, t, pos0, len, C_AQK + 256 + h * 64 + c8);
    const bf16_t* pr = P + (size_t)(row0 + t) * PW;
    R.v0 = *(const v4u*)(pr + C_AV + h * 128 + c8); R.v1 = *(const v4u*)(pr + C_AV + h * 128 + 64 + c8);
    { const bf16_t* po = P + (size_t)(row0 + (C.tid >> 3)) * PW + C_AO + h * 128 + (C.tid & 7) * 16; R.og0 = *(const v4u*)po; R.og1 = *(const v4u*)(po + 8); }
    const unsigned char* rec0 = rec_ptr(C.ws + WS_STA, c, h, 0);
    R.s0a = *(const v4u*)(rec0 + C.tid * 16); R.s0b = *(const v4u*)(rec0 + 8192 + C.tid * 16); R.s1a = *(const v4u*)(rec0 + RECB + C.tid * 16); R.s1b = *(const v4u*)(rec0 + RECB + 8192 + C.tid * 16);
    R.gi = 0.f; R.gf = 0.f; R.aux = 0.f;
    if (C.wave < 2) { const int dir = C.wave, tt = dir ? 63 - C.lane : C.lane; const bf16_t* prow = P + (size_t)(row0 + tt) * PW; R.gi = bf2f(prow[C_AI + dir * 4 + h]); R.gf = bf2f(prow[C_AF + dir * 4 + h]); R.aux = ((const float*)(rec0 + dir * RECB + REC_VEC))[66]; }
    else if (C.wave < 4) R.aux = ((const float*)(rec0 + (C.wave - 2) * RECB + REC_VEC))[C.lane];
}
DI void mlstm_c_unit(const Ctx& C0, int l, int c, int h, MCRegs& R, const float (&gain)[16], bool has_next, int cn, int hn) {
    Ctx C = C0; { int t_ = C0.tid; asm volatile("" : "+v"(t_)); C.tid = t_; C.lane = t_ & 63; }
    LAS unsigned char* L = C.lds + RING_OFF;
    LAS bf16_t* QS = (LAS bf16_t*)(L + MC_QS); LAS bf16_t* KS = (LAS bf16_t*)(L + MC_KS); LAS bf16_t* VT = (LAS bf16_t*)(L + MC_VT);
    LAS bf16_t* CT0 = (LAS bf16_t*)(L + MC_CT0); LAS bf16_t* CT1 = (LAS bf16_t*)(L + MC_CT1); LAS bf16_t* SB0 = (LAS bf16_t*)(L + MC_SB0); LAS bf16_t* SB1 = (LAS bf16_t*)(L + MC_SB1);
    LAS float* HS = (LAS float*)(L + MC_HS); LAS float* VEC = (LAS float*)(L + MC_VEC); const LAS float* cwt = (const LAS float*)(L + MC_CWT);
    const int row0 = c * 64;
    const float aux = R.aux;
    __syncthreads();
    if (C.wave < 2) {
        const int dir = C.wave, tt = dir ? 63 - C.lane : C.lane;
        const float* gb = INP(I_AGB) + l * 16;
        const float iv = R.gi + gb[dir * 4 + h], fv = logsigmoid_f(R.gf + gb[8 + dir * 4 + h]);
        const float b = wave_incl_sum(fv, C.lane);
        const float g = iv - b;
        const float cm = wave_incl_max(g, C.lane);
        const float m0 = aux;
        const float mm = fmaxf(m0, cm);
        LAS float* V = VEC + dir * 256;
        V[tt] = g; V[64 + tt] = mm; V[128 + tt] = __expf(m0 - mm); V[192 + tt] = __expf(-(b + mm));
    } else if (C.wave < 4) { (C.wave == 3 ? CT1 : CT0)[128 * LDT + C.lane] = (bf16_t)f2bf(aux); }
    else if (C.wave == 4) VT[128 * LDT + C.lane] = BF16_ONE;
    {
        const int t = C.lane, c8 = C.wave * 8;
        float y[8];
        conv_apply(R.q, cwt, c8, y);
        *(LAS v4u*)(QS + t * LDT + c8) = pack8f(y, 1.0f);
        conv_apply(R.k, cwt + 256, c8, y);
        *(LAS v4u*)(KS + t * LDT + c8) = pack8f(y, 0.125f);
        store_vt8(VT, R.v0, c8, t); store_vt8(VT, R.v1, 64 + c8, t);
    }
    store_ct16(CT0, R.s0a, R.s0b, C.tid); store_ct16(CT1, R.s1a, R.s1b, C.tid);
    const v4u og0 = R.og0, og1 = R.og1;
    asm volatile("" ::: "memory"); __builtin_amdgcn_sched_barrier(0);
    if (has_next) mlstm_c_load(C, cn, hn, R);
    asm volatile("" ::: "memory"); __builtin_amdgcn_sched_barrier(0);
    __syncthreads();
    {
        const int mt = C.wave & 3, nh = C.wave >> 2, fr = C.lane & 15, fq = C.lane >> 4;
        f32x4 acc[2]; acc[0] = (f32x4){0.f, 0.f, 0.f, 0.f}; acc[1] = acc[0];
        mma_tile<2, 2>(acc, QS + 16 * mt * LDT, LDT, KS + 32 * nh * LDT, LDT, C.lane);
#pragma unroll
        for (int nt = 0; nt < 2; ++nt)
#pragma unroll
            for (int i = 0; i < 4; ++i) {
                const int j = 16 * mt + fq * 4 + i, s2 = 32 * nh + nt * 16 + fr;
                const float v = acc[nt][i];
                const float d0 = __expf(VEC[s2] - VEC[64 + j]), d1 = __expf(VEC[256 + s2] - VEC[256 + 64 + j]);
                const unsigned pw = pk2(s2 <= j ? v * d0 : 0.f, s2 >= j ? v * d1 : 0.f);
                SB0[j * LDT + s2] = (bf16_t)pw; SB1[j * LDT + s2] = (bf16_t)(pw >> 16);
            }
    }
    __syncthreads();
    {
        const int mt = C.wave & 3, vh = C.wave >> 2, fr = C.lane & 15, fq = C.lane >> 4;
        f32x4 hsum[4];
#pragma unroll
        for (int nt = 0; nt < 4; ++nt) hsum[nt] = (f32x4){0.f, 0.f, 0.f, 0.f};
#pragma unroll
        for (int dir = 0; dir < 2; ++dir) {
            const LAS bf16_t* CT = dir ? CT1 : CT0; const LAS bf16_t* SB = dir ? SB1 : SB0; const LAS float* V = VEC + dir * 256;
            f32x4 acc[4], den[1];
#pragma unroll
            for (int nt = 0; nt < 4; ++nt) acc[nt] = (f32x4){0.f, 0.f, 0.f, 0.f};
            den[0] = (f32x4){0.f, 0.f, 0.f, 0.f};
            mma_tile<4, 2>(acc, QS + 16 * mt * LDT, LDT, CT + 64 * vh * LDT, LDT, C.lane);
            mma_tile<1, 2>(den, QS + 16 * mt * LDT, LDT, CT + 128 * LDT, LDT, C.lane);
#pragma unroll
            for (int i = 0; i < 4; ++i) { const float w = V[128 + 16 * mt + fq * 4 + i]; den[0][i] *= w;
#pragma unroll
                for (int nt = 0; nt < 4; ++nt) acc[nt][i] *= w; }
            mma_tile<4, 2>(acc, SB + 16 * mt * LDT, LDT, VT + 64 * vh * LDT, LDT, C.lane);
            mma_tile<1, 2>(den, SB + 16 * mt * LDT, LDT, VT + 128 * LDT, LDT, C.lane);
#pragma unroll
            for (int i = 0; i < 4; ++i) {
                const float dn = lx_f(den[0][i], C.lane & 48);
                const float inv = __builtin_amdgcn_rcpf(fmaxf(fabsf(dn), V[192 + 16 * mt + fq * 4 + i]));
#pragma unroll
                for (int nt = 0; nt < 4; ++nt) hsum[nt][i] += acc[nt][i] * inv;
            }
        }
#pragma unroll
        for (int i = 0; i < 4; ++i)
#pragma unroll
            for (int nt = 0; nt < 4; ++nt) HS[(16 * mt + fq * 4 + i) * 132 + 64 * vh + nt * 16 + fr] = hsum[nt][i];
    }
    __syncthreads();
    head_out<0, 132>(C, HS, og0, og1, row0, gain, (bf16_t*)(C.ws + WS_YA), h);
}
DI void load_gain16(float (&gain)[16], const float* g, int h, int tid) {
    asm volatile("" : "+v"(tid));
#pragma unroll
    for (int q = 0; q < 4; ++q) { const f32x4 v = *(const f32x4*)(g + h * 128 + (tid & 7) * 16 + 4 * q); gain[4 * q] = v[0]; gain[4 * q + 1] = v[1]; gain[4 * q + 2] = v[2]; gain[4 * q + 3] = v[3]; }
}
DI void mlstm_c_phase(const Ctx& C, int l) {
    LAS float* cwt = (LAS float*)(C.lds + RING_OFF + MC_CWT);
    int htab = -1; MCRegs R; float gain[16];
    const int NU = (l == DEPTH - 1 ? 512 : NCHUNK) * 4;
    int u = C.bx; if (u < NU) mlstm_c_load(C, u >> 2, u & 3, R);
    for (; u < NU; u += C.G) {
        const int h = u & 3, un = u + C.G;
        if (h != htab) { __syncthreads(); conv_table(C, cwt, l, h); load_gain16(gain, INP(I_ANG) + (size_t)l * 512, h, C.tid); htab = h; }
        mlstm_c_unit(C, l, u >> 2, h, R, gain, un < NU, un >> 2, un & 3);
    }
}

constexpr int LAP = 68;
constexpr int GA_LA0 = 0, GA_LA1 = 17408, GA_VT = 34816, GA_KT0 = 53248, GA_KT1 = 62464, GA_LOW = 71680, GA_WUT0 = 76800, GA_WUT1 = 81920;
constexpr int GC_QS0 = 0, GC_QS1 = 9216, GC_VT = 18432, GC_CT0 = 36864, GC_CT1 = 55296, GC_SB0 = 73728, GC_SB1 = 82944, GC_KS0 = 92160, GC_KS1 = 101376, GC_LA0 = 110592, GC_LA1 = 128000, GC_HS = 92160;
constexpr int GC_LOW = GC_CT0, GC_WUT0 = 145408, GC_WUT1 = 145408 + 5120;
static_assert(GC_WUT1 + 5120 <= RING_BYTES && GC_HS + 64 * 128 * 4 <= GC_LA1, "GLA (c) LDS map");
constexpr int LWD = 40;
struct GARegs { v4u low, k, v0, v1; };
struct GCRegs { v4u low, q, k, v0, v1, og0, og1; };
DI void gla_wut_table(const Ctx& C, LAS bf16_t* WUT0, LAS bf16_t* WUT1, int l, int h) {
    const int dir = C.tid >> 8, dk = (C.tid >> 2) & 63, ig = C.tid & 3;
    float w[8];
    const bool live = (ig >> 1) == dir;
    const float* wu = INP(I_CWUP) + ((size_t)(l * 2 + dir) * 16 + (ig & 1) * 8) * 256 + h * 64 + dk;
#pragma unroll
    for (int e = 0; e < 8; ++e) w[e] = live ? wu[e * 256] : 0.f;
    *(LAS v4u*)((dir ? WUT1 : WUT0) + dk * LWD + ig * 8) = pack8f(w, 1.0f);
}
DI void gla_logdecay(const Ctx& C, const v4u lowreg, const float (&bu)[4], LAS float* LA0, LAS float* LA1, LAS bf16_t* LOW, const LAS bf16_t* WUT0, const LAS bf16_t* WUT1) {
    { const int t = C.tid >> 3, part = C.tid & 7; if (part < 4) *(LAS v4u*)(LOW + t * LWD + part * 8) = lowreg; }
    __syncthreads();
    {
        const int dir = C.wave >> 2, mt = C.wave & 3, fr = C.lane & 15, fq = C.lane >> 4;
        f32x4 acc[4];
#pragma unroll
        for (int nt = 0; nt < 4; ++nt) acc[nt] = (f32x4){0.f, 0.f, 0.f, 0.f};
        mma_tile<4, 1>(acc, LOW + 16 * mt * LWD, LWD, dir ? WUT1 : WUT0, LWD, C.lane);
        LAS float* LA = dir ? LA1 : LA0;
#pragma unroll
        for (int nt = 0; nt < 4; ++nt)
#pragma unroll
            for (int i = 0; i < 4; ++i) LA[(16 * mt + fq * 4 + i) * LAP + nt * 16 + fr] = logsigmoid_f(acc[nt][i] + bu[nt]) * (1.0f / 16.0f);
    }
    __syncthreads();
    if (C.wave < 2) {
        LAS float* LA = C.wave ? LA1 : LA0;
        float a[64];
#pragma unroll
        for (int q = 0; q < 64; ++q) a[q] = LA[(C.wave ? 63 - q : q) * LAP + C.lane];
#pragma unroll
        for (int q = 1; q < 64; ++q) a[q] += a[q - 1];
#pragma unroll
        for (int q = 0; q < 64; ++q) LA[(C.wave ? 63 - q : q) * LAP + C.lane] = a[q];
    }
    __syncthreads();
}
DI void gla_bias4(float (&bu)[4], const Ctx& C, int l, int h) {
    int ln = C.lane; asm volatile("" : "+v"(ln));
    const float* b = INP(I_CBUP) + (size_t)(l * 2 + (C.wave >> 2)) * 256 + h * 64 + (ln & 15);
#pragma unroll
    for (int nt = 0; nt < 4; ++nt) bu[nt] = b[nt * 16];
}
DI void gla_a_load(const Ctx& C, int c, int h, GARegs& R) {
    const bf16_t* P = (const bf16_t*)(C.ws + WS_P);
    const int t = C.lane, c8 = C.wave * 8;
    const bf16_t* pr = P + (size_t)(c * 64 + t) * PW;
    R.low = *(const v4u*)(P + (size_t)(c * 64 + (C.tid >> 3)) * PW + C_CA + (C.tid & 3) * 8);
    R.k = *(const v4u*)(pr + C_CK + h * 64 + c8);
    R.v0 = *(const v4u*)(pr + C_CV + h * 128 + c8); R.v1 = *(const v4u*)(pr + C_CV + h * 128 + 64 + c8);
}
DI void gla_a_unit(const Ctx& C0, int c, int h, GARegs& R, const float (&bu)[4], bool has_next, int cn, int hn) {
    Ctx C = C0; { int t_ = C0.tid; asm volatile("" : "+v"(t_)); C.tid = t_; C.lane = t_ & 63; }
    LAS unsigned char* L = C.lds + RING_OFF;
    LAS float* LA0 = (LAS float*)(L + GA_LA0); LAS float* LA1 = (LAS float*)(L + GA_LA1);
    LAS bf16_t* VT = (LAS bf16_t*)(L + GA_VT); LAS bf16_t* KT0 = (LAS bf16_t*)(L + GA_KT0); LAS bf16_t* KT1 = (LAS bf16_t*)(L + GA_KT1);
    unsigned char* rec0 = rec_ptr(C.ws + WS_STC, c, h, 0);
    const int t = C.lane, c8 = C.wave * 8;
    __syncthreads();
    store_vt8(VT, R.v0, c8, t); store_vt8(VT, R.v1, 64 + c8, t);
    const v4u kreg = R.k;
    gla_logdecay(C, R.low, bu, LA0, LA1, (LAS bf16_t*)(L + GA_LOW), (const LAS bf16_t*)(L + GA_WUT0), (const LAS bf16_t*)(L + GA_WUT1));
    asm volatile("" ::: "memory"); __builtin_amdgcn_sched_barrier(0);
    if (has_next) gla_a_load(C, cn, hn, R);
    asm volatile("" ::: "memory"); __builtin_amdgcn_sched_barrier(0);
    {
        float k[8]; unpack8(kreg, k);
        float l0[8], l1[8], t0[8], t1[8];
        { const f32x4 a0 = *(const LAS f32x4*)(LA0 + t * LAP + c8), a1 = *(const LAS f32x4*)(LA0 + t * LAP + c8 + 4), b0 = *(const LAS f32x4*)(LA1 + t * LAP + c8), b1 = *(const LAS f32x4*)(LA1 + t * LAP + c8 + 4);
          const f32x4 e0 = *(const LAS f32x4*)(LA0 + 63 * LAP + c8), e1 = *(const LAS f32x4*)(LA0 + 63 * LAP + c8 + 4), f0 = *(const LAS f32x4*)(LA1 + c8), f1 = *(const LAS f32x4*)(LA1 + c8 + 4);
#pragma unroll
          for (int e = 0; e < 4; ++e) { l0[e] = a0[e]; l0[4 + e] = a1[e]; l1[e] = b0[e]; l1[4 + e] = b1[e]; t0[e] = e0[e]; t0[4 + e] = e1[e]; t1[e] = f0[e]; t1[4 + e] = f1[e]; } }
#pragma unroll
        for (int e = 0; e < 8; ++e) {
            const unsigned pw = pk2(k[e] * __expf(t0[e] - l0[e]), k[e] * __expf(t1[e] - l1[e]));
            KT0[(c8 + e) * LDT + t] = (bf16_t)pw; KT1[(c8 + e) * LDT + t] = (bf16_t)(pw >> 16);
        }
        if (C.tid < 64) ((float*)(rec0 + REC_VEC))[C.tid] = __expf(LA0[63 * LAP + C.tid]);
        else if (C.tid < 128) ((float*)(rec0 + RECB + REC_VEC))[C.tid - 64] = __expf(LA1[C.tid - 64]);
    }
    __syncthreads();
    delta_store<false>(C, (C.wave >> 2) ? KT1 : KT0, VT, rec0 + (C.wave >> 2) * RECB);
}
DI void gla_a_phase(const Ctx& C, int l) {
    LAS unsigned char* L = C.lds + RING_OFF;
    int htab = -1; GARegs R; float bu[4];
    int u = C.bx + (C.G >> 1); if (u >= C.G) u -= C.G;
    if (u < NCHUNK * 4) gla_a_load(C, u >> 2, u & 3, R);
    for (; u < NCHUNK * 4; u += C.G) {
        const int h = u & 3, un = u + C.G;
        if (h != htab) { __syncthreads(); gla_wut_table(C, (LAS bf16_t*)(L + GA_WUT0), (LAS bf16_t*)(L + GA_WUT1), l, h); gla_bias4(bu, C, l, h); htab = h; }
        gla_a_unit(C, u >> 2, h, R, bu, un < NCHUNK * 4, un >> 2, un & 3);
    }
}
DI void gla_c_load(const Ctx& C, int c, int h, GCRegs& R) {
    const bf16_t* P = (const bf16_t*)(C.ws + WS_P);
    const int t = C.lane, c8 = C.wave * 8;
    const bf16_t* pr = P + (size_t)(c * 64 + t) * PW;
    R.low = *(const v4u*)(P + (size_t)(c * 64 + (C.tid >> 3)) * PW + C_CA + (C.tid & 3) * 8);
    R.q = *(const v4u*)(pr + C_CQ + h * 64 + c8); R.k = *(const v4u*)(pr + C_CK + h * 64 + c8);
    R.v0 = *(const v4u*)(pr + C_CV + h * 128 + c8); R.v1 = *(const v4u*)(pr + C_CV + h * 128 + 64 + c8);
    { const bf16_t* po = P + (size_t)(c * 64 + (C.tid >> 3)) * PW + C_CR + h * 128 + (C.tid & 7) * 16; R.og0 = *(const v4u*)po; R.og1 = *(const v4u*)(po + 8); }
}
DI void gla_c_unit(const Ctx& C0, int c, int h, GCRegs& R, const float (&bu)[4], const float (&gain)[16], bool has_next, int cn, int hn) {
    Ctx C = C0; { int t_ = C0.tid; asm volatile("" : "+v"(t_)); C.tid = t_; C.lane = t_ & 63; }
    LAS unsigned char* L = C.lds + RING_OFF;
    LAS bf16_t* QS0 = (LAS bf16_t*)(L + GC_QS0); LAS bf16_t* QS1 = (LAS bf16_t*)(L + GC_QS1); LAS bf16_t* KS0 = (LAS bf16_t*)(L + GC_KS0); LAS bf16_t* KS1 = (LAS bf16_t*)(L + GC_KS1);
    LAS bf16_t* VT = (LAS bf16_t*)(L + GC_VT); LAS bf16_t* CT0 = (LAS bf16_t*)(L + GC_CT0); LAS bf16_t* CT1 = (LAS bf16_t*)(L + GC_CT1);
    LAS bf16_t* SB0 = (LAS bf16_t*)(L + GC_SB0); LAS bf16_t* SB1 = (LAS bf16_t*)(L + GC_SB1);
    LAS float* LA0 = (LAS float*)(L + GC_LA0); LAS float* LA1 = (LAS float*)(L + GC_LA1); LAS float* HS = (LAS float*)(L + GC_HS);
    const int t = C.lane, c8 = C.wave * 8;
    const unsigned char* rec0 = rec_ptr(C.ws + WS_STC, c, h, 0);
    const v4u s1a = *(const v4u*)(rec0 + RECB + C.tid * 16), s1b = *(const v4u*)(rec0 + RECB + 8192 + C.tid * 16);
    __syncthreads();
    store_vt8(VT, R.v0, c8, t); store_vt8(VT, R.v1, 64 + c8, t);
    const v4u s0a = *(const v4u*)(rec0 + C.tid * 16), s0b = *(const v4u*)(rec0 + 8192 + C.tid * 16);
    store_ct16(CT1, s1a, s1b, C.tid);
    gla_logdecay(C, R.low, bu, LA0, LA1, (LAS bf16_t*)(L + GC_LOW), (const LAS bf16_t*)(L + GC_WUT0), (const LAS bf16_t*)(L + GC_WUT1));
    {
        float q[8], k[8], a[8], b[8];
        unpack8(R.q, q); unpack8(R.k, k);
        float lb[8];
        { const f32x4 x0 = *(const LAS f32x4*)(LA0 + t * LAP + c8), x1 = *(const LAS f32x4*)(LA0 + t * LAP + c8 + 4);
#pragma unroll
          for (int e = 0; e < 4; ++e) { lb[e] = x0[e]; lb[4 + e] = x1[e]; } }
#pragma unroll
        for (int e = 0; e < 8; ++e) { const float bb = lb[e]; a[e] = q[e] * 0.125f * __expf(bb); b[e] = k[e] * __expf(-bb); }
        *(LAS v4u*)(QS0 + t * LDT + c8) = pack8f(a, 1.0f); *(LAS v4u*)(KS0 + t * LDT + c8) = pack8f(b, 1.0f);
        { const f32x4 x0 = *(const LAS f32x4*)(LA1 + t * LAP + c8), x1 = *(const LAS f32x4*)(LA1 + t * LAP + c8 + 4);
#pragma unroll
          for (int e = 0; e < 4; ++e) { lb[e] = x0[e]; lb[4 + e] = x1[e]; } }
#pragma unroll
        for (int e = 0; e < 8; ++e) { const float bb = lb[e]; a[e] = q[e] * 0.125f * __expf(bb); b[e] = k[e] * __expf(-bb); }
        *(LAS v4u*)(QS1 + t * LDT + c8) = pack8f(a, 1.0f); *(LAS v4u*)(KS1 + t * LDT + c8) = pack8f(b, 1.0f);
    }
    store_ct16(CT0, s0a, s0b, C.tid);
    const v4u og0 = R.og0, og1 = R.og1;
    asm volatile("" ::: "memory"); __builtin_amdgcn_sched_barrier(0);
    if (has_next) gla_c_load(C, cn, hn, R);
    asm volatile("" ::: "memory"); __builtin_amdgcn_sched_barrier(0);
    __syncthreads();
    {
        const int mt = C.wave & 3, nh = C.wave >> 2, fr = C.lane & 15, fq = C.lane >> 4;
#pragma unroll
        for (int dir = 0; dir < 2; ++dir) {
            f32x4 acc[2]; acc[0] = (f32x4){0.f, 0.f, 0.f, 0.f}; acc[1] = acc[0];
            mma_tile<2, 2>(acc, (dir ? QS1 : QS0) + 16 * mt * LDT, LDT, (dir ? KS1 : KS0) + 32 * nh * LDT, LDT, C.lane);
            LAS bf16_t* SB = dir ? SB1 : SB0;
#pragma unroll
            for (int nt = 0; nt < 2; ++nt)
#pragma unroll
                for (int i = 0; i < 4; ++i) { const int j = 16 * mt + fq * 4 + i, s2 = 32 * nh + nt * 16 + fr; const bool keep = dir ? (s2 >= j) : (s2 <= j); SB[j * LDT + s2] = (bf16_t)f2bf(keep ? acc[nt][i] : 0.f); }
        }
    }
    __syncthreads();
    {
        const int mt = C.wave & 3, vh = C.wave >> 2, fr = C.lane & 15, fq = C.lane >> 4;
        f32x4 acc[4];
#pragma unroll
        for (int nt = 0; nt < 4; ++nt) acc[nt] = (f32x4){0.f, 0.f, 0.f, 0.f};
        mma_tile<4, 2>(acc, QS0 + 16 * mt * LDT, LDT, CT0 + 64 * vh * LDT, LDT, C.lane);
        mma_tile<4, 2>(acc, SB0 + 16 * mt * LDT, LDT, VT + 64 * vh * LDT, LDT, C.lane);
        mma_tile<4, 2>(acc, QS1 + 16 * mt * LDT, LDT, CT1 + 64 * vh * LDT, LDT, C.lane);
        mma_tile<4, 2>(acc, SB1 + 16 * mt * LDT, LDT, VT + 64 * vh * LDT, LDT, C.lane);
#pragma unroll
        for (int i = 0; i < 4; ++i)
#pragma unroll
            for (int nt = 0; nt < 4; ++nt) HS[(16 * mt + fq * 4 + i) * 128 + 64 * vh + nt * 16 + fr] = acc[nt][i];
    }
    __syncthreads();
    head_out<1, 128>(C, HS, og0, og1, c * 64, gain, (bf16_t*)(C.ws + WS_YA) + 1024, h);
}
DI void gla_c_phase(const Ctx& C, int l) {
    LAS unsigned char* L = C.lds + RING_OFF;
    int htab = -1; GCRegs R; float bu[4], gain[16];
    const int NU = (l == DEPTH - 1 ? 512 : NCHUNK) * 4;
    int u = C.bx + (C.G >> 1); if (u >= C.G) u -= C.G;
    if (u < NU) gla_c_load(C, u >> 2, u & 3, R);
    for (; u < NU; u += C.G) {
        const int h = u & 3, un = u + C.G;
        if (h != htab) { __syncthreads(); gla_wut_table(C, (LAS bf16_t*)(L + GC_WUT0), (LAS bf16_t*)(L + GC_WUT1), l, h); gla_bias4(bu, C, l, h); load_gain16(gain, INP(I_CNG) + (size_t)l * 512, h, C.tid); htab = h; }
        gla_c_unit(C, u >> 2, h, R, bu, gain, un < NU, un >> 2, un & 3);
    }
}

DI int chain_chunk(int b, int dir, int n) { return n < 4 ? 512 + 4 * b + (dir ? 3 - n : n) : 64 * b + (dir ? 67 - n : n - 4); }
DI void unpack8s(const v4u x, float (&f)[8]) { unpack8(x, f); }
#ifndef PROBE_SKIP
#define PROBE_SKIP 0
#endif
DI void scan_b_units(const Ctx& C, bool probe = false) {
    for (int u = C.bx; u < 256; u += C.G) {
        const int mixer = u >> 7, item = (u & 127) * 2 + (C.wave >> 2), chain = item >> 2, slab = item & 3;
        const int b = chain >> 3, h = (chain >> 1) & 3, dir = chain & 1, tl = C.tid & 255, elem = slab * 2048 + tl * 8;
        unsigned char* base = C.ws + (probe ? WS_A2 + (size_t)mixer * ((size_t)NCHUNK * 8 * RECB) : (mixer ? WS_STC : WS_STA));
        float zz = 0.f; asm volatile("" : "+v"(zz));
        float st[8];
#pragma unroll
        for (int e = 0; e < 8; ++e) st[e] = zz;
        if (mixer == 0) {
            const bool nthr = (slab == 0 && tl < 64), mthr = (slab == 0 && tl == 0);
            float m = 0.f, nst = 0.f;
            v4u d[8]; float sB[8], sM[8], dn[8];
#define SB_LOAD_M(q, n) do { const unsigned char* r2 = rec_ptr(base, chain_chunk(b, dir, (n)), h, dir); const float* r2f = (const float*)(r2 + REC_VEC); d[q] = *(const v4u*)(r2 + elem * 2); sB[q] = r2f[64]; sM[q] = r2f[65]; dn[q] = nthr ? r2f[tl] : 0.f; } while (0)
#define SB_STEP_M(q, n, PF) do { unsigned char* rec = rec_ptr(base, chain_chunk(b, dir, (n)), h, dir); float* rf = (float*)(rec + REC_VEC); \
                float dd[8]; unpack8(d[q], dd); const float B = sB[q], Ml = sM[q], dnn = dn[q]; \
                if (!(probe && PROBE_SKIP == 7)) { *(v4u*)(rec + elem * 2) = pack8f(st, 1.0f); if (nthr) rf[tl] = nst; if (mthr) rf[66] = m; } \
                if (PF) SB_LOAD_M(q, (n) + 8); \
                const float mn = fmaxf(B + m, Ml), dec = __expf(B + m - mn), sc = __expf(Ml - mn); \
                _Pragma("unroll") for (int e = 0; e < 8; ++e) st[e] = st[e] * dec + dd[e] * sc; \
                nst = nst * dec + dnn * sc; m = mn; } while (0)
#pragma unroll
            for (int q = 0; q < 8; ++q) SB_LOAD_M(q, q);
            for (int n0 = 0; n0 < 56; n0 += 8) {
#pragma unroll
                for (int q = 0; q < 8; ++q) SB_STEP_M(q, n0 + q, true);
            }
#pragma unroll
            for (int q = 0; q < 8; ++q) SB_STEP_M(q, 56 + q, q < 4);
#pragma unroll
            for (int q = 0; q < 4; ++q) SB_STEP_M(q, 64 + q, false);
#undef SB_LOAD_M
#undef SB_STEP_M
        } else {
            v4u d[8]; f32x4 dca[8], dcb[8];
#define SB_LOAD_G(q, n) do { const unsigned char* r2 = rec_ptr(base, chain_chunk(b, dir, (n)), h, dir); const float* r2f = (const float*)(r2 + REC_VEC) + (elem & 63); d[q] = *(const v4u*)(r2 + elem * 2); dca[q] = *(const f32x4*)r2f; dcb[q] = *(const f32x4*)(r2f + 4); } while (0)
#define SB_STEP_G(q, n, PF) do { unsigned char* rec = rec_ptr(base, chain_chunk(b, dir, (n)), h, dir); \
                float dd[8]; unpack8(d[q], dd); const f32x4 da = dca[q], db = dcb[q]; \
                if (!(probe && PROBE_SKIP == 7)) *(v4u*)(rec + elem * 2) = pack8f(st, 1.0f); \
                if (PF) SB_LOAD_G(q, (n) + 8); \
                _Pragma("unroll") for (int e = 0; e < 4; ++e) { st[e] = st[e] * da[e] + dd[e]; st[4 + e] = st[4 + e] * db[e] + dd[4 + e]; } } while (0)
#pragma unroll
            for (int q = 0; q < 8; ++q) SB_LOAD_G(q, q);
            for (int n0 = 0; n0 < 56; n0 += 8) {
#pragma unroll
                for (int q = 0; q < 8; ++q) SB_STEP_G(q, n0 + q, true);
            }
#pragma unroll
            for (int q = 0; q < 8; ++q) SB_STEP_G(q, 56 + q, q < 4);
#pragma unroll
            for (int q = 0; q < 4; ++q) SB_STEP_G(q, 64 + q, false);
#undef SB_LOAD_G
#undef SB_STEP_G
        }
    }
}

constexpr int RH_HT = 0, RH_LD = 1028, RH_PART = 16 * RH_LD * 4, RH_PLD = 33;
constexpr int RL_CNT = 131584;
static_assert(RH_PART + 8 * 16 * RH_PLD * 4 <= RL_CNT && RL_CNT + 3 * 32 * 4 + 2 * 512 * 4 <= RING_BYTES, "router LDS map");
DI void phase_norm2_router(const Ctx& C, int l) {
    const int lane = C.lane, w = C.wave;
    const bf16_t* X = (const bf16_t*)(C.ws + WS_X); unsigned char* H8 = (unsigned char*)(C.ws + WS_H);
    const bf16_t* U = (const bf16_t*)(C.ws + WS_U);
    const float* MOD = (const float*)(C.ws + WS_MOD);
    int* TOKE = (int*)(C.ws + WS_TOKE); int* TOKP = (int*)(C.ws + WS_TOKP); float* TOKW = (float*)(C.ws + WS_TOKW);
    LAS float* HT = (LAS float*)(C.lds + RING_OFF + RH_HT); LAS float* PART = (LAS float*)(C.lds + RING_OFF + RH_PART); LAS int* cnt = (LAS int*)(C.lds + RING_OFF + RL_CNT);
    __syncthreads();
    if (C.tid < 32) cnt[C.tid] = 0;
    float Wreg[2][8][4];
    {
        const float* Wr = INP(I_WR) + (size_t)l * DM * NEXP + (size_t)(128 * w + 4 * (lane >> 4)) * NEXP + (lane & 15);
#pragma unroll
        for (int tl = 0; tl < 2; ++tl)
#pragma unroll
            for (int j = 0; j < 8; ++j)
#pragma unroll
                for (int m = 0; m < 4; ++m) Wreg[tl][j][m] = Wr[(size_t)(16 * j + m) * NEXP + 16 * tl];
    }
    f32x4 gn[4];
#pragma unroll
    for (int j = 0; j < 4; ++j) gn[j] = *(const f32x4*)(INP(I_GN2) + (size_t)l * DM + (lane + 64 * j) * 4);
    const float brl = INP(I_BR)[l * NEXP + (lane & 31)];
    const int ntiles = (l == DEPTH - 1 ? M_LAT : MROWS) / 16;
    v2u xr[2][4], ur[2][4];
    if (C.bx < ntiles) {
#pragma unroll
        for (int q = 0; q < 2; ++q)
#pragma unroll
            for (int j = 0; j < 4; ++j) { const size_t o = (size_t)(C.bx * 16 + 2 * w + q) * DM + (lane + 64 * j) * 4; xr[q][j] = *(const v2u*)(X + o); ur[q][j] = *(const v2u*)(U + o); }
    }
    for (int tile = C.bx; tile < ntiles; tile += C.G) {
        const int r0 = tile * 16 + 2 * w, mi = r0 < M_LAT ? (r0 >> 12) : 8;
        const float* sh = MOD + ((size_t)l * 9 + mi) * 6144 + 3 * DM; const float* sc = sh + DM; const float* g1 = sh - DM;
        f32x4 h[2][4]; float ss[2] = {0.f, 0.f};
#pragma unroll
        for (int q = 0; q < 2; ++q)
#pragma unroll
            for (int j = 0; j < 4; ++j) { const int c = (lane + 64 * j) * 4; const v2u uu = ur[q][j], xx = xr[q][j]; const f32x4 gg = *(const f32x4*)(g1 + c);
                h[q][j] = (f32x4){bf2f(xx.x & 0xffffu), bf2f(xx.x >> 16), bf2f(xx.y & 0xffffu), bf2f(xx.y >> 16)} + gg * (f32x4){bf2f(uu.x & 0xffffu), bf2f(uu.x >> 16), bf2f(uu.y & 0xffffu), bf2f(uu.y >> 16)};
                ss[q] += (h[q][j][0] * h[q][j][0] + h[q][j][1] * h[q][j][1]) + (h[q][j][2] * h[q][j][2] + h[q][j][3] * h[q][j][3]); }
        if (tile + C.G < ntiles) {
#pragma unroll
            for (int q = 0; q < 2; ++q)
#pragma unroll
                for (int j = 0; j < 4; ++j) { const size_t o = (size_t)((tile + C.G) * 16 + 2 * w + q) * DM + (lane + 64 * j) * 4; xr[q][j] = *(const v2u*)(X + o); ur[q][j] = *(const v2u*)(U + o); }
        }
#pragma unroll
        for (int q = 0; q < 2; ++q) {
            const float rstd = __builtin_amdgcn_rsqf(wave_sum(ss[q], lane) * (1.0f / DM) + EPS);
#pragma unroll
            for (int j = 0; j < 4; ++j) {
                const int c = (lane + 64 * j) * 4;
                const f32x4 s1 = *(const f32x4*)(sc + c), s0 = *(const f32x4*)(sh + c);
                const f32x4 hh = h[q][j] * rstd * gn[j] * (s1 + 1.0f) + s0;
                *(unsigned*)(H8 + (size_t)(r0 + q) * DM + c) = pk4_fp8(hh[0] * FP8_SH, hh[1] * FP8_SH, hh[2] * FP8_SH, hh[3] * FP8_SH);
                *(LAS f32x4*)(HT + (2 * w + q) * RH_LD + c) = hh;
            }
        }
        __syncthreads();
        {
            f32x4 acc0 = (f32x4){0.f, 0.f, 0.f, 0.f}, acc1 = acc0;
            const LAS float* ap = HT + (lane & 15) * RH_LD + 128 * w + 4 * (lane >> 4);
#pragma unroll
            for (int j = 0; j < 8; ++j) {
                const f32x4 a = *(const LAS f32x4*)(ap + 16 * j);
#pragma unroll
                for (int m = 0; m < 4; ++m) { acc0 = __builtin_amdgcn_mfma_f32_16x16x4f32(a[m], Wreg[0][j][m], acc0, 0, 0, 0); acc1 = __builtin_amdgcn_mfma_f32_16x16x4f32(a[m], Wreg[1][j][m], acc1, 0, 0, 0); }
            }
            LAS float* pp = PART + (w * 16 + 4 * (lane >> 4)) * RH_PLD + (lane & 15);
#pragma unroll
            for (int i = 0; i < 4; ++i) { pp[i * RH_PLD] = acc0[i]; pp[i * RH_PLD + 16] = acc1[i]; }
        }
        __syncthreads();
        {
            const int rowl = 2 * w + (lane >> 5), mye = lane & 31, myrow = tile * 16 + rowl;
            float my = brl;
#pragma unroll
            for (int ww = 0; ww < 8; ++ww) my += PART[(ww * 16 + rowl) * RH_PLD + mye];
            float tv[4]; int ti[4];
            {
                const bool hi2 = lane >= 32; int rank = 0;
#pragma unroll
                for (int j = 0; j < 32; ++j) {
                    const float oa = __int_as_float(__builtin_amdgcn_readlane(__float_as_int(my), j)), ob = __int_as_float(__builtin_amdgcn_readlane(__float_as_int(my), 32 + j));
                    const float o = hi2 ? ob : oa;
                    rank += (o > my || (o == my && j < mye)) ? 1 : 0;
                }
#pragma unroll
                for (int k = 0; k < 4; ++k) {
                    const unsigned long long bal = __ballot(rank == k);
                    const int ia = __builtin_ctz((unsigned)bal), ib = __builtin_ctz((unsigned)(bal >> 32));
                    const float va = __int_as_float(__builtin_amdgcn_readlane(__float_as_int(my), ia)), vb = __int_as_float(__builtin_amdgcn_readlane(__float_as_int(my), 32 + ib));
                    tv[k] = hi2 ? vb : va; ti[k] = hi2 ? ib : ia;
                }
            }
            const float e1 = __expf(tv[1] - tv[0]), e2 = __expf(tv[2] - tv[0]), e3 = __expf(tv[3] - tv[0]);
            const float inv = __builtin_amdgcn_rcpf(((1.0f + e1) + e2) + e3);
            if (mye < 4) {
                const int ek = mye == 0 ? ti[0] : mye == 1 ? ti[1] : mye == 2 ? ti[2] : ti[3];
                const float wk = (mye == 0 ? 1.0f : mye == 1 ? e1 : mye == 2 ? e2 : e3) * inv;
                const int pos = atomicAdd((int*)(cnt + ek), 1);
                const size_t o = (size_t)myrow * 4 + mye;
                TOKE[o] = ek; TOKP[o] = pos; TOKW[o] = wk;
            }
        }
    }
    __syncthreads();
    if (C.tid < 32) ((int*)(C.ws + WS_BLKCNT))[C.bx * 32 + C.tid] = cnt[C.tid];
}

DI void phase_gather(const Ctx& C, int l) {
    const int lane = C.lane;
    const unsigned char* H8 = (const unsigned char*)(C.ws + WS_H); unsigned char* XG = (unsigned char*)(C.ws + WS_XG);
    const int* TOKE = (const int*)(C.ws + WS_TOKE); int* TOKP = (int*)(C.ws + WS_TOKP); const float* TOKW = (const float*)(C.ws + WS_TOKW);
    float* SLOTW = (float*)(C.ws + WS_SLOTW); int* META = (int*)(C.ws + WS_MOEMETA);
    const int* BLKCNT = (const int*)(C.ws + WS_BLKCNT);
    LAS int* base = (LAS int*)(C.lds + RING_OFF + RL_CNT + 128); LAS int* tot = (LAS int*)(C.lds + RING_OFF + RL_CNT + 256);
    __syncthreads();
    {
        LAS int* pt = (LAS int*)(C.lds + RING_OFF + RL_CNT + 384); LAS int* pp = pt + 512;
        const int e = C.tid & 31, cq = C.tid >> 5;
        int t = 0, pre = 0;
#pragma unroll 16
        for (int b = cq; b < C.G; b += 16) { const int c = BLKCNT[b * 32 + e]; pre += (b < C.bx) ? c : 0; t += c; }
        pt[cq * 32 + e] = t; pp[cq * 32 + e] = pre;
        __syncthreads();
        if (C.tid < 32) { int ts = 0, ps = 0;
#pragma unroll
            for (int q = 0; q < 16; ++q) { ts += pt[q * 32 + C.tid]; ps += pp[q * 32 + C.tid]; }
            tot[C.tid] = ts; base[C.tid] = ps; }
    }
    __syncthreads();
    LAS int* toff = (LAS int*)(C.lds + RING_OFF + RL_CNT + 384);
    if (C.tid == 0) {
        int off = 0;
#pragma unroll 1
        for (int e = 0; e < NEXP; ++e) { const int padded = (tot[e] + 255) & ~255; base[e] += off; toff[e] = off >> 8; off += padded; }
        toff[NEXP] = off >> 8;
        if (C.bx == 0) META[0] = off >> 8;
    }
    __syncthreads();
    if (C.bx == 0) {
        const int nt = toff[NEXP];
        for (int t = C.tid; t < nt; t += 512) { int e = 0;
#pragma unroll
            for (int q = 1; q < NEXP; ++q) e += (t >= toff[q]) ? 1 : 0;
            META[16 + t] = e; }
    }
    const int ntiles = (l == DEPTH - 1 ? M_LAT : MROWS) / 16;
    int4 e4[2], p4[2]; f32x4 w4[2]; v4u a[2];
    if (C.bx < ntiles) {
#pragma unroll
        for (int q = 0; q < 2; ++q) { const int r = C.bx * 16 + 2 * C.wave + q;
            e4[q] = *(const int4*)(TOKE + (size_t)r * 4); p4[q] = *(const int4*)(TOKP + (size_t)r * 4); w4[q] = *(const f32x4*)(TOKW + (size_t)r * 4); a[q] = *(const v4u*)(H8 + (size_t)r * DM + lane * 16); }
    }
    for (int tile = C.bx; tile < ntiles; tile += C.G) {
        int4 ce[2], cp[2]; f32x4 cw[2]; v4u ca[2];
#pragma unroll
        for (int q = 0; q < 2; ++q) { ce[q] = e4[q]; cp[q] = p4[q]; cw[q] = w4[q]; ca[q] = a[q]; }
        if (tile + C.G < ntiles) {
#pragma unroll
            for (int q = 0; q < 2; ++q) { const int r = (tile + C.G) * 16 + 2 * C.wave + q;
                e4[q] = *(const int4*)(TOKE + (size_t)r * 4); p4[q] = *(const int4*)(TOKP + (size_t)r * 4); w4[q] = *(const f32x4*)(TOKW + (size_t)r * 4); a[q] = *(const v4u*)(H8 + (size_t)r * DM + lane * 16); }
        }
#pragma unroll
        for (int q = 0; q < 2; ++q) {
            const int r = tile * 16 + 2 * C.wave + q;
            const int s0 = base[ce[q].x] + cp[q].x, s1 = base[ce[q].y] + cp[q].y, s2 = base[ce[q].z] + cp[q].z, s3 = base[ce[q].w] + cp[q].w;
            *(v4u*)(XG + (size_t)s0 * DM + lane * 16) = ca[q]; *(v4u*)(XG + (size_t)s1 * DM + lane * 16) = ca[q]; *(v4u*)(XG + (size_t)s2 * DM + lane * 16) = ca[q]; *(v4u*)(XG + (size_t)s3 * DM + lane * 16) = ca[q];
            if (lane == 0) { *(int4*)(TOKP + (size_t)r * 4) = make_int4(s0, s1, s2, s3); SLOTW[s0] = cw[q][0]; SLOTW[s1] = cw[q][1]; SLOTW[s2] = cw[q][2]; SLOTW[s3] = cw[q][3]; }
        }
    }
}

DI void phase_attention(const Ctx& C, char* lds_generic, bool with_ctx) {
    typedef attn_body::bf16 abf;
    const abf* QR = (const abf*)(C.ws + WS_QR); const abf* KR = (const abf*)(C.ws + WS_KR); const abf* VR = (const abf*)(C.ws + WS_VR); abf* YB = (abf*)(C.ws + WS_YA) + 512;
    const int vcu = (C.G % 8 == 0) ? (C.bx % 8) * (C.G / 8) + C.bx / 8 : C.bx;
    const int per = (1024 + C.G - 1) / C.G;
    for (int i = 0; i < per; ++i) {
        const int idx = vcu * per + i; if (idx >= 1024) break;
        const int grp = idx >> 6, b = grp >> 1, kvh = grp & 1, hq = kvh * 4 + ((idx >> 4) & 3), qb = idx & 15;
        attn_body::attn_unit<8>((long)b * SEQ + qb * 256, hq, KVLEN / 64, QR, KR + (size_t)b * KVLEN * 128 + kvh * 64, VR + (size_t)b * KVLEN * 128 + kvh * 64, YB, lds_generic, C.wave);
    }
    for (int idx = C.bx; with_ctx && idx < 64; idx += C.G) {
        const int b = idx >> 3, hq = idx & 7;
        attn_body::attn_unit<8>((long)M_LAT + b * CTXL, hq, CTXL / 64, QR, KR + (size_t)b * KVLEN * 128 + (hq >> 2) * 64, VR + (size_t)b * KVLEN * 128 + (hq >> 2) * 64, YB, lds_generic, C.wave);
    }
}

constexpr int CW_CNT_FG = 16384;
struct ListOrder {
    int c, G, mode; bool ctx; unsigned* cnt;
    __device__ __forceinline__ bool next(int i, pg8::Unit& u) const {
        u.e = 0;
        const int npan = ctx ? 136 : 128;
        if (G != 256) { const int g = c + i * G; if (g >= npan * 4) return false; u.pm = g >> 2; u.pn = g & 3; return true; }
        const int x = c & 7, r = c >> 3;
        if (mode == 0 || !ctx) {
            if (i < 2) { u.pm = 64 * i + x * 8 + (r >> 2); u.pn = r & 3; return true; }
            if (mode == 0 && ctx && i == 2 && c < 32) { u.pm = 128 + x; u.pn = r; return true; }
            return false;
        }
        if (i == 0) { u.pm = x * 8 + (r >> 2); u.pn = r & 3; return true; }
        if (c < 32) return false;
        if (i == 1) { const int r1 = (c - 32) >> 3; u.pm = 64 + x * 7 + (r1 >> 2); u.pn = r1 & 3; return true; }
        if (i == 2 && c < 64) { u.pm = 120 + x; u.pn = (c - 32) >> 3; return true; }
        if (i == 2 && c < 96) { u.pm = 128 + x; u.pn = (c - 64) >> 3; return true; }
        return false;
    }
    __device__ __forceinline__ void a_ready(const pg8::Unit& u) const {
        if (mode == 0) return;
        unsigned* p = cnt + u.pm; unsigned sp = 0u;
        while (xb_ld(p) < 32u) { __builtin_amdgcn_s_sleep(2); if (++sp > (1u << 22)) break; }
        asm volatile("s_waitcnt vmcnt(0)" ::: "memory");
    }
    __device__ __forceinline__ void done(const pg8::Unit& u) const {
        if (mode != 0) return;
        asm volatile("s_waitcnt vmcnt(0)" ::: "memory");
        unsigned m_ = ~0u; asm volatile("" : "+s"(m_));
        if (__builtin_amdgcn_mbcnt_hi(m_, __builtin_amdgcn_mbcnt_lo(m_, 0u)) == 0u) (void)xb_add(cnt + u.pm, 1u);
    }
};

constexpr int NPH = 11;
constexpr int N_PHASES = 1 + DEPTH * NPH + 1;
struct KArgs { const float* in[N_IN]; float* out; unsigned char* ws; int ph_lo, ph_hi; };
static_assert(sizeof(KArgs) == N_IN * 8 + 8 + 8 + 8, "no padding bytes in the argument struct");

__global__ void __launch_bounds__(512, 2) mk_fwd(KArgs args) {
    extern __shared__ __attribute__((aligned(16))) unsigned char lds[];
    Ctx C;
    C.lds = (LAS unsigned char*)lds; C.ws = args.ws; C.in = args.in; C.out = args.out;
    C.tid = threadIdx.x; C.lane = C.tid & 63; C.wave = __builtin_amdgcn_readfirstlane(C.tid >> 6); C.G = gridDim.x; C.bx = blockIdx.x;
    for (int u = C.tid; u < (LDS_BYTES - LDSCTL_OFF) / 4; u += 512) ((LAS unsigned*)(C.lds + LDSCTL_OFF))[u] = 0u;
    __syncthreads();
    if ((unsigned)(uintptr_t)C.lds != 0u) __builtin_trap();
    if (C.tid == 0) { LAS unsigned* pw = (LAS unsigned*)(C.lds + MISC_OFF + 64); pw[0] = (unsigned)(uintptr_t)args.ws; pw[1] = (unsigned)((uintptr_t)args.ws >> 32); pw[2] = (unsigned)(uintptr_t)args.out; pw[3] = (unsigned)((uintptr_t)args.out >> 32); }
    __syncthreads();
#if MK_ONE_LAUNCH
    constexpr int lo = 0, hi = N_PHASES;
#else
    const int lo = args.ph_lo, hi = args.ph_hi;
#endif
    gu32* ctl = (gu32*)(C.ws + WS_CTL);
    XcdBarrier bar; bar.bar = (unsigned*)ctl + CW_BAR; bar.x = 0; bar.st = (volatile LAS unsigned*)(C.lds + MISC_OFF) + 8;
    if (hi - lo > 1) bar = xcd_barrier_post((unsigned*)ctl + CW_BAR, (volatile LAS unsigned*)(C.lds + MISC_OFF) + 8);
    bar.x = (unsigned)__builtin_amdgcn_readfirstlane((int)bar.x);
#define IN(k) (lo <= (k) && (k) < hi)
#ifndef PH_MASK
#define PH_MASK 0x1fff
#endif
#define ENAB(k) (((PH_MASK) >> (k)) & 1)
#ifndef DUP_MASK
#define DUP_MASK 0
#endif
#ifndef PROBE_SKIP
#define PROBE_SKIP 0
#endif
#define REPS(k) _Pragma("unroll 1") for (int rep_ = 0; rep_ < 1 + (((DUP_MASK) >> (k)) & 1); ++rep_)
#define SEAM(k) do { if (IN(k) && IN((k) + 1)) { XcdBarrier b2_ = bar; asm volatile("" : "+s"(b2_.x)); xcd_barrier(b2_); if ((DUP_MASK) & 0x2000) xcd_barrier(b2_); } } while (0)
    PG8_LAS unsigned char* glds = (PG8_LAS unsigned char*)(C.lds + RING_OFF);

    if (ENAB(0) && IN(0)) REPS(0) p0_prologue(launder(C));
    SEAM(0);
    for (int l = 0; l < DEPTH; ++l) {
        const int p = 1 + l * NPH;
        if (ENAB(1) && IN(p + 0)) REPS(1) phase_norm1(launder(C), l, rep_ ? 0.0f : 1.0f);
        SEAM(p + 0);
        if (ENAB(2) && IN(p + 1)) REPS(2) {
            const Ctx Cg = launder(C); unsigned char* const ws = Cg.ws;
            pg8::Gemm g{(const bf16_t*)(ws + WS_H), (const bf16_t*)(ws + WS_WTIN + (size_t)l * PW * DM), MROWS, PW, DM / 2, 0};
            pg8::StaticOrder S; S.init(MROWS, PW, C.G, C.bx);
            pg8::EpiStoreBf16 E{(bf16_t*)(ws + WS_P), PW, C_GATE, 1.0f / (FP8_SH * FP8_SW), rep_ ? PROBE_SKIP : 0};
#ifdef STAGGER_US
            { const unsigned long long t0_ = __builtin_amdgcn_s_memrealtime(), dl_ = (unsigned long long)(((C.bx >> 3) & 3) * STAGGER_US * 25);
              while (__builtin_amdgcn_s_memrealtime() - t0_ < dl_) __builtin_amdgcn_s_sleep(8); }
#endif
            pg8::gemm_phase<pg8::EpiStoreBf16, pg8::StaticOrder, true, true, true>(glds, g, S, E, C.wave);
        }
        SEAM(p + 1);
        if (ENAB(3) && IN(p + 2)) REPS(3) {
            if (!(rep_ && ((DUP_MASK) & 0x200000))) phase_attn_prep(launder(C), l);
            if (!(rep_ && ((DUP_MASK) & 0x400000))) mlstm_a_phase(launder(C), l);
            if (!(rep_ && ((DUP_MASK) & 0x800000))) gla_a_phase(launder(C), l);
        }
        SEAM(p + 2);
        if (ENAB(4) && IN(p + 3)) {
            scan_b_units(launder(C));
            if ((DUP_MASK) & 0x10000) { __syncthreads(); scan_b_units(launder(C), true); }
            __syncthreads();
            REPS(4) phase_attention(launder(C), (char*)lds + RING_OFF, l < DEPTH - 1);
        }
        SEAM(p + 3);
        if (ENAB(5) && IN(p + 4)) REPS(5) {
            if (!(rep_ && ((DUP_MASK) & 0x100000))) mlstm_c_phase(launder(C), l);
            if (!(rep_ && ((DUP_MASK) & 0x80000))) gla_c_phase(launder(C), l);
        }
        SEAM(p + 4);
        if (ENAB(6) && IN(p + 5)) {
            const Ctx Cg = launder(C); unsigned char* const ws = Cg.ws;
            const bool wctx = (l != DEPTH - 1);
            const int Meff = wctx ? MROWS : M_LAT;
            unsigned* const cnt = (unsigned*)(ws + WS_CTL) + CW_CNT_FG + l * 256;
            {
                pg8::Gemm g{(const bf16_t*)(ws + WS_YA), (const bf16_t*)(ws + WS_WTBR) + (size_t)l * DM * 1536, Meff, DM, 1536, 0};
                ListOrder S{C.bx, C.G, 0, wctx, cnt};
                pg8::EpiBranch E{(bf16_t*)(ws + WS_MRG), (const unsigned char*)(ws + WS_P) + 2 * C_GATE, PW * 2};
                pg8::gemm_phase<pg8::EpiBranch, ListOrder, true, true>(glds, g, S, E, C.wave);
            }
            {
                pg8::Gemm g{(const bf16_t*)(ws + WS_MRG), (const bf16_t*)(ws + WS_WTOUT) + (size_t)l * DM * DM, Meff, DM, DM, 0};
                ListOrder S{C.bx, C.G, 1, wctx, cnt};
                pg8::EpiResid E{(bf16_t*)(ws + WS_U), 0};
                pg8::gemm_phase<pg8::EpiResid, ListOrder, true, true>(glds, g, S, E, C.wave);
            }
        }
        SEAM(p + 6);
        if ((DUP_MASK) & 0x20000) {
            const Ctx Cg = launder(C); v4u* q = (v4u*)(Cg.ws + WS_P) + (size_t)C.bx * 131072 + Cg.tid; const v4u val = {1u, 2u, 3u, (unsigned)l};
#pragma unroll 4
            for (int i = 0; i < 256; ++i) q[i * 512] = val;
        }
        if ((DUP_MASK) & 0x40000) {
            const Ctx Cg = launder(C); const v4u* q = (const v4u*)(Cg.ws + WS_P) + (size_t)C.bx * 131072 + Cg.tid; v4u a = {0u, 0u, 0u, 0u};
#pragma unroll 16
            for (int i = 0; i < 256; ++i) { const v4u t = q[i * 512]; a.x ^= t.x; a.y ^= t.y; a.z ^= t.z; a.w ^= t.w; }
            if ((a.x ^ a.y ^ a.z ^ a.w) == 0x12345u) ((unsigned*)(Cg.ws + WS_P))[Cg.tid] = a.x;
        }
        if (ENAB(8) && IN(p + 7)) REPS(8) phase_norm2_router(launder(C), l);
        SEAM(p + 7);
        if (ENAB(9) && IN(p + 8)) REPS(9) phase_gather(launder(C), l);
        SEAM(p + 8);
        if (ENAB(10) && IN(p + 9)) REPS(10) {
            const Ctx Cg = launder(C); unsigned char* const ws = Cg.ws; const int* const META = (const int*)(ws + WS_MOEMETA);
            const int nM = __builtin_amdgcn_readfirstlane(META[0]);
            pg8::Gemm g{(const bf16_t*)(ws + WS_XG), (const bf16_t*)(ws + WS_WTE1 + (size_t)l * NEXP * 2048 * DM), nM * 256, 2048, DM / 2, (size_t)2048 * DM};
            pg8::StaticOrder S; S.init(nM * 256, 2048, C.G, C.bx, META + 16);
            pg8::EpiSwiglu E{(unsigned char*)(ws + WS_A2), INP(I_BE1) + (size_t)l * NEXP * 2048, 1.0f / (FP8_SH * FP8_SW), FP8_SA, rep_ ? PROBE_SKIP : 0};
            pg8::gemm_phase<pg8::EpiSwiglu, pg8::StaticOrder, true, true, true>(glds, g, S, E, C.wave);
        }
        SEAM(p + 9);
        if (ENAB(11) && IN(p + 10)) REPS(11) {
            const Ctx Cg = launder(C); unsigned char* const ws = Cg.ws; const int* const META = (const int*)(ws + WS_MOEMETA);
            const int nM = __builtin_amdgcn_readfirstlane(META[0]);
            pg8::Gemm g{(const bf16_t*)(ws + WS_A2), (const bf16_t*)(ws + WS_WTE2 + (size_t)l * NEXP * DM * DFF), nM * 256, DM, DFF / 2, (size_t)DM * DFF};
            pg8::StaticOrder S; S.init(nM * 256, DM, C.G, C.bx, META + 16);
            pg8::EpiMoeOut E{(bf16_t*)(ws + WS_YS), INP(I_BE2) + (size_t)l * NEXP * DM, (const float*)(ws + WS_SLOTW), 1.0f / (FP8_SA * FP8_SW), rep_ ? PROBE_SKIP : 0};
            pg8::gemm_phase<pg8::EpiMoeOut, pg8::StaticOrder, true, true, true>(glds, g, S, E, C.wave);
        }
        SEAM(p + 10);
    }
    if (ENAB(12) && IN(1 + DEPTH * NPH)) phase_norm1(launder(C), DEPTH, 1.0f);
#undef IN
#undef SEAM
}

extern "C" void kernel_launch(void* const* d_in, const int* in_sizes, int n_in, void* d_out, int out_size, void* d_ws, size_t ws_size, hipStream_t stream) {
    static int grid = 0;
    if (grid == 0) {
        if (n_in != N_IN || out_size != M_LAT * DM || ws_size < WS_END) { fprintf(stderr, "kernel_launch: unexpected shapes: n_in %d out %d ws %zu (need %zu); nothing launched\n", n_in, out_size, ws_size, (size_t)WS_END); grid = -1; return; }
        int dev = 0, cus = 0, per_cu = 0;
        if (hipGetDevice(&dev) != hipSuccess || hipDeviceGetAttribute(&cus, hipDeviceAttributeMultiprocessorCount, dev) != hipSuccess) { grid = -1; return; }
        if (hipFuncSetAttribute((const void*)mk_fwd, hipFuncAttributeMaxDynamicSharedMemorySize, LDS_BYTES) != hipSuccess) { fprintf(stderr, "kernel_launch: hipFuncSetAttribute failed\n"); grid = -1; return; }
        if (hipOccupancyMaxActiveBlocksPerMultiprocessor(&per_cu, (const void*)mk_fwd, 512, LDS_BYTES) != hipSuccess || per_cu < 1) fprintf(stderr, "kernel_launch: note: occupancy query reports %d\n", per_cu);
        (void)hipGetLastError();
        grid = cus;
    }
    if (grid < 0) return;
    (void)in_sizes;
    if (hipMemsetAsync((char*)d_ws + WS_CTL, 0, CTL_ZERO_BYTES, stream) != hipSuccess) return;
    KArgs a{};
    for (int i = 0; i < N_IN; ++i) a.in[i] = (const float*)d_in[i];
    a.out = (float*)d_out; a.ws = (unsigned char*)d_ws;
#if MK_ONE_LAUNCH
    a.ph_lo = 0; a.ph_hi = N_PHASES;
    hipLaunchKernelGGL(mk_fwd, dim3(grid), dim3(512), LDS_BYTES, stream, a);
#else
    for (int p = 0; p < N_PHASES; ++p) { a.ph_lo = p; a.ph_hi = p + 1; hipLaunchKernelGGL(mk_fwd, dim3(grid), dim3(512), LDS_BYTES, stream, a); }
#endif
}
```

```cpp
#include <hip/hip_runtime.h>
#include <hip/hip_bf16.h>
#include <cstdio>
#include <cstdint>

#ifndef MK_ONE_LAUNCH
#define MK_ONE_LAUNCH 1
#endif

#define DI __device__ __forceinline__
#define GAS __attribute__((address_space(1)))
#define LAS __attribute__((address_space(3)))

constexpr int DM = 1024, NBATCH = 8, SEQ = 4096, DEPTH = 4, CTXL = 256;
constexpr int M_LAT = NBATCH * SEQ, M_CTX = NBATCH * CTXL, MROWS = M_LAT + M_CTX;
constexpr int IN_W = 6960, PW = 7168;
constexpr int NCHUNK = MROWS / 64;
constexpr int KVLEN = CTXL + SEQ;
constexpr int NEXP = 32, TOPK = 4, DFF = 1024;
constexpr int MOE_ROWS_MAX = MROWS * TOPK + NEXP * 256;
constexpr float EPS = 1e-6f;
constexpr int C_AQK = 0, C_AV = 512, C_AI = 1024, C_AF = 1032, C_AO = 1040, C_BQ = 1552, C_BK = 2064, C_BV = 2192, C_CQ = 2320, C_CK = 2576, C_CV = 2832, C_CA = 3344, C_CR = 3376, C_GATE = 3888;
static_assert(C_GATE + 3 * DM == IN_W, "split");
enum { I_X = 0, I_C, I_CTX, I_CCTX, I_WADA, I_BADA, I_GN1, I_WIN, I_ACW, I_ACB, I_AGB, I_ANG, I_BQG, I_BKG, I_CWUP, I_CBUP, I_CNG, I_WBR, I_WOUT, I_GN2, I_WR, I_BR, I_WE1, I_BE1, I_WE2, I_BE2, I_GF, N_IN };

constexpr size_t al256(size_t x) { return (x + 255) & ~(size_t)255; }
constexpr size_t WS_CTL = 0, CTL_ZERO_BYTES = 1u << 20;
constexpr size_t WS_MOD = WS_CTL + CTL_ZERO_BYTES;
constexpr size_t WS_BLKCNT = WS_MOD + al256((size_t)DEPTH * 9 * 6 * DM * 4);
constexpr size_t WS_MOEMETA = WS_BLKCNT + al256(1024 * 32 * 4);
constexpr size_t WS_TOKE = WS_MOEMETA + 4096;
constexpr size_t WS_TOKP = WS_TOKE + (size_t)MROWS * 16;
constexpr size_t WS_TOKW = WS_TOKP + (size_t)MROWS * 16;
constexpr size_t WS_SLOTW = WS_TOKW + (size_t)MROWS * 16;
constexpr size_t WS_WTIN = WS_SLOTW + al256((size_t)MOE_ROWS_MAX * 4);
constexpr size_t WS_WTBR = WS_WTIN + (size_t)DEPTH * PW * DM * 2;
constexpr size_t WS_WTOUT = WS_WTBR + (size_t)DEPTH * 3 * DM * 512 * 2;
constexpr size_t WS_WTE1 = WS_WTOUT + (size_t)DEPTH * DM * DM * 2;
constexpr size_t WS_WTE2 = WS_WTE1 + (size_t)DEPTH * NEXP * 2 * DFF * DM * 2;
constexpr size_t WS_X = WS_WTE2 + (size_t)DEPTH * NEXP * DM * DFF * 2;
constexpr size_t WS_H = WS_X + (size_t)MROWS * DM * 4;
constexpr size_t WS_P = WS_H + (size_t)MROWS * DM * 2;
constexpr size_t WS_QR = WS_P + (size_t)MROWS * PW * 2;
constexpr size_t WS_KR = WS_QR + (size_t)MROWS * 512 * 2;
constexpr size_t WS_VR = WS_KR + (size_t)NBATCH * KVLEN * 128 * 2;
constexpr size_t WS_YA = WS_VR + (size_t)NBATCH * KVLEN * 128 * 2;
constexpr size_t WS_YB = WS_YA + (size_t)MROWS * 512 * 2;
constexpr size_t WS_YC = WS_YB + (size_t)MROWS * 512 * 2;
constexpr size_t WS_MRG = WS_YC + (size_t)MROWS * 512 * 2;
constexpr int RECB = 16896, REC_VEC = 16384;
constexpr size_t WS_STA = WS_MRG + (size_t)MROWS * DM * 2;
constexpr size_t WS_STC = WS_STA + (size_t)NCHUNK * 8 * RECB;
constexpr size_t WS_XG = WS_STC + (size_t)NCHUNK * 8 * RECB;
constexpr size_t WS_A2 = WS_XG + (size_t)MOE_ROWS_MAX * DM * 2;
constexpr size_t WS_YS = WS_A2 + (size_t)MOE_ROWS_MAX * DFF * 2;
constexpr size_t WS_U = WS_YS + (size_t)MOE_ROWS_MAX * DM * 2;
constexpr size_t WS_END = WS_U + (size_t)MROWS * DM * 2;
constexpr int CW_BAR = 4096;

constexpr int RING_OFF = 0, RING_BYTES = 155648;
constexpr int LDSCTL_OFF = RING_BYTES, MISC_OFF = LDSCTL_OFF + 320;
constexpr int LDS_BYTES = 156672;

typedef unsigned short bf16_t;
typedef unsigned v4u __attribute__((ext_vector_type(4)));
typedef unsigned v2u __attribute__((ext_vector_type(2)));
typedef float f32x4 __attribute__((ext_vector_type(4)));
typedef short bf16x8 __attribute__((ext_vector_type(8)));

DI float bf2f(unsigned h) { return __uint_as_float(h << 16); }
typedef float f32x2_h __attribute__((ext_vector_type(2))); typedef __bf16 bf16x2_h __attribute__((ext_vector_type(2)));
DI unsigned pk2(float lo, float hi) { const f32x2_h v = {lo, hi}; return __builtin_bit_cast(unsigned, __builtin_convertvector(v, bf16x2_h)); }
DI unsigned f2bf(float f) { return pk2(f, f) & 0xffffu; }
DI void unpack8(const v4u v, float (&o)[8]) { o[0] = bf2f(v.x & 0xffffu); o[1] = bf2f(v.x >> 16); o[2] = bf2f(v.y & 0xffffu); o[3] = bf2f(v.y >> 16); o[4] = bf2f(v.z & 0xffffu); o[5] = bf2f(v.z >> 16); o[6] = bf2f(v.w & 0xffffu); o[7] = bf2f(v.w >> 16); }
constexpr float FP8_SH = 8.0f, FP8_SW = 512.0f, FP8_SA = 4.0f;
DI float clamp448(float x) { return fminf(fmaxf(x, -448.0f), 448.0f); }
DI unsigned pk4_fp8(float a, float b, float c, float d) { unsigned w = __float_as_uint(a);   w = __builtin_amdgcn_cvt_pk_fp8_f32(clamp448(a), clamp448(b), w, false); w = __builtin_amdgcn_cvt_pk_fp8_f32(clamp448(c), clamp448(d), w, true); return w; }
DI float sigmoid_f(float x) { return __builtin_amdgcn_rcpf(1.f + __expf(-x)); }
DI float silu_f(float x) { return x * sigmoid_f(x); }
DI float logsigmoid_f(float x) { return fminf(x, 0.f) - __logf(1.f + __expf(-fabsf(x))); }
namespace pg8 {
#define PG8_LAS __attribute__((address_space(3)))
typedef unsigned short bf16_t;
typedef short bf16x8 __attribute__((ext_vector_type(8)));
typedef float f32x4 __attribute__((ext_vector_type(4)));
typedef unsigned u32x4 __attribute__((ext_vector_type(4)));
typedef int v4i_t __attribute__((ext_vector_type(4)));
typedef unsigned u32x2 __attribute__((ext_vector_type(2)));
constexpr int BM = 256, BK = 64, HALF = 128, HTB = HALF * BK * 2  , STAGE_BYTES = 8 * HTB, NXCD = 8, WGM = 8;

__host__ __device__ __forceinline__ int lds_byte(int r, int c) { const int st = (r >> 4) * 2 + (c >> 5), rr = r & 15, cc = c & 31, ob = rr * 64 + cc * 2; return st * 1024 + (ob ^ (((ob >> 9) & 1) << 5)); }
__host__ __device__ __forceinline__ void stage_rc(int b, int& R, int& C) { const int st = b / 1024, sb = b % 1024, swz = sb ^ (((sb >> 9) & 1) << 5); R = (st >> 1) * 16 + swz / 64; C = (st & 1) * 32 + (swz % 64) / 2; }
__host__ __device__ __forceinline__ int perm32(int rho) { const int n = rho >> 4, i = rho & 15; return 8 * (i >> 2) + 4 * n + (i & 3); }

struct Unit { int pm, pn, e; };
struct Gemm { const bf16_t* A; const bf16_t* Bt; int M, N, K; size_t bstride; };

struct StaticOrder {
    int nM, nN, nwg, G, c; const int* tile_e;
    __host__ __device__ void init(int M, int N, int G_, int c_, const int* te = nullptr) { nM = M / BM; nN = N / BM; nwg = nM * nN; G = G_; c = c_; tile_e = te; }
    __device__ __forceinline__ bool next(int i, Unit& u) const {
        const long L = (long)i * G + c; if (L >= nwg) return false;
        int wgid = (int)L; { const int q = nwg / NXCD, r = nwg % NXCD, xcd = wgid % NXCD, off = wgid / NXCD; wgid = (xcd < r ? xcd * (q + 1) : r * (q + 1) + (xcd - r) * q) + off; }
        const int nig = WGM * nN, gid = wgid / nig, fm = gid * WGM, gsz = (nM - fm) < WGM ? (nM - fm) : WGM;
        u.pm = fm + ((wgid % nig) % gsz); u.pn = (wgid % nig) / gsz; u.e = tile_e ? __builtin_amdgcn_readfirstlane(tile_e[u.pm]) : 0; return true;
    }
    __device__ __forceinline__ void a_ready(const Unit&) const {}
    __device__ __forceinline__ void done(const Unit&) const {}
};

__device__ __forceinline__ unsigned cvt_pk_bf16(float lo, float hi) { unsigned r; asm volatile("v_cvt_pk_bf16_f32 %0, %1, %2" : "=v"(r) : "v"(lo), "v"(hi)); return r; }
__device__ __forceinline__ u32x4 pack8(const f32x4 a, const f32x4 b) { u32x4 w; w.x = cvt_pk_bf16(a[0], a[1]); w.y = cvt_pk_bf16(a[2], a[3]); w.z = cvt_pk_bf16(b[0], b[1]); w.w = cvt_pk_bf16(b[2], b[3]); return w; }
__device__ __forceinline__ float bfl(unsigned v) { return __uint_as_float(v << 16); }
__device__ __forceinline__ float bfh(unsigned v) { return __uint_as_float(v & 0xffff0000u); }
__device__ __forceinline__ float sigm(float x) { return __builtin_amdgcn_rcpf(1.f + __expf(-x)); }

#ifndef AUX_B
#define AUX_B 0
#endif
#ifndef AUX_F
#define AUX_F 16
#endif
#ifndef AUX_G
#define AUX_G 0
#endif
#ifndef AUX_J
#define AUX_J 0
#endif
#ifndef AUX_K
#define AUX_K 0
#endif
__device__ __forceinline__ __amdgpu_buffer_rsrc_t mk_rs(const void* p) {
    unsigned lo = (unsigned)__builtin_amdgcn_readfirstlane((int)(unsigned)(uintptr_t)p), hi = (unsigned)__builtin_amdgcn_readfirstlane((int)(unsigned)((uintptr_t)p >> 32)); asm volatile("" : "+s"(lo), "+s"(hi));
    return __builtin_amdgcn_make_buffer_rsrc((void*)(((uintptr_t)hi << 32) | (uintptr_t)lo), 0, -1, 0x00020000); }
template <int AUX> __device__ __forceinline__ void st16(__amdgpu_buffer_rsrc_t rs, unsigned off, u32x4 v) { __builtin_amdgcn_raw_buffer_store_b128(v, rs, off, 0, AUX); }
template <int AUX> __device__ __forceinline__ void st8(__amdgpu_buffer_rsrc_t rs, unsigned off, u32x2 v) { __builtin_amdgcn_raw_buffer_store_b64(v, rs, off, 0, AUX); }
__device__ __forceinline__ void st16p(void* p, u32x4 v) { if (AUX_B == 16) asm volatile("global_store_dwordx4 %0, %1, off sc1\n\ts_nop 1" :: "v"(p), "v"(v) : "memory"); else *(u32x4*)p = v; }
__device__ __forceinline__ void st8p(void* p, u32x2 v) { if (AUX_B == 16) asm volatile("global_store_dwordx2 %0, %1, off sc1\n\ts_nop 1" :: "v"(p), "v"(v) : "memory"); else *(u32x2*)p = v; }
struct NoState {};
struct EpiStoreBf16 {
    static constexpr bool PERM = true, AFTER_DRAIN = false, HOOK = false; static constexpr int NST = 16; typedef NoState State;
    bf16_t* O; int ldc, sig_from; float inv; int probe_skip;
    __device__ __forceinline__ unsigned q8(float raw, float c2) const { const float e = __builtin_amdgcn_exp2f(raw * c2); return (unsigned)fmaxf(__builtin_rintf(__builtin_amdgcn_rcpf(__builtin_fmaf(e, 1.0f / 255.0f, 1.0f / 255.0f))), 1.0f); }
    __device__ __forceinline__ void operator()(const f32x4 (&acc)[2][2][4][2], const Unit& u, int wr, int wc, int fr, int fq, NoState&) const {
        const int row0 = u.pm * BM + wr * 64 + fr, col0 = u.pn * BM + wc * 32 + 8 * fq;
        if (probe_skip == 2) return;
#pragma unroll
        for (int bj = 0; bj < 2; ++bj) {
            const int col = col0 + bj * HALF; const bool sg = col >= sig_from;
#pragma unroll
            for (int ai = 0; ai < 2; ++ai)
#pragma unroll
                for (int m = 0; m < 4; ++m) {
                    const f32x4 a = acc[ai][bj][m][0] * inv, b = acc[ai][bj][m][1] * inv;
                    bf16_t* rowp = O + (size_t)(row0 + ai * HALF + m * 16) * ldc;
                    if (probe_skip == 1 && (a[0] + b[3]) != 12345.678f) continue;
                    if (probe_skip == 4 && (ai + m + bj) != 0 && (a[0] + b[3]) != 12345.678f) continue;
                    if (probe_skip == 3) { *(u32x4*)((unsigned char*)O + ((size_t)1 << 31) + (size_t)(u.pm * 28 + u.pn) * 131072 + (size_t)((((ai * 4 + m) * 2 + bj) * 8 + (wr * 4 + wc)) * 1024 + (fr + 16 * fq) * 16)) = pack8(a, b); continue; }
                    if (sg) { const f32x4 ra = acc[ai][bj][m][0], rb = acc[ai][bj][m][1]; const float c2 = inv * -1.4426950408889634f;
                        u32x2 w; w.x = q8(ra[0], c2) | (q8(ra[1], c2) << 8) | (q8(ra[2], c2) << 16) | (q8(ra[3], c2) << 24); w.y = q8(rb[0], c2) | (q8(rb[1], c2) << 8) | (q8(rb[2], c2) << 16) | (q8(rb[3], c2) << 24);
                        st8p((unsigned char*)(rowp + sig_from) + (col - sig_from), w); }
                    else st16p(rowp + col, pack8(a, b)); }
        }
    }
};
struct EpiBranch {
    static constexpr bool PERM = true, AFTER_DRAIN = false, HOOK = true; static constexpr int NST = 16; typedef NoState State;
    bf16_t* MRG; const unsigned char* gates; int ldg;
    static __device__ __forceinline__ float ub(unsigned v, int k) { return (float)((v >> (8 * k)) & 0xffu); }
    __device__ __forceinline__ void hook(f32x4 (&acc)[2][2][4][2], const Unit& u, int seg, int wr, int wc, int lane, NoState&) const {
        const int fr = lane & 15, fq = lane >> 4;
        const int row0 = u.pm * BM + wr * 64 + fr, col0 = u.pn * BM + wc * 32 + 8 * fq;
        const unsigned char* gp = gates + seg * 1024 + col0;
        u32x2 gb[2][4][2], ga[2][4][2];
#pragma unroll
        for (int ai = 0; ai < 2; ++ai)
#pragma unroll
            for (int m = 0; m < 4; ++m) { const size_t ro = (size_t)(row0 + ai * HALF + m * 16) * ldg;
#pragma unroll
                for (int bj = 0; bj < 2; ++bj) { gb[ai][m][bj] = *(const u32x2*)(gp + ro + bj * HALF); ga[ai][m][bj] = *(const u32x2*)(gp + ro - 1024 + bj * HALF); } }
        __builtin_amdgcn_sched_barrier(0);
#pragma unroll
        for (int ai = 0; ai < 2; ++ai)
#pragma unroll
            for (int m = 0; m < 4; ++m)
#pragma unroll
                for (int bj = 0; bj < 2; ++bj) {
                    const u32x2 b_ = gb[ai][m][bj], a_ = ga[ai][m][bj];
                    f32x4& a = acc[ai][bj][m][0]; f32x4& b = acc[ai][bj][m][1];
#pragma unroll
                    for (int k = 0; k < 4; ++k) { a[k] *= ub(a_.x, k) * __builtin_amdgcn_rcpf(ub(b_.x, k)); b[k] *= ub(a_.y, k) * __builtin_amdgcn_rcpf(ub(b_.y, k)); }
                }
    }
    __device__ __forceinline__ void operator()(const f32x4 (&acc)[2][2][4][2], const Unit& u, int wr, int wc, int fr, int fq, NoState&) const {
        const int row0 = u.pm * BM + wr * 64 + fr, col0 = u.pn * BM + wc * 32 + 8 * fq;
        u32x2 gv[2][4][2];
#pragma unroll
        for (int ai = 0; ai < 2; ++ai)
#pragma unroll
            for (int m = 0; m < 4; ++m)
#pragma unroll
                for (int bj = 0; bj < 2; ++bj) gv[ai][m][bj] = *(const u32x2*)(gates + (size_t)(row0 + ai * HALF + m * 16) * ldg + 2048 + col0 + bj * HALF);
        __builtin_amdgcn_sched_barrier(0);
        const __amdgpu_buffer_rsrc_t rsM = mk_rs(MRG);
#pragma unroll
        for (int ai = 0; ai < 2; ++ai)
#pragma unroll
            for (int m = 0; m < 4; ++m) { const size_t row = (size_t)(row0 + ai * HALF + m * 16);
#pragma unroll
                for (int bj = 0; bj < 2; ++bj) {
                    const u32x2 g_ = gv[ai][m][bj];
                    f32x4 a = acc[ai][bj][m][0], b = acc[ai][bj][m][1];
#pragma unroll
                    for (int k = 0; k < 4; ++k) { a[k] *= ub(g_.x, k) * (1.0f / 255.0f); b[k] *= ub(g_.y, k) * (1.0f / 255.0f); }
                    st16<AUX_F>(rsM, (unsigned)row * 2048u + (unsigned)(col0 + bj * HALF) * 2u, pack8(a, b)); } }
    }
};
struct EpiResid {
    static constexpr bool PERM = true, AFTER_DRAIN = false, HOOK = false; static constexpr int NST = 16; typedef NoState State;
    bf16_t* U; int probe_skip;
    __device__ __forceinline__ void operator()(const f32x4 (&acc)[2][2][4][2], const Unit& u, int wr, int wc, int fr, int fq, NoState&) const {
        const int row0 = u.pm * BM + wr * 64 + fr, col0 = u.pn * BM + wc * 32 + 8 * fq;
        if (probe_skip == 2) return;
        const __amdgpu_buffer_rsrc_t rsU = mk_rs(U);
#pragma unroll
        for (int ai = 0; ai < 2; ++ai)
#pragma unroll
            for (int m = 0; m < 4; ++m) { const unsigned rowb = (unsigned)(row0 + ai * HALF + m * 16) * 2048u + (unsigned)col0 * 2u;
#pragma unroll
                for (int bj = 0; bj < 2; ++bj) st16<AUX_G>(rsU, rowb + bj * HALF * 2, pack8(acc[ai][bj][m][0], acc[ai][bj][m][1])); }
    }
};
__device__ __forceinline__ float clamp448(float x) { return fminf(fmaxf(x, -448.0f), 448.0f); }
__device__ __forceinline__ unsigned pk4_fp8(float a, float b, float c, float d) { unsigned w = __float_as_uint(a);   w = __builtin_amdgcn_cvt_pk_fp8_f32(clamp448(a), clamp448(b), w, false); w = __builtin_amdgcn_cvt_pk_fp8_f32(clamp448(c), clamp448(d), w, true); return w; }
__device__ __forceinline__ unsigned pk4_fp8_nc(float a, float b, float c, float d) { unsigned w = __float_as_uint(a); w = __builtin_amdgcn_cvt_pk_fp8_f32(a, b, w, false); w = __builtin_amdgcn_cvt_pk_fp8_f32(c, d, w, true); return w; }
struct EpiSwiglu {
    static constexpr bool PERM = true, AFTER_DRAIN = false, HOOK = false; static constexpr int NST = 8; typedef NoState State;
    unsigned char* A2; const float* b1; float inv, oscale; int probe_skip;
    __device__ __forceinline__ void operator()(const f32x4 (&acc)[2][2][4][2], const Unit& u, int wr, int wc, int fr, int fq, NoState&) const {
        asm volatile("" ::: "memory");
        if (probe_skip == 2) return;
        const int row0 = u.pm * BM + wr * 64 + fr, j0 = u.pn * HALF + wc * 32 + 8 * fq;
        const float* bp = b1 + (size_t)u.e * 2048 + 2 * j0;
        const __amdgpu_buffer_rsrc_t rsA2 = mk_rs(A2);
        float bg[8], bu[8];
#pragma unroll
        for (int q = 0; q < 4; ++q) { const f32x4 t = *(const f32x4*)(bp + 4 * q); bg[2 * q] = t[0]; bu[2 * q] = t[1]; bg[2 * q + 1] = t[2]; bu[2 * q + 1] = t[3]; }
#pragma unroll
        for (int ai = 0; ai < 2; ++ai)
#pragma unroll
            for (int m = 0; m < 4; ++m) {
                float o[8];
#pragma unroll
                for (int e = 0; e < 8; ++e) {
                    float g = acc[ai][0][m][e >> 2][e & 3] * inv + bg[e], up = acc[ai][1][m][e >> 2][e & 3] * inv + bu[e];
                    g = fminf(g, 7.0f); up = fminf(fmaxf(up, -7.0f), 7.0f);
                    o[e] = __builtin_fmaf(up, oscale, oscale) * (g * __builtin_amdgcn_rcpf(1.0f + __builtin_amdgcn_exp2f(g * (-1.702f * 1.4426950408889634f)))); }
                u32x2 w; w.x = pk4_fp8_nc(o[0], o[1], o[2], o[3]); w.y = pk4_fp8_nc(o[4], o[5], o[6], o[7]);
                st8<AUX_J>(rsA2, (unsigned)(row0 + ai * HALF + m * 16) * 1024u + (unsigned)j0, w); }
    }
};
struct EpiMoeOut {
    static constexpr bool PERM = true, AFTER_DRAIN = false, HOOK = false; static constexpr int NST = 16; typedef NoState State;
    bf16_t* YS; float inv; int probe_skip;
    __device__ __forceinline__ void operator()(const f32x4 (&acc)[2][2][4][2], const Unit& u, int wr, int wc, int fr, int fq, NoState&) const {
        const int row0 = u.pm * BM + wr * 64 + fr, col0 = u.pn * BM + wc * 32 + 8 * fq;
        if (probe_skip == 2) return;
        const __amdgpu_buffer_rsrc_t rsY = mk_rs(YS);
#pragma unroll
        for (int ai = 0; ai < 2; ++ai)
#pragma unroll
            for (int m = 0; m < 4; ++m) { const unsigned rowb = (unsigned)(row0 + ai * HALF + m * 16) * 2048u + (unsigned)col0 * 2u;
#pragma unroll
                for (int bj = 0; bj < 2; ++bj) st16<AUX_K>(rsY, rowb + bj * HALF * 2, pack8(acc[ai][bj][m][0] * inv, acc[ai][bj][m][1] * inv)); }
    }
};

template <class Epi, class Sched, bool ALIGN_EPI = false, bool SP2 = false, bool F8 = false>
__device__ __forceinline__ void gemm_phase(PG8_LAS unsigned char* lds, const Gemm g, const Sched& S, const Epi& E, int wave_index) {
    unsigned msk_ = ~0u; asm volatile("" : "+s"(msk_)); const int tid_ = (wave_index << 6) | (int)__builtin_amdgcn_mbcnt_hi(msk_, __builtin_amdgcn_mbcnt_lo(msk_, 0u));
    const int tid = tid_, wid = __builtin_amdgcn_readfirstlane(tid >> 6), lane = tid & 63, wr = wid >> 2, wc = wid & 3, fr = lane & 15, fq = lane >> 4;
    const int K = g.K, nt = K / BK;
    unsigned voffA[2], voffB[2];
#pragma unroll
    for (int i = 0; i < 2; ++i) { int R, C; stage_rc(tid * 16 + i * 8192, R, C); const int Rb = Epi::PERM ? ((R & ~31) + perm32(R & 31)) : R;
        voffA[i] = (unsigned)(R * K + C) * 2u; voffB[i] = (unsigned)(Rb * K + C) * 2u; }
    const unsigned kstep = (unsigned)(BK * 2);
    const unsigned hstep = (unsigned)HALF * (unsigned)K * 2u;
    const unsigned tstep = 2u * hstep;
    const unsigned ldsw = (unsigned)wid * 1024u;
    const int aoff = lds_byte(wr * 64 + fr, fq * 8), boff = lds_byte(wc * 32 + fr, fq * 8);
#define PG8_SA(b, h) (((b) * 2 + (h)) * HTB)
#define PG8_SB(b, h) ((4 + (b) * 2 + (h)) * HTB)
#define PG8_RS_voffA rsA
#define PG8_RS_voffB rsB
#define PG8_STAGE(bufoff, gbase, voff) do { _Pragma("unroll") for (int _i = 0; _i < 2; ++_i) \
        __builtin_amdgcn_raw_ptr_buffer_load_lds(PG8_RS_##voff, (PG8_LAS void*)(lds + (bufoff) + ldsw + _i * 8192), 16, (voff)[_i], (gbase), 0, 0); } while (0)
#define PG8_LDA(dst, b, h) do { _Pragma("unroll") for (int m = 0; m < 4; ++m) _Pragma("unroll") for (int k = 0; k < 2; ++k) dst[m][k] = *(const PG8_LAS bf16x8*)(lds + PG8_SA(b, h) + aoff + m * 2048 + k * 1024); } while (0)
#define PG8_LDB(dst, b, h) do { _Pragma("unroll") for (int n = 0; n < 2; ++n) _Pragma("unroll") for (int k = 0; k < 2; ++k) dst[n][k] = *(const PG8_LAS bf16x8*)(lds + PG8_SB(b, h) + boff + n * 2048 + k * 1024); } while (0)
#define PG8_CAT(x) __builtin_shufflevector(__builtin_bit_cast(v4i_t, (x)[0]), __builtin_bit_cast(v4i_t, (x)[1]), 0, 1, 2, 3, 4, 5, 6, 7)
#define PG8_MMA(ai, bj, At, Bt) do { __builtin_amdgcn_s_setprio(1); _Pragma("unroll") for (int m = 0; m < 4; ++m) _Pragma("unroll") for (int n = 0; n < 2; ++n) { \
        if constexpr (F8) acc[ai][bj][m][n] = __builtin_amdgcn_mfma_scale_f32_16x16x128_f8f6f4(PG8_CAT(Bt[n]), PG8_CAT(At[m]), acc[ai][bj][m][n], 0, 0, 0, 0x7f7f7f7f, 0, 0x7f7f7f7f); \
        else { _Pragma("unroll") for (int k = 0; k < 2; ++k) acc[ai][bj][m][n] = __builtin_amdgcn_mfma_f32_16x16x32_bf16(Bt[n][k], At[m][k], acc[ai][bj][m][n], 0, 0, 0); } } __builtin_amdgcn_s_setprio(0); } while (0)
#define PG8_WAIT_V(n) asm volatile("s_waitcnt vmcnt(" #n ")" ::: "memory")
#define PG8_WAIT_L(n) asm volatile("s_waitcnt lgkmcnt(" #n ")" ::: "memory")
#define PG8_BAR __builtin_amdgcn_s_barrier()
#define PG8_SCHED __builtin_amdgcn_sched_barrier(0)
    Unit cur, nxt; int ui = 0;
    typename Epi::State est;
    if (!S.next(0, cur)) return;
    f32x4 acc[2][2][4][2];
#pragma unroll
    for (int a = 0; a < 2; ++a)
#pragma unroll
        for (int b = 0; b < 2; ++b)
#pragma unroll
            for (int m = 0; m < 4; ++m)
#pragma unroll
                for (int n = 0; n < 2; ++n) { f32x4 z_; asm volatile("v_mov_b32 %0, 0\n\tv_mov_b32 %1, 0\n\tv_mov_b32 %2, 0\n\tv_mov_b32 %3, 0" : "=v"(z_[0]), "=v"(z_[1]), "=v"(z_[2]), "=v"(z_[3])); acc[a][b][m][n] = z_; }
    bf16x8 At[4][2], B0[2][2], B1[2][2];
    const __amdgpu_buffer_rsrc_t rsA = __builtin_amdgcn_make_buffer_rsrc((void*)g.A, 0, -1, 0x00020000), rsB = __builtin_amdgcn_make_buffer_rsrc((void*)g.Bt, 0, -1, 0x00020000);
    unsigned cA = (unsigned)cur.pm * tstep, cB = (unsigned)cur.e * (unsigned)g.bstride + (unsigned)cur.pn * tstep;
    S.a_ready(cur);
    if constexpr (SP2) {
        PG8_STAGE(PG8_SB(0, 0), cB, voffB); PG8_STAGE(PG8_SB(0, 1), cB + hstep, voffB); PG8_STAGE(PG8_SA(0, 0), cA, voffA); PG8_STAGE(PG8_SA(0, 1), cA + hstep, voffA);
        if (wr == 1) PG8_BAR;
        PG8_WAIT_V(2); PG8_BAR;
        PG8_STAGE(PG8_SB(1, 0), cB + kstep, voffB); PG8_STAGE(PG8_SA(1, 0), cA + kstep, voffA); PG8_STAGE(PG8_SB(1, 1), cB + hstep + kstep, voffB);
        PG8_WAIT_V(6); PG8_BAR;
    } else {
        PG8_STAGE(PG8_SB(0, 0), cB, voffB); PG8_STAGE(PG8_SA(0, 0), cA, voffA); PG8_STAGE(PG8_SB(0, 1), cB + hstep, voffB); PG8_STAGE(PG8_SA(0, 1), cA + hstep, voffA);
        if (wr == 1) PG8_BAR;
        PG8_WAIT_V(4); PG8_BAR;
        PG8_STAGE(PG8_SB(1, 0), cB + kstep, voffB); PG8_STAGE(PG8_SA(1, 0), cA + kstep, voffA); PG8_STAGE(PG8_SB(1, 1), cB + hstep + kstep, voffB);
        PG8_WAIT_V(6); PG8_BAR;
    }
    for (;;) {
        const bool has_next = S.next(ui + 1, nxt);
        const unsigned nA = has_next ? (unsigned)nxt.pm * tstep : cA, nB = has_next ? (unsigned)nxt.e * (unsigned)g.bstride + (unsigned)nxt.pn * tstep : cB;
#pragma clang loop unroll(disable)
        for (int t = 0; t < nt; t += 2) {
            if constexpr (Epi::HOOK) { if (t > 0 && (t & 7) == 0) { if (wr == 0) PG8_BAR; E.hook(acc, cur, t >> 3, wr, wc, lane, est); if (wr == 1) PG8_BAR; } }
            const bool last = (t == nt - 2);
            const unsigned a1 = cA + (unsigned)(t + 1) * kstep;
            const unsigned a2 = last ? nA : cA + (unsigned)(t + 2) * kstep, b2 = last ? nB : cB + (unsigned)(t + 2) * kstep;
            const unsigned a3 = a2 + kstep, b3 = b2 + kstep;
            if (last && has_next) S.a_ready(nxt);
            if constexpr (SP2) {
            PG8_LDB(B0, 0, 0); PG8_LDB(B1, 0, 1); PG8_SCHED; PG8_LDA(At, 0, 0); PG8_STAGE(PG8_SA(1, 1), a1 + hstep, voffA);
            PG8_WAIT_V(8); PG8_WAIT_L(0); PG8_BAR; PG8_MMA(0, 0, At, B0); PG8_MMA(0, 1, At, B1); PG8_BAR; PG8_SCHED;
            PG8_LDA(At, 0, 1); PG8_STAGE(PG8_SB(0, 0), b2, voffB); PG8_STAGE(PG8_SB(0, 1), b2 + hstep, voffB); PG8_STAGE(PG8_SA(0, 0), a2, voffA);
            PG8_WAIT_V(8); PG8_WAIT_L(0); PG8_BAR; PG8_MMA(1, 0, At, B0); PG8_MMA(1, 1, At, B1); PG8_BAR; PG8_SCHED;
            PG8_LDB(B0, 1, 0); PG8_LDB(B1, 1, 1); PG8_SCHED; PG8_LDA(At, 1, 0); PG8_STAGE(PG8_SA(0, 1), a2 + hstep, voffA);
            PG8_WAIT_V(8); PG8_WAIT_L(0); PG8_BAR; PG8_MMA(0, 0, At, B0); PG8_MMA(0, 1, At, B1); PG8_BAR; PG8_SCHED;
            PG8_LDA(At, 1, 1); PG8_STAGE(PG8_SB(1, 0), b3, voffB); PG8_STAGE(PG8_SB(1, 1), b3 + hstep, voffB); PG8_STAGE(PG8_SA(1, 0), a3, voffA);
            PG8_WAIT_V(8); PG8_WAIT_L(0); PG8_BAR; PG8_MMA(1, 0, At, B0); PG8_MMA(1, 1, At, B1); PG8_BAR; PG8_SCHED;
            } else {
            PG8_LDB(B0, 0, 0); PG8_SCHED; PG8_LDA(At, 0, 0); PG8_STAGE(PG8_SA(1, 1), a1 + hstep, voffA);
            PG8_WAIT_L(8); PG8_BAR; PG8_WAIT_L(0); PG8_MMA(0, 0, At, B0); PG8_BAR; PG8_SCHED;
            PG8_LDB(B1, 0, 1); PG8_STAGE(PG8_SB(0, 0), b2, voffB);
            PG8_BAR; PG8_WAIT_L(0); PG8_MMA(0, 1, At, B1); PG8_BAR;
            PG8_LDA(At, 0, 1); PG8_STAGE(PG8_SA(0, 0), a2, voffA);
            PG8_BAR; PG8_WAIT_L(0); PG8_MMA(1, 0, At, B0); PG8_BAR; PG8_SCHED;
            PG8_STAGE(PG8_SB(0, 1), b2 + hstep, voffB);
            PG8_WAIT_V(6); PG8_BAR; PG8_MMA(1, 1, At, B1); PG8_BAR;
            PG8_LDB(B0, 1, 0); PG8_SCHED; PG8_LDA(At, 1, 0); PG8_STAGE(PG8_SA(0, 1), a2 + hstep, voffA);
            PG8_WAIT_L(8); PG8_BAR; PG8_WAIT_L(0); PG8_MMA(0, 0, At, B0); PG8_BAR; PG8_SCHED;
            PG8_LDB(B1, 1, 1); PG8_STAGE(PG8_SB(1, 0), b3, voffB);
            PG8_BAR; PG8_WAIT_L(0); PG8_MMA(0, 1, At, B1); PG8_BAR;
            PG8_LDA(At, 1, 1); PG8_STAGE(PG8_SA(1, 0), a3, voffA);
            PG8_BAR; PG8_WAIT_L(0); PG8_MMA(1, 0, At, B0); PG8_BAR; PG8_SCHED;
            PG8_STAGE(PG8_SB(1, 1), b3 + hstep, voffB);
            PG8_WAIT_V(6); PG8_BAR; PG8_MMA(1, 1, At, B1); PG8_BAR;
            }
        }
        if constexpr (ALIGN_EPI) { if (wr == 0) PG8_BAR; }
        if constexpr (!Epi::AFTER_DRAIN) { unsigned m2_ = ~0u; asm volatile("" : "+s"(m2_)); const int le_ = (int)__builtin_amdgcn_mbcnt_hi(m2_, __builtin_amdgcn_mbcnt_lo(m2_, 0u));
            E(acc, cur, wr, wc, le_ & 15, le_ >> 4, est); S.done(cur); }
        if (!has_next) break;
#pragma unroll
        for (int a = 0; a < 2; ++a)
#pragma unroll
            for (int b = 0; b < 2; ++b)
#pragma unroll
                for (int m = 0; m < 4; ++m)
#pragma unroll
                    for (int n = 0; n < 2; ++n) { f32x4 z_; asm volatile("v_mov_b32 %0, 0\n\tv_mov_b32 %1, 0\n\tv_mov_b32 %2, 0\n\tv_mov_b32 %3, 0" : "=v"(z_[0]), "=v"(z_[1]), "=v"(z_[2]), "=v"(z_[3])); acc[a][b][m][n] = z_; }
        cur = nxt; cA = nA; cB = nB; ++ui;
        if constexpr (ALIGN_EPI) { if (wr == 1) PG8_BAR; }
    }
    PG8_WAIT_V(0);
    if constexpr (!ALIGN_EPI) { if (wr == 0) PG8_BAR; }
    PG8_BAR;
    if constexpr (Epi::AFTER_DRAIN) { E.fused(acc, cur, wr, wc, fr, fq, lds, wid, lane); S.done(cur); }
#undef PG8_SA
#undef PG8_SB
#undef PG8_STAGE
#undef PG8_RS_voffA
#undef PG8_RS_voffB
#undef PG8_LDA
#undef PG8_LDB
#undef PG8_MMA
#undef PG8_CAT
#undef PG8_WAIT_V
#undef PG8_WAIT_L
#undef PG8_BAR
#undef PG8_SCHED
}
}
namespace attn_body {
using bf16=__hip_bfloat16;
using bf16x8=__attribute__((ext_vector_type(8)))short;
using s16x4=__attribute__((ext_vector_type(4)))short;
using f32x16=__attribute__((ext_vector_type(16)))float;
using u32x4=__attribute__((ext_vector_type(4)))unsigned;
constexpr int D=64,QP=512,KP=128,OP=1536;
constexpr int NW=8,QBLK=32,QB=QBLK*NW,KVBLK=64;
constexpr int ATTN_UNIT_ROWS=QB;
__device__ __forceinline__ int crow(int r,int hi){return (r&3)+8*(r>>2)+4*hi;}
#define SBAR() __builtin_amdgcn_sched_barrier(0)
__device__ __forceinline__ void cmask(f32x16&p0,f32x16&p1,int jb,int qrel,int hi){
  const float NEG=-INFINITY; int kb=64*jb+4*hi;
  #pragma unroll
  for(int r=0;r<16;++r){int kv=kb+(r&3)+8*(r>>2); if(kv>qrel)p0[r]=NEG; if(kv+32>qrel)p1[r]=NEG;}
}

constexpr int NSLOT=3, SLOTB=8192;
constexpr int LDS_K=0, LDS_V=NSLOT*SLOTB, LDS_WS=2*NSLOT*SLOTB, LDS_OST=LDS_WS+NW*64*4, LDS_BYTES=LDS_OST+NW*4096;
constexpr float C2=0.125f*1.4426950408889634f;
__device__ __forceinline__ void glds16(const void*gsrc,unsigned lds_dst){unsigned keep;
  asm volatile("s_mov_b32 %0, m0\n\ts_mov_b32 m0, %2\n\ts_nop 0\n\tglobal_load_lds_dwordx4 %1, off\n\ts_mov_b32 m0, %0":"=&s"(keep):"v"(gsrc),"s"(lds_dst):"memory");}
__device__ __forceinline__ float max3f(float a,float b,float c){float r;asm("v_max3_f32 %0, %1, %2, %3":"=v"(r):"v"(a),"v"(b),"v"(c));return r;}
__device__ __forceinline__ float max2f(float a,float b){float r;asm("v_max_f32_e32 %0, %1, %2":"=v"(r):"v"(a),"v"(b));return r;}
__device__ __forceinline__ float fadd_s(float a,float b){float r;asm("v_add_f32_e32 %0, %1, %2":"=v"(r):"v"(a),"v"(b));return r;}
__device__ __forceinline__ float fsub_s(float a,float b){float r;asm("v_sub_f32_e32 %0, %1, %2":"=v"(r):"v"(a),"v"(b));return r;}
typedef float f32x2_t __attribute__((ext_vector_type(2))); typedef __bf16 bf16x2_t __attribute__((ext_vector_type(2)));
__device__ __forceinline__ unsigned cvtpk_s(float lo,float hi){f32x2_t v={lo,hi};bf16x2_t b=__builtin_convertvector(v,bf16x2_t);return __builtin_bit_cast(unsigned,b);}
#define WAIT_BAR(N) asm volatile("s_waitcnt vmcnt(" #N ") lgkmcnt(0)\n\ts_barrier":::"memory")

__device__ __forceinline__ void qkt(f32x16&p0,f32x16&p1,const char*Kslot,const bf16x8*qr,const f32x16&negm,int r32,int hi){
  const char*kb=Kslot+hi*1024+r32*16;
  #pragma unroll
  for(int d0=0;d0<4;++d0){
    const bf16x8 b0=*reinterpret_cast<const bf16x8*>(kb+d0*2048);
    const bf16x8 b1=*reinterpret_cast<const bf16x8*>(kb+d0*2048+512);
    if(d0==0){p0=__builtin_amdgcn_mfma_f32_32x32x16_bf16(b0,qr[0],negm,0,0,0);p1=__builtin_amdgcn_mfma_f32_32x32x16_bf16(b1,qr[0],negm,0,0,0);}
    else{p0=__builtin_amdgcn_mfma_f32_32x32x16_bf16(b0,qr[d0],p0,0,0,0);p1=__builtin_amdgcn_mfma_f32_32x32x16_bf16(b1,qr[d0],p1,0,0,0);}}
}
typedef __attribute__((address_space(3))) const char* lds_cptr;
typedef short v4i16_t __attribute__((ext_vector_type(4)));
__device__ __forceinline__ void kload8(bf16x8*kf,lds_cptr kp){
  kf[0]=*(const __attribute__((address_space(3))) bf16x8*)(kp);      kf[1]=*(const __attribute__((address_space(3))) bf16x8*)(kp+512);
  kf[2]=*(const __attribute__((address_space(3))) bf16x8*)(kp+2048); kf[3]=*(const __attribute__((address_space(3))) bf16x8*)(kp+2560);
  kf[4]=*(const __attribute__((address_space(3))) bf16x8*)(kp+4096); kf[5]=*(const __attribute__((address_space(3))) bf16x8*)(kp+4608);
  kf[6]=*(const __attribute__((address_space(3))) bf16x8*)(kp+6144); kf[7]=*(const __attribute__((address_space(3))) bf16x8*)(kp+6656);
}
__device__ __forceinline__ void kload2(bf16x8*kf,lds_cptr kp,int j){ kf[2*j]=*(const __attribute__((address_space(3))) bf16x8*)(kp+j*2048); kf[2*j+1]=*(const __attribute__((address_space(3))) bf16x8*)(kp+j*2048+512); }
__device__ __forceinline__ s16x4 vtr(lds_cptr p){ return __builtin_bit_cast(s16x4,__builtin_amdgcn_ds_read_tr16_b64_v4i16((__attribute__((address_space(3))) v4i16_t*)p)); }
__device__ __forceinline__ float rowmax(const f32x16&p0,const f32x16&p1){
  float a=max3f(p0[0],p0[1],p1[0]),b=max3f(p0[2],p0[3],p1[1]);a=max3f(a,p1[2],p1[3]);
  #pragma unroll
  for(int r=4;r<16;r+=4){a=max3f(a,p0[r],p0[r+1]);b=max3f(b,p0[r+2],p0[r+3]);a=max3f(a,p1[r],p1[r+1]);b=max3f(b,p1[r+2],p1[r+3]);}
  const float m=max2f(a,b);
  auto rr=__builtin_amdgcn_permlane32_swap(__float_as_uint(m),__float_as_uint(m),false,false);
  return max2f(__uint_as_float(rr[0]),__uint_as_float(rr[1]));
}
__device__ __forceinline__ void pv(f32x16*o,int vb,bf16x8 pa0,bf16x8 pa1,bf16x8 pa2,bf16x8 pa3){
  #pragma unroll
  for(int d0=0;d0<2;++d0){s16x4 lo[4],hi[4];
    #pragma unroll
    for(int ks=0;ks<4;++ks){
      asm volatile("ds_read_b64_tr_b16 %0,%1 offset:%c2":"=&v"(lo[ks]):"v"(vb),"i"(d0*4096+ks*1024):"memory");
      asm volatile("ds_read_b64_tr_b16 %0,%1 offset:%c2":"=&v"(hi[ks]):"v"(vb),"i"(d0*4096+ks*1024+512):"memory");}
    asm volatile("s_waitcnt lgkmcnt(0)":::"memory");SBAR();
    #define PK(k) (bf16x8){lo[k][0],lo[k][1],lo[k][2],lo[k][3],hi[k][0],hi[k][1],hi[k][2],hi[k][3]}
    o[d0]=__builtin_amdgcn_mfma_f32_32x32x16_bf16(pa0,PK(0),o[d0],0,0,0);
    o[d0]=__builtin_amdgcn_mfma_f32_32x32x16_bf16(pa1,PK(1),o[d0],0,0,0);
    o[d0]=__builtin_amdgcn_mfma_f32_32x32x16_bf16(pa2,PK(2),o[d0],0,0,0);
    o[d0]=__builtin_amdgcn_mfma_f32_32x32x16_bf16(pa3,PK(3),o[d0],0,0,0);
    #undef PK
  }
}

#ifndef ATTN_STORE16
#define ATTN_STORE16(p,v) (*(u32x4*)(p)=(v))
#endif
template<int THRL> __device__ __forceinline__ void attn_unit(long qrow0,int h,int NT,const bf16*Q,const bf16*__restrict__ Kh,const bf16*__restrict__ Vh,bf16*O,char*shm,int wave_index){
  unsigned msk_=~0u; asm volatile("":"+s"(msk_)); const int tid=(wave_index<<6)|(int)__builtin_amdgcn_mbcnt_hi(msk_,__builtin_amdgcn_mbcnt_lo(msk_,0u)),lane=tid&63,r32=lane&31,hi=lane>>5; const int wid=__builtin_amdgcn_readfirstlane(tid>>6);
  const bf16*Qw=Q+(qrow0+wid*QBLK)*QP+h*D;
  const unsigned lds0=(unsigned)(uintptr_t)shm;
  float*wsf=(float*)(shm+LDS_WS)+wid*64;
  const bf16*ksrc=Kh+(long)lane*KP+wid*8;
  const bf16*vsrc=Vh+(long)(16*(wid&3)+(lane>>2))*KP+(wid>>2)*32+(lane&3)*8;
  const unsigned kdst=lds0+LDS_K+wid*1024, vdst=lds0+LDS_V+wid*1024;
  #define DMA_K(t,slot) glds16(ksrc+(long)(t)*KVBLK*KP,(unsigned)__builtin_amdgcn_readfirstlane(kdst+(slot)))
  #define DMA_V(t,slot) glds16(vsrc+(long)(t)*KVBLK*KP,(unsigned)__builtin_amdgcn_readfirstlane(vdst+(slot)))
  const int vb0=(int)(lds0+LDS_V)+((lane>>4)&1)*32+(lane&3)*8+(4*hi+((lane&15)>>2))*64;
  const char*Kbase=shm+LDS_K; bf16x8 kf[8];
  const lds_cptr shm3=(lds_cptr)shm; const lds_cptr kp0=shm3+LDS_K+hi*1024+r32*16; const lds_cptr vp0=shm3+LDS_V+((lane>>4)&1)*32+(lane&3)*8+(4*hi+((lane&15)>>2))*64;
  DMA_K(0,0);DMA_V(0,0);DMA_K(1,SLOTB);
  bf16x8 qr[4];
  #pragma unroll
  for(int d0=0;d0<4;++d0)qr[d0]=*reinterpret_cast<const bf16x8*>(&Qw[(long)r32*QP+d0*16+hi*8]);
  float mhat=0.f,l_reg=0.f;f32x16 o[2],negm; { float zz=0.f; asm volatile("":"+v"(zz));
    _Pragma("unroll") for(int r=0;r<16;++r){o[0][r]=zz;o[1][r]=zz;negm[r]=zz;} } asm volatile("":"+v"(negm));
  #define CMASK(P0,P1,t) do{}while(0)
  bool resc=false;
  #define START(P0,P1) do{ const float rm=rowmax(P0,P1); resc=false; \
    { const float dl=rm; mhat=fadd_s(mhat,dl); \
      _Pragma("unroll") for(int r=0;r<16;++r){P0[r]=fsub_s(P0[r],dl);P1[r]=fsub_s(P1[r],dl);} \
      _Pragma("unroll") for(int r=0;r<16;++r)negm[r]=-mhat; asm volatile("":"+v"(negm)); } \
    _Pragma("unroll") for(int r=0;r<16;++r)P0[r]=__builtin_amdgcn_exp2f(P0[r]); }while(0)
  #define RESC() do{ if(resc){ asm volatile("s_waitcnt lgkmcnt(0)":::"memory"); \
      _Pragma("unroll") for(int d_=0;d_<2;++d_) _Pragma("unroll") for(int r=0;r<16;++r)o[d_][r]*=wsf[crow(r,hi)]; } }while(0)
  f32x16 pA0,pA1,pB0,pB1;
  int sl_prev=0,sl_cur=0,sl_next=SLOTB;
  #define ROT() do{sl_prev=sl_cur;sl_cur=sl_next;sl_next=(sl_next==(NSLOT-1)*SLOTB)?0:sl_next+SLOTB;}while(0)
  DMA_K(2,2*SLOTB);
  WAIT_BAR(3);
  qkt(pA0,pA1,Kbase,qr,negm,r32,hi);asm volatile("s_nop 15\n\ts_nop 7":"+v"(pA0),"+v"(pA1));CMASK(pA0,pA1,0);
  START(pA0,pA1);
  _Pragma("unroll") for(int r=0;r<16;++r)pA1[r]=__builtin_amdgcn_exp2f(pA1[r]);
  WAIT_BAR(0);
  DMA_K(3,0);DMA_V(1,SLOTB);
  ROT();
  kload8(kf,kp0+sl_cur);
  WAIT_BAR(2);
  s16x4 vlo[8],vhi[8]; u32x4 pw0,pw1,pw2,pw3;
  #define PKW(P,B) cvtpk_s(P[B],P[B+1])
  #define PAF(k) __builtin_bit_cast(bf16x8,pw##k)
  #define VFR(i) (bf16x8){vlo[i][0],vlo[i][1],vlo[i][2],vlo[i][3],vhi[i][0],vhi[i][1],vhi[i][2],vhi[i][3]}
  #define PIN(x) asm volatile("":"+v"(x))
  #define MX3(a,b,c) __builtin_fmaxf(__builtin_fmaxf((a),(b)),(c))
  #define GAPA(MF,A0,A1,A2,A3,W0,W1,PW) do{ MF; sacc+=A0; sacc+=A1; sacc+=A2; sacc+=A3; PIN(sacc); W0; W1; PIN(PW); SBAR(); }while(0)
  #define EX(v) __builtin_amdgcn_exp2f(v)
  #define GAPB(MF,X,B) do{ MF; X[B]=EX(X[B]); X[B+1]=EX(X[B+1]); X[B+2]=EX(X[B+2]); X[B+3]=EX(X[B+3]); PIN(X); SBAR(); }while(0)
  #define VRD(i) do{ vlo[i]=vtr(vp_+(((i)>>2)*4096+((i)&3)*1024)); vhi[i]=vtr(vp_+(((i)>>2)*4096+((i)&3)*1024+512)); }while(0)
  #define KRD(G,j) do{ if(G){ kload2(kf,kp0+sl_next,j); SBAR(); } }while(0)
  #define STEP(C0,C1,P0,P1,t,GK,GV,GL) do{ SBAR(); \
    const lds_cptr vp_=vp0+sl_prev; \
    VRD(0); SBAR(); float sacc=(P0[0]+P0[1]); \
    GAPA(C0=__builtin_amdgcn_mfma_f32_32x32x16_bf16(kf[0],qr[0],negm,0,0,0), P0[2],P0[3],P0[4],P0[5],     pw0[0]=PKW(P0,0), pw0[1]=PKW(P0,2), pw0); \
    VRD(4); SBAR(); GAPA(C1=__builtin_amdgcn_mfma_f32_32x32x16_bf16(kf[1],qr[0],negm,0,0,0), P0[6],P0[7],P0[8],P0[9],     pw0[2]=PKW(P0,4), pw0[3]=PKW(P0,6), pw0); \
    VRD(1); SBAR(); GAPA(C0=__builtin_amdgcn_mfma_f32_32x32x16_bf16(kf[2],qr[1],C0,0,0,0),   P0[10],P0[11],P0[12],P0[13], pw1[0]=PKW(P0,8), pw1[1]=PKW(P0,10), pw1); \
    VRD(5); SBAR(); GAPA(C1=__builtin_amdgcn_mfma_f32_32x32x16_bf16(kf[3],qr[1],C1,0,0,0),   P0[14],P0[15],P1[0],P1[1],   pw1[2]=PKW(P0,12),pw1[3]=PKW(P0,14), pw1); \
    VRD(2); SBAR(); GAPA(C0=__builtin_amdgcn_mfma_f32_32x32x16_bf16(kf[4],qr[2],C0,0,0,0),   P1[2],P1[3],P1[4],P1[5],     pw2[0]=PKW(P1,0), pw2[1]=PKW(P1,2), pw2); \
    VRD(6); SBAR(); GAPA(C1=__builtin_amdgcn_mfma_f32_32x32x16_bf16(kf[5],qr[2],C1,0,0,0),   P1[6],P1[7],P1[8],P1[9],     pw2[2]=PKW(P1,4), pw2[3]=PKW(P1,6), pw2); \
    VRD(3); SBAR(); GAPA(C0=__builtin_amdgcn_mfma_f32_32x32x16_bf16(kf[6],qr[3],C0,0,0,0),   P1[10],P1[11],P1[12],P1[13], pw3[0]=PKW(P1,8), pw3[1]=PKW(P1,10), pw3); \
    VRD(7); SBAR(); GAPA(C1=__builtin_amdgcn_mfma_f32_32x32x16_bf16(kf[7],qr[3],C1,0,0,0),   P1[14],P1[15],0.f,0.f,       pw3[2]=PKW(P1,12),pw3[3]=PKW(P1,14), pw3); \
    l_reg+=sacc; \
    if(GK){DMA_K((t)+3,sl_cur);} if(GV){DMA_V((t)+1,sl_next);} \
    CMASK(C0,C1,t); \
    { float a=MX3(C0[0],C0[1],C1[0]),b=MX3(C0[2],C0[3],C1[1]); a=MX3(a,C1[2],C1[3]); \
      _Pragma("unroll") for(int r=4;r<16;r+=4){a=MX3(a,C0[r],C0[r+1]);b=MX3(b,C0[r+2],C0[r+3]);a=MX3(a,C1[r],C1[r+1]);b=MX3(b,C1[r+2],C1[r+3]);} \
      float rm=__builtin_fmaxf(a,b); { auto rr=__builtin_amdgcn_permlane32_swap(__float_as_uint(rm),__float_as_uint(rm),false,false); rm=__builtin_fmaxf(__uint_as_float(rr[0]),__uint_as_float(rr[1])); } \
      resc=false; \
      if(__builtin_expect(__any(rm>(float)THRL),0)){ const float dl=__builtin_fmaxf(rm,0.f); mhat+=dl; \
        _Pragma("unroll") for(int r=0;r<16;++r){C0[r]-=dl;C1[r]-=dl;} \
        _Pragma("unroll") for(int r=0;r<16;++r)negm[r]=-mhat; asm volatile("":"+v"(negm)); \
        const float f=__builtin_amdgcn_exp2f(-dl); l_reg*=f; if(hi==0)wsf[r32]=f; resc=true; } } \
    SBAR(); \
    GAPB(o[0]=__builtin_amdgcn_mfma_f32_32x32x16_bf16(PAF(0),VFR(0),o[0],0,0,0), C0,0); \
    GAPB(o[1]=__builtin_amdgcn_mfma_f32_32x32x16_bf16(PAF(0),VFR(4),o[1],0,0,0), C0,4); \
    KRD(GL,0); GAPB(o[0]=__builtin_amdgcn_mfma_f32_32x32x16_bf16(PAF(1),VFR(1),o[0],0,0,0), C0,8); \
    KRD(GL,1); GAPB(o[1]=__builtin_amdgcn_mfma_f32_32x32x16_bf16(PAF(1),VFR(5),o[1],0,0,0), C0,12); \
    KRD(GL,2); GAPB(o[0]=__builtin_amdgcn_mfma_f32_32x32x16_bf16(PAF(2),VFR(2),o[0],0,0,0), C1,0); \
    KRD(GL,3); GAPB(o[1]=__builtin_amdgcn_mfma_f32_32x32x16_bf16(PAF(2),VFR(6),o[1],0,0,0), C1,4); \
    GAPB(o[0]=__builtin_amdgcn_mfma_f32_32x32x16_bf16(PAF(3),VFR(3),o[0],0,0,0), C1,8); \
    GAPB(o[1]=__builtin_amdgcn_mfma_f32_32x32x16_bf16(PAF(3),VFR(7),o[1],0,0,0), C1,12); \
    }while(0)
  int t=1;
  #undef CMASK
  #define CMASK(P0,P1,t) do{}while(0)
  for(;t+5<NT;t+=2){
    STEP(pB0,pB1,pA0,pA1,t,true,true,true);     WAIT_BAR(2); RESC(); ROT();
    STEP(pA0,pA1,pB0,pB1,t+1,true,true,true);   WAIT_BAR(2); RESC(); ROT();
  }
  #undef CMASK
  #define CMASK(P0,P1,t) do{}while(0)
  #define ENDW(tt) do{ if((tt)+3<NT){WAIT_BAR(2);} else if((tt)+2<NT){WAIT_BAR(1);} else {WAIT_BAR(0);} }while(0)
  for(;t+1<NT;t+=2){
    STEP(pB0,pB1,pA0,pA1,t,(t+3<NT),(t+1<NT),(t+1<NT));       ENDW(t);   RESC(); ROT();
    STEP(pA0,pA1,pB0,pB1,t+1,(t+4<NT),(t+2<NT),(t+2<NT));     ENDW(t+1); RESC(); ROT();
  }
  STEP(pB0,pB1,pA0,pA1,NT-1,false,false,false); RESC();
  { float sacc=pB0[0]+pB0[1]; _Pragma("unroll") for(int r=2;r<16;++r)sacc+=pB0[r]; _Pragma("unroll") for(int r=0;r<16;++r)sacc+=pB1[r]; l_reg+=sacc;
    pw0=(u32x4){PKW(pB0,0),PKW(pB0,2),PKW(pB0,4),PKW(pB0,6)};pw1=(u32x4){PKW(pB0,8),PKW(pB0,10),PKW(pB0,12),PKW(pB0,14)};pw2=(u32x4){PKW(pB1,0),PKW(pB1,2),PKW(pB1,4),PKW(pB1,6)};pw3=(u32x4){PKW(pB1,8),PKW(pB1,10),PKW(pB1,12),PKW(pB1,14)};
    SBAR(); pv(o,vb0+sl_cur,PAF(0),PAF(1),PAF(2),PAF(3)); }
  #undef PKW
  #undef PAF
  #undef VFR
  #undef PIN
  #undef MX3
  #undef GAPA
  #undef GAPB
  #undef EX
  #undef VRD
  #undef KRD
  #undef STEP
  #undef ENDW
  {auto rr=__builtin_amdgcn_permlane32_swap(__float_as_uint(l_reg),__float_as_uint(l_reg),false,false);l_reg=__uint_as_float(rr[0])+__uint_as_float(rr[1]);}
  if(hi==0)wsf[32+r32]=l_reg;asm volatile("s_waitcnt lgkmcnt(0)":::"memory");
  float rli[16];
  #pragma unroll
  for(int r=0;r<16;++r)rli[r]=__builtin_amdgcn_rcpf(wsf[32+crow(r,hi)]);
  bf16*Ow=O+(qrow0+wid*QBLK)*OP+h*D;
  { bf16*stg=(bf16*)(shm+LDS_OST)+wid*2048;
    #pragma unroll
    for(int r=0;r<16;++r){const int orow=crow(r,hi);
      #pragma unroll
      for(int d0=0;d0<2;++d0)stg[orow*64+d0*32+r32]=__float2bfloat16(o[d0][r]*rli[r]);}
    asm volatile("s_waitcnt lgkmcnt(0)":::"memory");
    #pragma unroll
    for(int i=0;i<4;++i){const int row=i*8+(lane>>3),ch=lane&7; const u32x4 v=*(const u32x4*)(stg+row*64+ch*8); ATTN_STORE16(Ow+(long)row*OP+ch*8,v);} }
  asm volatile("s_waitcnt lgkmcnt(0)\n\ts_barrier":::"memory");
  #undef DMA_K
  #undef DMA_V
  #undef CMASK
  #undef START
  #undef RESC
  #undef ROT
}
constexpr int ATTN_LDS_BYTES=LDS_BYTES;
#undef SBAR
#undef WAIT_BAR
}
typedef GAS unsigned gu32;
typedef GAS unsigned long long gu64;
#define RLX_AGENT __ATOMIC_RELAXED, __HIP_MEMORY_SCOPE_AGENT
#define LDS_WAIT() asm volatile("s_waitcnt lgkmcnt(0)" ::: "memory")
#define VM_WAIT() asm volatile("s_waitcnt vmcnt(0)" ::: "memory")
__device__ __forceinline__ unsigned long long rt() { return __builtin_amdgcn_s_memrealtime(); }

#define XB_TMO      128
#define XB_XCNT(j)  (256  + 64 * (j))
#define XB_XSUB(j)  (1280 + 64 * (j))
#define XB_XGEN(j)  (2304 + 64 * (j))
#define XB_TOP      3328
#define XB_TOPGEN   3392
#define XCD_BAR_WORDS 3456
#define XB_SPIN_CAP (1u << 18)

__device__ __forceinline__ unsigned xb_ld(unsigned* p)              { return __hip_atomic_load(p, __ATOMIC_RELAXED, __HIP_MEMORY_SCOPE_AGENT); }
__device__ __forceinline__ unsigned xb_add(unsigned* p, unsigned v) { return __hip_atomic_fetch_add(p, v, __ATOMIC_RELAXED, __HIP_MEMORY_SCOPE_AGENT); }
__device__ __forceinline__ unsigned xb_xcc_id() { return (unsigned)__builtin_amdgcn_s_getreg((3 << 11) | 20) & 0xFu; }
#define XB_SPIN(cond, bar) do { unsigned _sp = 0; while (cond) { __builtin_amdgcn_s_sleep(1); \
    if ((++_sp & 255u) == 0u) { if (xb_ld(&(bar)[XB_TMO])) break; if (_sp > XB_SPIN_CAP) { atomicAdd(&(bar)[XB_TMO], 1u); break; } } } } while (0)

struct XcdBarrier {
    unsigned* bar; unsigned x;
    volatile LAS unsigned* st;
};

__device__ __forceinline__ XcdBarrier xcd_barrier_post(unsigned* bar, volatile LAS unsigned* st) {
    XcdBarrier b; b.bar = bar; b.x = xb_xcc_id(); b.st = st;
    if (threadIdx.x == 0) (void)xb_add(&bar[XB_XCNT(b.x)], 1u);
    return b;
}
__device__ __forceinline__ void xcd_barrier_complete(unsigned* bar, unsigned x, unsigned& nloc, unsigned& nx) {
    const unsigned G = gridDim.x * gridDim.y * gridDim.z;
    unsigned sum, cnt, mine, sp = 0u;
    for (;;) {
        sum = 0u; cnt = 0u; mine = 0u;
#pragma unroll
        for (unsigned j = 0; j < 16; ++j) { const unsigned c = xb_ld(&bar[XB_XCNT(j)]); sum += c; cnt += (c > 0u) ? 1u : 0u; mine = (j == x) ? c : mine; }
        if (sum == G) break;
        __builtin_amdgcn_s_sleep(1);
        if ((++sp & 255u) == 0u) { if (xb_ld(&bar[XB_TMO])) break; if (sp > XB_SPIN_CAP) { atomicAdd(&bar[XB_TMO], 1u); break; } }
    }
    nloc = mine > 0u ? mine : 1u; nx = cnt > 0u ? cnt : 1u;
}

__device__ __forceinline__ void xcd_barrier(const XcdBarrier& b) {
    asm volatile("s_waitcnt vmcnt(0)" ::: "memory");
    __syncthreads();
    if (threadIdx.x == 0) {
        unsigned zb_; asm volatile("v_mov_b32 %0, 0" : "=v"(zb_));
        unsigned* bar = (unsigned*)((unsigned char*)b.bar + zb_);
        __builtin_amdgcn_s_waitcnt(0);
        unsigned nloc = b.st[0], nx = b.st[1];
        if (nloc == 0u) { xcd_barrier_complete(bar, b.x, nloc, nx); b.st[0] = nloc; b.st[1] = nx; }
        const unsigned old = xb_add(&bar[XB_XSUB(b.x)], 1u);
        const unsigned gen = old / nloc;
        if (old + 1u == (gen + 1u) * nloc) {
            __builtin_amdgcn_fence(__ATOMIC_RELEASE, "agent");
            asm volatile("s_waitcnt vmcnt(0)" ::: "memory");
            const unsigned og = xb_add(&bar[XB_TOP], 1u);
            const unsigned tg = og / nx;
            if (og + 1u == (tg + 1u) * nx) xb_add(&bar[XB_TOPGEN], 1u);
            else XB_SPIN(xb_ld(&bar[XB_TOPGEN]) == tg, bar);
            __builtin_amdgcn_fence(__ATOMIC_ACQUIRE, "agent");
            xb_add(&bar[XB_XGEN(b.x)], 1u);
            asm volatile("s_waitcnt vmcnt(0)" ::: "memory");
        } else {
            XB_SPIN(xb_ld(&bar[XB_XGEN(b.x)]) == gen, bar);
            __builtin_amdgcn_fence(__ATOMIC_ACQUIRE, "agent");
            asm volatile("s_waitcnt vmcnt(0)" ::: "memory");
        }
    }
    __syncthreads();
}

DI float lx_f(float v, int src) { return __builtin_bit_cast(float, __builtin_amdgcn_ds_bpermute(src << 2, __builtin_bit_cast(int, v))); }
DI int lx_i(int v, int src) { return __builtin_amdgcn_ds_bpermute(src << 2, v); }
template <int CTRL> DI float dppf(float v) { return __builtin_bit_cast(float, __builtin_amdgcn_update_dpp(0, __builtin_bit_cast(int, v), CTRL, 0xf, 0xf, false)); }
DI float dx1(float v) { return dppf<0xB1>(v); }
DI float dx2(float v) { return dppf<0x4E>(v); }
DI float sum8(float v) { v += dx1(v); v += dx2(v); v += dppf<0x141>(v); return v; }
DI float wave_sum(float v, int lane) {
    (void)lane; v = sum8(v); v += dppf<0x140>(v);
    const float a = __builtin_bit_cast(float, __builtin_amdgcn_readlane(__builtin_bit_cast(int, v), 0)), b = __builtin_bit_cast(float, __builtin_amdgcn_readlane(__builtin_bit_cast(int, v), 16));
    const float c = __builtin_bit_cast(float, __builtin_amdgcn_readlane(__builtin_bit_cast(int, v), 32)), d = __builtin_bit_cast(float, __builtin_amdgcn_readlane(__builtin_bit_cast(int, v), 48));
    return (a + b) + (c + d);
}
DI float wave_max(float v, int lane) {
#pragma unroll
    for (int o = 1; o < 64; o <<= 1) v = fmaxf(v, lx_f(v, lane ^ o));
    return v;
}
DI float wave_incl_sum(float v, int lane) {
#pragma unroll
    for (int o = 1; o < 64; o <<= 1) { const float t = lx_f(v, lane - o); if (lane >= o) v += t; }
    return v;
}
DI float wave_incl_max(float v, int lane) {
#pragma unroll
    for (int o = 1; o < 64; o <<= 1) { const float t = lx_f(v, lane - o); if (lane >= o) v = fmaxf(v, t); }
    return v;
}
template <int NT, int KS> DI void mma_tile(f32x4 (&acc)[NT], const LAS bf16_t* A, int lda, const LAS bf16_t* Bt, int ldb, int lane) {
    const int fr = lane & 15, fq = lane >> 4;
#pragma unroll
    for (int ks = 0; ks < KS; ++ks) {
        const bf16x8 a = *(const LAS bf16x8*)(A + fr * lda + ks * 32 + fq * 8);
#pragma unroll
        for (int nt = 0; nt < NT; ++nt) {
            const bf16x8 b = *(const LAS bf16x8*)(Bt + (nt * 16 + fr) * ldb + ks * 32 + fq * 8);
            acc[nt] = __builtin_amdgcn_mfma_f32_16x16x32_bf16(a, b, acc[nt], 0, 0, 0);
        }
    }
}

struct Ctx {
    LAS unsigned char* lds;
    unsigned char* ws;
    const float* const* in;
    float* out;
    int tid, lane, wave, G, bx;
};
#define INP(k) ((const float*)(const GAS float*)C.in[k])
DI unsigned char* opaque_ptr(unsigned char* q) { unsigned lo = (unsigned)(uintptr_t)q, hi = (unsigned)((uintptr_t)q >> 32); lo = (unsigned)__builtin_amdgcn_readfirstlane((int)lo); hi = (unsigned)__builtin_amdgcn_readfirstlane((int)hi);
    asm volatile("" : "+s"(lo), "+s"(hi)); return (unsigned char*)(GAS unsigned char*)(((uintptr_t)hi << 32) | (uintptr_t)lo); }
DI Ctx launder(const Ctx& C0) { Ctx C = C0; unsigned m = ~0u; asm volatile("" : "+s"(m));
    { const LAS unsigned* pw = (const LAS unsigned*)(unsigned)(MISC_OFF + 64);
      unsigned w0 = pw[0], w1 = pw[1], o0 = pw[2], o1 = pw[3]; asm volatile("" : "+v"(w0), "+v"(w1), "+v"(o0), "+v"(o1));
      w0 = (unsigned)__builtin_amdgcn_readfirstlane((int)w0); w1 = (unsigned)__builtin_amdgcn_readfirstlane((int)w1); o0 = (unsigned)__builtin_amdgcn_readfirstlane((int)o0); o1 = (unsigned)__builtin_amdgcn_readfirstlane((int)o1);
      C.ws = (unsigned char*)(GAS unsigned char*)(((uintptr_t)w1 << 32) | (uintptr_t)w0); C.out = (float*)(GAS float*)(((uintptr_t)o1 << 32) | (uintptr_t)o0); }
    C.lane = (int)__builtin_amdgcn_mbcnt_hi(m, __builtin_amdgcn_mbcnt_lo(m, 0u)); C.tid = (C0.wave << 6) | C.lane; return C; }

struct MapId { DI int operator()(int c) const { return c; } };
struct MapTile { DI int operator()(int c) const { const int t = c & 255; return (c & ~255) + 128 * ((t >> 5) & 1) + 32 * (t >> 6) + (t & 31); } };
struct MapE1 { DI int operator()(int c) const { const int j = c >> 1; return (j >> 7) * 256 + (c & 1) * 128 + (j & 127); } };
template <class Map> DI void tr_item(const float* W, int K, int N, bf16_t* WT, LAS float* scr, int kb, int nb, int lane, Map map, int ldw) {
    const int k0 = 64 * kb, n0 = 64 * nb;
    const bool nv = (n0 + lane) < N;
    const float* src = W + (size_t)k0 * N + n0 + lane;
#pragma unroll 8
    for (int i = 0; i < 64; ++i) scr[i * 65 + lane] = nv ? src[(size_t)i * N] : 0.f;
    LDS_WAIT(); asm volatile("" ::: "memory");
    const int c = lane & 7;
#pragma unroll
    for (int j = 0; j < 8; ++j) {
        const int n = (lane >> 3) + 8 * j;
        if (n0 + n < N) {
            const LAS float* s = scr + (8 * c) * 65 + n;
            v4u o; o.x = pk2(s[0], s[65]); o.y = pk2(s[130], s[195]); o.z = pk2(s[260], s[325]); o.w = pk2(s[390], s[455]);
            *(v4u*)(WT + (size_t)map(n0 + n) * ldw + k0 + 8 * c) = o;
        }
    }
    LDS_WAIT(); asm volatile("" ::: "memory");
}
template <bool EDGE, class Map> DI void tr_item8_(const float* W, int K, int N, unsigned char* WT, LAS float* scr, int k0, int n0, int lane, Map map, float scale) {
    const bool nv = !EDGE || (n0 + lane) < N;
    const float* src = W + (size_t)k0 * N + n0 + (nv ? lane : 0);
    { float t[64];
#pragma unroll
        for (int i = 0; i < 64; ++i) t[i] = src[(size_t)i * N];
        __builtin_amdgcn_sched_barrier(0);
#pragma unroll
        for (int i = 0; i < 64; ++i) scr[i * 65 + lane] = t[i]; }
    LDS_WAIT(); asm volatile("" ::: "memory");
    const int c = lane & 3;
#pragma unroll
    for (int j = 0; j < 4; ++j) {
        const int n = (lane >> 2) + 16 * j;
        const LAS float* s = scr + (16 * c) * 65 + n;
        v4u o;
        o.x = pk4_fp8(s[0] * scale, s[65] * scale, s[130] * scale, s[195] * scale); o.y = pk4_fp8(s[260] * scale, s[325] * scale, s[390] * scale, s[455] * scale);
        o.z = pk4_fp8(s[520] * scale, s[585] * scale, s[650] * scale, s[715] * scale); o.w = pk4_fp8(s[780] * scale, s[845] * scale, s[910] * scale, s[975] * scale);
        if (!EDGE || n0 + n < N) *(v4u*)(WT + (size_t)map(n0 + n) * K + k0 + 16 * c) = o;
    }
    LDS_WAIT(); asm volatile("" ::: "memory");
}
template <class Map> DI void tr_item8(const float* W, int K, int N, unsigned char* WT, LAS float* scr, int kb, int nb, int lane, Map map, float scale) {
    if (64 * nb + 64 <= N) tr_item8_<false>(W, K, N, WT, scr, 64 * kb, 64 * nb, lane, map, scale); else tr_item8_<true>(W, K, N, WT, scr, 64 * kb, 64 * nb, lane, map, scale);
}
struct It8 { const float* src; unsigned char* dst; int N, K, k0, n0; bool e1, edge; };
DI void ld8(const It8& d, float (&t)[64], int lane) {
    const bool nv = !d.edge || (d.n0 + lane) < d.N;
    const float* s = d.src + (size_t)d.k0 * d.N + d.n0 + (nv ? lane : 0);
#pragma unroll
    for (int i = 0; i < 64; ++i) t[i] = s[(size_t)i * d.N];
}
DI void st8i(const It8& d, const float (&t)[64], LAS float* scr, int lane, float scale) {
#pragma unroll
    for (int i = 0; i < 64; ++i) scr[i * 65 + lane] = t[i];
    LDS_WAIT(); asm volatile("" ::: "memory");
    const int c = lane & 3;
#pragma unroll
    for (int j = 0; j < 4; ++j) {
        const int n = (lane >> 2) + 16 * j;
        const LAS float* s = scr + (16 * c) * 65 + n;
        v4u o;
        o.x = pk4_fp8(s[0] * scale, s[65] * scale, s[130] * scale, s[195] * scale); o.y = pk4_fp8(s[260] * scale, s[325] * scale, s[390] * scale, s[455] * scale);
        o.z = pk4_fp8(s[520] * scale, s[585] * scale, s[650] * scale, s[715] * scale); o.w = pk4_fp8(s[780] * scale, s[845] * scale, s[910] * scale, s[975] * scale);
        const int col = d.n0 + n, row = d.e1 ? MapE1()(col) : col;
        if (!d.edge || col < d.N) *(v4u*)(d.dst + (size_t)row * d.K + d.k0 + 16 * c) = o;
    }
    LDS_WAIT(); asm volatile("" ::: "memory");
}
DI void p0_prologue(const Ctx& C) {
    __syncthreads();
    {
        LAS float* sc = (LAS float*)(C.lds + RING_OFF);
        LAS float* red = (LAS float*)(C.lds + RING_OFF + 9 * 1024 * 4);
        for (int i = C.tid; i < 9 * 1024; i += 512) { const float v = (i < 8192) ? INP(I_C)[i] : INP(I_CCTX)[i - 8192]; sc[i] = silu_f(v); }
        __syncthreads();
        float* MOD = (float*)(C.ws + WS_MOD);
        for (int u = C.bx; u < DEPTH * 96; u += C.G) {
            const int l = u / 96, cg = u % 96, ci = C.tid & 63, kg = C.tid >> 6;
            const float* w = INP(I_WADA) + ((size_t)l * 1024 + kg * 128) * 6144 + cg * 64 + ci;
            float s[9];
#pragma unroll
            for (int b = 0; b < 9; ++b) s[b] = 0.f;
#pragma unroll 16
            for (int k = 0; k < 128; ++k) { const float wv = w[(size_t)k * 6144];
#pragma unroll
                for (int b = 0; b < 9; ++b) s[b] += sc[b * 1024 + kg * 128 + k] * wv; }
#pragma unroll
            for (int b = 0; b < 9; ++b) red[(kg * 9 + b) * 64 + ci] = s[b];
            __syncthreads();
            for (int o = C.tid; o < 9 * 64; o += 512) { const int b = o >> 6, c2 = o & 63; float t = 0.f;
#pragma unroll
                for (int g = 0; g < 8; ++g) t += red[(g * 9 + b) * 64 + c2];
                MOD[((size_t)l * 9 + b) * 6144 + cg * 64 + c2] = t + INP(I_BADA)[l * 6144 + cg * 64 + c2]; }
            __syncthreads();
        }
    }
    {
        LAS float* scr = (LAS float*)(C.lds + RING_OFF + C.wave * 16640);
        const int gw = C.bx * 8 + C.wave, NGW = C.G * 8;
        constexpr int IT_IN = 16 * 109, IT_BR = 8 * 16, IT_OUT = 16 * 16, IT_E1 = 16 * 32, IT_E2 = 16 * 16;
        constexpr int N0 = DEPTH * IT_IN, N1 = N0 + DEPTH * 3 * IT_BR, N2 = N1 + DEPTH * IT_OUT, N3 = N2 + DEPTH * NEXP * IT_E1, N4 = N3 + DEPTH * NEXP * IT_E2;
        for (int it = N0 + gw; it < N2; it += NGW) {
            if (it < N1) { const int q = it - N0, m = q / IT_BR, r = q % IT_BR; tr_item(INP(I_WBR) + (size_t)m * 512 * DM, 512, DM, (bf16_t*)(C.ws + WS_WTBR) + (size_t)(m / 3) * DM * 1536 + (m % 3) * 512, scr, r / 16, r % 16, C.lane, MapId(), 1536); }
            else { const int q = it - N1, m = q / IT_OUT, r = q % IT_OUT; tr_item(INP(I_WOUT) + (size_t)m * DM * DM, DM, DM, (bf16_t*)(C.ws + WS_WTOUT) + (size_t)m * DM * DM, scr, r / 16, r % 16, C.lane, MapId(), DM); }
        }
        constexpr int NJ = N0 + (N4 - N2);
        auto dec8 = [&](int j) -> It8 { It8 d;
            if (j < N0) { const int m = j / IT_IN, r = j % IT_IN; d.src = INP(I_WIN) + (size_t)m * DM * IN_W; d.dst = (unsigned char*)(C.ws + WS_WTIN) + (size_t)m * PW * DM; d.N = IN_W; d.K = DM; d.k0 = 64 * (r / 109); d.n0 = 64 * (r % 109); d.e1 = false; d.edge = (d.n0 + 64 > IN_W); }
            else { const int it = j - N0 + N2;
                if (it < N3) { const int q = it - N2, m = q / IT_E1, r = q % IT_E1; d.src = INP(I_WE1) + (size_t)m * DM * 2048; d.dst = (unsigned char*)(C.ws + WS_WTE1) + (size_t)m * 2048 * DM; d.N = 2048; d.K = DM; d.k0 = 64 * (r / 32); d.n0 = 64 * (r % 32); d.e1 = true; d.edge = false; }
                else { const int q = it - N3, m = q / IT_E2, r = q % IT_E2; d.src = INP(I_WE2) + (size_t)m * DFF * DM; d.dst = (unsigned char*)(C.ws + WS_WTE2) + (size_t)m * DM * DFF; d.N = DM; d.K = DFF; d.k0 = 64 * (r / 16); d.n0 = 64 * (r % 16); d.e1 = false; d.edge = false; } }
            return d; };
        It8 d0, d1; float t0[64], t1[64];
        int j = gw;
        if (j < NJ) { d0 = dec8(j); ld8(d0, t0, C.lane); }
        for (; j < NJ; j += 2 * NGW) {
            const int j1 = j + NGW, j2 = j1 + NGW;
            if (j1 < NJ) { d1 = dec8(j1); ld8(d1, t1, C.lane); }
            st8i(d0, t0, scr, C.lane, FP8_SW);
            if (j2 < NJ) { d0 = dec8(j2); ld8(d0, t0, C.lane); }
            if (j1 < NJ) st8i(d1, t1, scr, C.lane, FP8_SW);
        }
    }
}

DI void phase_norm1(const Ctx& C, int l, float pscale) {
    const int gw = C.bx * 8 + C.wave, NGW = C.G * 8, lane = C.lane;
    bf16_t* X = (bf16_t*)(C.ws + WS_X); unsigned char* H8 = (unsigned char*)(C.ws + WS_H);
    const float* MOD = (const float*)(C.ws + WS_MOD);
    const int* TOKP = (const int*)(C.ws + WS_TOKP); const int* TOKE = (const int*)(C.ws + WS_TOKE); const float* TOKW = (const float*)(C.ws + WS_TOKW); const bf16_t* YS = (const bf16_t*)(C.ws + WS_YS); const bf16_t* U = (const bf16_t*)(C.ws + WS_U);
    LAS float* BL = (LAS float*)(C.lds + RING_OFF);
    const bool fin = (l == DEPTH);
    const int nrows = fin ? M_LAT : MROWS;
    const int rpw = (nrows + NGW - 1) / NGW, rbeg = gw * rpw, rend = (rbeg + rpw < nrows) ? rbeg + rpw : nrows;
    f32x4 gn[4];
#pragma unroll
    for (int j = 0; j < 4; ++j) gn[j] = *(const f32x4*)((fin ? INP(I_GF) : INP(I_GN1) + (size_t)l * DM) + (lane + 64 * j) * 4);
    __syncthreads();
    if (l > 0) { const float* b2 = INP(I_BE2) + (size_t)(l - 1) * NEXP * DM;
#pragma unroll 4
        for (int i = C.tid; i < NEXP * DM / 4; i += 512) *(LAS f32x4*)(BL + i * 4) = *(const f32x4*)(b2 + i * 4); }
    __syncthreads();
    int mi_cur = -1; f32x4 g2v[4], g1v[4], s1v[4], s0v[4];
    int4 sl = make_int4(0, 0, 0, 0); v2u xr[4];
    if (rbeg < rend) {
        if (l > 0) { sl = *(const int4*)(TOKP + (size_t)rbeg * 4);
#pragma unroll
            for (int j = 0; j < 4; ++j) xr[j] = *(const v2u*)(X + (size_t)rbeg * DM + (lane + 64 * j) * 4); }
    }
    for (int r = rbeg; r < rend; ++r) {
        const int mi = r < M_LAT ? (r >> 12) : 8;
        if (mi != mi_cur) {
            mi_cur = mi;
#pragma unroll
            for (int j = 0; j < 4; ++j) { const int c = (lane + 64 * j) * 4;
                g2v[j] = (l > 0) ? *(const f32x4*)(MOD + ((size_t)(l - 1) * 9 + mi) * 6144 + 5 * DM + c) * pscale : (f32x4){0.f, 0.f, 0.f, 0.f};
                g1v[j] = (l > 0) ? *(const f32x4*)(MOD + ((size_t)(l - 1) * 9 + mi) * 6144 + 2 * DM + c) * pscale : (f32x4){0.f, 0.f, 0.f, 0.f};
                if (!fin) { s0v[j] = *(const f32x4*)(MOD + ((size_t)l * 9 + mi) * 6144 + c); s1v[j] = *(const f32x4*)(MOD + ((size_t)l * 9 + mi) * 6144 + DM + c) + 1.0f; } }
        }
        f32x4 v[4];
        if (l == 0) {
            const float* src = r < M_LAT ? INP(I_X) + (size_t)r * DM : INP(I_CTX) + (size_t)(r - M_LAT) * DM;
#pragma unroll
            for (int j = 0; j < 4; ++j) v[j] = *(const f32x4*)(src + (lane + 64 * j) * 4);
        } else {
            const bf16_t* y0 = YS + (size_t)sl.x * DM; const bf16_t* y1 = YS + (size_t)sl.y * DM; const bf16_t* y2 = YS + (size_t)sl.z * DM; const bf16_t* y3 = YS + (size_t)sl.w * DM;
            const int4 ce = *(const int4*)(TOKE + (size_t)r * 4); const f32x4 cw = *(const f32x4*)(TOKW + (size_t)r * 4);
            v2u ya[4], yb[4], yc[4], yd[4];
#pragma unroll
            for (int j = 0; j < 4; ++j) { const int c = (lane + 64 * j) * 4; ya[j] = *(const v2u*)(y0 + c); yb[j] = *(const v2u*)(y1 + c); yc[j] = *(const v2u*)(y2 + c); yd[j] = *(const v2u*)(y3 + c); }
#pragma unroll
            for (int j = 0; j < 4; ++j) { const v2u uu = *(const v2u*)(U + (size_t)r * DM + (lane + 64 * j) * 4); const v2u xx = xr[j]; v[j] = (f32x4){bf2f(xx.x & 0xffffu), bf2f(xx.x >> 16), bf2f(xx.y & 0xffffu), bf2f(xx.y >> 16)} + g1v[j] * (f32x4){bf2f(uu.x & 0xffffu), bf2f(uu.x >> 16), bf2f(uu.y & 0xffffu), bf2f(uu.y >> 16)}; }
            if (r + 1 < rend) { sl = *(const int4*)(TOKP + (size_t)(r + 1) * 4);
#pragma unroll
                for (int j = 0; j < 4; ++j) xr[j] = *(const v2u*)(X + (size_t)(r + 1) * DM + (lane + 64 * j) * 4); }
#pragma unroll
            for (int j = 0; j < 4; ++j) {
                const v2u a = ya[j], b = yb[j], cc = yc[j], d = yd[j]; const int c = (lane + 64 * j) * 4;
                const f32x4 b0 = *(const LAS f32x4*)(BL + ce.x * DM + c), b1 = *(const LAS f32x4*)(BL + ce.y * DM + c), b2v = *(const LAS f32x4*)(BL + ce.z * DM + c), b3 = *(const LAS f32x4*)(BL + ce.w * DM + c);
                const f32x4 fa = {bf2f(a.x & 0xffffu), bf2f(a.x >> 16), bf2f(a.y & 0xffffu), bf2f(a.y >> 16)}, fb = {bf2f(b.x & 0xffffu), bf2f(b.x >> 16), bf2f(b.y & 0xffffu), bf2f(b.y >> 16)};
                const f32x4 fc = {bf2f(cc.x & 0xffffu), bf2f(cc.x >> 16), bf2f(cc.y & 0xffffu), bf2f(cc.y >> 16)}, fd = {bf2f(d.x & 0xffffu), bf2f(d.x >> 16), bf2f(d.y & 0xffffu), bf2f(d.y >> 16)};
                const f32x4 f = (((fa + b0) * cw[0] + (fb + b1) * cw[1]) + (fc + b2v) * cw[2]) + (fd + b3) * cw[3];
                v[j] = v[j] + g2v[j] * f;
            }
        }
        if (!fin) {
#pragma unroll
            for (int j = 0; j < 4; ++j) { v2u o; o.x = pk2(v[j][0], v[j][1]); o.y = pk2(v[j][2], v[j][3]); *(v2u*)(X + (size_t)r * DM + (lane + 64 * j) * 4) = o; }
        }
        float ss = 0.f;
#pragma unroll
        for (int j = 0; j < 4; ++j) ss += (v[j][0] * v[j][0] + v[j][1] * v[j][1]) + (v[j][2] * v[j][2] + v[j][3] * v[j][3]);
        const float rstd = __builtin_amdgcn_rsqf(wave_sum(ss, lane) * (1.0f / DM) + EPS);
        if (fin) {
#pragma unroll
            for (int j = 0; j < 4; ++j) *(f32x4*)(C.out + (size_t)r * DM + (lane + 64 * j) * 4) = v[j] * rstd * gn[j];
        } else {
#pragma unroll
            for (int j = 0; j < 4; ++j) {
                const int c = (lane + 64 * j) * 4;
                const f32x4 h = v[j] * rstd * gn[j] * s1v[j] + s0v[j];
                *(unsigned*)(H8 + (size_t)r * DM + c) = pk4_fp8(h[0] * FP8_SH, h[1] * FP8_SH, h[2] * FP8_SH, h[3] * FP8_SH);
            }
        }
    }
}

DI void rope_cs(float (&c)[8], float (&s)[8], const float (&freq)[8], int lane, int t) {
    const int sub = lane & 7;
    const float pos = (sub >= 4) ? (float)(t & 63) : (float)(t >> 6);
#pragma unroll
    for (int e = 0; e < 8; ++e) { float rev = pos * freq[e]; rev -= floorf(rev); c[e] = __builtin_amdgcn_cosf(rev); s[e] = __builtin_amdgcn_sinf(rev); }
}
DI void rope_apply(float (&x)[8], const float (&c)[8], const float (&s)[8], int lane) {
    const bool second = (lane & 2) != 0;
#pragma unroll
    for (int e = 0; e < 8; ++e) { const float other = dx2(x[e]); x[e] = second ? (x[e] * c[e] + other * s[e]) : (x[e] * c[e] - other * s[e]); }
}
DI void phase_attn_prep(const Ctx& C, int l) {
    const int gw = C.bx * 8 + C.wave, NGW = C.G * 8, lane = C.lane;
    const bf16_t* P = (const bf16_t*)(C.ws + WS_P);
    bf16_t* QR = (bf16_t*)(C.ws + WS_QR); bf16_t* KR = (bf16_t*)(C.ws + WS_KR); bf16_t* VR = (bf16_t*)(C.ws + WS_VR);
    float gq[8], gk[8], freq[8];
#pragma unroll
    for (int e = 0; e < 8; ++e) { gq[e] = INP(I_BQG)[l * 64 + (lane & 7) * 8 + e]; gk[e] = INP(I_BKG)[l * 64 + (lane & 7) * 8 + e];
        freq[e] = __builtin_amdgcn_exp2f(-(float)((lane & 1) * 8 + e) * 0.83048202372184058696f) * 0.15915494309189533577f; }
    constexpr float C2 = 0.125f * 1.4426950408889634f;
    const int kl = lane & 15;
    v4u nq = {0u, 0u, 0u, 0u}, nk = nq, nv = nq;
    if (gw < MROWS) { const bf16_t* prow = P + (size_t)gw * PW; nq = *(const v4u*)(prow + C_BQ + lane * 8); nk = *(const v4u*)(prow + C_BK + kl * 8); nv = *(const v4u*)(prow + C_BV + kl * 8); }
    for (int r = gw; r < MROWS; r += NGW) {
        const bool lat = r < M_LAT;
        const int b = lat ? (r >> 12) : ((r - M_LAT) >> 8), t = lat ? (r & 4095) : ((r - M_LAT) & 255), kvpos = lat ? (CTXL + t) : t;
        const v4u cq = nq, ck = nk, cv = nv;
        if (r + NGW < MROWS) { const bf16_t* prow = P + (size_t)(r + NGW) * PW; nq = *(const v4u*)(prow + C_BQ + lane * 8); nk = *(const v4u*)(prow + C_BK + kl * 8); nv = *(const v4u*)(prow + C_BV + kl * 8); }
        float rc[8], rs[8];
        if (lat) rope_cs(rc, rs, freq, lane, t);
        float x[8];
        unpack8(cq, x);
        float ss = 0.f;
#pragma unroll
        for (int e = 0; e < 8; ++e) ss += x[e] * x[e];
        ss = sum8(ss);
        float rstd = __builtin_amdgcn_rsqf(ss * (1.0f / 64.0f) + EPS);
#pragma unroll
        for (int e = 0; e < 8; ++e) x[e] = x[e] * rstd * gq[e];
        if (lat) rope_apply(x, rc, rs, lane);
        { v4u o; o.x = pk2(x[0] * C2, x[1] * C2); o.y = pk2(x[2] * C2, x[3] * C2); o.z = pk2(x[4] * C2, x[5] * C2); o.w = pk2(x[6] * C2, x[7] * C2);
          *(v4u*)(QR + (size_t)r * 512 + lane * 8) = o; }
        unpack8(ck, x);
        ss = 0.f;
#pragma unroll
        for (int e = 0; e < 8; ++e) ss += x[e] * x[e];
        ss = sum8(ss);
        rstd = __builtin_amdgcn_rsqf(ss * (1.0f / 64.0f) + EPS);
#pragma unroll
        for (int e = 0; e < 8; ++e) x[e] = x[e] * rstd * gk[e];
        if (lat) rope_apply(x, rc, rs, lane);
        const size_t kvrow = ((size_t)b * KVLEN + kvpos) * 128;
        if (lane < 16) { v4u o; o.x = pk2(x[0], x[1]); o.y = pk2(x[2], x[3]); o.z = pk2(x[4], x[5]); o.w = pk2(x[6], x[7]); *(v4u*)(KR + kvrow + kl * 8) = o; }
        else if (lane < 32) { *(v4u*)(VR + kvrow + kl * 8) = cv; }
    }
}

constexpr int LDT = 72;
constexpr unsigned short BF16_ONE = 0x3F80;
DI int chunk_pos0(int c) { return (c < 512 ? (c & 63) : ((c - 512) & 3)) * 64; }
DI int chunk_len(int c) { return c < 512 ? SEQ : CTXL; }

struct ConvIn { v4u x0, xm, xp; };
DI void conv_load(ConvIn& r, const bf16_t* P, int row0, int t, int pos0, int seqlen, int col) {
    const bf16_t* p = P + (size_t)(row0 + t) * PW + col;
    r.x0 = *(const v4u*)p;
    r.xm = (v4u){0u, 0u, 0u, 0u}; r.xp = (v4u){0u, 0u, 0u, 0u};
    if (pos0 + t - 1 >= 0) r.xm = *(const v4u*)(p - PW);
    if (pos0 + t + 1 < seqlen) r.xp = *(const v4u*)(p + PW);
}
DI void conv_apply(const ConvIn& r, const LAS float* cwt, int c8, float (&y)[8]) {
    float xm[8], x0[8], xp[8]; unpack8(r.xm, xm); unpack8(r.x0, x0); unpack8(r.xp, xp);
#pragma unroll
    for (int hh = 0; hh < 2; ++hh) {
        const f32x4 w0 = *(const LAS f32x4*)(cwt + c8 + 4 * hh), w1 = *(const LAS f32x4*)(cwt + 64 + c8 + 4 * hh), w2 = *(const LAS f32x4*)(cwt + 128 + c8 + 4 * hh), bb = *(const LAS f32x4*)(cwt + 192 + c8 + 4 * hh);
#pragma unroll
        for (int e = 0; e < 4; ++e) y[4 * hh + e] = silu_f(xm[4 * hh + e] * w0[e] + x0[4 * hh + e] * w1[e] + xp[4 * hh + e] * w2[e] + bb[e]);
    }
}
DI void conv_table(const Ctx& C, LAS float* cwt, int l, int h) {
    const float* cw = INP(I_ACW) + (size_t)l * 3 * 512; const float* cb = INP(I_ACB) + (size_t)l * 512;
    const int qk = C.tid >> 8, row = (C.tid >> 6) & 3, ch = C.tid & 63, col = qk * 256 + h * 64 + ch;
    cwt[C.tid] = row < 3 ? cw[row * 512 + col] : cb[col];
}
DI v4u pack8f(const float (&y)[8], float sc) { v4u o; o.x = pk2(y[0] * sc, y[1] * sc); o.y = pk2(y[2] * sc, y[3] * sc); o.z = pk2(y[4] * sc, y[5] * sc); o.w = pk2(y[6] * sc, y[7] * sc); return o; }
DI void store_vt8(LAS bf16_t* VT, const v4u x, int col, int t) {
    LAS bf16_t* d = VT + col * LDT + t;
    d[0 * LDT] = (bf16_t)(x.x & 0xffffu); d[1 * LDT] = (bf16_t)(x.x >> 16); d[2 * LDT] = (bf16_t)(x.y & 0xffffu); d[3 * LDT] = (bf16_t)(x.y >> 16);
    d[4 * LDT] = (bf16_t)(x.z & 0xffffu); d[5 * LDT] = (bf16_t)(x.z >> 16); d[6 * LDT] = (bf16_t)(x.w & 0xffffu); d[7 * LDT] = (bf16_t)(x.w >> 16);
}
DI void store_ct(LAS bf16_t* CT, const f32x4 (&s)[4], int tid) {
#pragma unroll
    for (int q = 0; q < 4; ++q) {
        const int idx = tid * 4 + q * 2048, v = idx >> 6, d = idx & 63;
        v2u o; o.x = pk2(s[q][0], s[q][1]); o.y = pk2(s[q][2], s[q][3]);
        *(LAS v2u*)(CT + v * LDT + d) = o;
    }
}
template <int ACT, int HSLD> DI void head_out(const Ctx& C, const LAS float* HS, const v4u g0, const v4u g1, int row0, const float (&gain)[16], bf16_t* Y, int h) {
    const int t = C.tid >> 3, sub = C.tid & 7;
    float x[16]; float ss = 0.f;
#pragma unroll
    for (int q = 0; q < 4; ++q) { const f32x4 v = *(const LAS f32x4*)(HS + t * HSLD + sub * 16 + q * 4); x[4 * q] = v[0]; x[4 * q + 1] = v[1]; x[4 * q + 2] = v[2]; x[4 * q + 3] = v[3]; }
#pragma unroll
    for (int e = 0; e < 16; ++e) ss += x[e] * x[e];
    ss = sum8(ss);
    const float rstd = __builtin_amdgcn_rsqf(ss * (1.0f / 128.0f) + EPS);
    float ga[8], gb[8]; unpack8(g0, ga); unpack8(g1, gb);
    float o[16];
#pragma unroll
    for (int e = 0; e < 16; ++e) { const float gv = e < 8 ? ga[e] : gb[e - 8]; const float a = ACT == 0 ? sigmoid_f(gv) : silu_f(gv); o[e] = x[e] * rstd * gain[e] * a; }
    v4u w0, w1; w0.x = pk2(o[0], o[1]); w0.y = pk2(o[2], o[3]); w0.z = pk2(o[4], o[5]); w0.w = pk2(o[6], o[7]); w1.x = pk2(o[8], o[9]); w1.y = pk2(o[10], o[11]); w1.z = pk2(o[12], o[13]); w1.w = pk2(o[14], o[15]);
    bf16_t* yp = Y + (size_t)(row0 + t) * 1536 + h * 128 + sub * 16;
    *(v4u*)yp = w0; *(v4u*)(yp + 8) = w1;
}

DI unsigned char* rec_ptr(unsigned char* base, int c, int h, int dir) { return base + ((size_t)(c * 4 + h) * 2 + dir) * RECB; }
template <bool NVEC> DI void delta_store(const Ctx& C, const LAS bf16_t* KT, const LAS bf16_t* VT, unsigned char* rec) {
    const int part = C.wave & 3, fr = C.lane & 15, fq = C.lane >> 4;
    f32x4 acc[8];
#pragma unroll
    for (int nt = 0; nt < 8; ++nt) acc[nt] = (f32x4){0.f, 0.f, 0.f, 0.f};
    mma_tile<8, 2>(acc, KT + 16 * part * LDT, LDT, VT, LDT, C.lane);
    bf16_t* R = (bf16_t*)rec;
#pragma unroll
    for (int nt = 0; nt < 8; ++nt) { v2u o; o.x = pk2(acc[nt][0], acc[nt][1]); o.y = pk2(acc[nt][2], acc[nt][3]); *(v2u*)(R + (nt * 16 + fr) * 64 + 16 * part + fq * 4) = o; }
    if (NVEC) {
        f32x4 an[1]; an[0] = (f32x4){0.f, 0.f, 0.f, 0.f};
        mma_tile<1, 2>(an, KT + 16 * part * LDT, LDT, VT + 128 * LDT, LDT, C.lane);
        if (fr == 0) { float* nf = (float*)(rec + REC_VEC) + 16 * part + fq * 4; nf[0] = an[0][0]; nf[1] = an[0][1]; nf[2] = an[0][2]; nf[3] = an[0][3]; }
    }
}
DI void store_ct16(LAS bf16_t* CT, const v4u a, const v4u b, int tid) {
    { const int idx = tid * 8; *(LAS v4u*)(CT + (idx >> 6) * LDT + (idx & 63)) = a; }
    { const int idx = tid * 8 + 4096; *(LAS v4u*)(CT + (idx >> 6) * LDT + (idx & 63)) = b; }
}
constexpr int MC_QS = 0, MC_KS = 9216, MC_VT = 18432, MC_CT0 = 39168, MC_CT1 = 59904, MC_SB0 = 80640, MC_SB1 = 89856, MC_HS = 99072, MC_VEC = 132864, MC_CWT = 134912;
static_assert(MC_CWT + 2048 <= RING_BYTES, "mLSTM (c) LDS map");
constexpr int MA_VT = 0, MA_KT0 = 20736, MA_KT1 = 29952, MA_VEC = 39168, MA_CWT = 40192;
struct MARegs { ConvIn k; v4u v0, v1; float gi, gf; };
struct MCRegs { ConvIn q, k; v4u v0, v1, og0, og1, s0a, s0b, s1a, s1b; float gi, gf, aux; };
DI void mlstm_a_load(const Ctx& C, int c, int h, MARegs& R) {
    const bf16_t* P = (const bf16_t*)(C.ws + WS_P);
    const int row0 = c * 64, t = C.lane, c8 = C.wave * 8;
    conv_load(R.k, P, row0, t, chunk_pos0(c), chunk_len(c), C_AQK + 256 + h * 64 + c8);
    const bf16_t* pv = P + (size_t)(row0 + t) * PW + C_AV + h * 128 + c8;
    R.v0 = *(const v4u*)pv; R.v1 = *(const v4u*)(pv + 64);
    R.gi = 0.f; R.gf = 0.f;
    if (C.wave < 2) { const int dir = C.wave, tt = dir ? 63 - C.lane : C.lane; const bf16_t* prow = P + (size_t)(row0 + tt) * PW; R.gi = bf2f(prow[C_AI + dir * 4 + h]); R.gf = bf2f(prow[C_AF + dir * 4 + h]); }
}
DI void mlstm_a_unit(const Ctx& C0, int l, int c, int h, MARegs& R, bool has_next, int cn, int hn) {
    Ctx C = C0; { int t_ = C0.tid; asm volatile("" : "+v"(t_)); C.tid = t_; C.lane = t_ & 63; }
    LAS unsigned char* L = C.lds + RING_OFF;
    LAS bf16_t* VT = (LAS bf16_t*)(L + MA_VT); LAS bf16_t* KT0 = (LAS bf16_t*)(L + MA_KT0); LAS bf16_t* KT1 = (LAS bf16_t*)(L + MA_KT1); LAS float* VEC = (LAS float*)(L + MA_VEC);
    unsigned char* rec0 = rec_ptr(C.ws + WS_STA, c, h, 0);
    const int t = C.lane, c8 = C.wave * 8;
    __syncthreads();
    if (C.wave < 2) {
        const int dir = C.wave, tt = dir ? 63 - C.lane : C.lane;
        const float* gb = INP(I_AGB) + l * 16;
        const float iv = R.gi + gb[dir * 4 + h], fv = logsigmoid_f(R.gf + gb[8 + dir * 4 + h]);
        const float b = wave_incl_sum(fv, C.lane);
        const float B = lx_f(b, 63);
        const float a = B - b + iv;
        const float Ml = wave_max(a, C.lane);
        VEC[dir * 64 + tt] = __expf(a - Ml);
        if (C.lane == 0) { float* sf = (float*)(rec0 + dir * RECB + REC_VEC); sf[64] = B; sf[65] = Ml; }
    }
    float y[8]; conv_apply(R.k, (const LAS float*)(L + MA_CWT) + 256, c8, y);
    store_vt8(VT, R.v0, c8, t); store_vt8(VT, R.v1, 64 + c8, t);
    if (C.tid < 64) VT[128 * LDT + C.tid] = BF16_ONE;
    asm volatile("" ::: "memory"); __builtin_amdgcn_sched_barrier(0);
    if (has_next) mlstm_a_load(C, cn, hn, R);
    asm volatile("" ::: "memory"); __builtin_amdgcn_sched_barrier(0);
    __syncthreads();
    {
        const float w0 = VEC[t] * 0.125f, w1 = VEC[64 + t] * 0.125f;
#pragma unroll
        for (int e = 0; e < 8; ++e) { const unsigned pw = pk2(y[e] * w0, y[e] * w1); KT0[(c8 + e) * LDT + t] = (bf16_t)pw; KT1[(c8 + e) * LDT + t] = (bf16_t)(pw >> 16); }
    }
    __syncthreads();
    delta_store<true>(C, (C.wave >> 2) ? KT1 : KT0, VT, rec0 + (C.wave >> 2) * RECB);
}
DI void mlstm_a_phase(const Ctx& C, int l) {
    LAS float* cwt = (LAS float*)(C.lds + RING_OFF + MA_CWT);
    int htab = -1; MARegs R;
    int u = C.bx; if (u < NCHUNK * 4) mlstm_a_load(C, u >> 2, u & 3, R);
    for (; u < NCHUNK * 4; u += C.G) {
        const int h = u & 3, un = u + C.G;
        if (h != htab) { __syncthreads(); conv_table(C, cwt, l, h); htab = h; }
        mlstm_a_unit(C, l, u >> 2, h, R, un < NCHUNK * 4, un >> 2, un & 3);
    }
}
DI void mlstm_c_load(const Ctx& C, int c, int h, MCRegs& R) {
    const bf16_t* P = (const bf16_t*)(C.ws + WS_P);
    const int row0 = c * 64, t = C.lane, c8 = C.wave * 8, pos0 = chunk_pos0(c), len = chunk_len(c);
    conv_load(R.q, P, row0, t, pos0, len, C_AQK + h * 64 + c8);
    conv_load(R.k, P, row0, t, pos0, len, C_AQK + 256 + h * 64 + c8);
    const bf16_t* pr = P + (size_t)(row0 + t) * PW;
    R.v0 = *(const v4u*)(pr + C_AV + h * 128 + c8); R.v1 = *(const v4u*)(pr + C_AV + h * 128 + 64 + c8);
    { const bf16_t* po = P + (size_t)(row0 + (C.tid >> 3)) * PW + C_AO + h * 128 + (C.tid & 7) * 16; R.og0 = *(const v4u*)po; R.og1 = *(const v4u*)(po + 8); }
    const unsigned char* rec0 = rec_ptr(C.ws + WS_STA, c, h, 0);
    R.s0a = *(const v4u*)(rec0 + C.tid * 16); R.s0b = *(const v4u*)(rec0 + 8192 + C.tid * 16); R.s1a = *(const v4u*)(rec0 + RECB + C.tid * 16); R.s1b = *(const v4u*)(rec0 + RECB + 8192 + C.tid * 16);
    R.gi = 0.f; R.gf = 0.f; R.aux = 0.f;
    if (C.wave < 2) { const int dir = C.wave, tt = dir ? 63 - C.lane : C.lane; const bf16_t* prow = P + (size_t)(row0 + tt) * PW; R.gi = bf2f(prow[C_AI + dir * 4 + h]); R.gf = bf2f(prow[C_AF + dir * 4 + h]); R.aux = ((const float*)(rec0 + dir * RECB + REC_VEC))[66]; }
    else if (C.wave < 4) R.aux = ((const float*)(rec0 + (C.wave - 2) * RECB + REC_VEC))[C.lane];
}
DI void mlstm_c_unit(const Ctx& C0, int l, int c, int h, MCRegs& R, const float (&gain)[16], bool has_next, int cn, int hn) {
    Ctx C = C0; { int t_ = C0.tid; asm volatile("" : "+v"(t_)); C.tid = t_; C.lane = t_ & 63; }
    LAS unsigned char* L = C.lds + RING_OFF;
    LAS bf16_t* QS = (LAS bf16_t*)(L + MC_QS); LAS bf16_t* KS = (LAS bf16_t*)(L + MC_KS); LAS bf16_t* VT = (LAS bf16_t*)(L + MC_VT);
    LAS bf16_t* CT0 = (LAS bf16_t*)(L + MC_CT0); LAS bf16_t* CT1 = (LAS bf16_t*)(L + MC_CT1); LAS bf16_t* SB0 = (LAS bf16_t*)(L + MC_SB0); LAS bf16_t* SB1 = (LAS bf16_t*)(L + MC_SB1);
    LAS float* HS = (LAS float*)(L + MC_HS); LAS float* VEC = (LAS float*)(L + MC_VEC); const LAS float* cwt = (const LAS float*)(L + MC_CWT);
    const int row0 = c * 64;
    const float aux = R.aux;
    __syncthreads();
    if (C.wave < 2) {
        const int dir = C.wave, tt = dir ? 63 - C.lane : C.lane;
        const float* gb = INP(I_AGB) + l * 16;
        const float iv = R.gi + gb[dir * 4 + h], fv = logsigmoid_f(R.gf + gb[8 + dir * 4 + h]);
        const float b = wave_incl_sum(fv, C.lane);
        const float g = iv - b;
        const float cm = wave_incl_max(g, C.lane);
        const float m0 = aux;
        const float mm = fmaxf(m0, cm);
        LAS float* V = VEC + dir * 256;
        V[tt] = g; V[64 + tt] = mm; V[128 + tt] = __expf(m0 - mm); V[192 + tt] = __expf(-(b + mm));
    } else if (C.wave < 4) { (C.wave == 3 ? CT1 : CT0)[128 * LDT + C.lane] = (bf16_t)f2bf(aux); }
    else if (C.wave == 4) VT[128 * LDT + C.lane] = BF16_ONE;
    {
        const int t = C.lane, c8 = C.wave * 8;
        float y[8];
        conv_apply(R.q, cwt, c8, y);
        *(LAS v4u*)(QS + t * LDT + c8) = pack8f(y, 1.0f);
        conv_apply(R.k, cwt + 256, c8, y);
        *(LAS v4u*)(KS + t * LDT + c8) = pack8f(y, 0.125f);
        store_vt8(VT, R.v0, c8, t); store_vt8(VT, R.v1, 64 + c8, t);
    }
    store_ct16(CT0, R.s0a, R.s0b, C.tid); store_ct16(CT1, R.s1a, R.s1b, C.tid);
    const v4u og0 = R.og0, og1 = R.og1;
    asm volatile("" ::: "memory"); __builtin_amdgcn_sched_barrier(0);
    if (has_next) mlstm_c_load(C, cn, hn, R);
    asm volatile("" ::: "memory"); __builtin_amdgcn_sched_barrier(0);
    __syncthreads();
    {
        const int mt = C.wave & 3, nh = C.wave >> 2, fr = C.lane & 15, fq = C.lane >> 4;
        f32x4 acc[2]; acc[0] = (f32x4){0.f, 0.f, 0.f, 0.f}; acc[1] = acc[0];
        mma_tile<2, 2>(acc, QS + 16 * mt * LDT, LDT, KS + 32 * nh * LDT, LDT, C.lane);
#pragma unroll
        for (int nt = 0; nt < 2; ++nt)
#pragma unroll
            for (int i = 0; i < 4; ++i) {
                const int j = 16 * mt + fq * 4 + i, s2 = 32 * nh + nt * 16 + fr;
                const float v = acc[nt][i];
                const float d0 = __expf(VEC[s2] - VEC[64 + j]), d1 = __expf(VEC[256 + s2] - VEC[256 + 64 + j]);
                const unsigned pw = pk2(s2 <= j ? v * d0 : 0.f, s2 >= j ? v * d1 : 0.f);
                SB0[j * LDT + s2] = (bf16_t)pw; SB1[j * LDT + s2] = (bf16_t)(pw >> 16);
            }
    }
    __syncthreads();
    {
        const int mt = C.wave & 3, vh = C.wave >> 2, fr = C.lane & 15, fq = C.lane >> 4;
        f32x4 hsum[4];
#pragma unroll
        for (int nt = 0; nt < 4; ++nt) hsum[nt] = (f32x4){0.f, 0.f, 0.f, 0.f};
#pragma unroll
        for (int dir = 0; dir < 2; ++dir) {
            const LAS bf16_t* CT = dir ? CT1 : CT0; const LAS bf16_t* SB = dir ? SB1 : SB0; const LAS float* V = VEC + dir * 256;
            f32x4 acc[4], den[1];
#pragma unroll
            for (int nt = 0; nt < 4; ++nt) acc[nt] = (f32x4){0.f, 0.f, 0.f, 0.f};
            den[0] = (f32x4){0.f, 0.f, 0.f, 0.f};
            mma_tile<4, 2>(acc, QS + 16 * mt * LDT, LDT, CT + 64 * vh * LDT, LDT, C.lane);
            mma_tile<1, 2>(den, QS + 16 * mt * LDT, LDT, CT + 128 * LDT, LDT, C.lane);
#pragma unroll
            for (int i = 0; i < 4; ++i) { const float w = V[128 + 16 * mt + fq * 4 + i]; den[0][i] *= w;
#pragma unroll
                for (int nt = 0; nt < 4; ++nt) acc[nt][i] *= w; }
            mma_tile<4, 2>(acc, SB + 16 * mt * LDT, LDT, VT + 64 * vh * LDT, LDT, C.lane);
            mma_tile<1, 2>(den, SB + 16 * mt * LDT, LDT, VT + 128 * LDT, LDT, C.lane);
#pragma unroll
            for (int i = 0; i < 4; ++i) {
                const float dn = lx_f(den[0][i], C.lane & 48);
                const float inv = __builtin_amdgcn_rcpf(fmaxf(fabsf(dn), V[192 + 16 * mt + fq * 4 + i]));
#pragma unroll
                for (int nt = 0; nt < 4; ++nt) hsum[nt][i] += acc[nt][i] * inv;
            }
        }
#pragma unroll
        for (int i = 0; i < 4; ++i)
#pragma unroll
            for (int nt = 0; nt < 4; ++nt) HS[(16 * mt + fq * 4 + i) * 132 + 64 * vh + nt * 16 + fr] = hsum[nt][i];
    }
    __syncthreads();
    head_out<0, 132>(C, HS, og0, og1, row0, gain, (bf16_t*)(C.ws + WS_YA), h);
}
DI void load_gain16(float (&gain)[16], const float* g, int h, int tid) {
    asm volatile("" : "+v"(tid));
#pragma unroll
    for (int q = 0; q < 4; ++q) { const f32x4 v = *(const f32x4*)(g + h * 128 + (tid & 7) * 16 + 4 * q); gain[4 * q] = v[0]; gain[4 * q + 1] = v[1]; gain[4 * q + 2] = v[2]; gain[4 * q + 3] = v[3]; }
}
DI void mlstm_c_phase(const Ctx& C, int l) {
    LAS float* cwt = (LAS float*)(C.lds + RING_OFF + MC_CWT);
    int htab = -1; MCRegs R; float gain[16];
    const int NU = (l == DEPTH - 1 ? 512 : NCHUNK) * 4;
    int u = C.bx; if (u < NU) mlstm_c_load(C, u >> 2, u & 3, R);
    for (; u < NU; u += C.G) {
        const int h = u & 3, un = u + C.G;
        if (h != htab) { __syncthreads(); conv_table(C, cwt, l, h); load_gain16(gain, INP(I_ANG) + (size_t)l * 512, h, C.tid); htab = h; }
        mlstm_c_unit(C, l, u >> 2, h, R, gain, un < NU, un >> 2, un & 3);
    }
}

constexpr int LAP = 68;
constexpr int GA_LA0 = 0, GA_LA1 = 17408, GA_VT = 34816, GA_KT0 = 53248, GA_KT1 = 62464, GA_LOW = 71680, GA_WUT0 = 76800, GA_WUT1 = 81920;
constexpr int GC_QS0 = 0, GC_QS1 = 9216, GC_VT = 18432, GC_CT0 = 36864, GC_CT1 = 55296, GC_SB0 = 73728, GC_SB1 = 82944, GC_KS0 = 92160, GC_KS1 = 101376, GC_LA0 = 110592, GC_LA1 = 128000, GC_HS = 92160;
constexpr int GC_LOW = GC_CT0, GC_WUT0 = 145408, GC_WUT1 = 145408 + 5120;
static_assert(GC_WUT1 + 5120 <= RING_BYTES && GC_HS + 64 * 128 * 4 <= GC_LA1, "GLA (c) LDS map");
constexpr int LWD = 40;
struct GARegs { v4u low, k, v0, v1; };
struct GCRegs { v4u low, q, k, v0, v1, og0, og1; };
DI void gla_wut_table(const Ctx& C, LAS bf16_t* WUT0, LAS bf16_t* WUT1, int l, int h) {
    const int dir = C.tid >> 8, dk = (C.tid >> 2) & 63, ig = C.tid & 3;
    float w[8];
    const bool live = (ig >> 1) == dir;
    const float* wu = INP(I_CWUP) + ((size_t)(l * 2 + dir) * 16 + (ig & 1) * 8) * 256 + h * 64 + dk;
#pragma unroll
    for (int e = 0; e < 8; ++e) w[e] = live ? wu[e * 256] : 0.f;
    *(LAS v4u*)((dir ? WUT1 : WUT0) + dk * LWD + ig * 8) = pack8f(w, 1.0f);
}
DI void gla_logdecay(const Ctx& C, const v4u lowreg, const float (&bu)[4], LAS float* LA0, LAS float* LA1, LAS bf16_t* LOW, const LAS bf16_t* WUT0, const LAS bf16_t* WUT1) {
    { const int t = C.tid >> 3, part = C.tid & 7; if (part < 4) *(LAS v4u*)(LOW + t * LWD + part * 8) = lowreg; }
    __syncthreads();
    {
        const int dir = C.wave >> 2, mt = C.wave & 3, fr = C.lane & 15, fq = C.lane >> 4;
        f32x4 acc[4];
#pragma unroll
        for (int nt = 0; nt < 4; ++nt) acc[nt] = (f32x4){0.f, 0.f, 0.f, 0.f};
        mma_tile<4, 1>(acc, LOW + 16 * mt * LWD, LWD, dir ? WUT1 : WUT0, LWD, C.lane);
        LAS float* LA = dir ? LA1 : LA0;
#pragma unroll
        for (int nt = 0; nt < 4; ++nt)
#pragma unroll
            for (int i = 0; i < 4; ++i) LA[(16 * mt + fq * 4 + i) * LAP + nt * 16 + fr] = logsigmoid_f(acc[nt][i] + bu[nt]) * (1.0f / 16.0f);
    }
    __syncthreads();
    if (C.wave < 2) {
        LAS float* LA = C.wave ? LA1 : LA0;
        float a[64];
#pragma unroll
        for (int q = 0; q < 64; ++q) a[q] = LA[(C.wave ? 63 - q : q) * LAP + C.lane];
#pragma unroll
        for (int q = 1; q < 64; ++q) a[q] += a[q - 1];
#pragma unroll
        for (int q = 0; q < 64; ++q) LA[(C.wave ? 63 - q : q) * LAP + C.lane] = a[q];
    }
    __syncthreads();
}
DI void gla_bias4(float (&bu)[4], const Ctx& C, int l, int h) {
    int ln = C.lane; asm volatile("" : "+v"(ln));
    const float* b = INP(I_CBUP) + (size_t)(l * 2 + (C.wave >> 2)) * 256 + h * 64 + (ln & 15);
#pragma unroll
    for (int nt = 0; nt < 4; ++nt) bu[nt] = b[nt * 16];
}
DI void gla_a_load(const Ctx& C, int c, int h, GARegs& R) {
    const bf16_t* P = (const bf16_t*)(C.ws + WS_P);
    const int t = C.lane, c8 = C.wave * 8;
    const bf16_t* pr = P + (size_t)(c * 64 + t) * PW;
    R.low = *(const v4u*)(P + (size_t)(c * 64 + (C.tid >> 3)) * PW + C_CA + (C.tid & 3) * 8);
    R.k = *(const v4u*)(pr + C_CK + h * 64 + c8);
    R.v0 = *(const v4u*)(pr + C_CV + h * 128 + c8); R.v1 = *(const v4u*)(pr + C_CV + h * 128 + 64 + c8);
}
DI void gla_a_unit(const Ctx& C0, int c, int h, GARegs& R, const float (&bu)[4], bool has_next, int cn, int hn) {
    Ctx C = C0; { int t_ = C0.tid; asm volatile("" : "+v"(t_)); C.tid = t_; C.lane = t_ & 63; }
    LAS unsigned char* L = C.lds + RING_OFF;
    LAS float* LA0 = (LAS float*)(L + GA_LA0); LAS float* LA1 = (LAS float*)(L + GA_LA1);
    LAS bf16_t* VT = (LAS bf16_t*)(L + GA_VT); LAS bf16_t* KT0 = (LAS bf16_t*)(L + GA_KT0); LAS bf16_t* KT1 = (LAS bf16_t*)(L + GA_KT1);
    unsigned char* rec0 = rec_ptr(C.ws + WS_STC, c, h, 0);
    const int t = C.lane, c8 = C.wave * 8;
    __syncthreads();
    store_vt8(VT, R.v0, c8, t); store_vt8(VT, R.v1, 64 + c8, t);
    const v4u kreg = R.k;
    gla_logdecay(C, R.low, bu, LA0, LA1, (LAS bf16_t*)(L + GA_LOW), (const LAS bf16_t*)(L + GA_WUT0), (const LAS bf16_t*)(L + GA_WUT1));
    asm volatile("" ::: "memory"); __builtin_amdgcn_sched_barrier(0);
    if (has_next) gla_a_load(C, cn, hn, R);
    asm volatile("" ::: "memory"); __builtin_amdgcn_sched_barrier(0);
    {
        float k[8]; unpack8(kreg, k);
        float l0[8], l1[8], t0[8], t1[8];
        { const f32x4 a0 = *(const LAS f32x4*)(LA0 + t * LAP + c8), a1 = *(const LAS f32x4*)(LA0 + t * LAP + c8 + 4), b0 = *(const LAS f32x4*)(LA1 + t * LAP + c8), b1 = *(const LAS f32x4*)(LA1 + t * LAP + c8 + 4);
          const f32x4 e0 = *(const LAS f32x4*)(LA0 + 63 * LAP + c8), e1 = *(const LAS f32x4*)(LA0 + 63 * LAP + c8 + 4), f0 = *(const LAS f32x4*)(LA1 + c8), f1 = *(const LAS f32x4*)(LA1 + c8 + 4);
#pragma unroll
          for (int e = 0; e < 4; ++e) { l0[e] = a0[e]; l0[4 + e] = a1[e]; l1[e] = b0[e]; l1[4 + e] = b1[e]; t0[e] = e0[e]; t0[4 + e] = e1[e]; t1[e] = f0[e]; t1[4 + e] = f1[e]; } }
#pragma unroll
        for (int e = 0; e < 8; ++e) {
            const unsigned pw = pk2(k[e] * __expf(t0[e] - l0[e]), k[e] * __expf(t1[e] - l1[e]));
            KT0[(c8 + e) * LDT + t] = (bf16_t)pw; KT1[(c8 + e) * LDT + t] = (bf16_t)(pw >> 16);
        }
        if (C.tid < 64) ((float*)(rec0 + REC_VEC))[C.tid] = __expf(LA0[63 * LAP + C.tid]);
        else if (C.tid < 128) ((float*)(rec0 + RECB + REC_VEC))[C.tid - 64] = __expf(LA1[C.tid - 64]);
    }
    __syncthreads();
    delta_store<false>(C, (C.wave >> 2) ? KT1 : KT0, VT, rec0 + (C.wave >> 2) * RECB);
}
DI void gla_a_phase(const Ctx& C, int l) {
    LAS unsigned char* L = C.lds + RING_OFF;
    int htab = -1; GARegs R; float bu[4];
    int u = C.bx + (C.G >> 1); if (u >= C.G) u -= C.G;
    if (u < NCHUNK * 4) gla_a_load(C, u >> 2, u & 3, R);
    for (; u < NCHUNK * 4; u += C.G) {
        const int h = u & 3, un = u + C.G;
        if (h != htab) { __syncthreads(); gla_wut_table(C, (LAS bf16_t*)(L + GA_WUT0), (LAS bf16_t*)(L + GA_WUT1), l, h); gla_bias4(bu, C, l, h); htab = h; }
        gla_a_unit(C, u >> 2, h, R, bu, un < NCHUNK * 4, un >> 2, un & 3);
    }
}
DI void gla_c_load(const Ctx& C, int c, int h, GCRegs& R) {
    const bf16_t* P = (const bf16_t*)(C.ws + WS_P);
    const int t = C.lane, c8 = C.wave * 8;
    const bf16_t* pr = P + (size_t)(c * 64 + t) * PW;
    R.low = *(const v4u*)(P + (size_t)(c * 64 + (C.tid >> 3)) * PW + C_CA + (C.tid & 3) * 8);
    R.q = *(const v4u*)(pr + C_CQ + h * 64 + c8); R.k = *(const v4u*)(pr + C_CK + h * 64 + c8);
    R.v0 = *(const v4u*)(pr + C_CV + h * 128 + c8); R.v1 = *(const v4u*)(pr + C_CV + h * 128 + 64 + c8);
    { const bf16_t* po = P + (size_t)(c * 64 + (C.tid >> 3)) * PW + C_CR + h * 128 + (C.tid & 7) * 16; R.og0 = *(const v4u*)po; R.og1 = *(const v4u*)(po + 8); }
}
DI void gla_c_unit(const Ctx& C0, int c, int h, GCRegs& R, const float (&bu)[4], const float (&gain)[16], bool has_next, int cn, int hn) {
    Ctx C = C0; { int t_ = C0.tid; asm volatile("" : "+v"(t_)); C.tid = t_; C.lane = t_ & 63; }
    LAS unsigned char* L = C.lds + RING_OFF;
    LAS bf16_t* QS0 = (LAS bf16_t*)(L + GC_QS0); LAS bf16_t* QS1 = (LAS bf16_t*)(L + GC_QS1); LAS bf16_t* KS0 = (LAS bf16_t*)(L + GC_KS0); LAS bf16_t* KS1 = (LAS bf16_t*)(L + GC_KS1);
    LAS bf16_t* VT = (LAS bf16_t*)(L + GC_VT); LAS bf16_t* CT0 = (LAS bf16_t*)(L + GC_CT0); LAS bf16_t* CT1 = (LAS bf16_t*)(L + GC_CT1);
    LAS bf16_t* SB0 = (LAS bf16_t*)(L + GC_SB0); LAS bf16_t* SB1 = (LAS bf16_t*)(L + GC_SB1);
    LAS float* LA0 = (LAS float*)(L + GC_LA0); LAS float* LA1 = (LAS float*)(L + GC_LA1); LAS float* HS = (LAS float*)(L + GC_HS);
    const int t = C.lane, c8 = C.wave * 8;
    const unsigned char* rec0 = rec_ptr(C.ws + WS_STC, c, h, 0);
    const v4u s1a = *(const v4u*)(rec0 + RECB + C.tid * 16), s1b = *(const v4u*)(rec0 + RECB + 8192 + C.tid * 16);
    __syncthreads();
    store_vt8(VT, R.v0, c8, t); store_vt8(VT, R.v1, 64 + c8, t);
    const v4u s0a = *(const v4u*)(rec0 + C.tid * 16), s0b = *(const v4u*)(rec0 + 8192 + C.tid * 16);
    store_ct16(CT1, s1a, s1b, C.tid);
    gla_logdecay(C, R.low, bu, LA0, LA1, (LAS bf16_t*)(L + GC_LOW), (const LAS bf16_t*)(L + GC_WUT0), (const LAS bf16_t*)(L + GC_WUT1));
    {
        float q[8], k[8], a[8], b[8];
        unpack8(R.q, q); unpack8(R.k, k);
        float lb[8];
        { const f32x4 x0 = *(const LAS f32x4*)(LA0 + t * LAP + c8), x1 = *(const LAS f32x4*)(LA0 + t * LAP + c8 + 4);
#pragma unroll
          for (int e = 0; e < 4; ++e) { lb[e] = x0[e]; lb[4 + e] = x1[e]; } }
#pragma unroll
        for (int e = 0; e < 8; ++e) { const float bb = lb[e]; a[e] = q[e] * 0.125f * __expf(bb); b[e] = k[e] * __expf(-bb); }
        *(LAS v4u*)(QS0 + t * LDT + c8) = pack8f(a, 1.0f); *(LAS v4u*)(KS0 + t * LDT + c8) = pack8f(b, 1.0f);
        { const f32x4 x0 = *(const LAS f32x4*)(LA1 + t * LAP + c8), x1 = *(const LAS f32x4*)(LA1 + t * LAP + c8 + 4);
#pragma unroll
          for (int e = 0; e < 4; ++e) { lb[e] = x0[e]; lb[4 + e] = x1[e]; } }
#pragma unroll
        for (int e = 0; e < 8; ++e) { const float bb = lb[e]; a[e] = q[e] * 0.125f * __expf(bb); b[e] = k[e] * __expf(-bb); }
        *(LAS v4u*)(QS1 + t * LDT + c8) = pack8f(a, 1.0f); *(LAS v4u*)(KS1 + t * LDT + c8) = pack8f(b, 1.0f);
    }
    store_ct16(CT0, s0a, s0b, C.tid);
    const v4u og0 = R.og0, og1 = R.og1;
    asm volatile("" ::: "memory"); __builtin_amdgcn_sched_barrier(0);
    if (has_next) gla_c_load(C, cn, hn, R);
    asm volatile("" ::: "memory"); __builtin_amdgcn_sched_barrier(0);
    __syncthreads();
    {
        const int mt = C.wave & 3, nh = C.wave >> 2, fr = C.lane & 15, fq = C.lane >> 4;
#pragma unroll
        for (int dir = 0; dir < 2; ++dir) {
            f32x4 acc[2]; acc[0] = (f32x4){0.f, 0.f, 0.f, 0.f}; acc[1] = acc[0];
            mma_tile<2, 2>(acc, (dir ? QS1 : QS0) + 16 * mt * LDT, LDT, (dir ? KS1 : KS0) + 32 * nh * LDT, LDT, C.lane);
            LAS bf16_t* SB = dir ? SB1 : SB0;
#pragma unroll
            for (int nt = 0; nt < 2; ++nt)
#pragma unroll
                for (int i = 0; i < 4; ++i) { const int j = 16 * mt + fq * 4 + i, s2 = 32 * nh + nt * 16 + fr; const bool keep = dir ? (s2 >= j) : (s2 <= j); SB[j * LDT + s2] = (bf16_t)f2bf(keep ? acc[nt][i] : 0.f); }
        }
    }
    __syncthreads();
    {
        const int mt = C.wave & 3, vh = C.wave >> 2, fr = C.lane & 15, fq = C.lane >> 4;
        f32x4 acc[4];
#pragma unroll
        for (int nt = 0; nt < 4; ++nt) acc[nt] = (f32x4){0.f, 0.f, 0.f, 0.f};
        mma_tile<4, 2>(acc, QS0 + 16 * mt * LDT, LDT, CT0 + 64 * vh * LDT, LDT, C.lane);
        mma_tile<4, 2>(acc, SB0 + 16 * mt * LDT, LDT, VT + 64 * vh * LDT, LDT, C.lane);
        mma_tile<4, 2>(acc, QS1 + 16 * mt * LDT, LDT, CT1 + 64 * vh * LDT, LDT, C.lane);
        mma_tile<4, 2>(acc, SB1 + 16 * mt * LDT, LDT, VT + 64 * vh * LDT, LDT, C.lane);
#pragma unroll
        for (int i = 0; i < 4; ++i)
#pragma unroll
            for (int nt = 0; nt < 4; ++nt) HS[(16 * mt + fq * 4 + i) * 128 + 64 * vh + nt * 16 + fr] = acc[nt][i];
    }
    __syncthreads();
    head_out<1, 128>(C, HS, og0, og1, c * 64, gain, (bf16_t*)(C.ws + WS_YA) + 1024, h);
}
DI void gla_c_phase(const Ctx& C, int l) {
    LAS unsigned char* L = C.lds + RING_OFF;
    int htab = -1; GCRegs R; float bu[4], gain[16];
    const int NU = (l == DEPTH - 1 ? 512 : NCHUNK) * 4;
    int u = C.bx + (C.G >> 1); if (u >= C.G) u -= C.G;
    if (u < NU) gla_c_load(C, u >> 2, u & 3, R);
    for (; u < NU; u += C.G) {
        const int h = u & 3, un = u + C.G;
        if (h != htab) { __syncthreads(); gla_wut_table(C, (LAS bf16_t*)(L + GC_WUT0), (LAS bf16_t*)(L + GC_WUT1), l, h); gla_bias4(bu, C, l, h); load_gain16(gain, INP(I_CNG) + (size_t)l * 512, h, C.tid); htab = h; }
        gla_c_unit(C, u >> 2, h, R, bu, gain, un < NU, un >> 2, un & 3);
    }
}

DI int chain_chunk(int b, int dir, int n) { return n < 4 ? 512 + 4 * b + (dir ? 3 - n : n) : 64 * b + (dir ? 67 - n : n - 4); }
DI void unpack8s(const v4u x, float (&f)[8]) { unpack8(x, f); }
#ifndef PROBE_SKIP
#define PROBE_SKIP 0
#endif
DI void scan_b_units(const Ctx& C, bool probe = false) {
    for (int u = C.bx; u < 256; u += C.G) {
        const int mixer = u >> 7, item = (u & 127) * 2 + (C.wave >> 2), chain = item >> 2, slab = item & 3;
        const int b = chain >> 3, h = (chain >> 1) & 3, dir = chain & 1, tl = C.tid & 255, elem = slab * 2048 + tl * 8;
        unsigned char* base = C.ws + (probe ? WS_A2 + (size_t)mixer * ((size_t)NCHUNK * 8 * RECB) : (mixer ? WS_STC : WS_STA));
        float zz = 0.f; asm volatile("" : "+v"(zz));
        float st[8];
#pragma unroll
        for (int e = 0; e < 8; ++e) st[e] = zz;
        if (mixer == 0) {
            const bool nthr = (slab == 0 && tl < 64), mthr = (slab == 0 && tl == 0);
            float m = 0.f, nst = 0.f;
            v4u d[8]; float sB[8], sM[8], dn[8];
#define SB_LOAD_M(q, n) do { const unsigned char* r2 = rec_ptr(base, chain_chunk(b, dir, (n)), h, dir); const float* r2f = (const float*)(r2 + REC_VEC); d[q] = *(const v4u*)(r2 + elem * 2); sB[q] = r2f[64]; sM[q] = r2f[65]; dn[q] = nthr ? r2f[tl] : 0.f; } while (0)
#define SB_STEP_M(q, n, PF) do { unsigned char* rec = rec_ptr(base, chain_chunk(b, dir, (n)), h, dir); float* rf = (float*)(rec + REC_VEC); \
                float dd[8]; unpack8(d[q], dd); const float B = sB[q], Ml = sM[q], dnn = dn[q]; \
                if (!(probe && PROBE_SKIP == 7)) { *(v4u*)(rec + elem * 2) = pack8f(st, 1.0f); if (nthr) rf[tl] = nst; if (mthr) rf[66] = m; } \
                if (PF) SB_LOAD_M(q, (n) + 8); \
                const float mn = fmaxf(B + m, Ml), dec = __expf(B + m - mn), sc = __expf(Ml - mn); \
                _Pragma("unroll") for (int e = 0; e < 8; ++e) st[e] = st[e] * dec + dd[e] * sc; \
                nst = nst * dec + dnn * sc; m = mn; } while (0)
#pragma unroll
            for (int q = 0; q < 8; ++q) SB_LOAD_M(q, q);
            for (int n0 = 0; n0 < 56; n0 += 8) {
#pragma unroll
                for (int q = 0; q < 8; ++q) SB_STEP_M(q, n0 + q, true);
            }
#pragma unroll
            for (int q = 0; q < 8; ++q) SB_STEP_M(q, 56 + q, q < 4);
#pragma unroll
            for (int q = 0; q < 4; ++q) SB_STEP_M(q, 64 + q, false);
#undef SB_LOAD_M
#undef SB_STEP_M
        } else {
            v4u d[8]; f32x4 dca[8], dcb[8];
#define SB_LOAD_G(q, n) do { const unsigned char* r2 = rec_ptr(base, chain_chunk(b, dir, (n)), h, dir); const float* r2f = (const float*)(r2 + REC_VEC) + (elem & 63); d[q] = *(const v4u*)(r2 + elem * 2); dca[q] = *(const f32x4*)r2f; dcb[q] = *(const f32x4*)(r2f + 4); } while (0)
#define SB_STEP_G(q, n, PF) do { unsigned char* rec = rec_ptr(base, chain_chunk(b, dir, (n)), h, dir); \
                float dd[8]; unpack8(d[q], dd); const f32x4 da = dca[q], db = dcb[q]; \
                if (!(probe && PROBE_SKIP == 7)) *(v4u*)(rec + elem * 2) = pack8f(st, 1.0f); \
                if (PF) SB_LOAD_G(q, (n) + 8); \
                _Pragma("unroll") for (int e = 0; e < 4; ++e) { st[e] = st[e] * da[e] + dd[e]; st[4 + e] = st[4 + e] * db[e] + dd[4 + e]; } } while (0)
#pragma unroll
            for (int q = 0; q < 8; ++q) SB_LOAD_G(q, q);
            for (int n0 = 0; n0 < 56; n0 += 8) {
#pragma unroll
                for (int q = 0; q < 8; ++q) SB_STEP_G(q, n0 + q, true);
            }
#pragma unroll
            for (int q = 0; q < 8; ++q) SB_STEP_G(q, 56 + q, q < 4);
#pragma unroll
            for (int q = 0; q < 4; ++q) SB_STEP_G(q, 64 + q, false);
#undef SB_LOAD_G
#undef SB_STEP_G
        }
    }
}

constexpr int RH_HT = 0, RH_LD = 1028, RH_PART = 16 * RH_LD * 4, RH_PLD = 33;
constexpr int RL_CNT = 131584;
static_assert(RH_PART + 8 * 16 * RH_PLD * 4 <= RL_CNT && RL_CNT + 3 * 32 * 4 + 2 * 512 * 4 <= RING_BYTES, "router LDS map");
DI void phase_norm2_router(const Ctx& C, int l) {
    const int lane = C.lane, w = C.wave;
    const bf16_t* X = (const bf16_t*)(C.ws + WS_X); unsigned char* H8 = (unsigned char*)(C.ws + WS_H);
    const bf16_t* U = (const bf16_t*)(C.ws + WS_U);
    const float* MOD = (const float*)(C.ws + WS_MOD);
    int* TOKE = (int*)(C.ws + WS_TOKE); int* TOKP = (int*)(C.ws + WS_TOKP); float* TOKW = (float*)(C.ws + WS_TOKW);
    LAS float* HT = (LAS float*)(C.lds + RING_OFF + RH_HT); LAS float* PART = (LAS float*)(C.lds + RING_OFF + RH_PART); LAS int* cnt = (LAS int*)(C.lds + RING_OFF + RL_CNT);
    __syncthreads();
    if (C.tid < 32) cnt[C.tid] = 0;
    float Wreg[2][8][4];
    {
        const float* Wr = INP(I_WR) + (size_t)l * DM * NEXP + (size_t)(128 * w + 4 * (lane >> 4)) * NEXP + (lane & 15);
#pragma unroll
        for (int tl = 0; tl < 2; ++tl)
#pragma unroll
            for (int j = 0; j < 8; ++j)
#pragma unroll
                for (int m = 0; m < 4; ++m) Wreg[tl][j][m] = Wr[(size_t)(16 * j + m) * NEXP + 16 * tl];
    }
    f32x4 gn[4];
#pragma unroll
    for (int j = 0; j < 4; ++j) gn[j] = *(const f32x4*)(INP(I_GN2) + (size_t)l * DM + (lane + 64 * j) * 4);
    const float brl = INP(I_BR)[l * NEXP + (lane & 31)];
    const int ntiles = (l == DEPTH - 1 ? M_LAT : MROWS) / 16;
    v2u xr[2][4], ur[2][4];
    if (C.bx < ntiles) {
#pragma unroll
        for (int q = 0; q < 2; ++q)
#pragma unroll
            for (int j = 0; j < 4; ++j) { const size_t o = (size_t)(C.bx * 16 + 2 * w + q) * DM + (lane + 64 * j) * 4; xr[q][j] = *(const v2u*)(X + o); ur[q][j] = *(const v2u*)(U + o); }
    }
    for (int tile = C.bx; tile < ntiles; tile += C.G) {
        const int r0 = tile * 16 + 2 * w, mi = r0 < M_LAT ? (r0 >> 12) : 8;
        const float* sh = MOD + ((size_t)l * 9 + mi) * 6144 + 3 * DM; const float* sc = sh + DM; const float* g1 = sh - DM;
        f32x4 h[2][4]; float ss[2] = {0.f, 0.f};
#pragma unroll
        for (int q = 0; q < 2; ++q)
#pragma unroll
            for (int j = 0; j < 4; ++j) { const int c = (lane + 64 * j) * 4; const v2u uu = ur[q][j], xx = xr[q][j]; const f32x4 gg = *(const f32x4*)(g1 + c);
                h[q][j] = (f32x4){bf2f(xx.x & 0xffffu), bf2f(xx.x >> 16), bf2f(xx.y & 0xffffu), bf2f(xx.y >> 16)} + gg * (f32x4){bf2f(uu.x & 0xffffu), bf2f(uu.x >> 16), bf2f(uu.y & 0xffffu), bf2f(uu.y >> 16)};
                ss[q] += (h[q][j][0] * h[q][j][0] + h[q][j][1] * h[q][j][1]) + (h[q][j][2] * h[q][j][2] + h[q][j][3] * h[q][j][3]); }
        if (tile + C.G < ntiles) {
#pragma unroll
            for (int q = 0; q < 2; ++q)
#pragma unroll
                for (int j = 0; j < 4; ++j) { const size_t o = (size_t)((tile + C.G) * 16 + 2 * w + q) * DM + (lane + 64 * j) * 4; xr[q][j] = *(const v2u*)(X + o); ur[q][j] = *(const v2u*)(U + o); }
        }
#pragma unroll
        for (int q = 0; q < 2; ++q) {
            const float rstd = __builtin_amdgcn_rsqf(wave_sum(ss[q], lane) * (1.0f / DM) + EPS);
#pragma unroll
            for (int j = 0; j < 4; ++j) {
                const int c = (lane + 64 * j) * 4;
                const f32x4 s1 = *(const f32x4*)(sc + c), s0 = *(const f32x4*)(sh + c);
                const f32x4 hh = h[q][j] * rstd * gn[j] * (s1 + 1.0f) + s0;
                *(unsigned*)(H8 + (size_t)(r0 + q) * DM + c) = pk4_fp8(hh[0] * FP8_SH, hh[1] * FP8_SH, hh[2] * FP8_SH, hh[3] * FP8_SH);
                *(LAS f32x4*)(HT + (2 * w + q) * RH_LD + c) = hh;
            }
        }
        __syncthreads();
        {
            f32x4 acc0 = (f32x4){0.f, 0.f, 0.f, 0.f}, acc1 = acc0;
            const LAS float* ap = HT + (lane & 15) * RH_LD + 128 * w + 4 * (lane >> 4);
#pragma unroll
            for (int j = 0; j < 8; ++j) {
                const f32x4 a = *(const LAS f32x4*)(ap + 16 * j);
#pragma unroll
                for (int m = 0; m < 4; ++m) { acc0 = __builtin_amdgcn_mfma_f32_16x16x4f32(a[m], Wreg[0][j][m], acc0, 0, 0, 0); acc1 = __builtin_amdgcn_mfma_f32_16x16x4f32(a[m], Wreg[1][j][m], acc1, 0, 0, 0); }
            }
            LAS float* pp = PART + (w * 16 + 4 * (lane >> 4)) * RH_PLD + (lane & 15);
#pragma unroll
            for (int i = 0; i < 4; ++i) { pp[i * RH_PLD] = acc0[i]; pp[i * RH_PLD + 16] = acc1[i]; }
        }
        __syncthreads();
        {
            const int rowl = 2 * w + (lane >> 5), mye = lane & 31, myrow = tile * 16 + rowl;
            float my = brl;
#pragma unroll
            for (int ww = 0; ww < 8; ++ww) my += PART[(ww * 16 + rowl) * RH_PLD + mye];
            float tv[4]; int ti[4];
            {
                const bool hi2 = lane >= 32; int rank = 0;
#pragma unroll
                for (int j = 0; j < 32; ++j) {
                    const float oa = __int_as_float(__builtin_amdgcn_readlane(__float_as_int(my), j)), ob = __int_as_float(__builtin_amdgcn_readlane(__float_as_int(my), 32 + j));
                    const float o = hi2 ? ob : oa;
                    rank += (o > my || (o == my && j < mye)) ? 1 : 0;
                }
#pragma unroll
                for (int k = 0; k < 4; ++k) {
                    const unsigned long long bal = __ballot(rank == k);
                    const int ia = __builtin_ctz((unsigned)bal), ib = __builtin_ctz((unsigned)(bal >> 32));
                    const float va = __int_as_float(__builtin_amdgcn_readlane(__float_as_int(my), ia)), vb = __int_as_float(__builtin_amdgcn_readlane(__float_as_int(my), 32 + ib));
                    tv[k] = hi2 ? vb : va; ti[k] = hi2 ? ib : ia;
                }
            }
            const float e1 = __expf(tv[1] - tv[0]), e2 = __expf(tv[2] - tv[0]), e3 = __expf(tv[3] - tv[0]);
            const float inv = __builtin_amdgcn_rcpf(((1.0f + e1) + e2) + e3);
            if (mye < 4) {
                const int ek = mye == 0 ? ti[0] : mye == 1 ? ti[1] : mye == 2 ? ti[2] : ti[3];
                const float wk = (mye == 0 ? 1.0f : mye == 1 ? e1 : mye == 2 ? e2 : e3) * inv;
                const int pos = atomicAdd((int*)(cnt + ek), 1);
                const size_t o = (size_t)myrow * 4 + mye;
                TOKE[o] = ek; TOKP[o] = pos; TOKW[o] = wk;
            }
        }
    }
    __syncthreads();
    if (C.tid < 32) ((int*)(C.ws + WS_BLKCNT))[C.bx * 32 + C.tid] = cnt[C.tid];
}

DI void phase_gather(const Ctx& C, int l) {
    const int lane = C.lane;
    const unsigned char* H8 = (const unsigned char*)(C.ws + WS_H); unsigned char* XG = (unsigned char*)(C.ws + WS_XG);
    const int* TOKE = (const int*)(C.ws + WS_TOKE); int* TOKP = (int*)(C.ws + WS_TOKP); const float* TOKW = (const float*)(C.ws + WS_TOKW);
    float* SLOTW = (float*)(C.ws + WS_SLOTW); int* META = (int*)(C.ws + WS_MOEMETA);
    const int* BLKCNT = (const int*)(C.ws + WS_BLKCNT);
    LAS int* base = (LAS int*)(C.lds + RING_OFF + RL_CNT + 128); LAS int* tot = (LAS int*)(C.lds + RING_OFF + RL_CNT + 256);
    __syncthreads();
    {
        LAS int* pt = (LAS int*)(C.lds + RING_OFF + RL_CNT + 384); LAS int* pp = pt + 512;
        const int e = C.tid & 31, cq = C.tid >> 5;
        int t = 0, pre = 0;
#pragma unroll 16
        for (int b = cq; b < C.G; b += 16) { const int c = BLKCNT[b * 32 + e]; pre += (b < C.bx) ? c : 0; t += c; }
        pt[cq * 32 + e] = t; pp[cq * 32 + e] = pre;
        __syncthreads();
        if (C.tid < 32) { int ts = 0, ps = 0;
#pragma unroll
            for (int q = 0; q < 16; ++q) { ts += pt[q * 32 + C.tid]; ps += pp[q * 32 + C.tid]; }
            tot[C.tid] = ts; base[C.tid] = ps; }
    }
    __syncthreads();
    LAS int* toff = (LAS int*)(C.lds + RING_OFF + RL_CNT + 384);
    if (C.tid == 0) {
        int off = 0;
#pragma unroll 1
        for (int e = 0; e < NEXP; ++e) { const int padded = (tot[e] + 255) & ~255; base[e] += off; toff[e] = off >> 8; off += padded; }
        toff[NEXP] = off >> 8;
        if (C.bx == 0) META[0] = off >> 8;
    }
    __syncthreads();
    if (C.bx == 0) {
        const int nt = toff[NEXP];
        for (int t = C.tid; t < nt; t += 512) { int e = 0;
#pragma unroll
            for (int q = 1; q < NEXP; ++q) e += (t >= toff[q]) ? 1 : 0;
            META[16 + t] = e; }
    }
    const int ntiles = (l == DEPTH - 1 ? M_LAT : MROWS) / 16;
    int4 e4[2], p4[2]; f32x4 w4[2]; v4u a[2];
    if (C.bx < ntiles) {
#pragma unroll
        for (int q = 0; q < 2; ++q) { const int r = C.bx * 16 + 2 * C.wave + q;
            e4[q] = *(const int4*)(TOKE + (size_t)r * 4); p4[q] = *(const int4*)(TOKP + (size_t)r * 4); w4[q] = *(const f32x4*)(TOKW + (size_t)r * 4); a[q] = *(const v4u*)(H8 + (size_t)r * DM + lane * 16); }
    }
    for (int tile = C.bx; tile < ntiles; tile += C.G) {
        int4 ce[2], cp[2]; f32x4 cw[2]; v4u ca[2];
#pragma unroll
        for (int q = 0; q < 2; ++q) { ce[q] = e4[q]; cp[q] = p4[q]; cw[q] = w4[q]; ca[q] = a[q]; }
        if (tile + C.G < ntiles) {
#pragma unroll
            for (int q = 0; q < 2; ++q) { const int r = (tile + C.G) * 16 + 2 * C.wave + q;
                e4[q] = *(const int4*)(TOKE + (size_t)r * 4); p4[q] = *(const int4*)(TOKP + (size_t)r * 4); w4[q] = *(const f32x4*)(TOKW + (size_t)r * 4); a[q] = *(const v4u*)(H8 + (size_t)r * DM + lane * 16); }
        }
#pragma unroll
        for (int q = 0; q < 2; ++q) {
            const int r = tile * 16 + 2 * C.wave + q;
            const int s0 = base[ce[q].x] + cp[q].x, s1 = base[ce[q].y] + cp[q].y, s2 = base[ce[q].z] + cp[q].z, s3 = base[ce[q].w] + cp[q].w;
            *(v4u*)(XG + (size_t)s0 * DM + lane * 16) = ca[q]; *(v4u*)(XG + (size_t)s1 * DM + lane * 16) = ca[q]; *(v4u*)(XG + (size_t)s2 * DM + lane * 16) = ca[q]; *(v4u*)(XG + (size_t)s3 * DM + lane * 16) = ca[q];
            if (lane == 0) { *(int4*)(TOKP + (size_t)r * 4) = make_int4(s0, s1, s2, s3); SLOTW[s0] = cw[q][0]; SLOTW[s1] = cw[q][1]; SLOTW[s2] = cw[q][2]; SLOTW[s3] = cw[q][3]; }
        }
    }
}

DI void phase_attention(const Ctx& C, char* lds_generic, bool with_ctx) {
    typedef attn_body::bf16 abf;
    const abf* QR = (const abf*)(C.ws + WS_QR); const abf* KR = (const abf*)(C.ws + WS_KR); const abf* VR = (const abf*)(C.ws + WS_VR); abf* YB = (abf*)(C.ws + WS_YA) + 512;
    const int vcu = (C.G % 8 == 0) ? (C.bx % 8) * (C.G / 8) + C.bx / 8 : C.bx;
    const int per = (1024 + C.G - 1) / C.G;
    for (int i = 0; i < per; ++i) {
        const int idx = vcu * per + i; if (idx >= 1024) break;
        const int grp = idx >> 6, b = grp >> 1, kvh = grp & 1, hq = kvh * 4 + ((idx >> 4) & 3), qb = idx & 15;
        attn_body::attn_unit<8>((long)b * SEQ + qb * 256, hq, KVLEN / 64, QR, KR + (size_t)b * KVLEN * 128 + kvh * 64, VR + (size_t)b * KVLEN * 128 + kvh * 64, YB, lds_generic, C.wave);
    }
    for (int idx = C.bx; with_ctx && idx < 64; idx += C.G) {
        const int b = idx >> 3, hq = idx & 7;
        attn_body::attn_unit<8>((long)M_LAT + b * CTXL, hq, CTXL / 64, QR, KR + (size_t)b * KVLEN * 128 + (hq >> 2) * 64, VR + (size_t)b * KVLEN * 128 + (hq >> 2) * 64, YB, lds_generic, C.wave);
    }
}

constexpr int CW_CNT_FG = 16384;
struct ListOrder {
    int c, G, mode; bool ctx; unsigned* cnt;
    __device__ __forceinline__ bool next(int i, pg8::Unit& u) const {
        u.e = 0;
        const int npan = ctx ? 136 : 128;
        if (G != 256) { const int g = c + i * G; if (g >= npan * 4) return false; u.pm = g >> 2; u.pn = g & 3; return true; }
        const int x = c & 7, r = c >> 3;
        if (mode == 0 || !ctx) {
            if (i < 2) { u.pm = 64 * i + x * 8 + (r >> 2); u.pn = r & 3; return true; }
            if (mode == 0 && ctx && i == 2 && c < 32) { u.pm = 128 + x; u.pn = r; return true; }
            return false;
        }
        if (i == 0) { u.pm = x * 8 + (r >> 2); u.pn = r & 3; return true; }
        if (c < 32) return false;
        if (i == 1) { const int r1 = (c - 32) >> 3; u.pm = 64 + x * 7 + (r1 >> 2); u.pn = r1 & 3; return true; }
        if (i == 2 && c < 64) { u.pm = 120 + x; u.pn = (c - 32) >> 3; return true; }
        if (i == 2 && c < 96) { u.pm = 128 + x; u.pn = (c - 64) >> 3; return true; }
        return false;
    }
    __device__ __forceinline__ void a_ready(const pg8::Unit& u) const {
        if (mode == 0) return;
        unsigned* p = cnt + u.pm; unsigned sp = 0u;
        while (xb_ld(p) < 32u) { __builtin_amdgcn_s_sleep(2); if (++sp > (1u << 22)) break; }
        asm volatile("s_waitcnt vmcnt(0)" ::: "memory");
    }
    __device__ __forceinline__ void done(const pg8::Unit& u) const {
        if (mode != 0) return;
        asm volatile("s_waitcnt vmcnt(0)" ::: "memory");
        unsigned m_ = ~0u; asm volatile("" : "+s"(m_));
        if (__builtin_amdgcn_mbcnt_hi(m_, __builtin_amdgcn_mbcnt_lo(m_, 0u)) == 0u) (void)xb_add(cnt + u.pm, 1u);
    }
};

constexpr int NPH = 11;
constexpr int N_PHASES = 1 + DEPTH * NPH + 1;
struct KArgs { const float* in[N_IN]; float* out; unsigned char* ws; int ph_lo, ph_hi; };
static_assert(sizeof(KArgs) == N_IN * 8 + 8 + 8 + 8, "no padding bytes in the argument struct");

__global__ void __launch_bounds__(512, 2) mk_fwd(KArgs args) {
    extern __shared__ __attribute__((aligned(16))) unsigned char lds[];
    Ctx C;
    C.lds = (LAS unsigned char*)lds; C.ws = args.ws; C.in = args.in; C.out = args.out;
    C.tid = threadIdx.x; C.lane = C.tid & 63; C.wave = __builtin_amdgcn_readfirstlane(C.tid >> 6); C.G = gridDim.x; C.bx = blockIdx.x;
    for (int u = C.tid; u < (LDS_BYTES - LDSCTL_OFF) / 4; u += 512) ((LAS unsigned*)(C.lds + LDSCTL_OFF))[u] = 0u;
    __syncthreads();
    if ((unsigned)(uintptr_t)C.lds != 0u) __builtin_trap();
    if (C.tid == 0) { LAS unsigned* pw = (LAS unsigned*)(C.lds + MISC_OFF + 64); pw[0] = (unsigned)(uintptr_t)args.ws; pw[1] = (unsigned)((uintptr_t)args.ws >> 32); pw[2] = (unsigned)(uintptr_t)args.out; pw[3] = (unsigned)((uintptr_t)args.out >> 32); }
    __syncthreads();
#if MK_ONE_LAUNCH
    constexpr int lo = 0, hi = N_PHASES;
#else
    const int lo = args.ph_lo, hi = args.ph_hi;
#endif
    gu32* ctl = (gu32*)(C.ws + WS_CTL);
    XcdBarrier bar; bar.bar = (unsigned*)ctl + CW_BAR; bar.x = 0; bar.st = (volatile LAS unsigned*)(C.lds + MISC_OFF) + 8;
    if (hi - lo > 1) bar = xcd_barrier_post((unsigned*)ctl + CW_BAR, (volatile LAS unsigned*)(C.lds + MISC_OFF) + 8);
    bar.x = (unsigned)__builtin_amdgcn_readfirstlane((int)bar.x);
#define IN(k) (lo <= (k) && (k) < hi)
#ifndef PH_MASK
#define PH_MASK 0x1fff
#endif
#define ENAB(k) (((PH_MASK) >> (k)) & 1)
#ifndef DUP_MASK
#define DUP_MASK 0
#endif
#ifndef PROBE_SKIP
#define PROBE_SKIP 0
#endif
#define REPS(k) _Pragma("unroll 1") for (int rep_ = 0; rep_ < 1 + (((DUP_MASK) >> (k)) & 1); ++rep_)
#define SEAM(k) do { if (IN(k) && IN((k) + 1)) { XcdBarrier b2_ = bar; asm volatile("" : "+s"(b2_.x)); xcd_barrier(b2_); if ((DUP_MASK) & 0x2000) xcd_barrier(b2_); } } while (0)
    PG8_LAS unsigned char* glds = (PG8_LAS unsigned char*)(C.lds + RING_OFF);

    if (ENAB(0) && IN(0)) REPS(0) p0_prologue(launder(C));
    SEAM(0);
    for (int l = 0; l < DEPTH; ++l) {
        const int p = 1 + l * NPH;
        if (ENAB(1) && IN(p + 0)) REPS(1) phase_norm1(launder(C), l, rep_ ? 0.0f : 1.0f);
        SEAM(p + 0);
        if (ENAB(2) && IN(p + 1)) REPS(2) {
            const Ctx Cg = launder(C); unsigned char* const ws = Cg.ws;
            pg8::Gemm g{(const bf16_t*)(ws + WS_H), (const bf16_t*)(ws + WS_WTIN + (size_t)l * PW * DM), MROWS, PW, DM / 2, 0};
            pg8::StaticOrder S; S.init(MROWS, PW, C.G, C.bx);
            pg8::EpiStoreBf16 E{(bf16_t*)(ws + WS_P), PW, C_GATE, 1.0f / (FP8_SH * FP8_SW), rep_ ? PROBE_SKIP : 0};
#ifdef STAGGER_US
            { const unsigned long long t0_ = __builtin_amdgcn_s_memrealtime(), dl_ = (unsigned long long)(((C.bx >> 3) & 3) * STAGGER_US * 25);
              while (__builtin_amdgcn_s_memrealtime() - t0_ < dl_) __builtin_amdgcn_s_sleep(8); }
#endif
            pg8::gemm_phase<pg8::EpiStoreBf16, pg8::StaticOrder, true, true, true>(glds, g, S, E, C.wave);
        }
        SEAM(p + 1);
        if (ENAB(3) && IN(p + 2)) REPS(3) {
            if (!(rep_ && ((DUP_MASK) & 0x200000))) phase_attn_prep(launder(C), l);
            if (!(rep_ && ((DUP_MASK) & 0x400000))) mlstm_a_phase(launder(C), l);
            if (!(rep_ && ((DUP_MASK) & 0x800000))) gla_a_phase(launder(C), l);
        }
        SEAM(p + 2);
        if (ENAB(4) && IN(p + 3)) {
            scan_b_units(launder(C));
            if ((DUP_MASK) & 0x10000) { __syncthreads(); scan_b_units(launder(C), true); }
            __syncthreads();
            REPS(4) phase_attention(launder(C), (char*)lds + RING_OFF, l < DEPTH - 1);
        }
        SEAM(p + 3);
        if (ENAB(5) && IN(p + 4)) REPS(5) {
            if (!(rep_ && ((DUP_MASK) & 0x100000))) mlstm_c_phase(launder(C), l);
            if (!(rep_ && ((DUP_MASK) & 0x80000))) gla_c_phase(launder(C), l);
        }
        SEAM(p + 4);
        if (ENAB(6) && IN(p + 5)) {
            const Ctx Cg = launder(C); unsigned char* const ws = Cg.ws;
            const bool wctx = (l != DEPTH - 1);
            const int Meff = wctx ? MROWS : M_LAT;
            unsigned* const cnt = (unsigned*)(ws + WS_CTL) + CW_CNT_FG + l * 256;
            {
                pg8::Gemm g{(const bf16_t*)(ws + WS_YA), (const bf16_t*)(ws + WS_WTBR) + (size_t)l * DM * 1536, Meff, DM, 1536, 0};
                ListOrder S{C.bx, C.G, 0, wctx, cnt};
                pg8::EpiBranch E{(bf16_t*)(ws + WS_MRG), (const unsigned char*)(ws + WS_P) + 2 * C_GATE, PW * 2};
                pg8::gemm_phase<pg8::EpiBranch, ListOrder, true, true>(glds, g, S, E, C.wave);
            }
            {
                pg8::Gemm g{(const bf16_t*)(ws + WS_MRG), (const bf16_t*)(ws + WS_WTOUT) + (size_t)l * DM * DM, Meff, DM, DM, 0};
                ListOrder S{C.bx, C.G, 1, wctx, cnt};
                pg8::EpiResid E{(bf16_t*)(ws + WS_U), 0};
                pg8::gemm_phase<pg8::EpiResid, ListOrder, true, true>(glds, g, S, E, C.wave);
            }
        }
        SEAM(p + 6);
        if ((DUP_MASK) & 0x20000) {
            const Ctx Cg = launder(C); v4u* q = (v4u*)(Cg.ws + WS_P) + (size_t)C.bx * 131072 + Cg.tid; const v4u val = {1u, 2u, 3u, (unsigned)l};
#pragma unroll 4
            for (int i = 0; i < 256; ++i) q[i * 512] = val;
        }
        if ((DUP_MASK) & 0x40000) {
            const Ctx Cg = launder(C); const v4u* q = (const v4u*)(Cg.ws + WS_P) + (size_t)C.bx * 131072 + Cg.tid; v4u a = {0u, 0u, 0u, 0u};
#pragma unroll 16
            for (int i = 0; i < 256; ++i) { const v4u t = q[i * 512]; a.x ^= t.x; a.y ^= t.y; a.z ^= t.z; a.w ^= t.w; }
            if ((a.x ^ a.y ^ a.z ^ a.w) == 0x12345u) ((unsigned*)(Cg.ws + WS_P))[Cg.tid] = a.x;
        }
        if (ENAB(8) && IN(p + 7)) REPS(8) phase_norm2_router(launder(C), l);
        SEAM(p + 7);
        if (ENAB(9) && IN(p + 8)) REPS(9) phase_gather(launder(C), l);
        SEAM(p + 8);
        if (ENAB(10) && IN(p + 9)) REPS(10) {
            const Ctx Cg = launder(C); unsigned char* const ws = Cg.ws; const int* const META = (const int*)(ws + WS_MOEMETA);
            const int nM = __builtin_amdgcn_readfirstlane(META[0]);
            pg8::Gemm g{(const bf16_t*)(ws + WS_XG), (const bf16_t*)(ws + WS_WTE1 + (size_t)l * NEXP * 2048 * DM), nM * 256, 2048, DM / 2, (size_t)2048 * DM};
            pg8::StaticOrder S; S.init(nM * 256, 2048, C.G, C.bx, META + 16);
            pg8::EpiSwiglu E{(unsigned char*)(ws + WS_A2), INP(I_BE1) + (size_t)l * NEXP * 2048, 1.0f / (FP8_SH * FP8_SW), FP8_SA, rep_ ? PROBE_SKIP : 0};
            pg8::gemm_phase<pg8::EpiSwiglu, pg8::StaticOrder, true, true, true>(glds, g, S, E, C.wave);
        }
        SEAM(p + 9);
        if (ENAB(11) && IN(p + 10)) REPS(11) {
            const Ctx Cg = launder(C); unsigned char* const ws = Cg.ws; const int* const META = (const int*)(ws + WS_MOEMETA);
            const int nM = __builtin_amdgcn_readfirstlane(META[0]);
            pg8::Gemm g{(const bf16_t*)(ws + WS_A2), (const bf16_t*)(ws + WS_WTE2 + (size_t)l * NEXP * DM * DFF), nM * 256, DM, DFF / 2, (size_t)DM * DFF};
            pg8::StaticOrder S; S.init(nM * 256, DM, C.G, C.bx, META + 16);
            pg8::EpiMoeOut E{(bf16_t*)(ws + WS_YS), 1.0f / (FP8_SA * FP8_SW), rep_ ? PROBE_SKIP : 0};
            pg8::gemm_phase<pg8::EpiMoeOut, pg8::StaticOrder, true, true, true>(glds, g, S, E, C.wave);
        }
        SEAM(p + 10);
    }
    if (ENAB(12) && IN(1 + DEPTH * NPH)) phase_norm1(launder(C), DEPTH, 1.0f);
#undef IN
#undef SEAM
}

extern "C" void kernel_launch(void* const* d_in, const int* in_sizes, int n_in, void* d_out, int out_size, void* d_ws, size_t ws_size, hipStream_t stream) {
    static int grid = 0;
    if (grid == 0) {
        if (n_in != N_IN || out_size != M_LAT * DM || ws_size < WS_END) { fprintf(stderr, "kernel_launch: unexpected shapes: n_in %d out %d ws %zu (need %zu); nothing launched\n", n_in, out_size, ws_size, (size_t)WS_END); grid = -1; return; }
        int dev = 0, cus = 0, per_cu = 0;
        if (hipGetDevice(&dev) != hipSuccess || hipDeviceGetAttribute(&cus, hipDeviceAttributeMultiprocessorCount, dev) != hipSuccess) { grid = -1; return; }
        if (hipFuncSetAttribute((const void*)mk_fwd, hipFuncAttributeMaxDynamicSharedMemorySize, LDS_BYTES) != hipSuccess) { fprintf(stderr, "kernel_launch: hipFuncSetAttribute failed\n"); grid = -1; return; }
        if (hipOccupancyMaxActiveBlocksPerMultiprocessor(&per_cu, (const void*)mk_fwd, 512, LDS_BYTES) != hipSuccess || per_cu < 1) fprintf(stderr, "kernel_launch: note: occupancy query reports %d\n", per_cu);
        (void)hipGetLastError();
        grid = cus;
    }
    if (grid < 0) return;
    (void)in_sizes;
    if (hipMemsetAsync((char*)d_ws + WS_CTL, 0, CTL_ZERO_BYTES, stream) != hipSuccess) return;
    KArgs a{};
    for (int i = 0; i < N_IN; ++i) a.in[i] = (const float*)d_in[i];
    a.out = (float*)d_out; a.ws = (unsigned char*)d_ws;
#if MK_ONE_LAUNCH
    a.ph_lo = 0; a.ph_hi = N_PHASES;
    hipLaunchKernelGGL(mk_fwd, dim3(grid), dim3(512), LDS_BYTES, stream, a);
#else
    for (int p = 0; p < N_PHASES; ++p) { a.ph_lo = p; a.ph_hi = p + 1; hipLaunchKernelGGL(mk_fwd, dim3(grid), dim3(512), LDS_BYTES, stream, a); }
#endif
}
```

```cpp
#include <hip/hip_runtime.h>
#include <hip/hip_bf16.h>
#include <cstdio>
#include <cstdint>

#ifndef MK_ONE_LAUNCH
#define MK_ONE_LAUNCH 1
#endif

#define DI __device__ __forceinline__
#define GAS __attribute__((address_space(1)))
#define LAS __attribute__((address_space(3)))

constexpr int DM = 1024, NBATCH = 8, SEQ = 4096, DEPTH = 4, CTXL = 256;
constexpr int M_LAT = NBATCH * SEQ, M_CTX = NBATCH * CTXL, MROWS = M_LAT + M_CTX;
constexpr int IN_W = 6960, PW = 7168;
constexpr int NCHUNK = MROWS / 64;
constexpr int KVLEN = CTXL + SEQ;
constexpr int NEXP = 32, TOPK = 4, DFF = 1024;
constexpr int MOE_ROWS_MAX = MROWS * TOPK + NEXP * 256;
constexpr float EPS = 1e-6f;
constexpr int C_AQK = 0, C_AV = 512, C_AI = 1024, C_AF = 1032, C_AO = 1040, C_BQ = 1552, C_BK = 2064, C_BV = 2192, C_CQ = 2320, C_CK = 2576, C_CV = 2832, C_CA = 3344, C_CR = 3376, C_GATE = 3888;
static_assert(C_GATE + 3 * DM == IN_W, "split");
enum { I_X = 0, I_C, I_CTX, I_CCTX, I_WADA, I_BADA, I_GN1, I_WIN, I_ACW, I_ACB, I_AGB, I_ANG, I_BQG, I_BKG, I_CWUP, I_CBUP, I_CNG, I_WBR, I_WOUT, I_GN2, I_WR, I_BR, I_WE1, I_BE1, I_WE2, I_BE2, I_GF, N_IN };

constexpr size_t al256(size_t x) { return (x + 255) & ~(size_t)255; }
constexpr size_t WS_CTL = 0, CTL_ZERO_BYTES = 1u << 20;
constexpr size_t WS_MOD = WS_CTL + CTL_ZERO_BYTES;
constexpr size_t WS_BLKCNT = WS_MOD + al256((size_t)DEPTH * 9 * 6 * DM * 4);
constexpr size_t WS_MOEMETA = WS_BLKCNT + al256(1024 * 32 * 4);
constexpr size_t WS_TOKE = WS_MOEMETA + 4096;
constexpr size_t WS_TOKP = WS_TOKE + (size_t)MROWS * 16;
constexpr size_t WS_TOKW = WS_TOKP + (size_t)MROWS * 16;
constexpr size_t WS_SLOTW = WS_TOKW + (size_t)MROWS * 16;
constexpr size_t WS_WTIN = WS_SLOTW + al256((size_t)MOE_ROWS_MAX * 4);
constexpr size_t WS_WTBR = WS_WTIN + (size_t)DEPTH * PW * DM * 2;
constexpr size_t WS_WTOUT = WS_WTBR + (size_t)DEPTH * 3 * DM * 512 * 2;
constexpr size_t WS_WTE1 = WS_WTOUT + (size_t)DEPTH * DM * DM * 2;
constexpr size_t WS_WTE2 = WS_WTE1 + (size_t)DEPTH * NEXP * 2 * DFF * DM * 2;
constexpr size_t WS_X = WS_WTE2 + (size_t)DEPTH * NEXP * DM * DFF * 2;
constexpr size_t WS_H = WS_X + (size_t)MROWS * DM * 4;
constexpr size_t WS_P = WS_H + (size_t)MROWS * DM * 2;
constexpr size_t WS_QR = WS_P + (size_t)MROWS * PW * 2;
constexpr size_t WS_KR = WS_QR + (size_t)MROWS * 512 * 2;
constexpr size_t WS_VR = WS_KR + (size_t)NBATCH * KVLEN * 128 * 2;
constexpr size_t WS_YA = WS_VR + (size_t)NBATCH * KVLEN * 128 * 2;
constexpr size_t WS_YB = WS_YA + (size_t)MROWS * 512 * 2;
constexpr size_t WS_YC = WS_YB + (size_t)MROWS * 512 * 2;
constexpr size_t WS_MRG = WS_YC + (size_t)MROWS * 512 * 2;
constexpr int RECB = 16896, REC_VEC = 16384;
constexpr size_t WS_STA = WS_MRG + (size_t)MROWS * DM * 2;
constexpr size_t WS_STC = WS_STA + (size_t)NCHUNK * 8 * RECB;
constexpr size_t WS_XG = WS_STC + (size_t)NCHUNK * 8 * RECB;
constexpr size_t WS_A2 = WS_XG + (size_t)MOE_ROWS_MAX * DM * 2;
constexpr size_t WS_YS = WS_A2 + (size_t)MOE_ROWS_MAX * DFF * 2;
constexpr size_t WS_U = WS_YS + (size_t)MOE_ROWS_MAX * DM * 2;
constexpr size_t WS_END = WS_U + (size_t)MROWS * DM * 2;
constexpr int CW_BAR = 4096;

constexpr int RING_OFF = 0, RING_BYTES = 155648;
constexpr int LDSCTL_OFF = RING_BYTES, MISC_OFF = LDSCTL_OFF + 320;
constexpr int LDS_BYTES = 156672;

typedef unsigned short bf16_t;
typedef unsigned v4u __attribute__((ext_vector_type(4)));
typedef unsigned v2u __attribute__((ext_vector_type(2)));
typedef float f32x4 __attribute__((ext_vector_type(4)));
typedef short bf16x8 __attribute__((ext_vector_type(8)));

DI float bf2f(unsigned h) { return __uint_as_float(h << 16); }
typedef float f32x2_h __attribute__((ext_vector_type(2))); typedef __bf16 bf16x2_h __attribute__((ext_vector_type(2)));
DI unsigned pk2(float lo, float hi) { const f32x2_h v = {lo, hi}; return __builtin_bit_cast(unsigned, __builtin_convertvector(v, bf16x2_h)); }
DI unsigned f2bf(float f) { return pk2(f, f) & 0xffffu; }
DI void unpack8(const v4u v, float (&o)[8]) { o[0] = bf2f(v.x & 0xffffu); o[1] = bf2f(v.x >> 16); o[2] = bf2f(v.y & 0xffffu); o[3] = bf2f(v.y >> 16); o[4] = bf2f(v.z & 0xffffu); o[5] = bf2f(v.z >> 16); o[6] = bf2f(v.w & 0xffffu); o[7] = bf2f(v.w >> 16); }
constexpr float FP8_SH = 8.0f, FP8_SW = 512.0f, FP8_SA = 4.0f, FP8_SY = 8.0f, FP8_SU = 4.0f;
DI float clamp448(float x) { return fminf(fmaxf(x, -448.0f), 448.0f); }
DI unsigned pk4_fp8(float a, float b, float c, float d) { unsigned w = __float_as_uint(a);   w = __builtin_amdgcn_cvt_pk_fp8_f32(clamp448(a), clamp448(b), w, false); w = __builtin_amdgcn_cvt_pk_fp8_f32(clamp448(c), clamp448(d), w, true); return w; }
DI f32x4 unpack4_fp8(unsigned w, float sc) { const auto lo = __builtin_amdgcn_cvt_pk_f32_fp8((int)w, false), hi = __builtin_amdgcn_cvt_pk_f32_fp8((int)w, true); return (f32x4){lo[0], lo[1], hi[0], hi[1]} * sc; }
DI float sigmoid_f(float x) { return __builtin_amdgcn_rcpf(1.f + __expf(-x)); }
DI float silu_f(float x) { return x * sigmoid_f(x); }
DI float logsigmoid_f(float x) { return fminf(x, 0.f) - __logf(1.f + __expf(-fabsf(x))); }
namespace pg8 {
#define PG8_LAS __attribute__((address_space(3)))
typedef unsigned short bf16_t;
typedef short bf16x8 __attribute__((ext_vector_type(8)));
typedef float f32x4 __attribute__((ext_vector_type(4)));
typedef unsigned u32x4 __attribute__((ext_vector_type(4)));
typedef int v4i_t __attribute__((ext_vector_type(4)));
typedef unsigned u32x2 __attribute__((ext_vector_type(2)));
constexpr int BM = 256, BK = 64, HALF = 128, HTB = HALF * BK * 2  , STAGE_BYTES = 8 * HTB, NXCD = 8, WGM = 8;

__host__ __device__ __forceinline__ int lds_byte(int r, int c) { const int st = (r >> 4) * 2 + (c >> 5), rr = r & 15, cc = c & 31, ob = rr * 64 + cc * 2; return st * 1024 + (ob ^ (((ob >> 9) & 1) << 5)); }
__host__ __device__ __forceinline__ void stage_rc(int b, int& R, int& C) { const int st = b / 1024, sb = b % 1024, swz = sb ^ (((sb >> 9) & 1) << 5); R = (st >> 1) * 16 + swz / 64; C = (st & 1) * 32 + (swz % 64) / 2; }
__host__ __device__ __forceinline__ int perm32(int rho) { const int n = rho >> 4, i = rho & 15; return 8 * (i >> 2) + 4 * n + (i & 3); }

struct Unit { int pm, pn, e; };
struct Gemm { const bf16_t* A; const bf16_t* Bt; int M, N, K; size_t bstride; };

struct StaticOrder {
    int nM, nN, nwg, G, c; const int* tile_e;
    __host__ __device__ void init(int M, int N, int G_, int c_, const int* te = nullptr) { nM = M / BM; nN = N / BM; nwg = nM * nN; G = G_; c = c_; tile_e = te; }
    __device__ __forceinline__ bool next(int i, Unit& u) const {
        const long L = (long)i * G + c; if (L >= nwg) return false;
        int wgid = (int)L; { const int q = nwg / NXCD, r = nwg % NXCD, xcd = wgid % NXCD, off = wgid / NXCD; wgid = (xcd < r ? xcd * (q + 1) : r * (q + 1) + (xcd - r) * q) + off; }
        const int nig = WGM * nN, gid = wgid / nig, fm = gid * WGM, gsz = (nM - fm) < WGM ? (nM - fm) : WGM;
        u.pm = fm + ((wgid % nig) % gsz); u.pn = (wgid % nig) / gsz; u.e = tile_e ? __builtin_amdgcn_readfirstlane(tile_e[u.pm]) : 0; return true;
    }
    __device__ __forceinline__ void a_ready(const Unit&) const {}
    __device__ __forceinline__ void done(const Unit&) const {}
};

__device__ __forceinline__ unsigned cvt_pk_bf16(float lo, float hi) { unsigned r; asm volatile("v_cvt_pk_bf16_f32 %0, %1, %2" : "=v"(r) : "v"(lo), "v"(hi)); return r; }
__device__ __forceinline__ u32x4 pack8(const f32x4 a, const f32x4 b) { u32x4 w; w.x = cvt_pk_bf16(a[0], a[1]); w.y = cvt_pk_bf16(a[2], a[3]); w.z = cvt_pk_bf16(b[0], b[1]); w.w = cvt_pk_bf16(b[2], b[3]); return w; }
__device__ __forceinline__ float bfl(unsigned v) { return __uint_as_float(v << 16); }
__device__ __forceinline__ float bfh(unsigned v) { return __uint_as_float(v & 0xffff0000u); }
__device__ __forceinline__ float sigm(float x) { return __builtin_amdgcn_rcpf(1.f + __expf(-x)); }

#ifndef AUX_B
#define AUX_B 0
#endif
#ifndef AUX_F
#define AUX_F 16
#endif
#ifndef AUX_G
#define AUX_G 0
#endif
#ifndef AUX_J
#define AUX_J 0
#endif
#ifndef AUX_K
#define AUX_K 0
#endif
__device__ __forceinline__ __amdgpu_buffer_rsrc_t mk_rs(const void* p) {
    unsigned lo = (unsigned)__builtin_amdgcn_readfirstlane((int)(unsigned)(uintptr_t)p), hi = (unsigned)__builtin_amdgcn_readfirstlane((int)(unsigned)((uintptr_t)p >> 32)); asm volatile("" : "+s"(lo), "+s"(hi));
    return __builtin_amdgcn_make_buffer_rsrc((void*)(((uintptr_t)hi << 32) | (uintptr_t)lo), 0, -1, 0x00020000); }
template <int AUX> __device__ __forceinline__ void st16(__amdgpu_buffer_rsrc_t rs, unsigned off, u32x4 v) { __builtin_amdgcn_raw_buffer_store_b128(v, rs, off, 0, AUX); }
template <int AUX> __device__ __forceinline__ void st8(__amdgpu_buffer_rsrc_t rs, unsigned off, u32x2 v) { __builtin_amdgcn_raw_buffer_store_b64(v, rs, off, 0, AUX); }
__device__ __forceinline__ void st16p(void* p, u32x4 v) { if (AUX_B == 16) asm volatile("global_store_dwordx4 %0, %1, off sc1\n\ts_nop 1" :: "v"(p), "v"(v) : "memory"); else *(u32x4*)p = v; }
__device__ __forceinline__ void st8p(void* p, u32x2 v) { if (AUX_B == 16) asm volatile("global_store_dwordx2 %0, %1, off sc1\n\ts_nop 1" :: "v"(p), "v"(v) : "memory"); else *(u32x2*)p = v; }
struct NoState {};
struct EpiStoreBf16 {
    static constexpr bool PERM = true, AFTER_DRAIN = false, HOOK = false; static constexpr int NST = 16; typedef NoState State;
    bf16_t* O; int ldc, sig_from; float inv; int probe_skip;
    __device__ __forceinline__ unsigned q8(float raw, float c2) const { const float e = __builtin_amdgcn_exp2f(raw * c2); return (unsigned)fmaxf(__builtin_rintf(__builtin_amdgcn_rcpf(__builtin_fmaf(e, 1.0f / 255.0f, 1.0f / 255.0f))), 1.0f); }
    __device__ __forceinline__ void operator()(const f32x4 (&acc)[2][2][4][2], const Unit& u, int wr, int wc, int fr, int fq, NoState&) const {
        const int row0 = u.pm * BM + wr * 64 + fr, col0 = u.pn * BM + wc * 32 + 8 * fq;
        if (probe_skip == 2) return;
#pragma unroll
        for (int bj = 0; bj < 2; ++bj) {
            const int col = col0 + bj * HALF; const bool sg = col >= sig_from;
#pragma unroll
            for (int ai = 0; ai < 2; ++ai)
#pragma unroll
                for (int m = 0; m < 4; ++m) {
                    const f32x4 a = acc[ai][bj][m][0] * inv, b = acc[ai][bj][m][1] * inv;
                    bf16_t* rowp = O + (size_t)(row0 + ai * HALF + m * 16) * ldc;
                    if (probe_skip == 1 && (a[0] + b[3]) != 12345.678f) continue;
                    if (probe_skip == 4 && (ai + m + bj) != 0 && (a[0] + b[3]) != 12345.678f) continue;
                    if (probe_skip == 3) { *(u32x4*)((unsigned char*)O + ((size_t)1 << 31) + (size_t)(u.pm * 28 + u.pn) * 131072 + (size_t)((((ai * 4 + m) * 2 + bj) * 8 + (wr * 4 + wc)) * 1024 + (fr + 16 * fq) * 16)) = pack8(a, b); continue; }
                    if (sg) { const f32x4 ra = acc[ai][bj][m][0], rb = acc[ai][bj][m][1]; const float c2 = inv * -1.4426950408889634f;
                        u32x2 w; w.x = q8(ra[0], c2) | (q8(ra[1], c2) << 8) | (q8(ra[2], c2) << 16) | (q8(ra[3], c2) << 24); w.y = q8(rb[0], c2) | (q8(rb[1], c2) << 8) | (q8(rb[2], c2) << 16) | (q8(rb[3], c2) << 24);
                        st8p((unsigned char*)(rowp + sig_from) + (col - sig_from), w); }
                    else st16p(rowp + col, pack8(a, b)); }
        }
    }
};
struct EpiBranch {
    static constexpr bool PERM = true, AFTER_DRAIN = false, HOOK = true; static constexpr int NST = 16; typedef NoState State;
    bf16_t* MRG; const unsigned char* gates; int ldg;
    static __device__ __forceinline__ float ub(unsigned v, int k) { return (float)((v >> (8 * k)) & 0xffu); }
    __device__ __forceinline__ void hook(f32x4 (&acc)[2][2][4][2], const Unit& u, int seg, int wr, int wc, int lane, NoState&) const {
        const int fr = lane & 15, fq = lane >> 4;
        const int row0 = u.pm * BM + wr * 64 + fr, col0 = u.pn * BM + wc * 32 + 8 * fq;
        const unsigned char* gp = gates + seg * 1024 + col0;
        u32x2 gb[2][4][2], ga[2][4][2];
#pragma unroll
        for (int ai = 0; ai < 2; ++ai)
#pragma unroll
            for (int m = 0; m < 4; ++m) { const size_t ro = (size_t)(row0 + ai * HALF + m * 16) * ldg;
#pragma unroll
                for (int bj = 0; bj < 2; ++bj) { gb[ai][m][bj] = *(const u32x2*)(gp + ro + bj * HALF); ga[ai][m][bj] = *(const u32x2*)(gp + ro - 1024 + bj * HALF); } }
        __builtin_amdgcn_sched_barrier(0);
#pragma unroll
        for (int ai = 0; ai < 2; ++ai)
#pragma unroll
            for (int m = 0; m < 4; ++m)
#pragma unroll
                for (int bj = 0; bj < 2; ++bj) {
                    const u32x2 b_ = gb[ai][m][bj], a_ = ga[ai][m][bj];
                    f32x4& a = acc[ai][bj][m][0]; f32x4& b = acc[ai][bj][m][1];
#pragma unroll
                    for (int k = 0; k < 4; ++k) { a[k] *= ub(a_.x, k) * __builtin_amdgcn_rcpf(ub(b_.x, k)); b[k] *= ub(a_.y, k) * __builtin_amdgcn_rcpf(ub(b_.y, k)); }
                }
    }
    __device__ __forceinline__ void operator()(const f32x4 (&acc)[2][2][4][2], const Unit& u, int wr, int wc, int fr, int fq, NoState&) const {
        const int row0 = u.pm * BM + wr * 64 + fr, col0 = u.pn * BM + wc * 32 + 8 * fq;
        u32x2 gv[2][4][2];
#pragma unroll
        for (int ai = 0; ai < 2; ++ai)
#pragma unroll
            for (int m = 0; m < 4; ++m)
#pragma unroll
                for (int bj = 0; bj < 2; ++bj) gv[ai][m][bj] = *(const u32x2*)(gates + (size_t)(row0 + ai * HALF + m * 16) * ldg + 2048 + col0 + bj * HALF);
        __builtin_amdgcn_sched_barrier(0);
        const __amdgpu_buffer_rsrc_t rsM = mk_rs(MRG);
#pragma unroll
        for (int ai = 0; ai < 2; ++ai)
#pragma unroll
            for (int m = 0; m < 4; ++m) { const size_t row = (size_t)(row0 + ai * HALF + m * 16);
#pragma unroll
                for (int bj = 0; bj < 2; ++bj) {
                    const u32x2 g_ = gv[ai][m][bj];
                    f32x4 a = acc[ai][bj][m][0], b = acc[ai][bj][m][1];
#pragma unroll
                    for (int k = 0; k < 4; ++k) { a[k] *= ub(g_.x, k) * (1.0f / 255.0f); b[k] *= ub(g_.y, k) * (1.0f / 255.0f); }
                    st16<AUX_F>(rsM, (unsigned)row * 2048u + (unsigned)(col0 + bj * HALF) * 2u, pack8(a, b)); } }
    }
};
__device__ __forceinline__ unsigned pk4_fp8e(float a, float b, float c, float d) { a = fminf(fmaxf(a, -448.0f), 448.0f); b = fminf(fmaxf(b, -448.0f), 448.0f); c = fminf(fmaxf(c, -448.0f), 448.0f); d = fminf(fmaxf(d, -448.0f), 448.0f); unsigned w = __float_as_uint(a); w = __builtin_amdgcn_cvt_pk_fp8_f32(a, b, w, false); w = __builtin_amdgcn_cvt_pk_fp8_f32(c, d, w, true); return w; }
struct EpiResid {
    static constexpr bool PERM = true, AFTER_DRAIN = false, HOOK = false; static constexpr int NST = 16; typedef NoState State;
    bf16_t* U; int probe_skip; float oscale;
    __device__ __forceinline__ void operator()(const f32x4 (&acc)[2][2][4][2], const Unit& u, int wr, int wc, int fr, int fq, NoState&) const {
        const int row0 = u.pm * BM + wr * 64 + fr, colc = u.pn * BM + wc * 64 + 16 * fq;
        if (probe_skip == 2) return;
        const __amdgpu_buffer_rsrc_t rsU = mk_rs(U);
#pragma unroll
        for (int ai = 0; ai < 2; ++ai)
#pragma unroll
            for (int m = 0; m < 4; ++m) { const unsigned rowb = (unsigned)(row0 + ai * HALF + m * 16) * 1024u + (unsigned)colc;
                u32x4 w;
                { const f32x4 a = acc[ai][0][m][0] * oscale, b = acc[ai][0][m][1] * oscale; w.x = pk4_fp8e(a[0], a[1], a[2], a[3]); w.y = pk4_fp8e(b[0], b[1], b[2], b[3]); }
                { const f32x4 a = acc[ai][1][m][0] * oscale, b = acc[ai][1][m][1] * oscale; w.z = pk4_fp8e(a[0], a[1], a[2], a[3]); w.w = pk4_fp8e(b[0], b[1], b[2], b[3]); }
                st16<AUX_G>(rsU, rowb, w); }
    }
};
__device__ __forceinline__ float clamp448(float x) { return fminf(fmaxf(x, -448.0f), 448.0f); }
__device__ __forceinline__ unsigned pk4_fp8(float a, float b, float c, float d) { unsigned w = __float_as_uint(a);   w = __builtin_amdgcn_cvt_pk_fp8_f32(clamp448(a), clamp448(b), w, false); w = __builtin_amdgcn_cvt_pk_fp8_f32(clamp448(c), clamp448(d), w, true); return w; }
__device__ __forceinline__ unsigned pk4_fp8_nc(float a, float b, float c, float d) { unsigned w = __float_as_uint(a); w = __builtin_amdgcn_cvt_pk_fp8_f32(a, b, w, false); w = __builtin_amdgcn_cvt_pk_fp8_f32(c, d, w, true); return w; }
struct EpiSwiglu {
    static constexpr bool PERM = true, AFTER_DRAIN = false, HOOK = false; static constexpr int NST = 8; typedef NoState State;
    unsigned char* A2; const float* b1; float inv, oscale; int probe_skip;
    __device__ __forceinline__ void operator()(const f32x4 (&acc)[2][2][4][2], const Unit& u, int wr, int wc, int fr, int fq, NoState&) const {
        asm volatile("" ::: "memory");
        if (probe_skip == 2) return;
        const int row0 = u.pm * BM + wr * 64 + fr, j0 = u.pn * HALF + wc * 32 + 8 * fq;
        const float* bp = b1 + (size_t)u.e * 2048 + 2 * j0;
        const __amdgpu_buffer_rsrc_t rsA2 = mk_rs(A2);
        float bg[8], bu[8];
#pragma unroll
        for (int q = 0; q < 4; ++q) { const f32x4 t = *(const f32x4*)(bp + 4 * q); bg[2 * q] = t[0]; bu[2 * q] = t[1]; bg[2 * q + 1] = t[2]; bu[2 * q + 1] = t[3]; }
#pragma unroll
        for (int ai = 0; ai < 2; ++ai)
#pragma unroll
            for (int m = 0; m < 4; ++m) {
                float o[8];
#pragma unroll
                for (int e = 0; e < 8; ++e) {
                    float g = acc[ai][0][m][e >> 2][e & 3] * inv + bg[e], up = acc[ai][1][m][e >> 2][e & 3] * inv + bu[e];
                    g = fminf(g, 7.0f); up = fminf(fmaxf(up, -7.0f), 7.0f);
                    o[e] = __builtin_fmaf(up, oscale, oscale) * (g * __builtin_amdgcn_rcpf(1.0f + __builtin_amdgcn_exp2f(g * (-1.702f * 1.4426950408889634f)))); }
                u32x2 w; w.x = pk4_fp8_nc(o[0], o[1], o[2], o[3]); w.y = pk4_fp8_nc(o[4], o[5], o[6], o[7]);
                st8<AUX_J>(rsA2, (unsigned)(row0 + ai * HALF + m * 16) * 1024u + (unsigned)j0, w); }
    }
};
struct EpiMoeOut {
    static constexpr bool PERM = true, AFTER_DRAIN = false, HOOK = false; static constexpr int NST = 16; typedef NoState State;
    bf16_t* YS; float inv; int probe_skip;
    __device__ __forceinline__ void operator()(const f32x4 (&acc)[2][2][4][2], const Unit& u, int wr, int wc, int fr, int fq, NoState&) const {
        const int row0 = u.pm * BM + wr * 64 + fr, colc = u.pn * BM + wc * 64 + 16 * fq;
        if (probe_skip == 2) return;
        const __amdgpu_buffer_rsrc_t rsY = mk_rs(YS);
#pragma unroll
        for (int ai = 0; ai < 2; ++ai)
#pragma unroll
            for (int m = 0; m < 4; ++m) { const unsigned rowb = (unsigned)(row0 + ai * HALF + m * 16) * 1024u + (unsigned)colc;
                u32x4 w;
                { const f32x4 a = acc[ai][0][m][0] * inv, b = acc[ai][0][m][1] * inv; w.x = pk4_fp8(a[0], a[1], a[2], a[3]); w.y = pk4_fp8(b[0], b[1], b[2], b[3]); }
                { const f32x4 a = acc[ai][1][m][0] * inv, b = acc[ai][1][m][1] * inv; w.z = pk4_fp8(a[0], a[1], a[2], a[3]); w.w = pk4_fp8(b[0], b[1], b[2], b[3]); }
                st16<AUX_K>(rsY, rowb, w); }
    }
};

template <class Epi, class Sched, bool ALIGN_EPI = false, bool SP2 = false, bool F8 = false>
__device__ __forceinline__ void gemm_phase(PG8_LAS unsigned char* lds, const Gemm g, const Sched& S, const Epi& E, int wave_index) {
    unsigned msk_ = ~0u; asm volatile("" : "+s"(msk_)); const int tid_ = (wave_index << 6) | (int)__builtin_amdgcn_mbcnt_hi(msk_, __builtin_amdgcn_mbcnt_lo(msk_, 0u));
    const int tid = tid_, wid = __builtin_amdgcn_readfirstlane(tid >> 6), lane = tid & 63, wr = wid >> 2, wc = wid & 3, fr = lane & 15, fq = lane >> 4;
    const int K = g.K, nt = K / BK;
    unsigned voffA[2], voffB[2];
#pragma unroll
    for (int i = 0; i < 2; ++i) { int R, C; stage_rc(tid * 16 + i * 8192, R, C); const int Rb = Epi::PERM ? ((R & ~31) + perm32(R & 31)) : R;
        voffA[i] = (unsigned)(R * K + C) * 2u; voffB[i] = (unsigned)(Rb * K + C) * 2u; }
    const unsigned kstep = (unsigned)(BK * 2);
    const unsigned hstep = (unsigned)HALF * (unsigned)K * 2u;
    const unsigned tstep = 2u * hstep;
    const unsigned ldsw = (unsigned)wid * 1024u;
    const int aoff = lds_byte(wr * 64 + fr, fq * 8), boff = lds_byte(wc * 32 + fr, fq * 8);
#define PG8_SA(b, h) (((b) * 2 + (h)) * HTB)
#define PG8_SB(b, h) ((4 + (b) * 2 + (h)) * HTB)
#define PG8_RS_voffA rsA
#define PG8_RS_voffB rsB
#define PG8_STAGE(bufoff, gbase, voff) do { _Pragma("unroll") for (int _i = 0; _i < 2; ++_i) \
        __builtin_amdgcn_raw_ptr_buffer_load_lds(PG8_RS_##voff, (PG8_LAS void*)(lds + (bufoff) + ldsw + _i * 8192), 16, (voff)[_i], (gbase), 0, 0); } while (0)
#define PG8_LDA(dst, b, h) do { _Pragma("unroll") for (int m = 0; m < 4; ++m) _Pragma("unroll") for (int k = 0; k < 2; ++k) dst[m][k] = *(const PG8_LAS bf16x8*)(lds + PG8_SA(b, h) + aoff + m * 2048 + k * 1024); } while (0)
#define PG8_LDB(dst, b, h) do { _Pragma("unroll") for (int n = 0; n < 2; ++n) _Pragma("unroll") for (int k = 0; k < 2; ++k) dst[n][k] = *(const PG8_LAS bf16x8*)(lds + PG8_SB(b, h) + boff + n * 2048 + k * 1024); } while (0)
#define PG8_CAT(x) __builtin_shufflevector(__builtin_bit_cast(v4i_t, (x)[0]), __builtin_bit_cast(v4i_t, (x)[1]), 0, 1, 2, 3, 4, 5, 6, 7)
#define PG8_MMA(ai, bj, At, Bt) do { __builtin_amdgcn_s_setprio(1); _Pragma("unroll") for (int m = 0; m < 4; ++m) _Pragma("unroll") for (int n = 0; n < 2; ++n) { \
        if constexpr (F8) acc[ai][bj][m][n] = __builtin_amdgcn_mfma_scale_f32_16x16x128_f8f6f4(PG8_CAT(Bt[n]), PG8_CAT(At[m]), acc[ai][bj][m][n], 0, 0, 0, 0x7f7f7f7f, 0, 0x7f7f7f7f); \
        else { _Pragma("unroll") for (int k = 0; k < 2; ++k) acc[ai][bj][m][n] = __builtin_amdgcn_mfma_f32_16x16x32_bf16(Bt[n][k], At[m][k], acc[ai][bj][m][n], 0, 0, 0); } } __builtin_amdgcn_s_setprio(0); } while (0)
#define PG8_WAIT_V(n) asm volatile("s_waitcnt vmcnt(" #n ")" ::: "memory")
#define PG8_WAIT_L(n) asm volatile("s_waitcnt lgkmcnt(" #n ")" ::: "memory")
#define PG8_BAR __builtin_amdgcn_s_barrier()
#define PG8_SCHED __builtin_amdgcn_sched_barrier(0)
    Unit cur, nxt; int ui = 0;
    typename Epi::State est;
    if (!S.next(0, cur)) return;
    f32x4 acc[2][2][4][2];
#pragma unroll
    for (int a = 0; a < 2; ++a)
#pragma unroll
        for (int b = 0; b < 2; ++b)
#pragma unroll
            for (int m = 0; m < 4; ++m)
#pragma unroll
                for (int n = 0; n < 2; ++n) { f32x4 z_; asm volatile("v_mov_b32 %0, 0\n\tv_mov_b32 %1, 0\n\tv_mov_b32 %2, 0\n\tv_mov_b32 %3, 0" : "=v"(z_[0]), "=v"(z_[1]), "=v"(z_[2]), "=v"(z_[3])); acc[a][b][m][n] = z_; }
    bf16x8 At[4][2], B0[2][2], B1[2][2];
    const __amdgpu_buffer_rsrc_t rsA = __builtin_amdgcn_make_buffer_rsrc((void*)g.A, 0, -1, 0x00020000), rsB = __builtin_amdgcn_make_buffer_rsrc((void*)g.Bt, 0, -1, 0x00020000);
    unsigned cA = (unsigned)cur.pm * tstep, cB = (unsigned)cur.e * (unsigned)g.bstride + (unsigned)cur.pn * tstep;
    S.a_ready(cur);
    if constexpr (SP2) {
        PG8_STAGE(PG8_SB(0, 0), cB, voffB); PG8_STAGE(PG8_SB(0, 1), cB + hstep, voffB); PG8_STAGE(PG8_SA(0, 0), cA, voffA); PG8_STAGE(PG8_SA(0, 1), cA + hstep, voffA);
        if (wr == 1) PG8_BAR;
        PG8_WAIT_V(2); PG8_BAR;
        PG8_STAGE(PG8_SB(1, 0), cB + kstep, voffB); PG8_STAGE(PG8_SA(1, 0), cA + kstep, voffA); PG8_STAGE(PG8_SB(1, 1), cB + hstep + kstep, voffB);
        PG8_WAIT_V(6); PG8_BAR;
    } else {
        PG8_STAGE(PG8_SB(0, 0), cB, voffB); PG8_STAGE(PG8_SA(0, 0), cA, voffA); PG8_STAGE(PG8_SB(0, 1), cB + hstep, voffB); PG8_STAGE(PG8_SA(0, 1), cA + hstep, voffA);
        if (wr == 1) PG8_BAR;
        PG8_WAIT_V(4); PG8_BAR;
        PG8_STAGE(PG8_SB(1, 0), cB + kstep, voffB); PG8_STAGE(PG8_SA(1, 0), cA + kstep, voffA); PG8_STAGE(PG8_SB(1, 1), cB + hstep + kstep, voffB);
        PG8_WAIT_V(6); PG8_BAR;
    }
    for (;;) {
        const bool has_next = S.next(ui + 1, nxt);
        const unsigned nA = has_next ? (unsigned)nxt.pm * tstep : cA, nB = has_next ? (unsigned)nxt.e * (unsigned)g.bstride + (unsigned)nxt.pn * tstep : cB;
#pragma clang loop unroll(disable)
        for (int t = 0; t < nt; t += 2) {
            if constexpr (Epi::HOOK) { if (t > 0 && (t & 7) == 0) { if (wr == 0) PG8_BAR; E.hook(acc, cur, t >> 3, wr, wc, lane, est); if (wr == 1) PG8_BAR; } }
            const bool last = (t == nt - 2);
            const unsigned a1 = cA + (unsigned)(t + 1) * kstep;
            const unsigned a2 = last ? nA : cA + (unsigned)(t + 2) * kstep, b2 = last ? nB : cB + (unsigned)(t + 2) * kstep;
            const unsigned a3 = a2 + kstep, b3 = b2 + kstep;
            if (last && has_next) S.a_ready(nxt);
            if constexpr (SP2) {
            PG8_LDB(B0, 0, 0); PG8_LDB(B1, 0, 1); PG8_SCHED; PG8_LDA(At, 0, 0); PG8_STAGE(PG8_SA(1, 1), a1 + hstep, voffA);
            PG8_WAIT_V(8); PG8_WAIT_L(0); PG8_BAR; PG8_MMA(0, 0, At, B0); PG8_MMA(0, 1, At, B1); PG8_BAR; PG8_SCHED;
            PG8_LDA(At, 0, 1); PG8_STAGE(PG8_SB(0, 0), b2, voffB); PG8_STAGE(PG8_SB(0, 1), b2 + hstep, voffB); PG8_STAGE(PG8_SA(0, 0), a2, voffA);
            PG8_WAIT_V(8); PG8_WAIT_L(0); PG8_BAR; PG8_MMA(1, 0, At, B0); PG8_MMA(1, 1, At, B1); PG8_BAR; PG8_SCHED;
            PG8_LDB(B0, 1, 0); PG8_LDB(B1, 1, 1); PG8_SCHED; PG8_LDA(At, 1, 0); PG8_STAGE(PG8_SA(0, 1), a2 + hstep, voffA);
            PG8_WAIT_V(8); PG8_WAIT_L(0); PG8_BAR; PG8_MMA(0, 0, At, B0); PG8_MMA(0, 1, At, B1); PG8_BAR; PG8_SCHED;
            PG8_LDA(At, 1, 1); PG8_STAGE(PG8_SB(1, 0), b3, voffB); PG8_STAGE(PG8_SB(1, 1), b3 + hstep, voffB); PG8_STAGE(PG8_SA(1, 0), a3, voffA);
            PG8_WAIT_V(8); PG8_WAIT_L(0); PG8_BAR; PG8_MMA(1, 0, At, B0); PG8_MMA(1, 1, At, B1); PG8_BAR; PG8_SCHED;
            } else {
            PG8_LDB(B0, 0, 0); PG8_SCHED; PG8_LDA(At, 0, 0); PG8_STAGE(PG8_SA(1, 1), a1 + hstep, voffA);
            PG8_WAIT_L(8); PG8_BAR; PG8_WAIT_L(0); PG8_MMA(0, 0, At, B0); PG8_BAR; PG8_SCHED;
            PG8_LDB(B1, 0, 1); PG8_STAGE(PG8_SB(0, 0), b2, voffB);
            PG8_BAR; PG8_WAIT_L(0); PG8_MMA(0, 1, At, B1); PG8_BAR;
            PG8_LDA(At, 0, 1); PG8_STAGE(PG8_SA(0, 0), a2, voffA);
            PG8_BAR; PG8_WAIT_L(0); PG8_MMA(1, 0, At, B0); PG8_BAR; PG8_SCHED;
            PG8_STAGE(PG8_SB(0, 1), b2 + hstep, voffB);
            PG8_WAIT_V(6); PG8_BAR; PG8_MMA(1, 1, At, B1); PG8_BAR;
            PG8_LDB(B0, 1, 0); PG8_SCHED; PG8_LDA(At, 1, 0); PG8_STAGE(PG8_SA(0, 1), a2 + hstep, voffA);
            PG8_WAIT_L(8); PG8_BAR; PG8_WAIT_L(0); PG8_MMA(0, 0, At, B0); PG8_BAR; PG8_SCHED;
            PG8_LDB(B1, 1, 1); PG8_STAGE(PG8_SB(1, 0), b3, voffB);
            PG8_BAR; PG8_WAIT_L(0); PG8_MMA(0, 1, At, B1); PG8_BAR;
            PG8_LDA(At, 1, 1); PG8_STAGE(PG8_SA(1, 0), a3, voffA);
            PG8_BAR; PG8_WAIT_L(0); PG8_MMA(1, 0, At, B0); PG8_BAR; PG8_SCHED;
            PG8_STAGE(PG8_SB(1, 1), b3 + hstep, voffB);
            PG8_WAIT_V(6); PG8_BAR; PG8_MMA(1, 1, At, B1); PG8_BAR;
            }
        }
        if constexpr (ALIGN_EPI) { if (wr == 0) PG8_BAR; }
        if constexpr (!Epi::AFTER_DRAIN) { unsigned m2_ = ~0u; asm volatile("" : "+s"(m2_)); const int le_ = (int)__builtin_amdgcn_mbcnt_hi(m2_, __builtin_amdgcn_mbcnt_lo(m2_, 0u));
            E(acc, cur, wr, wc, le_ & 15, le_ >> 4, est); S.done(cur); }
        if (!has_next) break;
#pragma unroll
        for (int a = 0; a < 2; ++a)
#pragma unroll
            for (int b = 0; b < 2; ++b)
#pragma unroll
                for (int m = 0; m < 4; ++m)
#pragma unroll
                    for (int n = 0; n < 2; ++n) { f32x4 z_; asm volatile("v_mov_b32 %0, 0\n\tv_mov_b32 %1, 0\n\tv_mov_b32 %2, 0\n\tv_mov_b32 %3, 0" : "=v"(z_[0]), "=v"(z_[1]), "=v"(z_[2]), "=v"(z_[3])); acc[a][b][m][n] = z_; }
        cur = nxt; cA = nA; cB = nB; ++ui;
        if constexpr (ALIGN_EPI) { if (wr == 1) PG8_BAR; }
    }
    PG8_WAIT_V(0);
    if constexpr (!ALIGN_EPI) { if (wr == 0) PG8_BAR; }
    PG8_BAR;
    if constexpr (Epi::AFTER_DRAIN) { E.fused(acc, cur, wr, wc, fr, fq, lds, wid, lane); S.done(cur); }
#undef PG8_SA
#undef PG8_SB
#undef PG8_STAGE
#undef PG8_RS_voffA
#undef PG8_RS_voffB
#undef PG8_LDA
#undef PG8_LDB
#undef PG8_MMA
#undef PG8_CAT
#undef PG8_WAIT_V
#undef PG8_WAIT_L
#undef PG8_BAR
#undef PG8_SCHED
}
}
namespace attn_body {
using bf16=__hip_bfloat16;
using bf16x8=__attribute__((ext_vector_type(8)))short;
using s16x4=__attribute__((ext_vector_type(4)))short;
using f32x16=__attribute__((ext_vector_type(16)))float;
using u32x4=__attribute__((ext_vector_type(4)))unsigned;
constexpr int D=64,QP=512,KP=128,OP=1536;
constexpr int NW=8,QBLK=32,QB=QBLK*NW,KVBLK=64;
constexpr int ATTN_UNIT_ROWS=QB;
__device__ __forceinline__ int crow(int r,int hi){return (r&3)+8*(r>>2)+4*hi;}
#define SBAR() __builtin_amdgcn_sched_barrier(0)
__device__ __forceinline__ void cmask(f32x16&p0,f32x16&p1,int jb,int qrel,int hi){
  const float NEG=-INFINITY; int kb=64*jb+4*hi;
  #pragma unroll
  for(int r=0;r<16;++r){int kv=kb+(r&3)+8*(r>>2); if(kv>qrel)p0[r]=NEG; if(kv+32>qrel)p1[r]=NEG;}
}

constexpr int NSLOT=3, SLOTB=8192;
constexpr int LDS_K=0, LDS_V=NSLOT*SLOTB, LDS_WS=2*NSLOT*SLOTB, LDS_OST=LDS_WS+NW*64*4, LDS_BYTES=LDS_OST+NW*4096;
constexpr float C2=0.125f*1.4426950408889634f;
__device__ __forceinline__ void glds16(const void*gsrc,unsigned lds_dst){unsigned keep;
  asm volatile("s_mov_b32 %0, m0\n\ts_mov_b32 m0, %2\n\ts_nop 0\n\tglobal_load_lds_dwordx4 %1, off\n\ts_mov_b32 m0, %0":"=&s"(keep):"v"(gsrc),"s"(lds_dst):"memory");}
__device__ __forceinline__ float max3f(float a,float b,float c){float r;asm("v_max3_f32 %0, %1, %2, %3":"=v"(r):"v"(a),"v"(b),"v"(c));return r;}
__device__ __forceinline__ float max2f(float a,float b){float r;asm("v_max_f32_e32 %0, %1, %2":"=v"(r):"v"(a),"v"(b));return r;}
__device__ __forceinline__ float fadd_s(float a,float b){float r;asm("v_add_f32_e32 %0, %1, %2":"=v"(r):"v"(a),"v"(b));return r;}
__device__ __forceinline__ float fsub_s(float a,float b){float r;asm("v_sub_f32_e32 %0, %1, %2":"=v"(r):"v"(a),"v"(b));return r;}
typedef float f32x2_t __attribute__((ext_vector_type(2))); typedef __bf16 bf16x2_t __attribute__((ext_vector_type(2)));
__device__ __forceinline__ unsigned cvtpk_s(float lo,float hi){f32x2_t v={lo,hi};bf16x2_t b=__builtin_convertvector(v,bf16x2_t);return __builtin_bit_cast(unsigned,b);}
#define WAIT_BAR(N) asm volatile("s_waitcnt vmcnt(" #N ") lgkmcnt(0)\n\ts_barrier":::"memory")

__device__ __forceinline__ void qkt(f32x16&p0,f32x16&p1,const char*Kslot,const bf16x8*qr,const f32x16&negm,int r32,int hi){
  const char*kb=Kslot+hi*1024+r32*16;
  #pragma unroll
  for(int d0=0;d0<4;++d0){
    const bf16x8 b0=*reinterpret_cast<const bf16x8*>(kb+d0*2048);
    const bf16x8 b1=*reinterpret_cast<const bf16x8*>(kb+d0*2048+512);
    if(d0==0){p0=__builtin_amdgcn_mfma_f32_32x32x16_bf16(b0,qr[0],negm,0,0,0);p1=__builtin_amdgcn_mfma_f32_32x32x16_bf16(b1,qr[0],negm,0,0,0);}
    else{p0=__builtin_amdgcn_mfma_f32_32x32x16_bf16(b0,qr[d0],p0,0,0,0);p1=__builtin_amdgcn_mfma_f32_32x32x16_bf16(b1,qr[d0],p1,0,0,0);}}
}
typedef __attribute__((address_space(3))) const char* lds_cptr;
typedef short v4i16_t __attribute__((ext_vector_type(4)));
__device__ __forceinline__ void kload8(bf16x8*kf,lds_cptr kp){
  kf[0]=*(const __attribute__((address_space(3))) bf16x8*)(kp);      kf[1]=*(const __attribute__((address_space(3))) bf16x8*)(kp+512);
  kf[2]=*(const __attribute__((address_space(3))) bf16x8*)(kp+2048); kf[3]=*(const __attribute__((address_space(3))) bf16x8*)(kp+2560);
  kf[4]=*(const __attribute__((address_space(3))) bf16x8*)(kp+4096); kf[5]=*(const __attribute__((address_space(3))) bf16x8*)(kp+4608);
  kf[6]=*(const __attribute__((address_space(3))) bf16x8*)(kp+6144); kf[7]=*(const __attribute__((address_space(3))) bf16x8*)(kp+6656);
}
__device__ __forceinline__ void kload2(bf16x8*kf,lds_cptr kp,int j){ kf[2*j]=*(const __attribute__((address_space(3))) bf16x8*)(kp+j*2048); kf[2*j+1]=*(const __attribute__((address_space(3))) bf16x8*)(kp+j*2048+512); }
__device__ __forceinline__ s16x4 vtr(lds_cptr p){ return __builtin_bit_cast(s16x4,__builtin_amdgcn_ds_read_tr16_b64_v4i16((__attribute__((address_space(3))) v4i16_t*)p)); }
__device__ __forceinline__ float rowmax(const f32x16&p0,const f32x16&p1){
  float a=max3f(p0[0],p0[1],p1[0]),b=max3f(p0[2],p0[3],p1[1]);a=max3f(a,p1[2],p1[3]);
  #pragma unroll
  for(int r=4;r<16;r+=4){a=max3f(a,p0[r],p0[r+1]);b=max3f(b,p0[r+2],p0[r+3]);a=max3f(a,p1[r],p1[r+1]);b=max3f(b,p1[r+2],p1[r+3]);}
  const float m=max2f(a,b);
  auto rr=__builtin_amdgcn_permlane32_swap(__float_as_uint(m),__float_as_uint(m),false,false);
  return max2f(__uint_as_float(rr[0]),__uint_as_float(rr[1]));
}
__device__ __forceinline__ void pv(f32x16*o,int vb,bf16x8 pa0,bf16x8 pa1,bf16x8 pa2,bf16x8 pa3){
  #pragma unroll
  for(int d0=0;d0<2;++d0){s16x4 lo[4],hi[4];
    #pragma unroll
    for(int ks=0;ks<4;++ks){
      asm volatile("ds_read_b64_tr_b16 %0,%1 offset:%c2":"=&v"(lo[ks]):"v"(vb),"i"(d0*4096+ks*1024):"memory");
      asm volatile("ds_read_b64_tr_b16 %0,%1 offset:%c2":"=&v"(hi[ks]):"v"(vb),"i"(d0*4096+ks*1024+512):"memory");}
    asm volatile("s_waitcnt lgkmcnt(0)":::"memory");SBAR();
    #define PK(k) (bf16x8){lo[k][0],lo[k][1],lo[k][2],lo[k][3],hi[k][0],hi[k][1],hi[k][2],hi[k][3]}
    o[d0]=__builtin_amdgcn_mfma_f32_32x32x16_bf16(pa0,PK(0),o[d0],0,0,0);
    o[d0]=__builtin_amdgcn_mfma_f32_32x32x16_bf16(pa1,PK(1),o[d0],0,0,0);
    o[d0]=__builtin_amdgcn_mfma_f32_32x32x16_bf16(pa2,PK(2),o[d0],0,0,0);
    o[d0]=__builtin_amdgcn_mfma_f32_32x32x16_bf16(pa3,PK(3),o[d0],0,0,0);
    #undef PK
  }
}

#ifndef ATTN_STORE16
#define ATTN_STORE16(p,v) (*(u32x4*)(p)=(v))
#endif
template<int THRL> __device__ __forceinline__ void attn_unit(long qrow0,int h,int NT,const bf16*Q,const bf16*__restrict__ Kh,const bf16*__restrict__ Vh,bf16*O,char*shm,int wave_index){
  unsigned msk_=~0u; asm volatile("":"+s"(msk_)); const int tid=(wave_index<<6)|(int)__builtin_amdgcn_mbcnt_hi(msk_,__builtin_amdgcn_mbcnt_lo(msk_,0u)),lane=tid&63,r32=lane&31,hi=lane>>5; const int wid=__builtin_amdgcn_readfirstlane(tid>>6);
  const bf16*Qw=Q+(qrow0+wid*QBLK)*QP+h*D;
  const unsigned lds0=(unsigned)(uintptr_t)shm;
  float*wsf=(float*)(shm+LDS_WS)+wid*64;
  const bf16*ksrc=Kh+(long)lane*KP+wid*8;
  const bf16*vsrc=Vh+(long)(16*(wid&3)+(lane>>2))*KP+(wid>>2)*32+(lane&3)*8;
  const unsigned kdst=lds0+LDS_K+wid*1024, vdst=lds0+LDS_V+wid*1024;
  #define DMA_K(t,slot) glds16(ksrc+(long)(t)*KVBLK*KP,(unsigned)__builtin_amdgcn_readfirstlane(kdst+(slot)))
  #define DMA_V(t,slot) glds16(vsrc+(long)(t)*KVBLK*KP,(unsigned)__builtin_amdgcn_readfirstlane(vdst+(slot)))
  const int vb0=(int)(lds0+LDS_V)+((lane>>4)&1)*32+(lane&3)*8+(4*hi+((lane&15)>>2))*64;
  const char*Kbase=shm+LDS_K; bf16x8 kf[8];
  const lds_cptr shm3=(lds_cptr)shm; const lds_cptr kp0=shm3+LDS_K+hi*1024+r32*16; const lds_cptr vp0=shm3+LDS_V+((lane>>4)&1)*32+(lane&3)*8+(4*hi+((lane&15)>>2))*64;
  DMA_K(0,0);DMA_V(0,0);DMA_K(1,SLOTB);
  bf16x8 qr[4];
  #pragma unroll
  for(int d0=0;d0<4;++d0)qr[d0]=*reinterpret_cast<const bf16x8*>(&Qw[(long)r32*QP+d0*16+hi*8]);
  float mhat=0.f,l_reg=0.f;f32x16 o[2],negm; { float zz=0.f; asm volatile("":"+v"(zz));
    _Pragma("unroll") for(int r=0;r<16;++r){o[0][r]=zz;o[1][r]=zz;negm[r]=zz;} } asm volatile("":"+v"(negm));
  #define CMASK(P0,P1,t) do{}while(0)
  bool resc=false;
  #define START(P0,P1) do{ const float rm=rowmax(P0,P1); resc=false; \
    { const float dl=rm; mhat=fadd_s(mhat,dl); \
      _Pragma("unroll") for(int r=0;r<16;++r){P0[r]=fsub_s(P0[r],dl);P1[r]=fsub_s(P1[r],dl);} \
      _Pragma("unroll") for(int r=0;r<16;++r)negm[r]=-mhat; asm volatile("":"+v"(negm)); } \
    _Pragma("unroll") for(int r=0;r<16;++r)P0[r]=__builtin_amdgcn_exp2f(P0[r]); }while(0)
  #define RESC() do{ if(resc){ asm volatile("s_waitcnt lgkmcnt(0)":::"memory"); \
      _Pragma("unroll") for(int d_=0;d_<2;++d_) _Pragma("unroll") for(int r=0;r<16;++r)o[d_][r]*=wsf[crow(r,hi)]; } }while(0)
  f32x16 pA0,pA1,pB0,pB1;
  int sl_prev=0,sl_cur=0,sl_next=SLOTB;
  #define ROT() do{sl_prev=sl_cur;sl_cur=sl_next;sl_next=(sl_next==(NSLOT-1)*SLOTB)?0:sl_next+SLOTB;}while(0)
  DMA_K(2,2*SLOTB);
  WAIT_BAR(3);
  qkt(pA0,pA1,Kbase,qr,negm,r32,hi);asm volatile("s_nop 15\n\ts_nop 7":"+v"(pA0),"+v"(pA1));CMASK(pA0,pA1,0);
  START(pA0,pA1);
  _Pragma("unroll") for(int r=0;r<16;++r)pA1[r]=__builtin_amdgcn_exp2f(pA1[r]);
  WAIT_BAR(0);
  DMA_K(3,0);DMA_V(1,SLOTB);
  ROT();
  kload8(kf,kp0+sl_cur);
  WAIT_BAR(2);
  s16x4 vlo[8],vhi[8]; u32x4 pw0,pw1,pw2,pw3;
  #define PKW(P,B) cvtpk_s(P[B],P[B+1])
  #define PAF(k) __builtin_bit_cast(bf16x8,pw##k)
  #define VFR(i) (bf16x8){vlo[i][0],vlo[i][1],vlo[i][2],vlo[i][3],vhi[i][0],vhi[i][1],vhi[i][2],vhi[i][3]}
  #define PIN(x) asm volatile("":"+v"(x))
  #define MX3(a,b,c) __builtin_fmaxf(__builtin_fmaxf((a),(b)),(c))
  #define GAPA(MF,A0,A1,A2,A3,W0,W1,PW) do{ MF; sacc+=A0; sacc+=A1; sacc+=A2; sacc+=A3; PIN(sacc); W0; W1; PIN(PW); SBAR(); }while(0)
  #define EX(v) __builtin_amdgcn_exp2f(v)
  #define GAPB(MF,X,B) do{ MF; X[B]=EX(X[B]); X[B+1]=EX(X[B+1]); X[B+2]=EX(X[B+2]); X[B+3]=EX(X[B+3]); PIN(X); SBAR(); }while(0)
  #define VRD(i) do{ vlo[i]=vtr(vp_+(((i)>>2)*4096+((i)&3)*1024)); vhi[i]=vtr(vp_+(((i)>>2)*4096+((i)&3)*1024+512)); }while(0)
  #define KRD(G,j) do{ if(G){ kload2(kf,kp0+sl_next,j); SBAR(); } }while(0)
  #define STEP(C0,C1,P0,P1,t,GK,GV,GL) do{ SBAR(); \
    const lds_cptr vp_=vp0+sl_prev; \
    VRD(0); SBAR(); float sacc=(P0[0]+P0[1]); \
    GAPA(C0=__builtin_amdgcn_mfma_f32_32x32x16_bf16(kf[0],qr[0],negm,0,0,0), P0[2],P0[3],P0[4],P0[5],     pw0[0]=PKW(P0,0), pw0[1]=PKW(P0,2), pw0); \
    VRD(4); SBAR(); GAPA(C1=__builtin_amdgcn_mfma_f32_32x32x16_bf16(kf[1],qr[0],negm,0,0,0), P0[6],P0[7],P0[8],P0[9],     pw0[2]=PKW(P0,4), pw0[3]=PKW(P0,6), pw0); \
    VRD(1); SBAR(); GAPA(C0=__builtin_amdgcn_mfma_f32_32x32x16_bf16(kf[2],qr[1],C0,0,0,0),   P0[10],P0[11],P0[12],P0[13], pw1[0]=PKW(P0,8), pw1[1]=PKW(P0,10), pw1); \
    VRD(5); SBAR(); GAPA(C1=__builtin_amdgcn_mfma_f32_32x32x16_bf16(kf[3],qr[1],C1,0,0,0),   P0[14],P0[15],P1[0],P1[1],   pw1[2]=PKW(P0,12),pw1[3]=PKW(P0,14), pw1); \
    VRD(2); SBAR(); GAPA(C0=__builtin_amdgcn_mfma_f32_32x32x16_bf16(kf[4],qr[2],C0,0,0,0),   P1[2],P1[3],P1[4],P1[5],     pw2[0]=PKW(P1,0), pw2[1]=PKW(P1,2), pw2); \
    VRD(6); SBAR(); GAPA(C1=__builtin_amdgcn_mfma_f32_32x32x16_bf16(kf[5],qr[2],C1,0,0,0),   P1[6],P1[7],P1[8],P1[9],     pw2[2]=PKW(P1,4), pw2[3]=PKW(P1,6), pw2); \
    VRD(3); SBAR(); GAPA(C0=__builtin_amdgcn_mfma_f32_32x32x16_bf16(kf[6],qr[3],C0,0,0,0),   P1[10],P1[11],P1[12],P1[13], pw3[0]=PKW(P1,8), pw3[1]=PKW(P1,10), pw3); \
    VRD(7); SBAR(); GAPA(C1=__builtin_amdgcn_mfma_f32_32x32x16_bf16(kf[7],qr[3],C1,0,0,0),   P1[14],P1[15],0.f,0.f,       pw3[2]=PKW(P1,12),pw3[3]=PKW(P1,14), pw3); \
    l_reg+=sacc; \
    if(GK){DMA_K((t)+3,sl_cur);} if(GV){DMA_V((t)+1,sl_next);} \
    CMASK(C0,C1,t); \
    { float a=MX3(C0[0],C0[1],C1[0]),b=MX3(C0[2],C0[3],C1[1]); a=MX3(a,C1[2],C1[3]); \
      _Pragma("unroll") for(int r=4;r<16;r+=4){a=MX3(a,C0[r],C0[r+1]);b=MX3(b,C0[r+2],C0[r+3]);a=MX3(a,C1[r],C1[r+1]);b=MX3(b,C1[r+2],C1[r+3]);} \
      float rm=__builtin_fmaxf(a,b); { auto rr=__builtin_amdgcn_permlane32_swap(__float_as_uint(rm),__float_as_uint(rm),false,false); rm=__builtin_fmaxf(__uint_as_float(rr[0]),__uint_as_float(rr[1])); } \
      resc=false; \
      if(__builtin_expect(__any(rm>(float)THRL),0)){ const float dl=__builtin_fmaxf(rm,0.f); mhat+=dl; \
        _Pragma("unroll") for(int r=0;r<16;++r){C0[r]-=dl;C1[r]-=dl;} \
        _Pragma("unroll") for(int r=0;r<16;++r)negm[r]=-mhat; asm volatile("":"+v"(negm)); \
        const float f=__builtin_amdgcn_exp2f(-dl); l_reg*=f; if(hi==0)wsf[r32]=f; resc=true; } } \
    SBAR(); \
    GAPB(o[0]=__builtin_amdgcn_mfma_f32_32x32x16_bf16(PAF(0),VFR(0),o[0],0,0,0), C0,0); \
    GAPB(o[1]=__builtin_amdgcn_mfma_f32_32x32x16_bf16(PAF(0),VFR(4),o[1],0,0,0), C0,4); \
    KRD(GL,0); GAPB(o[0]=__builtin_amdgcn_mfma_f32_32x32x16_bf16(PAF(1),VFR(1),o[0],0,0,0), C0,8); \
    KRD(GL,1); GAPB(o[1]=__builtin_amdgcn_mfma_f32_32x32x16_bf16(PAF(1),VFR(5),o[1],0,0,0), C0,12); \
    KRD(GL,2); GAPB(o[0]=__builtin_amdgcn_mfma_f32_32x32x16_bf16(PAF(2),VFR(2),o[0],0,0,0), C1,0); \
    KRD(GL,3); GAPB(o[1]=__builtin_amdgcn_mfma_f32_32x32x16_bf16(PAF(2),VFR(6),o[1],0,0,0), C1,4); \
    GAPB(o[0]=__builtin_amdgcn_mfma_f32_32x32x16_bf16(PAF(3),VFR(3),o[0],0,0,0), C1,8); \
    GAPB(o[1]=__builtin_amdgcn_mfma_f32_32x32x16_bf16(PAF(3),VFR(7),o[1],0,0,0), C1,12); \
    }while(0)
  int t=1;
  #undef CMASK
  #define CMASK(P0,P1,t) do{}while(0)
  for(;t+5<NT;t+=2){
    STEP(pB0,pB1,pA0,pA1,t,true,true,true);     WAIT_BAR(2); RESC(); ROT();
    STEP(pA0,pA1,pB0,pB1,t+1,true,true,true);   WAIT_BAR(2); RESC(); ROT();
  }
  #undef CMASK
  #define CMASK(P0,P1,t) do{}while(0)
  #define ENDW(tt) do{ if((tt)+3<NT){WAIT_BAR(2);} else if((tt)+2<NT){WAIT_BAR(1);} else {WAIT_BAR(0);} }while(0)
  for(;t+1<NT;t+=2){
    STEP(pB0,pB1,pA0,pA1,t,(t+3<NT),(t+1<NT),(t+1<NT));       ENDW(t);   RESC(); ROT();
    STEP(pA0,pA1,pB0,pB1,t+1,(t+4<NT),(t+2<NT),(t+2<NT));     ENDW(t+1); RESC(); ROT();
  }
  STEP(pB0,pB1,pA0,pA1,NT-1,false,false,false); RESC();
  { float sacc=pB0[0]+pB0[1]; _Pragma("unroll") for(int r=2;r<16;++r)sacc+=pB0[r]; _Pragma("unroll") for(int r=0;r<16;++r)sacc+=pB1[r]; l_reg+=sacc;
    pw0=(u32x4){PKW(pB0,0),PKW(pB0,2),PKW(pB0,4),PKW(pB0,6)};pw1=(u32x4){PKW(pB0,8),PKW(pB0,10),PKW(pB0,12),PKW(pB0,14)};pw2=(u32x4){PKW(pB1,0),PKW(pB1,2),PKW(pB1,4),PKW(pB1,6)};pw3=(u32x4){PKW(pB1,8),PKW(pB1,10),PKW(pB1,12),PKW(pB1,14)};
    SBAR(); pv(o,vb0+sl_cur,PAF(0),PAF(1),PAF(2),PAF(3)); }
  #undef PKW
  #undef PAF
  #undef VFR
  #undef PIN
  #undef MX3
  #undef GAPA
  #undef GAPB
  #undef EX
  #undef VRD
  #undef KRD
  #undef STEP
  #undef ENDW
  {auto rr=__builtin_amdgcn_permlane32_swap(__float_as_uint(l_reg),__float_as_uint(l_reg),false,false);l_reg=__uint_as_float(rr[0])+__uint_as_float(rr[1]);}
  if(hi==0)wsf[32+r32]=l_reg;asm volatile("s_waitcnt lgkmcnt(0)":::"memory");
  float rli[16];
  #pragma unroll
  for(int r=0;r<16;++r)rli[r]=__builtin_amdgcn_rcpf(wsf[32+crow(r,hi)]);
  bf16*Ow=O+(qrow0+wid*QBLK)*OP+h*D;
  { bf16*stg=(bf16*)(shm+LDS_OST)+wid*2048;
    #pragma unroll
    for(int r=0;r<16;++r){const int orow=crow(r,hi);
      #pragma unroll
      for(int d0=0;d0<2;++d0)stg[orow*64+d0*32+r32]=__float2bfloat16(o[d0][r]*rli[r]);}
    asm volatile("s_waitcnt lgkmcnt(0)":::"memory");
    #pragma unroll
    for(int i=0;i<4;++i){const int row=i*8+(lane>>3),ch=lane&7; const u32x4 v=*(const u32x4*)(stg+row*64+ch*8); ATTN_STORE16(Ow+(long)row*OP+ch*8,v);} }
  asm volatile("s_waitcnt lgkmcnt(0)\n\ts_barrier":::"memory");
  #undef DMA_K
  #undef DMA_V
  #undef CMASK
  #undef START
  #undef RESC
  #undef ROT
}
constexpr int ATTN_LDS_BYTES=LDS_BYTES;
#undef SBAR
#undef WAIT_BAR
}
typedef GAS unsigned gu32;
typedef GAS unsigned long long gu64;
#define RLX_AGENT __ATOMIC_RELAXED, __HIP_MEMORY_SCOPE_AGENT
#define LDS_WAIT() asm volatile("s_waitcnt lgkmcnt(0)" ::: "memory")
#define VM_WAIT() asm volatile("s_waitcnt vmcnt(0)" ::: "memory")
__device__ __forceinline__ unsigned long long rt() { return __builtin_amdgcn_s_memrealtime(); }

#define XB_TMO      128
#define XB_XCNT(j)  (256  + 64 * (j))
#define XB_XSUB(j)  (1280 + 64 * (j))
#define XB_XGEN(j)  (2304 + 64 * (j))
#define XB_TOP      3328
#define XB_TOPGEN   3392
#define XCD_BAR_WORDS 3456
#define XB_SPIN_CAP (1u << 18)

__device__ __forceinline__ unsigned xb_ld(unsigned* p)              { return __hip_atomic_load(p, __ATOMIC_RELAXED, __HIP_MEMORY_SCOPE_AGENT); }
__device__ __forceinline__ unsigned xb_add(unsigned* p, unsigned v) { return __hip_atomic_fetch_add(p, v, __ATOMIC_RELAXED, __HIP_MEMORY_SCOPE_AGENT); }
__device__ __forceinline__ unsigned xb_xcc_id() { return (unsigned)__builtin_amdgcn_s_getreg((3 << 11) | 20) & 0xFu; }
#define XB_SPIN(cond, bar) do { unsigned _sp = 0; while (cond) { __builtin_amdgcn_s_sleep(1); \
    if ((++_sp & 255u) == 0u) { if (xb_ld(&(bar)[XB_TMO])) break; if (_sp > XB_SPIN_CAP) { atomicAdd(&(bar)[XB_TMO], 1u); break; } } } } while (0)

struct XcdBarrier {
    unsigned* bar; unsigned x;
    volatile LAS unsigned* st;
};

__device__ __forceinline__ XcdBarrier xcd_barrier_post(unsigned* bar, volatile LAS unsigned* st) {
    XcdBarrier b; b.bar = bar; b.x = xb_xcc_id(); b.st = st;
    if (threadIdx.x == 0) (void)xb_add(&bar[XB_XCNT(b.x)], 1u);
    return b;
}
__device__ __forceinline__ void xcd_barrier_complete(unsigned* bar, unsigned x, unsigned& nloc, unsigned& nx) {
    const unsigned G = gridDim.x * gridDim.y * gridDim.z;
    unsigned sum, cnt, mine, sp = 0u;
    for (;;) {
        sum = 0u; cnt = 0u; mine = 0u;
#pragma unroll
        for (unsigned j = 0; j < 16; ++j) { const unsigned c = xb_ld(&bar[XB_XCNT(j)]); sum += c; cnt += (c > 0u) ? 1u : 0u; mine = (j == x) ? c : mine; }
        if (sum == G) break;
        __builtin_amdgcn_s_sleep(1);
        if ((++sp & 255u) == 0u) { if (xb_ld(&bar[XB_TMO])) break; if (sp > XB_SPIN_CAP) { atomicAdd(&bar[XB_TMO], 1u); break; } }
    }
    nloc = mine > 0u ? mine : 1u; nx = cnt > 0u ? cnt : 1u;
}

__device__ __forceinline__ void xcd_barrier(const XcdBarrier& b) {
    asm volatile("s_waitcnt vmcnt(0)" ::: "memory");
    __syncthreads();
    if (threadIdx.x == 0) {
        unsigned zb_; asm volatile("v_mov_b32 %0, 0" : "=v"(zb_));
        unsigned* bar = (unsigned*)((unsigned char*)b.bar + zb_);
        __builtin_amdgcn_s_waitcnt(0);
        unsigned nloc = b.st[0], nx = b.st[1];
        if (nloc == 0u) { xcd_barrier_complete(bar, b.x, nloc, nx); b.st[0] = nloc; b.st[1] = nx; }
        const unsigned old = xb_add(&bar[XB_XSUB(b.x)], 1u);
        const unsigned gen = old / nloc;
        if (old + 1u == (gen + 1u) * nloc) {
            __builtin_amdgcn_fence(__ATOMIC_RELEASE, "agent");
            asm volatile("s_waitcnt vmcnt(0)" ::: "memory");
            const unsigned og = xb_add(&bar[XB_TOP], 1u);
            const unsigned tg = og / nx;
            if (og + 1u == (tg + 1u) * nx) xb_add(&bar[XB_TOPGEN], 1u);
            else XB_SPIN(xb_ld(&bar[XB_TOPGEN]) == tg, bar);
            __builtin_amdgcn_fence(__ATOMIC_ACQUIRE, "agent");
            xb_add(&bar[XB_XGEN(b.x)], 1u);
            asm volatile("s_waitcnt vmcnt(0)" ::: "memory");
        } else {
            XB_SPIN(xb_ld(&bar[XB_XGEN(b.x)]) == gen, bar);
            __builtin_amdgcn_fence(__ATOMIC_ACQUIRE, "agent");
            asm volatile("s_waitcnt vmcnt(0)" ::: "memory");
        }
    }
    __syncthreads();
}

DI float lx_f(float v, int src) { return __builtin_bit_cast(float, __builtin_amdgcn_ds_bpermute(src << 2, __builtin_bit_cast(int, v))); }
DI int lx_i(int v, int src) { return __builtin_amdgcn_ds_bpermute(src << 2, v); }
template <int CTRL> DI float dppf(float v) { return __builtin_bit_cast(float, __builtin_amdgcn_update_dpp(0, __builtin_bit_cast(int, v), CTRL, 0xf, 0xf, false)); }
DI float dx1(float v) { return dppf<0xB1>(v); }
DI float dx2(float v) { return dppf<0x4E>(v); }
DI float sum8(float v) { v += dx1(v); v += dx2(v); v += dppf<0x141>(v); return v; }
DI float wave_sum(float v, int lane) {
    (void)lane; v = sum8(v); v += dppf<0x140>(v);
    const float a = __builtin_bit_cast(float, __builtin_amdgcn_readlane(__builtin_bit_cast(int, v), 0)), b = __builtin_bit_cast(float, __builtin_amdgcn_readlane(__builtin_bit_cast(int, v), 16));
    const float c = __builtin_bit_cast(float, __builtin_amdgcn_readlane(__builtin_bit_cast(int, v), 32)), d = __builtin_bit_cast(float, __builtin_amdgcn_readlane(__builtin_bit_cast(int, v), 48));
    return (a + b) + (c + d);
}
DI float wave_max(float v, int lane) {
#pragma unroll
    for (int o = 1; o < 64; o <<= 1) v = fmaxf(v, lx_f(v, lane ^ o));
    return v;
}
DI float wave_incl_sum(float v, int lane) {
#pragma unroll
    for (int o = 1; o < 64; o <<= 1) { const float t = lx_f(v, lane - o); if (lane >= o) v += t; }
    return v;
}
DI float wave_incl_max(float v, int lane) {
#pragma unroll
    for (int o = 1; o < 64; o <<= 1) { const float t = lx_f(v, lane - o); if (lane >= o) v = fmaxf(v, t); }
    return v;
}
template <int NT, int KS> DI void mma_tile(f32x4 (&acc)[NT], const LAS bf16_t* A, int lda, const LAS bf16_t* Bt, int ldb, int lane) {
    const int fr = lane & 15, fq = lane >> 4;
#pragma unroll
    for (int ks = 0; ks < KS; ++ks) {
        const bf16x8 a = *(const LAS bf16x8*)(A + fr * lda + ks * 32 + fq * 8);
#pragma unroll
        for (int nt = 0; nt < NT; ++nt) {
            const bf16x8 b = *(const LAS bf16x8*)(Bt + (nt * 16 + fr) * ldb + ks * 32 + fq * 8);
            acc[nt] = __builtin_amdgcn_mfma_f32_16x16x32_bf16(a, b, acc[nt], 0, 0, 0);
        }
    }
}

struct Ctx {
    LAS unsigned char* lds;
    unsigned char* ws;
    const float* const* in;
    float* out;
    int tid, lane, wave, G, bx;
};
#define INP(k) ((const float*)(const GAS float*)C.in[k])
DI unsigned char* opaque_ptr(unsigned char* q) { unsigned lo = (unsigned)(uintptr_t)q, hi = (unsigned)((uintptr_t)q >> 32); lo = (unsigned)__builtin_amdgcn_readfirstlane((int)lo); hi = (unsigned)__builtin_amdgcn_readfirstlane((int)hi);
    asm volatile("" : "+s"(lo), "+s"(hi)); return (unsigned char*)(GAS unsigned char*)(((uintptr_t)hi << 32) | (uintptr_t)lo); }
DI Ctx launder(const Ctx& C0) { Ctx C = C0; unsigned m = ~0u; asm volatile("" : "+s"(m));
    { const LAS unsigned* pw = (const LAS unsigned*)(unsigned)(MISC_OFF + 64);
      unsigned w0 = pw[0], w1 = pw[1], o0 = pw[2], o1 = pw[3]; asm volatile("" : "+v"(w0), "+v"(w1), "+v"(o0), "+v"(o1));
      w0 = (unsigned)__builtin_amdgcn_readfirstlane((int)w0); w1 = (unsigned)__builtin_amdgcn_readfirstlane((int)w1); o0 = (unsigned)__builtin_amdgcn_readfirstlane((int)o0); o1 = (unsigned)__builtin_amdgcn_readfirstlane((int)o1);
      C.ws = (unsigned char*)(GAS unsigned char*)(((uintptr_t)w1 << 32) | (uintptr_t)w0); C.out = (float*)(GAS float*)(((uintptr_t)o1 << 32) | (uintptr_t)o0); }
    C.lane = (int)__builtin_amdgcn_mbcnt_hi(m, __builtin_amdgcn_mbcnt_lo(m, 0u)); C.tid = (C0.wave << 6) | C.lane; return C; }

struct MapId { DI int operator()(int c) const { return c; } };
struct MapTile { DI int operator()(int c) const { const int t = c & 255; return (c & ~255) + 128 * ((t >> 5) & 1) + 32 * (t >> 6) + (t & 31); } };
struct MapCat { DI int operator()(int c) const { const int t = c & 255; return (c & ~255) + ((t >> 3) & 1) * 128 + (t >> 6) * 32 + ((t >> 4) & 3) * 8 + (t & 7); } };
struct MapE1 { DI int operator()(int c) const { const int j = c >> 1; return (j >> 7) * 256 + (c & 1) * 128 + (j & 127); } };
template <class Map> DI void tr_item(const float* W, int K, int N, bf16_t* WT, LAS float* scr, int kb, int nb, int lane, Map map, int ldw) {
    const int k0 = 64 * kb, n0 = 64 * nb;
    const bool nv = (n0 + lane) < N;
    const float* src = W + (size_t)k0 * N + n0 + lane;
#pragma unroll 8
    for (int i = 0; i < 64; ++i) scr[i * 65 + lane] = nv ? src[(size_t)i * N] : 0.f;
    LDS_WAIT(); asm volatile("" ::: "memory");
    const int c = lane & 7;
#pragma unroll
    for (int j = 0; j < 8; ++j) {
        const int n = (lane >> 3) + 8 * j;
        if (n0 + n < N) {
            const LAS float* s = scr + (8 * c) * 65 + n;
            v4u o; o.x = pk2(s[0], s[65]); o.y = pk2(s[130], s[195]); o.z = pk2(s[260], s[325]); o.w = pk2(s[390], s[455]);
            *(v4u*)(WT + (size_t)map(n0 + n) * ldw + k0 + 8 * c) = o;
        }
    }
    LDS_WAIT(); asm volatile("" ::: "memory");
}
template <bool EDGE, class Map> DI void tr_item8_(const float* W, int K, int N, unsigned char* WT, LAS float* scr, int k0, int n0, int lane, Map map, float scale) {
    const bool nv = !EDGE || (n0 + lane) < N;
    const float* src = W + (size_t)k0 * N + n0 + (nv ? lane : 0);
    { float t[64];
#pragma unroll
        for (int i = 0; i < 64; ++i) t[i] = src[(size_t)i * N];
        __builtin_amdgcn_sched_barrier(0);
#pragma unroll
        for (int i = 0; i < 64; ++i) scr[i * 65 + lane] = t[i]; }
    LDS_WAIT(); asm volatile("" ::: "memory");
    const int c = lane & 3;
#pragma unroll
    for (int j = 0; j < 4; ++j) {
        const int n = (lane >> 2) + 16 * j;
        const LAS float* s = scr + (16 * c) * 65 + n;
        v4u o;
        o.x = pk4_fp8(s[0] * scale, s[65] * scale, s[130] * scale, s[195] * scale); o.y = pk4_fp8(s[260] * scale, s[325] * scale, s[390] * scale, s[455] * scale);
        o.z = pk4_fp8(s[520] * scale, s[585] * scale, s[650] * scale, s[715] * scale); o.w = pk4_fp8(s[780] * scale, s[845] * scale, s[910] * scale, s[975] * scale);
        if (!EDGE || n0 + n < N) *(v4u*)(WT + (size_t)map(n0 + n) * K + k0 + 16 * c) = o;
    }
    LDS_WAIT(); asm volatile("" ::: "memory");
}
template <class Map> DI void tr_item8(const float* W, int K, int N, unsigned char* WT, LAS float* scr, int kb, int nb, int lane, Map map, float scale) {
    if (64 * nb + 64 <= N) tr_item8_<false>(W, K, N, WT, scr, 64 * kb, 64 * nb, lane, map, scale); else tr_item8_<true>(W, K, N, WT, scr, 64 * kb, 64 * nb, lane, map, scale);
}
struct It8 { const float* src; unsigned char* dst; int N, K, k0, n0; bool e1, edge, cat; };
DI void ld8(const It8& d, float (&t)[64], int lane) {
    const bool nv = !d.edge || (d.n0 + lane) < d.N;
    const float* s = d.src + (size_t)d.k0 * d.N + d.n0 + (nv ? lane : 0);
#pragma unroll
    for (int i = 0; i < 64; ++i) t[i] = s[(size_t)i * d.N];
}
DI void st8i(const It8& d, const float (&t)[64], LAS float* scr, int lane, float scale) {
#pragma unroll
    for (int i = 0; i < 64; ++i) scr[i * 65 + lane] = t[i];
    LDS_WAIT(); asm volatile("" ::: "memory");
    const int c = lane & 3;
#pragma unroll
    for (int j = 0; j < 4; ++j) {
        const int n = (lane >> 2) + 16 * j;
        const LAS float* s = scr + (16 * c) * 65 + n;
        v4u o;
        o.x = pk4_fp8(s[0] * scale, s[65] * scale, s[130] * scale, s[195] * scale); o.y = pk4_fp8(s[260] * scale, s[325] * scale, s[390] * scale, s[455] * scale);
        o.z = pk4_fp8(s[520] * scale, s[585] * scale, s[650] * scale, s[715] * scale); o.w = pk4_fp8(s[780] * scale, s[845] * scale, s[910] * scale, s[975] * scale);
        const int col = d.n0 + n, row = d.e1 ? MapE1()(col) : d.cat ? MapCat()(col) : col;
        if (!d.edge || col < d.N) *(v4u*)(d.dst + (size_t)row * d.K + d.k0 + 16 * c) = o;
    }
    LDS_WAIT(); asm volatile("" ::: "memory");
}
DI void p0_prologue(const Ctx& C) {
    __syncthreads();
    {
        LAS float* sc = (LAS float*)(C.lds + RING_OFF);
        LAS float* red = (LAS float*)(C.lds + RING_OFF + 9 * 1024 * 4);
        for (int i = C.tid; i < 9 * 1024; i += 512) { const float v = (i < 8192) ? INP(I_C)[i] : INP(I_CCTX)[i - 8192]; sc[i] = silu_f(v); }
        __syncthreads();
        float* MOD = (float*)(C.ws + WS_MOD);
        for (int u = C.bx; u < DEPTH * 96; u += C.G) {
            const int l = u / 96, cg = u % 96, ci = C.tid & 63, kg = C.tid >> 6;
            const float* w = INP(I_WADA) + ((size_t)l * 1024 + kg * 128) * 6144 + cg * 64 + ci;
            float s[9];
#pragma unroll
            for (int b = 0; b < 9; ++b) s[b] = 0.f;
#pragma unroll 16
            for (int k = 0; k < 128; ++k) { const float wv = w[(size_t)k * 6144];
#pragma unroll
                for (int b = 0; b < 9; ++b) s[b] += sc[b * 1024 + kg * 128 + k] * wv; }
#pragma unroll
            for (int b = 0; b < 9; ++b) red[(kg * 9 + b) * 64 + ci] = s[b];
            __syncthreads();
            for (int o = C.tid; o < 9 * 64; o += 512) { const int b = o >> 6, c2 = o & 63; float t = 0.f;
#pragma unroll
                for (int g = 0; g < 8; ++g) t += red[(g * 9 + b) * 64 + c2];
                MOD[((size_t)l * 9 + b) * 6144 + cg * 64 + c2] = t + INP(I_BADA)[l * 6144 + cg * 64 + c2]; }
            __syncthreads();
        }
    }
    {
        LAS float* scr = (LAS float*)(C.lds + RING_OFF + C.wave * 16640);
        const int gw = C.bx * 8 + C.wave, NGW = C.G * 8;
        constexpr int IT_IN = 16 * 109, IT_BR = 8 * 16, IT_OUT = 16 * 16, IT_E1 = 16 * 32, IT_E2 = 16 * 16;
        constexpr int N0 = DEPTH * IT_IN, N1 = N0 + DEPTH * 3 * IT_BR, N2 = N1 + DEPTH * IT_OUT, N3 = N2 + DEPTH * NEXP * IT_E1, N4 = N3 + DEPTH * NEXP * IT_E2;
        for (int it = N0 + gw; it < N2; it += NGW) {
            if (it < N1) { const int q = it - N0, m = q / IT_BR, r = q % IT_BR; tr_item(INP(I_WBR) + (size_t)m * 512 * DM, 512, DM, (bf16_t*)(C.ws + WS_WTBR) + (size_t)(m / 3) * DM * 1536 + (m % 3) * 512, scr, r / 16, r % 16, C.lane, MapId(), 1536); }
            else { const int q = it - N1, m = q / IT_OUT, r = q % IT_OUT; tr_item(INP(I_WOUT) + (size_t)m * DM * DM, DM, DM, (bf16_t*)(C.ws + WS_WTOUT) + (size_t)m * DM * DM, scr, r / 16, r % 16, C.lane, MapCat(), DM); }
        }
        constexpr int NJ = N0 + (N4 - N2);
        auto dec8 = [&](int j) -> It8 { It8 d;
            if (j < N0) { const int m = j / IT_IN, r = j % IT_IN; d.src = INP(I_WIN) + (size_t)m * DM * IN_W; d.dst = (unsigned char*)(C.ws + WS_WTIN) + (size_t)m * PW * DM; d.N = IN_W; d.K = DM; d.k0 = 64 * (r / 109); d.n0 = 64 * (r % 109); d.e1 = false; d.cat = false; d.edge = (d.n0 + 64 > IN_W); }
            else { const int it = j - N0 + N2;
                if (it < N3) { const int q = it - N2, m = q / IT_E1, r = q % IT_E1; d.src = INP(I_WE1) + (size_t)m * DM * 2048; d.dst = (unsigned char*)(C.ws + WS_WTE1) + (size_t)m * 2048 * DM; d.N = 2048; d.K = DM; d.k0 = 64 * (r / 32); d.n0 = 64 * (r % 32); d.e1 = true; d.cat = false; d.edge = false; }
                else { const int q = it - N3, m = q / IT_E2, r = q % IT_E2; d.src = INP(I_WE2) + (size_t)m * DFF * DM; d.dst = (unsigned char*)(C.ws + WS_WTE2) + (size_t)m * DM * DFF; d.N = DM; d.K = DFF; d.k0 = 64 * (r / 16); d.n0 = 64 * (r % 16); d.e1 = false; d.cat = true; d.edge = false; } }
            return d; };
        It8 d0, d1; float t0[64], t1[64];
        int j = gw;
        if (j < NJ) { d0 = dec8(j); ld8(d0, t0, C.lane); }
        for (; j < NJ; j += 2 * NGW) {
            const int j1 = j + NGW, j2 = j1 + NGW;
            if (j1 < NJ) { d1 = dec8(j1); ld8(d1, t1, C.lane); }
            st8i(d0, t0, scr, C.lane, FP8_SW);
            if (j2 < NJ) { d0 = dec8(j2); ld8(d0, t0, C.lane); }
            if (j1 < NJ) st8i(d1, t1, scr, C.lane, FP8_SW);
        }
    }
}

DI void phase_norm1(const Ctx& C, int l, float pscale) {
    const int gw = C.bx * 8 + C.wave, NGW = C.G * 8, lane = C.lane;
    bf16_t* X = (bf16_t*)(C.ws + WS_X); unsigned char* H8 = (unsigned char*)(C.ws + WS_H);
    const float* MOD = (const float*)(C.ws + WS_MOD);
    const int* TOKP = (const int*)(C.ws + WS_TOKP); const int* TOKE = (const int*)(C.ws + WS_TOKE); const float* TOKW = (const float*)(C.ws + WS_TOKW); const bf16_t* YS = (const bf16_t*)(C.ws + WS_YS); const unsigned char* U = (const unsigned char*)(C.ws + WS_U);
    LAS float* BL = (LAS float*)(C.lds + RING_OFF);
    const bool fin = (l == DEPTH);
    const int nrows = fin ? M_LAT : MROWS;
    const int rpw = (nrows + NGW - 1) / NGW, rbeg = gw * rpw, rend = (rbeg + rpw < nrows) ? rbeg + rpw : nrows;
    f32x4 gn[4];
#pragma unroll
    for (int j = 0; j < 4; ++j) gn[j] = *(const f32x4*)((fin ? INP(I_GF) : INP(I_GN1) + (size_t)l * DM) + (lane + 64 * j) * 4);
    __syncthreads();
    if (l > 0) { const float* b2 = INP(I_BE2) + (size_t)(l - 1) * NEXP * DM;
#pragma unroll 4
        for (int i = C.tid; i < NEXP * DM / 4; i += 512) *(LAS f32x4*)(BL + i * 4) = *(const f32x4*)(b2 + i * 4); }
    __syncthreads();
    int mi_cur = -1; f32x4 g2v[4], g1v[4], s1v[4], s0v[4];
    int4 sl = make_int4(0, 0, 0, 0); v2u xr[4];
    if (rbeg < rend) {
        if (l > 0) { sl = *(const int4*)(TOKP + (size_t)rbeg * 4);
#pragma unroll
            for (int j = 0; j < 4; ++j) xr[j] = *(const v2u*)(X + (size_t)rbeg * DM + (lane + 64 * j) * 4); }
    }
    for (int r = rbeg; r < rend; ++r) {
        const int mi = r < M_LAT ? (r >> 12) : 8;
        if (mi != mi_cur) {
            mi_cur = mi;
#pragma unroll
            for (int j = 0; j < 4; ++j) { const int c = (lane + 64 * j) * 4;
                g2v[j] = (l > 0) ? *(const f32x4*)(MOD + ((size_t)(l - 1) * 9 + mi) * 6144 + 5 * DM + c) * pscale : (f32x4){0.f, 0.f, 0.f, 0.f};
                g1v[j] = (l > 0) ? *(const f32x4*)(MOD + ((size_t)(l - 1) * 9 + mi) * 6144 + 2 * DM + c) * pscale : (f32x4){0.f, 0.f, 0.f, 0.f};
                if (!fin) { s0v[j] = *(const f32x4*)(MOD + ((size_t)l * 9 + mi) * 6144 + c); s1v[j] = *(const f32x4*)(MOD + ((size_t)l * 9 + mi) * 6144 + DM + c) + 1.0f; } }
        }
        f32x4 v[4];
        if (l == 0) {
            const float* src = r < M_LAT ? INP(I_X) + (size_t)r * DM : INP(I_CTX) + (size_t)(r - M_LAT) * DM;
#pragma unroll
            for (int j = 0; j < 4; ++j) v[j] = *(const f32x4*)(src + (lane + 64 * j) * 4);
        } else {
            const unsigned char* y0 = (const unsigned char*)YS + (size_t)sl.x * DM; const unsigned char* y1 = (const unsigned char*)YS + (size_t)sl.y * DM; const unsigned char* y2 = (const unsigned char*)YS + (size_t)sl.z * DM; const unsigned char* y3 = (const unsigned char*)YS + (size_t)sl.w * DM;
            const int4 ce = *(const int4*)(TOKE + (size_t)r * 4); const f32x4 cw = *(const f32x4*)(TOKW + (size_t)r * 4);
            unsigned ya[4], yb[4], yc[4], yd[4];
#pragma unroll
            for (int j = 0; j < 4; ++j) { const int c = (lane + 64 * j) * 4; ya[j] = *(const unsigned*)(y0 + c); yb[j] = *(const unsigned*)(y1 + c); yc[j] = *(const unsigned*)(y2 + c); yd[j] = *(const unsigned*)(y3 + c); }
#pragma unroll
            for (int j = 0; j < 4; ++j) { const unsigned uu = *(const unsigned*)(U + (size_t)r * DM + (lane + 64 * j) * 4); const v2u xx = xr[j]; v[j] = (f32x4){bf2f(xx.x & 0xffffu), bf2f(xx.x >> 16), bf2f(xx.y & 0xffffu), bf2f(xx.y >> 16)} + g1v[j] * unpack4_fp8(uu, 1.0f / FP8_SU); }
            if (r + 1 < rend) { sl = *(const int4*)(TOKP + (size_t)(r + 1) * 4);
#pragma unroll
                for (int j = 0; j < 4; ++j) xr[j] = *(const v2u*)(X + (size_t)(r + 1) * DM + (lane + 64 * j) * 4); }
#pragma unroll
            for (int j = 0; j < 4; ++j) {
                const unsigned a = ya[j], b = yb[j], cc = yc[j], d = yd[j]; const int c = (lane + 64 * j) * 4;
                const f32x4 b0 = *(const LAS f32x4*)(BL + ce.x * DM + c), b1 = *(const LAS f32x4*)(BL + ce.y * DM + c), b2v = *(const LAS f32x4*)(BL + ce.z * DM + c), b3 = *(const LAS f32x4*)(BL + ce.w * DM + c);
#define Y8(w_) ((f32x4){__builtin_amdgcn_cvt_pk_f32_fp8((int)(w_), false)[0], __builtin_amdgcn_cvt_pk_f32_fp8((int)(w_), false)[1], __builtin_amdgcn_cvt_pk_f32_fp8((int)(w_), true)[0], __builtin_amdgcn_cvt_pk_f32_fp8((int)(w_), true)[1]} * (1.0f / FP8_SY))
                const f32x4 fa = Y8(a), fb = Y8(b), fc = Y8(cc), fd = Y8(d);
#undef Y8
                const f32x4 f = (((fa + b0) * cw[0] + (fb + b1) * cw[1]) + (fc + b2v) * cw[2]) + (fd + b3) * cw[3];
                v[j] = v[j] + g2v[j] * f;
            }
        }
        if (!fin) {
#pragma unroll
            for (int j = 0; j < 4; ++j) { v2u o; o.x = pk2(v[j][0], v[j][1]); o.y = pk2(v[j][2], v[j][3]); *(v2u*)(X + (size_t)r * DM + (lane + 64 * j) * 4) = o; }
        }
        float ss = 0.f;
#pragma unroll
        for (int j = 0; j < 4; ++j) ss += (v[j][0] * v[j][0] + v[j][1] * v[j][1]) + (v[j][2] * v[j][2] + v[j][3] * v[j][3]);
        const float rstd = __builtin_amdgcn_rsqf(wave_sum(ss, lane) * (1.0f / DM) + EPS);
        if (fin) {
#pragma unroll
            for (int j = 0; j < 4; ++j) *(f32x4*)(C.out + (size_t)r * DM + (lane + 64 * j) * 4) = v[j] * rstd * gn[j];
        } else {
#pragma unroll
            for (int j = 0; j < 4; ++j) {
                const int c = (lane + 64 * j) * 4;
                const f32x4 h = v[j] * rstd * gn[j] * s1v[j] + s0v[j];
                *(unsigned*)(H8 + (size_t)r * DM + c) = pk4_fp8(h[0] * FP8_SH, h[1] * FP8_SH, h[2] * FP8_SH, h[3] * FP8_SH);
            }
        }
    }
}

DI void rope_cs(float (&c)[8], float (&s)[8], const float (&freq)[8], int lane, int t) {
    const int sub = lane & 7;
    const float pos = (sub >= 4) ? (float)(t & 63) : (float)(t >> 6);
#pragma unroll
    for (int e = 0; e < 8; ++e) { float rev = pos * freq[e]; rev -= floorf(rev); c[e] = __builtin_amdgcn_cosf(rev); s[e] = __builtin_amdgcn_sinf(rev); }
}
DI void rope_apply(float (&x)[8], const float (&c)[8], const float (&s)[8], int lane) {
    const bool second = (lane & 2) != 0;
#pragma unroll
    for (int e = 0; e < 8; ++e) { const float other = dx2(x[e]); x[e] = second ? (x[e] * c[e] + other * s[e]) : (x[e] * c[e] - other * s[e]); }
}
DI void phase_attn_prep(const Ctx& C, int l) {
    const int gw = C.bx * 8 + C.wave, NGW = C.G * 8, lane = C.lane;
    const bf16_t* P = (const bf16_t*)(C.ws + WS_P);
    bf16_t* QR = (bf16_t*)(C.ws + WS_QR); bf16_t* KR = (bf16_t*)(C.ws + WS_KR); bf16_t* VR = (bf16_t*)(C.ws + WS_VR);
    float gq[8], gk[8], freq[8];
#pragma unroll
    for (int e = 0; e < 8; ++e) { gq[e] = INP(I_BQG)[l * 64 + (lane & 7) * 8 + e]; gk[e] = INP(I_BKG)[l * 64 + (lane & 7) * 8 + e];
        freq[e] = __builtin_amdgcn_exp2f(-(float)((lane & 1) * 8 + e) * 0.83048202372184058696f) * 0.15915494309189533577f; }
    constexpr float C2 = 0.125f * 1.4426950408889634f;
    const int kl = lane & 15;
    v4u nq = {0u, 0u, 0u, 0u}, nk = nq, nv = nq;
    if (gw < MROWS) { const bf16_t* prow = P + (size_t)gw * PW; nq = *(const v4u*)(prow + C_BQ + lane * 8); nk = *(const v4u*)(prow + C_BK + kl * 8); nv = *(const v4u*)(prow + C_BV + kl * 8); }
    for (int r = gw; r < MROWS; r += NGW) {
        const bool lat = r < M_LAT;
        const int b = lat ? (r >> 12) : ((r - M_LAT) >> 8), t = lat ? (r & 4095) : ((r - M_LAT) & 255), kvpos = lat ? (CTXL + t) : t;
        const v4u cq = nq, ck = nk, cv = nv;
        if (r + NGW < MROWS) { const bf16_t* prow = P + (size_t)(r + NGW) * PW; nq = *(const v4u*)(prow + C_BQ + lane * 8); nk = *(const v4u*)(prow + C_BK + kl * 8); nv = *(const v4u*)(prow + C_BV + kl * 8); }
        float rc[8], rs[8];
        if (lat) rope_cs(rc, rs, freq, lane, t);
        float x[8];
        unpack8(cq, x);
        float ss = 0.f;
#pragma unroll
        for (int e = 0; e < 8; ++e) ss += x[e] * x[e];
        ss = sum8(ss);
        float rstd = __builtin_amdgcn_rsqf(ss * (1.0f / 64.0f) + EPS);
#pragma unroll
        for (int e = 0; e < 8; ++e) x[e] = x[e] * rstd * gq[e];
        if (lat) rope_apply(x, rc, rs, lane);
        { v4u o; o.x = pk2(x[0] * C2, x[1] * C2); o.y = pk2(x[2] * C2, x[3] * C2); o.z = pk2(x[4] * C2, x[5] * C2); o.w = pk2(x[6] * C2, x[7] * C2);
          *(v4u*)(QR + (size_t)r * 512 + lane * 8) = o; }
        unpack8(ck, x);
        ss = 0.f;
#pragma unroll
        for (int e = 0; e < 8; ++e) ss += x[e] * x[e];
        ss = sum8(ss);
        rstd = __builtin_amdgcn_rsqf(ss * (1.0f / 64.0f) + EPS);
#pragma unroll
        for (int e = 0; e < 8; ++e) x[e] = x[e] * rstd * gk[e];
        if (lat) rope_apply(x, rc, rs, lane);
        const size_t kvrow = ((size_t)b * KVLEN + kvpos) * 128;
        if (lane < 16) { v4u o; o.x = pk2(x[0], x[1]); o.y = pk2(x[2], x[3]); o.z = pk2(x[4], x[5]); o.w = pk2(x[6], x[7]); *(v4u*)(KR + kvrow + kl * 8) = o; }
        else if (lane < 32) { *(v4u*)(VR + kvrow + kl * 8) = cv; }
    }
}

constexpr int LDT = 72;
constexpr unsigned short BF16_ONE = 0x3F80;
DI int chunk_pos0(int c) { return (c < 512 ? (c & 63) : ((c - 512) & 3)) * 64; }
DI int chunk_len(int c) { return c < 512 ? SEQ : CTXL; }

struct ConvIn { v4u x0, xm, xp; };
DI void conv_load(ConvIn& r, const bf16_t* P, int row0, int t, int pos0, int seqlen, int col) {
    const bf16_t* p = P + (size_t)(row0 + t) * PW + col;
    r.x0 = *(const v4u*)p;
    r.xm = (v4u){0u, 0u, 0u, 0u}; r.xp = (v4u){0u, 0u, 0u, 0u};
    if (pos0 + t - 1 >= 0) r.xm = *(const v4u*)(p - PW);
    if (pos0 + t + 1 < seqlen) r.xp = *(const v4u*)(p + PW);
}
DI void conv_apply(const ConvIn& r, const LAS float* cwt, int c8, float (&y)[8]) {
    float xm[8], x0[8], xp[8]; unpack8(r.xm, xm); unpack8(r.x0, x0); unpack8(r.xp, xp);
#pragma unroll
    for (int hh = 0; hh < 2; ++hh) {
        const f32x4 w0 = *(const LAS f32x4*)(cwt + c8 + 4 * hh), w1 = *(const LAS f32x4*)(cwt + 64 + c8 + 4 * hh), w2 = *(const LAS f32x4*)(cwt + 128 + c8 + 4 * hh), bb = *(const LAS f32x4*)(cwt + 192 + c8 + 4 * hh);
#pragma unroll
        for (int e = 0; e < 4; ++e) y[4 * hh + e] = silu_f(xm[4 * hh + e] * w0[e] + x0[4 * hh + e] * w1[e] + xp[4 * hh + e] * w2[e] + bb[e]);
    }
}
DI void conv_table(const Ctx& C, LAS float* cwt, int l, int h) {
    const float* cw = INP(I_ACW) + (size_t)l * 3 * 512; const float* cb = INP(I_ACB) + (size_t)l * 512;
    const int qk = C.tid >> 8, row = (C.tid >> 6) & 3, ch = C.tid & 63, col = qk * 256 + h * 64 + ch;
    cwt[C.tid] = row < 3 ? cw[row * 512 + col] : cb[col];
}
DI v4u pack8f(const float (&y)[8], float sc) { v4u o; o.x = pk2(y[0] * sc, y[1] * sc); o.y = pk2(y[2] * sc, y[3] * sc); o.z = pk2(y[4] * sc, y[5] * sc); o.w = pk2(y[6] * sc, y[7] * sc); return o; }
DI void store_vt8(LAS bf16_t* VT, const v4u x, int col, int t) {
    LAS bf16_t* d = VT + col * LDT + t;
    d[0 * LDT] = (bf16_t)(x.x & 0xffffu); d[1 * LDT] = (bf16_t)(x.x >> 16); d[2 * LDT] = (bf16_t)(x.y & 0xffffu); d[3 * LDT] = (bf16_t)(x.y >> 16);
    d[4 * LDT] = (bf16_t)(x.z & 0xffffu); d[5 * LDT] = (bf16_t)(x.z >> 16); d[6 * LDT] = (bf16_t)(x.w & 0xffffu); d[7 * LDT] = (bf16_t)(x.w >> 16);
}
DI void store_ct(LAS bf16_t* CT, const f32x4 (&s)[4], int tid) {
#pragma unroll
    for (int q = 0; q < 4; ++q) {
        const int idx = tid * 4 + q * 2048, v = idx >> 6, d = idx & 63;
        v2u o; o.x = pk2(s[q][0], s[q][1]); o.y = pk2(s[q][2], s[q][3]);
        *(LAS v2u*)(CT + v * LDT + d) = o;
    }
}
template <int ACT, int HSLD> DI void head_out(const Ctx& C, const LAS float* HS, const v4u g0, const v4u g1, int row0, const float (&gain)[16], bf16_t* Y, int h) {
    const int t = C.tid >> 3, sub = C.tid & 7;
    float x[16]; float ss = 0.f;
#pragma unroll
    for (int q = 0; q < 4; ++q) { const f32x4 v = *(const LAS f32x4*)(HS + t * HSLD + sub * 16 + q * 4); x[4 * q] = v[0]; x[4 * q + 1] = v[1]; x[4 * q + 2] = v[2]; x[4 * q + 3] = v[3]; }
#pragma unroll
    for (int e = 0; e < 16; ++e) ss += x[e] * x[e];
    ss = sum8(ss);
    const float rstd = __builtin_amdgcn_rsqf(ss * (1.0f / 128.0f) + EPS);
    float ga[8], gb[8]; unpack8(g0, ga); unpack8(g1, gb);
    float o[16];
#pragma unroll
    for (int e = 0; e < 16; ++e) { const float gv = e < 8 ? ga[e] : gb[e - 8]; const float a = ACT == 0 ? sigmoid_f(gv) : silu_f(gv); o[e] = x[e] * rstd * gain[e] * a; }
    v4u w0, w1; w0.x = pk2(o[0], o[1]); w0.y = pk2(o[2], o[3]); w0.z = pk2(o[4], o[5]); w0.w = pk2(o[6], o[7]); w1.x = pk2(o[8], o[9]); w1.y = pk2(o[10], o[11]); w1.z = pk2(o[12], o[13]); w1.w = pk2(o[14], o[15]);
    bf16_t* yp = Y + (size_t)(row0 + t) * 1536 + h * 128 + sub * 16;
    *(v4u*)yp = w0; *(v4u*)(yp + 8) = w1;
}

DI unsigned char* rec_ptr(unsigned char* base, int c, int h, int dir) { return base + ((size_t)(c * 4 + h) * 2 + dir) * RECB; }
template <bool NVEC> DI void delta_store(const Ctx& C, const LAS bf16_t* KT, const LAS bf16_t* VT, unsigned char* rec) {
    const int part = C.wave & 3, fr = C.lane & 15, fq = C.lane >> 4;
    f32x4 acc[8];
#pragma unroll
    for (int nt = 0; nt < 8; ++nt) acc[nt] = (f32x4){0.f, 0.f, 0.f, 0.f};
    mma_tile<8, 2>(acc, KT + 16 * part * LDT, LDT, VT, LDT, C.lane);
    bf16_t* R = (bf16_t*)rec;
#pragma unroll
    for (int nt = 0; nt < 8; ++nt) { v2u o; o.x = pk2(acc[nt][0], acc[nt][1]); o.y = pk2(acc[nt][2], acc[nt][3]); *(v2u*)(R + (nt * 16 + fr) * 64 + 16 * part + fq * 4) = o; }
    if (NVEC) {
        f32x4 an[1]; an[0] = (f32x4){0.f, 0.f, 0.f, 0.f};
        mma_tile<1, 2>(an, KT + 16 * part * LDT, LDT, VT + 128 * LDT, LDT, C.lane);
        if (fr == 0) { float* nf = (float*)(rec + REC_VEC) + 16 * part + fq * 4; nf[0] = an[0][0]; nf[1] = an[0][1]; nf[2] = an[0][2]; nf[3] = an[0][3]; }
    }
}
DI void store_ct16(LAS bf16_t* CT, const v4u a, const v4u b, int tid) {
    { const int idx = tid * 8; *(LAS v4u*)(CT + (idx >> 6) * LDT + (idx & 63)) = a; }
    { const int idx = tid * 8 + 4096; *(LAS v4u*)(CT + (idx >> 6) * LDT + (idx & 63)) = b; }
}
constexpr int MC_QS = 0, MC_KS = 9216, MC_VT = 18432, MC_CT0 = 39168, MC_CT1 = 59904, MC_SB0 = 80640, MC_SB1 = 89856, MC_HS = 99072, MC_VEC = 132864, MC_CWT = 134912;
static_assert(MC_CWT + 2048 <= RING_BYTES, "mLSTM (c) LDS map");
constexpr int MA_VT = 0, MA_KT0 = 20736, MA_KT1 = 29952, MA_VEC = 39168, MA_CWT = 40192;
struct MARegs { ConvIn k; v4u v0, v1; float gi, gf; };
struct MCRegs { ConvIn q, k; v4u v0, v1, og0, og1, s0a, s0b, s1a, s1b; float gi, gf, aux; };
DI void mlstm_a_load(const Ctx& C, int c, int h, MARegs& R) {
    const bf16_t* P = (const bf16_t*)(C.ws + WS_P);
    const int row0 = c * 64, t = C.lane, c8 = C.wave * 8;
    conv_load(R.k, P, row0, t, chunk_pos0(c), chunk_len(c), C_AQK + 256 + h * 64 + c8);
    const bf16_t* pv = P + (size_t)(row0 + t) * PW + C_AV + h * 128 + c8;
    R.v0 = *(const v4u*)pv; R.v1 = *(const v4u*)(pv + 64);
    R.gi = 0.f; R.gf = 0.f;
    if (C.wave < 2) { const int dir = C.wave, tt = dir ? 63 - C.lane : C.lane; const bf16_t* prow = P + (size_t)(row0 + tt) * PW; R.gi = bf2f(prow[C_AI + dir * 4 + h]); R.gf = bf2f(prow[C_AF + dir * 4 + h]); }
}
DI void mlstm_a_unit(const Ctx& C0, int l, int c, int h, MARegs& R, bool has_next, int cn, int hn) {
    Ctx C = C0; { int t_ = C0.tid; asm volatile("" : "+v"(t_)); C.tid = t_; C.lane = t_ & 63; }
    LAS unsigned char* L = C.lds + RING_OFF;
    LAS bf16_t* VT = (LAS bf16_t*)(L + MA_VT); LAS bf16_t* KT0 = (LAS bf16_t*)(L + MA_KT0); LAS bf16_t* KT1 = (LAS bf16_t*)(L + MA_KT1); LAS float* VEC = (LAS float*)(L + MA_VEC);
    unsigned char* rec0 = rec_ptr(C.ws + WS_STA, c, h, 0);
    const int t = C.lane, c8 = C.wave * 8;
    __syncthreads();
    if (C.wave < 2) {
        const int dir = C.wave, tt = dir ? 63 - C.lane : C.lane;
        const float* gb = INP(I_AGB) + l * 16;
        const float iv = R.gi + gb[dir * 4 + h], fv = logsigmoid_f(R.gf + gb[8 + dir * 4 + h]);
        const float b = wave_incl_sum(fv, C.lane);
        const float B = lx_f(b, 63);
        const float a = B - b + iv;
        const float Ml = wave_max(a, C.lane);
        VEC[dir * 64 + tt] = __expf(a - Ml);
        if (C.lane == 0) { float* sf = (float*)(rec0 + dir * RECB + REC_VEC); sf[64] = B; sf[65] = Ml; }
    }
    float y[8]; conv_apply(R.k, (const LAS float*)(L + MA_CWT) + 256, c8, y);
    store_vt8(VT, R.v0, c8, t); store_vt8(VT, R.v1, 64 + c8, t);
    if (C.tid < 64) VT[128 * LDT + C.tid] = BF16_ONE;
    asm volatile("" ::: "memory"); __builtin_amdgcn_sched_barrier(0);
    if (has_next) mlstm_a_load(C, cn, hn, R);
    asm volatile("" ::: "memory"); __builtin_amdgcn_sched_barrier(0);
    __syncthreads();
    {
        const float w0 = VEC[t] * 0.125f, w1 = VEC[64 + t] * 0.125f;
#pragma unroll
        for (int e = 0; e < 8; ++e) { const unsigned pw = pk2(y[e] * w0, y[e] * w1); KT0[(c8 + e) * LDT + t] = (bf16_t)pw; KT1[(c8 + e) * LDT + t] = (bf16_t)(pw >> 16); }
    }
    __syncthreads();
    delta_store<true>(C, (C.wave >> 2) ? KT1 : KT0, VT, rec0 + (C.wave >> 2) * RECB);
}
DI void mlstm_a_phase(const Ctx& C, int l) {
    LAS float* cwt = (LAS float*)(C.lds + RING_OFF + MA_CWT);
    int htab = -1; MARegs R;
    int u = C.bx; if (u < NCHUNK * 4) mlstm_a_load(C, u >> 2, u & 3, R);
    for (; u < NCHUNK * 4; u += C.G) {
        const int h = u & 3, un = u + C.G;
        if (h != htab) { __syncthreads(); conv_table(C, cwt, l, h); htab = h; }
        mlstm_a_unit(C, l, u >> 2, h, R, un < NCHUNK * 4, un >> 2, un & 3);
    }
}
DI void mlstm_c_load(const Ctx& C, int c, int h, MCRegs& R) {
    const bf16_t* P = (const bf16_t*)(C.ws + WS_P);
    const int row0 = c * 64, t = C.lane, c8 = C.wave * 8, pos0 = chunk_pos0(c), len = chunk_len(c);
    conv_load(R.q, P, row0, t, pos0, len, C_AQK + h * 64 + c8);
    conv_load(R.k, P, row0, t, pos0, len, C_AQK + 256 + h * 64 + c8);
    const bf16_t* pr = P + (size_t)(row0 + t) * PW;
    R.v0 = *(const v4u*)(pr + C_AV + h * 128 + c8); R.v1 = *(const v4u*)(pr + C_AV + h * 128 + 64 + c8);
    { const bf16_t* po = P + (size_t)(row0 + (C.tid >> 3)) * PW + C_AO + h * 128 + (C.tid & 7) * 16; R.og0 = *(const v4u*)po; R.og1 = *(const v4u*)(po + 8); }
    const unsigned char* rec0 = rec_ptr(C.ws + WS_STA, c, h, 0);
    R.s0a = *(const v4u*)(rec0 + C.tid * 16); R.s0b = *(const v4u*)(rec0 + 8192 + C.tid * 16); R.s1a = *(const v4u*)(rec0 + RECB + C.tid * 16); R.s1b = *(const v4u*)(rec0 + RECB + 8192 + C.tid * 16);
    R.gi = 0.f; R.gf = 0.f; R.aux = 0.f;
    if (C.wave < 2) { const int dir = C.wave, tt = dir ? 63 - C.lane : C.lane; const bf16_t* prow = P + (size_t)(row0 + tt) * PW; R.gi = bf2f(prow[C_AI + dir * 4 + h]); R.gf = bf2f(prow[C_AF + dir * 4 + h]); R.aux = ((const float*)(rec0 + dir * RECB + REC_VEC))[66]; }
    else if (C.wave < 4) R.aux = ((const float*)(rec0 + (C.wave - 2) * RECB + REC_VEC))[C.lane];
}
DI void mlstm_c_unit(const Ctx& C0, int l, int c, int h, MCRegs& R, const float (&gain)[16], bool has_next, int cn, int hn) {
    Ctx C = C0; { int t_ = C0.tid; asm volatile("" : "+v"(t_)); C.tid = t_; C.lane = t_ & 63; }
    LAS unsigned char* L = C.lds + RING_OFF;
    LAS bf16_t* QS = (LAS bf16_t*)(L + MC_QS); LAS bf16_t* KS = (LAS bf16_t*)(L + MC_KS); LAS bf16_t* VT = (LAS bf16_t*)(L + MC_VT);
    LAS bf16_t* CT0 = (LAS bf16_t*)(L + MC_CT0); LAS bf16_t* CT1 = (LAS bf16_t*)(L + MC_CT1); LAS bf16_t* SB0 = (LAS bf16_t*)(L + MC_SB0); LAS bf16_t* SB1 = (LAS bf16_t*)(L + MC_SB1);
    LAS float* HS = (LAS float*)(L + MC_HS); LAS float* VEC = (LAS float*)(L + MC_VEC); const LAS float* cwt = (const LAS float*)(L + MC_CWT);
    const int row0 = c * 64;
    const float aux = R.aux;
    __syncthreads();
    if (C.wave < 2) {
        const int dir = C.wave, tt = dir ? 63 - C.lane : C.lane;
        const float* gb = INP(I_AGB) + l * 16;
        const float iv = R.gi + gb[dir * 4 + h], fv = logsigmoid_f(R.gf + gb[8 + dir * 4 + h]);
        const float b = wave_incl_sum(fv, C.lane);
        const float g = iv - b;
        const float cm = wave_incl_max(g, C.lane);
        const float m0 = aux;
        const float mm = fmaxf(m0, cm);
        LAS float* V = VEC + dir * 256;
        V[tt] = g; V[64 + tt] = mm; V[128 + tt] = __expf(m0 - mm); V[192 + tt] = __expf(-(b + mm));
    } else if (C.wave < 4) { (C.wave == 3 ? CT1 : CT0)[128 * LDT + C.lane] = (bf16_t)f2bf(aux); }
    else if (C.wave == 4) VT[128 * LDT + C.lane] = BF16_ONE;
    {
        const int t = C.lane, c8 = C.wave * 8;
        float y[8];
        conv_apply(R.q, cwt, c8, y);
        *(LAS v4u*)(QS + t * LDT + c8) = pack8f(y, 1.0f);
        conv_apply(R.k, cwt + 256, c8, y);
        *(LAS v4u*)(KS + t * LDT + c8) = pack8f(y, 0.125f);
        store_vt8(VT, R.v0, c8, t); store_vt8(VT, R.v1, 64 + c8, t);
    }
    store_ct16(CT0, R.s0a, R.s0b, C.tid); store_ct16(CT1, R.s1a, R.s1b, C.tid);
    const v4u og0 = R.og0, og1 = R.og1;
    asm volatile("" ::: "memory"); __builtin_amdgcn_sched_barrier(0);
    if (has_next) mlstm_c_load(C, cn, hn, R);
    asm volatile("" ::: "memory"); __builtin_amdgcn_sched_barrier(0);
    __syncthreads();
    {
        const int mt = C.wave & 3, nh = C.wave >> 2, fr = C.lane & 15, fq = C.lane >> 4;
        f32x4 acc[2]; acc[0] = (f32x4){0.f, 0.f, 0.f, 0.f}; acc[1] = acc[0];
        mma_tile<2, 2>(acc, QS + 16 * mt * LDT, LDT, KS + 32 * nh * LDT, LDT, C.lane);
#pragma unroll
        for (int nt = 0; nt < 2; ++nt)
#pragma unroll
            for (int i = 0; i < 4; ++i) {
                const int j = 16 * mt + fq * 4 + i, s2 = 32 * nh + nt * 16 + fr;
                const float v = acc[nt][i];
                const float d0 = __expf(VEC[s2] - VEC[64 + j]), d1 = __expf(VEC[256 + s2] - VEC[256 + 64 + j]);
                const unsigned pw = pk2(s2 <= j ? v * d0 : 0.f, s2 >= j ? v * d1 : 0.f);
                SB0[j * LDT + s2] = (bf16_t)pw; SB1[j * LDT + s2] = (bf16_t)(pw >> 16);
            }
    }
    __syncthreads();
    {
        const int mt = C.wave & 3, vh = C.wave >> 2, fr = C.lane & 15, fq = C.lane >> 4;
        f32x4 hsum[4];
#pragma unroll
        for (int nt = 0; nt < 4; ++nt) hsum[nt] = (f32x4){0.f, 0.f, 0.f, 0.f};
#pragma unroll
        for (int dir = 0; dir < 2; ++dir) {
            const LAS bf16_t* CT = dir ? CT1 : CT0; const LAS bf16_t* SB = dir ? SB1 : SB0; const LAS float* V = VEC + dir * 256;
            f32x4 acc[4], den[1];
#pragma unroll
            for (int nt = 0; nt < 4; ++nt) acc[nt] = (f32x4){0.f, 0.f, 0.f, 0.f};
            den[0] = (f32x4){0.f, 0.f, 0.f, 0.f};
            mma_tile<4, 2>(acc, QS + 16 * mt * LDT, LDT, CT + 64 * vh * LDT, LDT, C.lane);
            mma_tile<1, 2>(den, QS + 16 * mt * LDT, LDT, CT + 128 * LDT, LDT, C.lane);
#pragma unroll
            for (int i = 0; i < 4; ++i) { const float w = V[128 + 16 * mt + fq * 4 + i]; den[0][i] *= w;
#pragma unroll
                for (int nt = 0; nt < 4; ++nt) acc[nt][i] *= w; }
            mma_tile<4, 2>(acc, SB + 16 * mt * LDT, LDT, VT + 64 * vh * LDT, LDT, C.lane);
            mma_tile<1, 2>(den, SB + 16 * mt * LDT, LDT, VT + 128 * LDT, LDT, C.lane);
#pragma unroll
            for (int i = 0; i < 4; ++i) {
                const float dn = lx_f(den[0][i], C.lane & 48);
                const float inv = __builtin_amdgcn_rcpf(fmaxf(fabsf(dn), V[192 + 16 * mt + fq * 4 + i]));
#pragma unroll
                for (int nt = 0; nt < 4; ++nt) hsum[nt][i] += acc[nt][i] * inv;
            }
        }
#pragma unroll
        for (int i = 0; i < 4; ++i)
#pragma unroll
            for (int nt = 0; nt < 4; ++nt) HS[(16 * mt + fq * 4 + i) * 132 + 64 * vh + nt * 16 + fr] = hsum[nt][i];
    }
    __syncthreads();
    head_out<0, 132>(C, HS, og0, og1, row0, gain, (bf16_t*)(C.ws + WS_YA), h);
}
DI void load_gain16(float (&gain)[16], const float* g, int h, int tid) {
    asm volatile("" : "+v"(tid));
#pragma unroll
    for (int q = 0; q < 4; ++q) { const f32x4 v = *(const f32x4*)(g + h * 128 + (tid & 7) * 16 + 4 * q); gain[4 * q] = v[0]; gain[4 * q + 1] = v[1]; gain[4 * q + 2] = v[2]; gain[4 * q + 3] = v[3]; }
}
DI void mlstm_c_phase(const Ctx& C, int l) {
    LAS float* cwt = (LAS float*)(C.lds + RING_OFF + MC_CWT);
    int htab = -1; MCRegs R; float gain[16];
    const int NU = (l == DEPTH - 1 ? 512 : NCHUNK) * 4;
    int u = C.bx; if (u < NU) mlstm_c_load(C, u >> 2, u & 3, R);
    for (; u < NU; u += C.G) {
        const int h = u & 3, un = u + C.G;
        if (h != htab) { __syncthreads(); conv_table(C, cwt, l, h); load_gain16(gain, INP(I_ANG) + (size_t)l * 512, h, C.tid); htab = h; }
        mlstm_c_unit(C, l, u >> 2, h, R, gain, un < NU, un >> 2, un & 3);
    }
}

constexpr int LAP = 68;
constexpr int GA_LA0 = 0, GA_LA1 = 17408, GA_VT = 34816, GA_KT0 = 53248, GA_KT1 = 62464, GA_LOW = 71680, GA_WUT0 = 76800, GA_WUT1 = 81920;
constexpr int GC_QS0 = 0, GC_QS1 = 9216, GC_VT = 18432, GC_CT0 = 36864, GC_CT1 = 55296, GC_SB0 = 73728, GC_SB1 = 82944, GC_KS0 = 92160, GC_KS1 = 101376, GC_LA0 = 110592, GC_LA1 = 128000, GC_HS = 92160;
constexpr int GC_LOW = GC_CT0, GC_WUT0 = 145408, GC_WUT1 = 145408 + 5120;
static_assert(GC_WUT1 + 5120 <= RING_BYTES && GC_HS + 64 * 128 * 4 <= GC_LA1, "GLA (c) LDS map");
constexpr int LWD = 40;
struct GARegs { v4u low, k, v0, v1; };
struct GCRegs { v4u low, q, k, v0, v1, og0, og1; };
DI void gla_wut_table(const Ctx& C, LAS bf16_t* WUT0, LAS bf16_t* WUT1, int l, int h) {
    const int dir = C.tid >> 8, dk = (C.tid >> 2) & 63, ig = C.tid & 3;
    float w[8];
    const bool live = (ig >> 1) == dir;
    const float* wu = INP(I_CWUP) + ((size_t)(l * 2 + dir) * 16 + (ig & 1) * 8) * 256 + h * 64 + dk;
#pragma unroll
    for (int e = 0; e < 8; ++e) w[e] = live ? wu[e * 256] : 0.f;
    *(LAS v4u*)((dir ? WUT1 : WUT0) + dk * LWD + ig * 8) = pack8f(w, 1.0f);
}
DI void gla_logdecay(const Ctx& C, const v4u lowreg, const float (&bu)[4], LAS float* LA0, LAS float* LA1, LAS bf16_t* LOW, const LAS bf16_t* WUT0, const LAS bf16_t* WUT1) {
    { const int t = C.tid >> 3, part = C.tid & 7; if (part < 4) *(LAS v4u*)(LOW + t * LWD + part * 8) = lowreg; }
    __syncthreads();
    {
        const int dir = C.wave >> 2, mt = C.wave & 3, fr = C.lane & 15, fq = C.lane >> 4;
        f32x4 acc[4];
#pragma unroll
        for (int nt = 0; nt < 4; ++nt) acc[nt] = (f32x4){0.f, 0.f, 0.f, 0.f};
        mma_tile<4, 1>(acc, LOW + 16 * mt * LWD, LWD, dir ? WUT1 : WUT0, LWD, C.lane);
        LAS float* LA = dir ? LA1 : LA0;
#pragma unroll
        for (int nt = 0; nt < 4; ++nt)
#pragma unroll
            for (int i = 0; i < 4; ++i) LA[(16 * mt + fq * 4 + i) * LAP + nt * 16 + fr] = logsigmoid_f(acc[nt][i] + bu[nt]) * (1.0f / 16.0f);
    }
    __syncthreads();
    if (C.wave < 2) {
        LAS float* LA = C.wave ? LA1 : LA0;
        float a[64];
#pragma unroll
        for (int q = 0; q < 64; ++q) a[q] = LA[(C.wave ? 63 - q : q) * LAP + C.lane];
#pragma unroll
        for (int q = 1; q < 64; ++q) a[q] += a[q - 1];
#pragma unroll
        for (int q = 0; q < 64; ++q) LA[(C.wave ? 63 - q : q) * LAP + C.lane] = a[q];
    }
    __syncthreads();
}
DI void gla_bias4(float (&bu)[4], const Ctx& C, int l, int h) {
    int ln = C.lane; asm volatile("" : "+v"(ln));
    const float* b = INP(I_CBUP) + (size_t)(l * 2 + (C.wave >> 2)) * 256 + h * 64 + (ln & 15);
#pragma unroll
    for (int nt = 0; nt < 4; ++nt) bu[nt] = b[nt * 16];
}
DI void gla_a_load(const Ctx& C, int c, int h, GARegs& R) {
    const bf16_t* P = (const bf16_t*)(C.ws + WS_P);
    const int t = C.lane, c8 = C.wave * 8;
    const bf16_t* pr = P + (size_t)(c * 64 + t) * PW;
    R.low = *(const v4u*)(P + (size_t)(c * 64 + (C.tid >> 3)) * PW + C_CA + (C.tid & 3) * 8);
    R.k = *(const v4u*)(pr + C_CK + h * 64 + c8);
    R.v0 = *(const v4u*)(pr + C_CV + h * 128 + c8); R.v1 = *(const v4u*)(pr + C_CV + h * 128 + 64 + c8);
}
DI void gla_a_unit(const Ctx& C0, int c, int h, GARegs& R, const float (&bu)[4], bool has_next, int cn, int hn) {
    Ctx C = C0; { int t_ = C0.tid; asm volatile("" : "+v"(t_)); C.tid = t_; C.lane = t_ & 63; }
    LAS unsigned char* L = C.lds + RING_OFF;
    LAS float* LA0 = (LAS float*)(L + GA_LA0); LAS float* LA1 = (LAS float*)(L + GA_LA1);
    LAS bf16_t* VT = (LAS bf16_t*)(L + GA_VT); LAS bf16_t* KT0 = (LAS bf16_t*)(L + GA_KT0); LAS bf16_t* KT1 = (LAS bf16_t*)(L + GA_KT1);
    unsigned char* rec0 = rec_ptr(C.ws + WS_STC, c, h, 0);
    const int t = C.lane, c8 = C.wave * 8;
    __syncthreads();
    store_vt8(VT, R.v0, c8, t); store_vt8(VT, R.v1, 64 + c8, t);
    const v4u kreg = R.k;
    gla_logdecay(C, R.low, bu, LA0, LA1, (LAS bf16_t*)(L + GA_LOW), (const LAS bf16_t*)(L + GA_WUT0), (const LAS bf16_t*)(L + GA_WUT1));
    asm volatile("" ::: "memory"); __builtin_amdgcn_sched_barrier(0);
    if (has_next) gla_a_load(C, cn, hn, R);
    asm volatile("" ::: "memory"); __builtin_amdgcn_sched_barrier(0);
    {
        float k[8]; unpack8(kreg, k);
        float l0[8], l1[8], t0[8], t1[8];
        { const f32x4 a0 = *(const LAS f32x4*)(LA0 + t * LAP + c8), a1 = *(const LAS f32x4*)(LA0 + t * LAP + c8 + 4), b0 = *(const LAS f32x4*)(LA1 + t * LAP + c8), b1 = *(const LAS f32x4*)(LA1 + t * LAP + c8 + 4);
          const f32x4 e0 = *(const LAS f32x4*)(LA0 + 63 * LAP + c8), e1 = *(const LAS f32x4*)(LA0 + 63 * LAP + c8 + 4), f0 = *(const LAS f32x4*)(LA1 + c8), f1 = *(const LAS f32x4*)(LA1 + c8 + 4);
#pragma unroll
          for (int e = 0; e < 4; ++e) { l0[e] = a0[e]; l0[4 + e] = a1[e]; l1[e] = b0[e]; l1[4 + e] = b1[e]; t0[e] = e0[e]; t0[4 + e] = e1[e]; t1[e] = f0[e]; t1[4 + e] = f1[e]; } }
#pragma unroll
        for (int e = 0; e < 8; ++e) {
            const unsigned pw = pk2(k[e] * __expf(t0[e] - l0[e]), k[e] * __expf(t1[e] - l1[e]));
            KT0[(c8 + e) * LDT + t] = (bf16_t)pw; KT1[(c8 + e) * LDT + t] = (bf16_t)(pw >> 16);
        }
        if (C.tid < 64) ((float*)(rec0 + REC_VEC))[C.tid] = __expf(LA0[63 * LAP + C.tid]);
        else if (C.tid < 128) ((float*)(rec0 + RECB + REC_VEC))[C.tid - 64] = __expf(LA1[C.tid - 64]);
    }
    __syncthreads();
    delta_store<false>(C, (C.wave >> 2) ? KT1 : KT0, VT, rec0 + (C.wave >> 2) * RECB);
}
DI void gla_a_phase(const Ctx& C, int l) {
    LAS unsigned char* L = C.lds + RING_OFF;
    int htab = -1; GARegs R; float bu[4];
    int u = C.bx + (C.G >> 1); if (u >= C.G) u -= C.G;
    if (u < NCHUNK * 4) gla_a_load(C, u >> 2, u & 3, R);
    for (; u < NCHUNK * 4; u += C.G) {
        const int h = u & 3, un = u + C.G;
        if (h != htab) { __syncthreads(); gla_wut_table(C, (LAS bf16_t*)(L + GA_WUT0), (LAS bf16_t*)(L + GA_WUT1), l, h); gla_bias4(bu, C, l, h); htab = h; }
        gla_a_unit(C, u >> 2, h, R, bu, un < NCHUNK * 4, un >> 2, un & 3);
    }
}
DI void gla_c_load(const Ctx& C, int c, int h, GCRegs& R) {
    const bf16_t* P = (const bf16_t*)(C.ws + WS_P);
    const int t = C.lane, c8 = C.wave * 8;
    const bf16_t* pr = P + (size_t)(c * 64 + t) * PW;
    R.low = *(const v4u*)(P + (size_t)(c * 64 + (C.tid >> 3)) * PW + C_CA + (C.tid & 3) * 8);
    R.q = *(const v4u*)(pr + C_CQ + h * 64 + c8); R.k = *(const v4u*)(pr + C_CK + h * 64 + c8);
    R.v0 = *(const v4u*)(pr + C_CV + h * 128 + c8); R.v1 = *(const v4u*)(pr + C_CV + h * 128 + 64 + c8);
    { const bf16_t* po = P + (size_t)(c * 64 + (C.tid >> 3)) * PW + C_CR + h * 128 + (C.tid & 7) * 16; R.og0 = *(const v4u*)po; R.og1 = *(const v4u*)(po + 8); }
}
DI void gla_c_unit(const Ctx& C0, int c, int h, GCRegs& R, const float (&bu)[4], const float (&gain)[16], bool has_next, int cn, int hn) {
    Ctx C = C0; { int t_ = C0.tid; asm volatile("" : "+v"(t_)); C.tid = t_; C.lane = t_ & 63; }
    LAS unsigned char* L = C.lds + RING_OFF;
    LAS bf16_t* QS0 = (LAS bf16_t*)(L + GC_QS0); LAS bf16_t* QS1 = (LAS bf16_t*)(L + GC_QS1); LAS bf16_t* KS0 = (LAS bf16_t*)(L + GC_KS0); LAS bf16_t* KS1 = (LAS bf16_t*)(L + GC_KS1);
    LAS bf16_t* VT = (LAS bf16_t*)(L + GC_VT); LAS bf16_t* CT0 = (LAS bf16_t*)(L + GC_CT0); LAS bf16_t* CT1 = (LAS bf16_t*)(L + GC_CT1);
    LAS bf16_t* SB0 = (LAS bf16_t*)(L + GC_SB0); LAS bf16_t* SB1 = (LAS bf16_t*)(L + GC_SB1);
    LAS float* LA0 = (LAS float*)(L + GC_LA0); LAS float* LA1 = (LAS float*)(L + GC_LA1); LAS float* HS = (LAS float*)(L + GC_HS);
    const int t = C.lane, c8 = C.wave * 8;
    const unsigned char* rec0 = rec_ptr(C.ws + WS_STC, c, h, 0);
    const v4u s1a = *(const v4u*)(rec0 + RECB + C.tid * 16), s1b = *(const v4u*)(rec0 + RECB + 8192 + C.tid * 16);
    __syncthreads();
    store_vt8(VT, R.v0, c8, t); store_vt8(VT, R.v1, 64 + c8, t);
    const v4u s0a = *(const v4u*)(rec0 + C.tid * 16), s0b = *(const v4u*)(rec0 + 8192 + C.tid * 16);
    store_ct16(CT1, s1a, s1b, C.tid);
    gla_logdecay(C, R.low, bu, LA0, LA1, (LAS bf16_t*)(L + GC_LOW), (const LAS bf16_t*)(L + GC_WUT0), (const LAS bf16_t*)(L + GC_WUT1));
    {
        float q[8], k[8], a[8], b[8];
        unpack8(R.q, q); unpack8(R.k, k);
        float lb[8];
        { const f32x4 x0 = *(const LAS f32x4*)(LA0 + t * LAP + c8), x1 = *(const LAS f32x4*)(LA0 + t * LAP + c8 + 4);
#pragma unroll
          for (int e = 0; e < 4; ++e) { lb[e] = x0[e]; lb[4 + e] = x1[e]; } }
#pragma unroll
        for (int e = 0; e < 8; ++e) { const float bb = lb[e]; a[e] = q[e] * 0.125f * __expf(bb); b[e] = k[e] * __expf(-bb); }
        *(LAS v4u*)(QS0 + t * LDT + c8) = pack8f(a, 1.0f); *(LAS v4u*)(KS0 + t * LDT + c8) = pack8f(b, 1.0f);
        { const f32x4 x0 = *(const LAS f32x4*)(LA1 + t * LAP + c8), x1 = *(const LAS f32x4*)(LA1 + t * LAP + c8 + 4);
#pragma unroll
          for (int e = 0; e < 4; ++e) { lb[e] = x0[e]; lb[4 + e] = x1[e]; } }
#pragma unroll
        for (int e = 0; e < 8; ++e) { const float bb = lb[e]; a[e] = q[e] * 0.125f * __expf(bb); b[e] = k[e] * __expf(-bb); }
        *(LAS v4u*)(QS1 + t * LDT + c8) = pack8f(a, 1.0f); *(LAS v4u*)(KS1 + t * LDT + c8) = pack8f(b, 1.0f);
    }
    store_ct16(CT0, s0a, s0b, C.tid);
    const v4u og0 = R.og0, og1 = R.og1;
    asm volatile("" ::: "memory"); __builtin_amdgcn_sched_barrier(0);
    if (has_next) gla_c_load(C, cn, hn, R);
    asm volatile("" ::: "memory"); __builtin_amdgcn_sched_barrier(0);
    __syncthreads();
    {
        const int mt = C.wave & 3, nh = C.wave >> 2, fr = C.lane & 15, fq = C.lane >> 4;
#pragma unroll
        for (int dir = 0; dir < 2; ++dir) {
            f32x4 acc[2]; acc[0] = (f32x4){0.f, 0.f, 0.f, 0.f}; acc[1] = acc[0];
            mma_tile<2, 2>(acc, (dir ? QS1 : QS0) + 16 * mt * LDT, LDT, (dir ? KS1 : KS0) + 32 * nh * LDT, LDT, C.lane);
            LAS bf16_t* SB = dir ? SB1 : SB0;
#pragma unroll
            for (int nt = 0; nt < 2; ++nt)
#pragma unroll
                for (int i = 0; i < 4; ++i) { const int j = 16 * mt + fq * 4 + i, s2 = 32 * nh + nt * 16 + fr; const bool keep = dir ? (s2 >= j) : (s2 <= j); SB[j * LDT + s2] = (bf16_t)f2bf(keep ? acc[nt][i] : 0.f); }
        }
    }
    __syncthreads();
    {
        const int mt = C.wave & 3, vh = C.wave >> 2, fr = C.lane & 15, fq = C.lane >> 4;
        f32x4 acc[4];
#pragma unroll
        for (int nt = 0; nt < 4; ++nt) acc[nt] = (f32x4){0.f, 0.f, 0.f, 0.f};
        mma_tile<4, 2>(acc, QS0 + 16 * mt * LDT, LDT, CT0 + 64 * vh * LDT, LDT, C.lane);
        mma_tile<4, 2>(acc, SB0 + 16 * mt * LDT, LDT, VT + 64 * vh * LDT, LDT, C.lane);
        mma_tile<4, 2>(acc, QS1 + 16 * mt * LDT, LDT, CT1 + 64 * vh * LDT, LDT, C.lane);
        mma_tile<4, 2>(acc, SB1 + 16 * mt * LDT, LDT, VT + 64 * vh * LDT, LDT, C.lane);
#pragma unroll
        for (int i = 0; i < 4; ++i)
#pragma unroll
            for (int nt = 0; nt < 4; ++nt) HS[(16 * mt + fq * 4 + i) * 128 + 64 * vh + nt * 16 + fr] = acc[nt][i];
    }
    __syncthreads();
    head_out<1, 128>(C, HS, og0, og1, c * 64, gain, (bf16_t*)(C.ws + WS_YA) + 1024, h);
}
DI void gla_c_phase(const Ctx& C, int l) {
    LAS unsigned char* L = C.lds + RING_OFF;
    int htab = -1; GCRegs R; float bu[4], gain[16];
    const int NU = (l == DEPTH - 1 ? 512 : NCHUNK) * 4;
    int u = C.bx + (C.G >> 1); if (u >= C.G) u -= C.G;
    if (u < NU) gla_c_load(C, u >> 2, u & 3, R);
    for (; u < NU; u += C.G) {
        const int h = u & 3, un = u + C.G;
        if (h != htab) { __syncthreads(); gla_wut_table(C, (LAS bf16_t*)(L + GC_WUT0), (LAS bf16_t*)(L + GC_WUT1), l, h); gla_bias4(bu, C, l, h); load_gain16(gain, INP(I_CNG) + (size_t)l * 512, h, C.tid); htab = h; }
        gla_c_unit(C, u >> 2, h, R, bu, gain, un < NU, un >> 2, un & 3);
    }
}

DI int chain_chunk(int b, int dir, int n) { return n < 4 ? 512 + 4 * b + (dir ? 3 - n : n) : 64 * b + (dir ? 67 - n : n - 4); }
DI void unpack8s(const v4u x, float (&f)[8]) { unpack8(x, f); }
#ifndef PROBE_SKIP
#define PROBE_SKIP 0
#endif
DI void scan_b_units(const Ctx& C, bool probe = false) {
    for (int u = C.bx; u < 256; u += C.G) {
        const int mixer = u >> 7, item = (u & 127) * 2 + (C.wave >> 2), chain = item >> 2, slab = item & 3;
        const int b = chain >> 3, h = (chain >> 1) & 3, dir = chain & 1, tl = C.tid & 255, elem = slab * 2048 + tl * 8;
        unsigned char* base = C.ws + (probe ? WS_A2 + (size_t)mixer * ((size_t)NCHUNK * 8 * RECB) : (mixer ? WS_STC : WS_STA));
        float zz = 0.f; asm volatile("" : "+v"(zz));
        float st[8];
#pragma unroll
        for (int e = 0; e < 8; ++e) st[e] = zz;
        if (mixer == 0) {
            const bool nthr = (slab == 0 && tl < 64), mthr = (slab == 0 && tl == 0);
            float m = 0.f, nst = 0.f;
            v4u d[8]; float sB[8], sM[8], dn[8];
#define SB_LOAD_M(q, n) do { const unsigned char* r2 = rec_ptr(base, chain_chunk(b, dir, (n)), h, dir); const float* r2f = (const float*)(r2 + REC_VEC); d[q] = *(const v4u*)(r2 + elem * 2); sB[q] = r2f[64]; sM[q] = r2f[65]; dn[q] = nthr ? r2f[tl] : 0.f; } while (0)
#define SB_STEP_M(q, n, PF) do { unsigned char* rec = rec_ptr(base, chain_chunk(b, dir, (n)), h, dir); float* rf = (float*)(rec + REC_VEC); \
                float dd[8]; unpack8(d[q], dd); const float B = sB[q], Ml = sM[q], dnn = dn[q]; \
                if (!(probe && PROBE_SKIP == 7)) { *(v4u*)(rec + elem * 2) = pack8f(st, 1.0f); if (nthr) rf[tl] = nst; if (mthr) rf[66] = m; } \
                if (PF) SB_LOAD_M(q, (n) + 8); \
                const float mn = fmaxf(B + m, Ml), dec = __expf(B + m - mn), sc = __expf(Ml - mn); \
                _Pragma("unroll") for (int e = 0; e < 8; ++e) st[e] = st[e] * dec + dd[e] * sc; \
                nst = nst * dec + dnn * sc; m = mn; } while (0)
#pragma unroll
            for (int q = 0; q < 8; ++q) SB_LOAD_M(q, q);
            for (int n0 = 0; n0 < 56; n0 += 8) {
#pragma unroll
                for (int q = 0; q < 8; ++q) SB_STEP_M(q, n0 + q, true);
            }
#pragma unroll
            for (int q = 0; q < 8; ++q) SB_STEP_M(q, 56 + q, q < 4);
#pragma unroll
            for (int q = 0; q < 4; ++q) SB_STEP_M(q, 64 + q, false);
#undef SB_LOAD_M
#undef SB_STEP_M
        } else {
            v4u d[8]; f32x4 dca[8], dcb[8];
#define SB_LOAD_G(q, n) do { const unsigned char* r2 = rec_ptr(base, chain_chunk(b, dir, (n)), h, dir); const float* r2f = (const float*)(r2 + REC_VEC) + (elem & 63); d[q] = *(const v4u*)(r2 + elem * 2); dca[q] = *(const f32x4*)r2f; dcb[q] = *(const f32x4*)(r2f + 4); } while (0)
#define SB_STEP_G(q, n, PF) do { unsigned char* rec = rec_ptr(base, chain_chunk(b, dir, (n)), h, dir); \
                float dd[8]; unpack8(d[q], dd); const f32x4 da = dca[q], db = dcb[q]; \
                if (!(probe && PROBE_SKIP == 7)) *(v4u*)(rec + elem * 2) = pack8f(st, 1.0f); \
                if (PF) SB_LOAD_G(q, (n) + 8); \
                _Pragma("unroll") for (int e = 0; e < 4; ++e) { st[e] = st[e] * da[e] + dd[e]; st[4 + e] = st[4 + e] * db[e] + dd[4 + e]; } } while (0)
#pragma unroll
            for (int q = 0; q < 8; ++q) SB_LOAD_G(q, q);
            for (int n0 = 0; n0 < 56; n0 += 8) {
#pragma unroll
                for (int q = 0; q < 8; ++q) SB_STEP_G(q, n0 + q, true);
            }
#pragma unroll
            for (int q = 0; q < 8; ++q) SB_STEP_G(q, 56 + q, q < 4);
#pragma unroll
            for (int q = 0; q < 4; ++q) SB_STEP_G(q, 64 + q, false);
#undef SB_LOAD_G
#undef SB_STEP_G
        }
    }
}

constexpr int RH_HT = 0, RH_LD = 1028, RH_PART = 16 * RH_LD * 4, RH_PLD = 33;
constexpr int RL_CNT = 131584;
static_assert(RH_PART + 8 * 16 * RH_PLD * 4 <= RL_CNT && RL_CNT + 3 * 32 * 4 + 2 * 512 * 4 <= RING_BYTES, "router LDS map");
DI void phase_norm2_router(const Ctx& C, int l) {
    const int lane = C.lane, w = C.wave;
    const bf16_t* X = (const bf16_t*)(C.ws + WS_X); unsigned char* H8 = (unsigned char*)(C.ws + WS_H);
    const unsigned char* U = (const unsigned char*)(C.ws + WS_U);
    const float* MOD = (const float*)(C.ws + WS_MOD);
    int* TOKE = (int*)(C.ws + WS_TOKE); int* TOKP = (int*)(C.ws + WS_TOKP); float* TOKW = (float*)(C.ws + WS_TOKW);
    LAS float* HT = (LAS float*)(C.lds + RING_OFF + RH_HT); LAS float* PART = (LAS float*)(C.lds + RING_OFF + RH_PART); LAS int* cnt = (LAS int*)(C.lds + RING_OFF + RL_CNT);
    __syncthreads();
    if (C.tid < 32) cnt[C.tid] = 0;
    float Wreg[2][8][4];
    {
        const float* Wr = INP(I_WR) + (size_t)l * DM * NEXP + (size_t)(128 * w + 4 * (lane >> 4)) * NEXP + (lane & 15);
#pragma unroll
        for (int tl = 0; tl < 2; ++tl)
#pragma unroll
            for (int j = 0; j < 8; ++j)
#pragma unroll
                for (int m = 0; m < 4; ++m) Wreg[tl][j][m] = Wr[(size_t)(16 * j + m) * NEXP + 16 * tl];
    }
    f32x4 gn[4];
#pragma unroll
    for (int j = 0; j < 4; ++j) gn[j] = *(const f32x4*)(INP(I_GN2) + (size_t)l * DM + (lane + 64 * j) * 4);
    const float brl = INP(I_BR)[l * NEXP + (lane & 31)];
    const int ntiles = (l == DEPTH - 1 ? M_LAT : MROWS) / 16;
    v2u xr[2][4]; unsigned ur[2][4];
    if (C.bx < ntiles) {
#pragma unroll
        for (int q = 0; q < 2; ++q)
#pragma unroll
            for (int j = 0; j < 4; ++j) { const size_t o = (size_t)(C.bx * 16 + 2 * w + q) * DM + (lane + 64 * j) * 4; xr[q][j] = *(const v2u*)(X + o); ur[q][j] = *(const unsigned*)(U + o); }
    }
    int mi_cur = -1; f32x4 g1v[4], s1v[4], s0v[4];
    for (int tile = C.bx; tile < ntiles; tile += C.G) {
        const int r0 = tile * 16 + 2 * w, mi = r0 < M_LAT ? (r0 >> 12) : 8;
        if (mi != mi_cur) { mi_cur = mi;
            const float* sh = MOD + ((size_t)l * 9 + mi) * 6144 + 3 * DM; const float* sc = sh + DM; const float* g1 = sh - DM;
#pragma unroll
            for (int j = 0; j < 4; ++j) { const int c = (lane + 64 * j) * 4; g1v[j] = *(const f32x4*)(g1 + c); s1v[j] = *(const f32x4*)(sc + c) + 1.0f; s0v[j] = *(const f32x4*)(sh + c); } }
        f32x4 h[2][4]; float ss[2] = {0.f, 0.f};
#pragma unroll
        for (int q = 0; q < 2; ++q)
#pragma unroll
            for (int j = 0; j < 4; ++j) { const int c = (lane + 64 * j) * 4; const unsigned uu = ur[q][j]; const v2u xx = xr[q][j]; const f32x4 gg = g1v[j];
                h[q][j] = (f32x4){bf2f(xx.x & 0xffffu), bf2f(xx.x >> 16), bf2f(xx.y & 0xffffu), bf2f(xx.y >> 16)} + gg * unpack4_fp8(uu, 1.0f / FP8_SU);
                ss[q] += (h[q][j][0] * h[q][j][0] + h[q][j][1] * h[q][j][1]) + (h[q][j][2] * h[q][j][2] + h[q][j][3] * h[q][j][3]); }
        if (tile + C.G < ntiles) {
#pragma unroll
            for (int q = 0; q < 2; ++q)
#pragma unroll
                for (int j = 0; j < 4; ++j) { const size_t o = (size_t)((tile + C.G) * 16 + 2 * w + q) * DM + (lane + 64 * j) * 4; xr[q][j] = *(const v2u*)(X + o); ur[q][j] = *(const unsigned*)(U + o); }
        }
#pragma unroll
        for (int q = 0; q < 2; ++q) {
            const float rstd = __builtin_amdgcn_rsqf(wave_sum(ss[q], lane) * (1.0f / DM) + EPS);
#pragma unroll
            for (int j = 0; j < 4; ++j) {
                const int c = (lane + 64 * j) * 4;
                const f32x4 hh = h[q][j] * rstd * gn[j] * s1v[j] + s0v[j];
                *(unsigned*)(H8 + (size_t)(r0 + q) * DM + c) = pk4_fp8(hh[0] * FP8_SH, hh[1] * FP8_SH, hh[2] * FP8_SH, hh[3] * FP8_SH);
                *(LAS f32x4*)(HT + (2 * w + q) * RH_LD + c) = hh;
            }
        }
        __syncthreads();
        {
            f32x4 acc0 = (f32x4){0.f, 0.f, 0.f, 0.f}, acc1 = acc0;
            const LAS float* ap = HT + (lane & 15) * RH_LD + 128 * w + 4 * (lane >> 4);
#pragma unroll
            for (int j = 0; j < 8; ++j) {
                const f32x4 a = *(const LAS f32x4*)(ap + 16 * j);
#pragma unroll
                for (int m = 0; m < 4; ++m) { acc0 = __builtin_amdgcn_mfma_f32_16x16x4f32(a[m], Wreg[0][j][m], acc0, 0, 0, 0); acc1 = __builtin_amdgcn_mfma_f32_16x16x4f32(a[m], Wreg[1][j][m], acc1, 0, 0, 0); }
            }
            LAS float* pp = PART + (w * 16 + 4 * (lane >> 4)) * RH_PLD + (lane & 15);
#pragma unroll
            for (int i = 0; i < 4; ++i) { pp[i * RH_PLD] = acc0[i]; pp[i * RH_PLD + 16] = acc1[i]; }
        }
        __syncthreads();
        {
            const int rowl = 2 * w + (lane >> 5), mye = lane & 31, myrow = tile * 16 + rowl;
            float my = brl;
#pragma unroll
            for (int ww = 0; ww < 8; ++ww) my += PART[(ww * 16 + rowl) * RH_PLD + mye];
            float tv[4]; int ti[4];
            {
                const bool hi2 = lane >= 32; int rank = 0;
#pragma unroll
                for (int j = 0; j < 32; ++j) {
                    const float oa = __int_as_float(__builtin_amdgcn_readlane(__float_as_int(my), j)), ob = __int_as_float(__builtin_amdgcn_readlane(__float_as_int(my), 32 + j));
                    const float o = hi2 ? ob : oa;
                    rank += (o > my || (o == my && j < mye)) ? 1 : 0;
                }
#pragma unroll
                for (int k = 0; k < 4; ++k) {
                    const unsigned long long bal = __ballot(rank == k);
                    const int ia = __builtin_ctz((unsigned)bal), ib = __builtin_ctz((unsigned)(bal >> 32));
                    const float va = __int_as_float(__builtin_amdgcn_readlane(__float_as_int(my), ia)), vb = __int_as_float(__builtin_amdgcn_readlane(__float_as_int(my), 32 + ib));
                    tv[k] = hi2 ? vb : va; ti[k] = hi2 ? ib : ia;
                }
            }
            const float e1 = __expf(tv[1] - tv[0]), e2 = __expf(tv[2] - tv[0]), e3 = __expf(tv[3] - tv[0]);
            const float inv = __builtin_amdgcn_rcpf(((1.0f + e1) + e2) + e3);
            if (mye < 4) {
                const int ek = mye == 0 ? ti[0] : mye == 1 ? ti[1] : mye == 2 ? ti[2] : ti[3];
                const float wk = (mye == 0 ? 1.0f : mye == 1 ? e1 : mye == 2 ? e2 : e3) * inv;
                const int pos = atomicAdd((int*)(cnt + ek), 1);
                const size_t o = (size_t)myrow * 4 + mye;
                TOKE[o] = ek; TOKP[o] = pos; TOKW[o] = wk;
            }
        }
    }
    __syncthreads();
    if (C.tid < 32) ((int*)(C.ws + WS_BLKCNT))[C.bx * 32 + C.tid] = cnt[C.tid];
}

DI void phase_gather(const Ctx& C, int l) {
    const int lane = C.lane;
    const unsigned char* H8 = (const unsigned char*)(C.ws + WS_H); unsigned char* XG = (unsigned char*)(C.ws + WS_XG);
    const int* TOKE = (const int*)(C.ws + WS_TOKE); int* TOKP = (int*)(C.ws + WS_TOKP); const float* TOKW = (const float*)(C.ws + WS_TOKW);
    float* SLOTW = (float*)(C.ws + WS_SLOTW); int* META = (int*)(C.ws + WS_MOEMETA);
    const int* BLKCNT = (const int*)(C.ws + WS_BLKCNT);
    LAS int* base = (LAS int*)(C.lds + RING_OFF + RL_CNT + 128); LAS int* tot = (LAS int*)(C.lds + RING_OFF + RL_CNT + 256);
    __syncthreads();
    {
        LAS int* pt = (LAS int*)(C.lds + RING_OFF + RL_CNT + 384); LAS int* pp = pt + 512;
        const int e = C.tid & 31, cq = C.tid >> 5;
        int t = 0, pre = 0;
#pragma unroll 16
        for (int b = cq; b < C.G; b += 16) { const int c = BLKCNT[b * 32 + e]; pre += (b < C.bx) ? c : 0; t += c; }
        pt[cq * 32 + e] = t; pp[cq * 32 + e] = pre;
        __syncthreads();
        if (C.tid < 32) { int ts = 0, ps = 0;
#pragma unroll
            for (int q = 0; q < 16; ++q) { ts += pt[q * 32 + C.tid]; ps += pp[q * 32 + C.tid]; }
            tot[C.tid] = ts; base[C.tid] = ps; }
    }
    __syncthreads();
    LAS int* toff = (LAS int*)(C.lds + RING_OFF + RL_CNT + 384);
    if (C.tid == 0) {
        int off = 0;
#pragma unroll 1
        for (int e = 0; e < NEXP; ++e) { const int padded = (tot[e] + 255) & ~255; base[e] += off; toff[e] = off >> 8; off += padded; }
        toff[NEXP] = off >> 8;
        if (C.bx == 0) META[0] = off >> 8;
    }
    __syncthreads();
    if (C.bx == 0) {
        const int nt = toff[NEXP];
        for (int t = C.tid; t < nt; t += 512) { int e = 0;
#pragma unroll
            for (int q = 1; q < NEXP; ++q) e += (t >= toff[q]) ? 1 : 0;
            META[16 + t] = e; }
    }
    const int ntiles = (l == DEPTH - 1 ? M_LAT : MROWS) / 16;
    int4 e4[2], p4[2]; f32x4 w4[2]; v4u a[2];
    if (C.bx < ntiles) {
#pragma unroll
        for (int q = 0; q < 2; ++q) { const int r = C.bx * 16 + 2 * C.wave + q;
            e4[q] = *(const int4*)(TOKE + (size_t)r * 4); p4[q] = *(const int4*)(TOKP + (size_t)r * 4); w4[q] = *(const f32x4*)(TOKW + (size_t)r * 4); a[q] = *(const v4u*)(H8 + (size_t)r * DM + lane * 16); }
    }
    for (int tile = C.bx; tile < ntiles; tile += C.G) {
        int4 ce[2], cp[2]; f32x4 cw[2]; v4u ca[2];
#pragma unroll
        for (int q = 0; q < 2; ++q) { ce[q] = e4[q]; cp[q] = p4[q]; cw[q] = w4[q]; ca[q] = a[q]; }
        if (tile + C.G < ntiles) {
#pragma unroll
            for (int q = 0; q < 2; ++q) { const int r = (tile + C.G) * 16 + 2 * C.wave + q;
                e4[q] = *(const int4*)(TOKE + (size_t)r * 4); p4[q] = *(const int4*)(TOKP + (size_t)r * 4); w4[q] = *(const f32x4*)(TOKW + (size_t)r * 4); a[q] = *(const v4u*)(H8 + (size_t)r * DM + lane * 16); }
        }
#pragma unroll
        for (int q = 0; q < 2; ++q) {
            const int r = tile * 16 + 2 * C.wave + q;
            const int s0 = base[ce[q].x] + cp[q].x, s1 = base[ce[q].y] + cp[q].y, s2 = base[ce[q].z] + cp[q].z, s3 = base[ce[q].w] + cp[q].w;
            *(v4u*)(XG + (size_t)s0 * DM + lane * 16) = ca[q]; *(v4u*)(XG + (size_t)s1 * DM + lane * 16) = ca[q]; *(v4u*)(XG + (size_t)s2 * DM + lane * 16) = ca[q]; *(v4u*)(XG + (size_t)s3 * DM + lane * 16) = ca[q];
            if (lane == 0) { *(int4*)(TOKP + (size_t)r * 4) = make_int4(s0, s1, s2, s3); SLOTW[s0] = cw[q][0]; SLOTW[s1] = cw[q][1]; SLOTW[s2] = cw[q][2]; SLOTW[s3] = cw[q][3]; }
        }
    }
}

DI void phase_attention(const Ctx& C, char* lds_generic, bool with_ctx) {
    typedef attn_body::bf16 abf;
    const abf* QR = (const abf*)(C.ws + WS_QR); const abf* KR = (const abf*)(C.ws + WS_KR); const abf* VR = (const abf*)(C.ws + WS_VR); abf* YB = (abf*)(C.ws + WS_YA) + 512;
    const int vcu = (C.G % 8 == 0) ? (C.bx % 8) * (C.G / 8) + C.bx / 8 : C.bx;
    const int per = (1024 + C.G - 1) / C.G;
    for (int i = 0; i < per; ++i) {
        const int idx = vcu * per + i; if (idx >= 1024) break;
        const int grp = idx >> 6, b = grp >> 1, kvh = grp & 1, hq = kvh * 4 + ((idx >> 4) & 3), qb = idx & 15;
        attn_body::attn_unit<8>((long)b * SEQ + qb * 256, hq, KVLEN / 64, QR, KR + (size_t)b * KVLEN * 128 + kvh * 64, VR + (size_t)b * KVLEN * 128 + kvh * 64, YB, lds_generic, C.wave);
    }
    for (int idx = C.bx; with_ctx && idx < 64; idx += C.G) {
        const int b = idx >> 3, hq = idx & 7;
        attn_body::attn_unit<8>((long)M_LAT + b * CTXL, hq, CTXL / 64, QR, KR + (size_t)b * KVLEN * 128 + (hq >> 2) * 64, VR + (size_t)b * KVLEN * 128 + (hq >> 2) * 64, YB, lds_generic, C.wave);
    }
}

constexpr int CW_CNT_FG = 16384;
struct ListOrder {
    int c, G, mode; bool ctx; unsigned* cnt;
    __device__ __forceinline__ bool next(int i, pg8::Unit& u) const {
        u.e = 0;
        const int npan = ctx ? 136 : 128;
        if (G != 256) { const int g = c + i * G; if (g >= npan * 4) return false; u.pm = g >> 2; u.pn = g & 3; return true; }
        const int x = c & 7, r = c >> 3;
        if (mode == 0 || !ctx) {
            if (i < 2) { u.pm = 64 * i + x * 8 + (r >> 2); u.pn = r & 3; return true; }
            if (mode == 0 && ctx && i == 2 && c < 32) { u.pm = 128 + x; u.pn = r; return true; }
            return false;
        }
        if (i == 0) { u.pm = x * 8 + (r >> 2); u.pn = r & 3; return true; }
        if (c < 32) return false;
        if (i == 1) { const int r1 = (c - 32) >> 3; u.pm = 64 + x * 7 + (r1 >> 2); u.pn = r1 & 3; return true; }
        if (i == 2 && c < 64) { u.pm = 120 + x; u.pn = (c - 32) >> 3; return true; }
        if (i == 2 && c < 96) { u.pm = 128 + x; u.pn = (c - 64) >> 3; return true; }
        return false;
    }
    __device__ __forceinline__ void a_ready(const pg8::Unit& u) const {
        if (mode == 0) return;
        unsigned* p = cnt + u.pm; unsigned sp = 0u;
        while (xb_ld(p) < 32u) { __builtin_amdgcn_s_sleep(2); if (++sp > (1u << 22)) break; }
        asm volatile("s_waitcnt vmcnt(0)" ::: "memory");
    }
    __device__ __forceinline__ void done(const pg8::Unit& u) const {
        if (mode != 0) return;
        asm volatile("s_waitcnt vmcnt(0)" ::: "memory");
        unsigned m_ = ~0u; asm volatile("" : "+s"(m_));
        if (__builtin_amdgcn_mbcnt_hi(m_, __builtin_amdgcn_mbcnt_lo(m_, 0u)) == 0u) (void)xb_add(cnt + u.pm, 1u);
    }
};

constexpr int NPH = 11;
constexpr int N_PHASES = 1 + DEPTH * NPH + 1;
struct KArgs { const float* in[N_IN]; float* out; unsigned char* ws; int ph_lo, ph_hi; };
static_assert(sizeof(KArgs) == N_IN * 8 + 8 + 8 + 8, "no padding bytes in the argument struct");

__global__ void __launch_bounds__(512, 2) mk_fwd(KArgs args) {
    extern __shared__ __attribute__((aligned(16))) unsigned char lds[];
    Ctx C;
    C.lds = (LAS unsigned char*)lds; C.ws = args.ws; C.in = args.in; C.out = args.out;
    C.tid = threadIdx.x; C.lane = C.tid & 63; C.wave = __builtin_amdgcn_readfirstlane(C.tid >> 6); C.G = gridDim.x; C.bx = blockIdx.x;
    for (int u = C.tid; u < (LDS_BYTES - LDSCTL_OFF) / 4; u += 512) ((LAS unsigned*)(C.lds + LDSCTL_OFF))[u] = 0u;
    __syncthreads();
    if ((unsigned)(uintptr_t)C.lds != 0u) __builtin_trap();
    if (C.tid == 0) { LAS unsigned* pw = (LAS unsigned*)(C.lds + MISC_OFF + 64); pw[0] = (unsigned)(uintptr_t)args.ws; pw[1] = (unsigned)((uintptr_t)args.ws >> 32); pw[2] = (unsigned)(uintptr_t)args.out; pw[3] = (unsigned)((uintptr_t)args.out >> 32); }
    __syncthreads();
#if MK_ONE_LAUNCH
    constexpr int lo = 0, hi = N_PHASES;
#else
    const int lo = args.ph_lo, hi = args.ph_hi;
#endif
    gu32* ctl = (gu32*)(C.ws + WS_CTL);
    XcdBarrier bar; bar.bar = (unsigned*)ctl + CW_BAR; bar.x = 0; bar.st = (volatile LAS unsigned*)(C.lds + MISC_OFF) + 8;
    if (hi - lo > 1) bar = xcd_barrier_post((unsigned*)ctl + CW_BAR, (volatile LAS unsigned*)(C.lds + MISC_OFF) + 8);
    bar.x = (unsigned)__builtin_amdgcn_readfirstlane((int)bar.x);
#define IN(k) (lo <= (k) && (k) < hi)
#ifndef PH_MASK
#define PH_MASK 0x1fff
#endif
#define ENAB(k) (((PH_MASK) >> (k)) & 1)
#ifndef DUP_MASK
#define DUP_MASK 0
#endif
#ifndef PROBE_SKIP
#define PROBE_SKIP 0
#endif
#define REPS(k) _Pragma("unroll 1") for (int rep_ = 0; rep_ < 1 + (((DUP_MASK) >> (k)) & 1); ++rep_)
#define SEAM(k) do { if (IN(k) && IN((k) + 1)) { XcdBarrier b2_ = bar; asm volatile("" : "+s"(b2_.x)); xcd_barrier(b2_); if ((DUP_MASK) & 0x2000) xcd_barrier(b2_); } } while (0)
    PG8_LAS unsigned char* glds = (PG8_LAS unsigned char*)(C.lds + RING_OFF);

    if (ENAB(0) && IN(0)) REPS(0) p0_prologue(launder(C));
    SEAM(0);
    for (int l = 0; l < DEPTH; ++l) {
        const int p = 1 + l * NPH;
        if (ENAB(1) && IN(p + 0)) REPS(1) phase_norm1(launder(C), l, rep_ ? 0.0f : 1.0f);
        SEAM(p + 0);
        if (ENAB(2) && IN(p + 1)) REPS(2) {
            const Ctx Cg = launder(C); unsigned char* const ws = Cg.ws;
            pg8::Gemm g{(const bf16_t*)(ws + WS_H), (const bf16_t*)(ws + WS_WTIN + (size_t)l * PW * DM), MROWS, PW, DM / 2, 0};
            pg8::StaticOrder S; S.init(MROWS, PW, C.G, C.bx);
            pg8::EpiStoreBf16 E{(bf16_t*)(ws + WS_P), PW, C_GATE, 1.0f / (FP8_SH * FP8_SW), rep_ ? PROBE_SKIP : 0};
#ifdef STAGGER_US
            { const unsigned long long t0_ = __builtin_amdgcn_s_memrealtime(), dl_ = (unsigned long long)(((C.bx >> 3) & 3) * STAGGER_US * 25);
              while (__builtin_amdgcn_s_memrealtime() - t0_ < dl_) __builtin_amdgcn_s_sleep(8); }
#endif
            pg8::gemm_phase<pg8::EpiStoreBf16, pg8::StaticOrder, true, true, true>(glds, g, S, E, C.wave);
        }
        SEAM(p + 1);
        if (ENAB(3) && IN(p + 2)) REPS(3) {
            if (!(rep_ && ((DUP_MASK) & 0x200000))) phase_attn_prep(launder(C), l);
            if (!(rep_ && ((DUP_MASK) & 0x400000))) mlstm_a_phase(launder(C), l);
            if (!(rep_ && ((DUP_MASK) & 0x800000))) gla_a_phase(launder(C), l);
        }
        SEAM(p + 2);
        if (ENAB(4) && IN(p + 3)) {
            scan_b_units(launder(C));
            if ((DUP_MASK) & 0x10000) { __syncthreads(); scan_b_units(launder(C), true); }
            __syncthreads();
            REPS(4) phase_attention(launder(C), (char*)lds + RING_OFF, l < DEPTH - 1);
        }
        SEAM(p + 3);
        if (ENAB(5) && IN(p + 4)) REPS(5) {
            if (!(rep_ && ((DUP_MASK) & 0x100000))) mlstm_c_phase(launder(C), l);
            if (!(rep_ && ((DUP_MASK) & 0x80000))) gla_c_phase(launder(C), l);
        }
        SEAM(p + 4);
        if (ENAB(6) && IN(p + 5)) {
            const Ctx Cg = launder(C); unsigned char* const ws = Cg.ws;
            const bool wctx = (l != DEPTH - 1);
            const int Meff = wctx ? MROWS : M_LAT;
            unsigned* const cnt = (unsigned*)(ws + WS_CTL) + CW_CNT_FG + l * 256;
            {
                pg8::Gemm g{(const bf16_t*)(ws + WS_YA), (const bf16_t*)(ws + WS_WTBR) + (size_t)l * DM * 1536, Meff, DM, 1536, 0};
                ListOrder S{C.bx, C.G, 0, wctx, cnt};
                pg8::EpiBranch E{(bf16_t*)(ws + WS_MRG), (const unsigned char*)(ws + WS_P) + 2 * C_GATE, PW * 2};
                pg8::gemm_phase<pg8::EpiBranch, ListOrder, true, true>(glds, g, S, E, C.wave);
            }
            {
                pg8::Gemm g{(const bf16_t*)(ws + WS_MRG), (const bf16_t*)(ws + WS_WTOUT) + (size_t)l * DM * DM, Meff, DM, DM, 0};
                ListOrder S{C.bx, C.G, 1, wctx, cnt};
                pg8::EpiResid E{(bf16_t*)(ws + WS_U), 0, FP8_SU};
                pg8::gemm_phase<pg8::EpiResid, ListOrder, true, true>(glds, g, S, E, C.wave);
            }
        }
        SEAM(p + 6);
        if ((DUP_MASK) & 0x20000) {
            const Ctx Cg = launder(C); v4u* q = (v4u*)(Cg.ws + WS_P) + (size_t)C.bx * 131072 + Cg.tid; const v4u val = {1u, 2u, 3u, (unsigned)l};
#pragma unroll 4
            for (int i = 0; i < 256; ++i) q[i * 512] = val;
        }
        if ((DUP_MASK) & 0x40000) {
            const Ctx Cg = launder(C); const v4u* q = (const v4u*)(Cg.ws + WS_P) + (size_t)C.bx * 131072 + Cg.tid; v4u a = {0u, 0u, 0u, 0u};
#pragma unroll 16
            for (int i = 0; i < 256; ++i) { const v4u t = q[i * 512]; a.x ^= t.x; a.y ^= t.y; a.z ^= t.z; a.w ^= t.w; }
            if ((a.x ^ a.y ^ a.z ^ a.w) == 0x12345u) ((unsigned*)(Cg.ws + WS_P))[Cg.tid] = a.x;
        }
        if (ENAB(8) && IN(p + 7)) REPS(8) phase_norm2_router(launder(C), l);
        SEAM(p + 7);
        if (ENAB(9) && IN(p + 8)) REPS(9) phase_gather(launder(C), l);
        SEAM(p + 8);
        if (ENAB(10) && IN(p + 9)) REPS(10) {
            const Ctx Cg = launder(C); unsigned char* const ws = Cg.ws; const int* const META = (const int*)(ws + WS_MOEMETA);
            const int nM = __builtin_amdgcn_readfirstlane(META[0]);
            pg8::Gemm g{(const bf16_t*)(ws + WS_XG), (const bf16_t*)(ws + WS_WTE1 + (size_t)l * NEXP * 2048 * DM), nM * 256, 2048, DM / 2, (size_t)2048 * DM};
            pg8::StaticOrder S; S.init(nM * 256, 2048, C.G, C.bx, META + 16);
            pg8::EpiSwiglu E{(unsigned char*)(ws + WS_A2), INP(I_BE1) + (size_t)l * NEXP * 2048, 1.0f / (FP8_SH * FP8_SW), FP8_SA, rep_ ? PROBE_SKIP : 0};
            pg8::gemm_phase<pg8::EpiSwiglu, pg8::StaticOrder, true, true, true>(glds, g, S, E, C.wave);
        }
        SEAM(p + 9);
        if (ENAB(11) && IN(p + 10)) REPS(11) {
            const Ctx Cg = launder(C); unsigned char* const ws = Cg.ws; const int* const META = (const int*)(ws + WS_MOEMETA);
            const int nM = __builtin_amdgcn_readfirstlane(META[0]);
            pg8::Gemm g{(const bf16_t*)(ws + WS_A2), (const bf16_t*)(ws + WS_WTE2 + (size_t)l * NEXP * DM * DFF), nM * 256, DM, DFF / 2, (size_t)DM * DFF};
            pg8::StaticOrder S; S.init(nM * 256, DM, C.G, C.bx, META + 16);
            pg8::EpiMoeOut E{(bf16_t*)(ws + WS_YS), FP8_SY / (FP8_SA * FP8_SW), rep_ ? PROBE_SKIP : 0};
            pg8::gemm_phase<pg8::EpiMoeOut, pg8::StaticOrder, true, true, true>(glds, g, S, E, C.wave);
        }
        SEAM(p + 10);
    }
    if (ENAB(12) && IN(1 + DEPTH * NPH)) phase_norm1(launder(C), DEPTH, 1.0f);
#undef IN
#undef SEAM
}

extern "C" void kernel_launch(void* const* d_in, const int* in_sizes, int n_in, void* d_out, int out_size, void* d_ws, size_t ws_size, hipStream_t stream) {
    static int grid = 0;
    if (grid == 0) {
        if (n_in != N_IN || out_size != M_LAT * DM || ws_size < WS_END) { fprintf(stderr, "kernel_launch: unexpected shapes: n_in %d out %d ws %zu (need %zu); nothing launched\n", n_in, out_size, ws_size, (size_t)WS_END); grid = -1; return; }
        int dev = 0, cus = 0, per_cu = 0;
        if (hipGetDevice(&dev) != hipSuccess || hipDeviceGetAttribute(&cus, hipDeviceAttributeMultiprocessorCount, dev) != hipSuccess) { grid = -1; return; }
        if (hipFuncSetAttribute((const void*)mk_fwd, hipFuncAttributeMaxDynamicSharedMemorySize, LDS_BYTES) != hipSuccess) { fprintf(stderr, "kernel_launch: hipFuncSetAttribute failed\n"); grid = -1; return; }
        if (hipOccupancyMaxActiveBlocksPerMultiprocessor(&per_cu, (const void*)mk_fwd, 512, LDS_BYTES) != hipSuccess || per_cu < 1) fprintf(stderr, "kernel_launch: note: occupancy query reports %d\n", per_cu);
        (void)hipGetLastError();
        grid = cus;
    }
    if (grid < 0) return;
    (void)in_sizes;
    if (hipMemsetAsync((char*)d_ws + WS_CTL, 0, CTL_ZERO_BYTES, stream) != hipSuccess) return;
    KArgs a{};
    for (int i = 0; i < N_IN; ++i) a.in[i] = (const float*)d_in[i];
    a.out = (float*)d_out; a.ws = (unsigned char*)d_ws;
#if MK_ONE_LAUNCH
    a.ph_lo = 0; a.ph_hi = N_PHASES;
    hipLaunchKernelGGL(mk_fwd, dim3(grid), dim3(512), LDS_BYTES, stream, a);
#else
    for (int p = 0; p < N_PHASES; ++p) { a.ph_lo = p; a.ph_hi = p + 1; hipLaunchKernelGGL(mk_fwd, dim3(grid), dim3(512), LDS_BYTES, stream, a); }
#endif
}
```
